# Optimizing an MI355X kernel written in HIP

```python
import jax
import jax.numpy as jnp
from jax import lax
import numpy as np

D_MODEL = 1024
BATCH = 16
SEQ = 2048
DEPTH = 1

MEM_LEN = 256
GDN_HEADS = 4
GDN_DK = 128
GDN_DV = 128
GDN_CONV = 4
GDN_CHUNK = 64
SB_HEADS = 8
SB_DH = 64
SB_QBLOCK = 128
MEM_HEADS = 4
MEM_DH = 128
N_BRANCHES = 3
N_EXPERTS = 32
TOP_K = 4
D_FF = D_MODEL
SWIGLU_LIMIT = 7.0
SWIGLU_ALPHA = 1.702
MOE_BLOCK = 128
LN_EPS = 1e-5
NORM_EPS = 1e-6
DEEPNORM_ALPHA = (2 * DEPTH) ** 0.25
DEEPNORM_BETA = (8 * DEPTH) ** -0.25

GDN_QK = GDN_HEADS * GDN_DK
GDN_V = GDN_HEADS * GDN_DV
SB_W = SB_HEADS * SB_DH
MEM_W = MEM_HEADS * MEM_DH
GDN_CONV_CH = 2 * GDN_QK + GDN_V
IN_SIZES = (GDN_QK, GDN_QK, GDN_V, GDN_V, GDN_HEADS, GDN_HEADS, SB_W, SB_W, SB_W, MEM_W, N_BRANCHES * D_MODEL)
D_IN = sum(IN_SIZES)

kernel_name = 'hybrid_gdn_stickbreak_memxattn_moe_deepnorm'


def _layer_norm(x, g, b):
    xf = x.astype(jnp.float32)
    mu = jnp.mean(xf, -1, keepdims=True)
    var = jnp.mean(jnp.square(xf - mu), -1, keepdims=True)
    y = (xf - mu) * lax.rsqrt(var + LN_EPS) * g.astype(jnp.float32) + b.astype(jnp.float32)
    return y.astype(x.dtype)


def _l2norm(t):
    return t * lax.rsqrt(jnp.sum(t * t, -1, keepdims=True) + NORM_EPS)


def _heads(t, n):
    b, s, _ = t.shape
    return t.reshape(b, s, n, -1).transpose(0, 2, 1, 3)


def _causal_depthwise_conv(x, w):
    return lax.conv_general_dilated(
        x, w[:, None, :].astype(x.dtype), window_strides=(1,),
        padding=((w.shape[0] - 1, 0),), dimension_numbers=('NWC', 'WIO', 'NWC'),
        feature_group_count=x.shape[-1])


def _gated_delta_rule(q, k, v, g, beta):
    b, h, s, dk = q.shape
    dv = v.shape[-1]
    n = s // GDN_CHUNK
    q = q.reshape(b, h, n, GDN_CHUNK, dk)
    k = k.reshape(b, h, n, GDN_CHUNK, dk)
    v = v.reshape(b, h, n, GDN_CHUNK, dv)
    g = g.reshape(b, h, n, GDN_CHUNK)
    beta = beta.reshape(b, h, n, GDN_CHUNK)
    gc = jnp.cumsum(g, axis=-1)
    idx = jnp.arange(GDN_CHUNK)
    lower_incl = idx[:, None] >= idx[None, :]
    lower_strict = idx[:, None] > idx[None, :]
    diff = gc[..., :, None] - gc[..., None, :]
    decay = jnp.where(lower_incl, jnp.exp(jnp.where(lower_incl, diff, 0.0)), 0.0)
    kk = jnp.einsum('bhncd,bhnjd->bhncj', k, k)
    a_mat = jnp.where(lower_strict, kk * decay * beta[..., None], 0.0)
    rhs = jnp.concatenate([v * beta[..., None], k * (beta * jnp.exp(gc))[..., None]], axis=-1)
    sol = lax.linalg.triangular_solve(a_mat, rhs, left_side=True, lower=True, unit_diagonal=True)
    u, w = sol[..., :dv], sol[..., dv:]
    attn = jnp.einsum('bhncd,bhnjd->bhncj', q, k) * decay
    g_last = gc[..., -1]
    qg = q * jnp.exp(gc)[..., None]
    kd = k * jnp.exp(g_last[..., None] - gc)[..., None]

    def step(state, xs):
        qg_i, kd_i, u_i, w_i, attn_i, gl_i = xs
        v_new = u_i - jnp.einsum('bhck,bhkv->bhcv', w_i, state)
        o_i = jnp.einsum('bhck,bhkv->bhcv', qg_i, state) + jnp.einsum('bhcj,bhjv->bhcv', attn_i, v_new)
        state = state * jnp.exp(gl_i)[..., None, None] + jnp.einsum('bhck,bhcv->bhkv', kd_i, v_new)
        return state, o_i

    xs = tuple(jnp.moveaxis(t, 2, 0) for t in (qg, kd, u, w, attn, g_last))
    state0 = jnp.zeros((b, h, dk, dv), jnp.float32)
    _, o = lax.scan(step, state0, xs)
    return jnp.moveaxis(o, 0, 2).reshape(b, h, s, dv)


def _stick_breaking_attention(q, k, v):
    s_len, dh = q.shape[2], q.shape[3]
    scale = dh ** -0.5
    outs = []
    for blk in range(s_len // SB_QBLOCK):
        q0 = blk * SB_QBLOCK
        q1 = q0 + SB_QBLOCK
        kb, vb = k[:, :, :q1], v[:, :, :q1]
        z = jnp.einsum('bhqd,bhkd->bhqk', q[:, :, q0:q1], kb).astype(jnp.float32) * scale
        query_pos = q0 + jnp.arange(SB_QBLOCK)
        key_pos = jnp.arange(q1)
        causal = key_pos[None, :] < query_pos[:, None]
        log_stay = jnp.where(causal, jax.nn.log_sigmoid(-z), 0.0)
        log_stay_after = lax.cumsum(log_stay, axis=3, reverse=True) - log_stay
        weights = jnp.where(causal, jnp.exp(jax.nn.log_sigmoid(z) + log_stay_after), 0.0)
        outs.append(jnp.einsum('bhqk,bhkd->bhqd', weights.astype(vb.dtype), vb))
    return jnp.concatenate(outs, axis=2)


def _memory_attention(q, k, v):
    scores = jnp.einsum('bhqd,bhmd->bhqm', q, k).astype(jnp.float32) * (q.shape[-1] ** -0.5)
    p = jax.nn.softmax(scores, axis=-1)
    return jnp.einsum('bhqm,bhmd->bhqd', p.astype(v.dtype), v)


def _moe(x, w_router, b_router, w_gate_up, b_gate_up, w_down, b_down):
    b, s, d = x.shape
    t = b * s
    xt = x.reshape(t, d)
    logits = (xt @ w_router).astype(jnp.float32) + b_router.astype(jnp.float32)
    top_val, top_idx = lax.top_k(logits, TOP_K)
    gate = jax.nn.softmax(top_val, axis=-1)
    n_assign = t * TOP_K
    expert_flat = top_idx.reshape(n_assign)
    token_flat = jnp.repeat(jnp.arange(t, dtype=jnp.int32), TOP_K)
    gate_flat = gate.reshape(n_assign)
    order = jnp.argsort(expert_flat)
    e_sorted = expert_flat[order]
    t_sorted = token_flat[order]
    g_sorted = gate_flat[order]
    counts = jnp.bincount(expert_flat, length=N_EXPERTS)
    padded = (counts + MOE_BLOCK - 1) // MOE_BLOCK * MOE_BLOCK
    group_start = jnp.cumsum(counts) - counts
    padded_end = jnp.cumsum(padded)
    padded_start = padded_end - padded
    dst = padded_start[e_sorted] + jnp.arange(n_assign, dtype=jnp.int32) - group_start[e_sorted]
    n_blocks = -(-n_assign // MOE_BLOCK) + N_EXPERTS
    p_len = n_blocks * MOE_BLOCK
    tok_pad = jnp.full((p_len,), t, jnp.int32).at[dst].set(t_sorted)
    gate_pad = jnp.zeros((p_len,), jnp.float32).at[dst].set(g_sorted)
    block_start = jnp.arange(n_blocks, dtype=jnp.int32) * MOE_BLOCK
    block_expert = jnp.minimum(jnp.searchsorted(padded_end, block_start, side='right'), N_EXPERTS - 1)
    x_pad = jnp.concatenate([xt, jnp.zeros((1, d), xt.dtype)], axis=0)[tok_pad].reshape(n_blocks, MOE_BLOCK, d)

    def expert_block(args):
        xb, e = args
        hid = xb @ w_gate_up[e] + b_gate_up[e]
        glu = jnp.minimum(hid[:, :D_FF], SWIGLU_LIMIT)
        lin = jnp.clip(hid[:, D_FF:], -SWIGLU_LIMIT, SWIGLU_LIMIT)
        act = glu * jax.nn.sigmoid(SWIGLU_ALPHA * glu) * (lin + 1.0)
        return act @ w_down[e] + b_down[e]

    y_pad = lax.map(expert_block, (x_pad, block_expert)).reshape(p_len, d)
    y = jnp.zeros((t + 1, d), jnp.float32).at[tok_pad].add(y_pad.astype(jnp.float32) * gate_pad[:, None])[:t]
    return y.astype(x.dtype).reshape(b, s, d)


def setup_inputs(seed: int = 0) -> dict:
    key = jax.random.key(seed)
    ks = jax.random.split(key, 24)
    f32 = jnp.float32
    nrm = lambda k, shape, scale: jax.random.normal(k, shape, f32) * scale
    dt = jnp.exp(jax.random.uniform(ks[5], (DEPTH, GDN_HEADS), f32, np.log(1e-3), np.log(1e-1)))
    return {
        'x': nrm(ks[0], (BATCH, SEQ, D_MODEL), 1.0),
        'mem': nrm(ks[1], (BATCH, MEM_LEN, D_MODEL), 1.0),
        'w_in': nrm(ks[2], (DEPTH, D_MODEL, D_IN), D_MODEL ** -0.5),
        'w_conv': nrm(ks[3], (DEPTH, GDN_CONV, GDN_CONV_CH), GDN_CONV ** -0.5),
        'a_log': jnp.log(jax.random.uniform(ks[4], (DEPTH, GDN_HEADS), f32, 1.0, 16.0)),
        'dt_bias': dt + jnp.log(-jnp.expm1(-dt)),
        'gdn_norm_w': 1.0 + nrm(ks[6], (DEPTH, GDN_DV), 0.01),
        'w_mem_kv': nrm(ks[7], (DEPTH, D_MODEL, 2 * MEM_W), D_MODEL ** -0.5),
        'w_p_gdn': nrm(ks[8], (DEPTH, GDN_V, D_MODEL), GDN_V ** -0.5),
        'w_p_sb': nrm(ks[9], (DEPTH, SB_W, D_MODEL), SB_W ** -0.5),
        'w_p_mem': nrm(ks[10], (DEPTH, MEM_W, D_MODEL), MEM_W ** -0.5),
        'w_o': nrm(ks[11], (DEPTH, D_MODEL, D_MODEL), D_MODEL ** -0.5 * DEEPNORM_BETA),
        'ln1_g': 1.0 + nrm(ks[12], (DEPTH, D_MODEL), 0.01),
        'ln1_b': nrm(ks[13], (DEPTH, D_MODEL), 0.01),
        'w_router': nrm(ks[14], (DEPTH, D_MODEL, N_EXPERTS), D_MODEL ** -0.5),
        'b_router': nrm(ks[15], (DEPTH, N_EXPERTS), 0.01),
        'w_gate_up': nrm(ks[16], (DEPTH, N_EXPERTS, D_MODEL, 2 * D_FF), D_MODEL ** -0.5),
        'b_gate_up': nrm(ks[17], (DEPTH, N_EXPERTS, 2 * D_FF), 0.01),
        'w_down': nrm(ks[18], (DEPTH, N_EXPERTS, D_FF, D_MODEL), D_FF ** -0.5 * DEEPNORM_BETA),
        'b_down': nrm(ks[19], (DEPTH, N_EXPERTS, D_MODEL), 0.01),
        'ln2_g': 1.0 + nrm(ks[20], (DEPTH, D_MODEL), 0.01),
        'ln2_b': nrm(ks[21], (DEPTH, D_MODEL), 0.01),
    }


def reference(x, mem, w_in, w_conv, a_log, dt_bias, gdn_norm_w, w_mem_kv, w_p_gdn, w_p_sb, w_p_mem, w_o,
              ln1_g, ln1_b, w_router, b_router, w_gate_up, b_gate_up, w_down, b_down, ln2_g, ln2_b):
    b, s, d = x.shape
    split_idx = np.cumsum(IN_SIZES)[:-1].tolist()
    for l in range(DEPTH):
        proj = x @ w_in[l]
        gq, gk, gv, gz, ga, gb, sq, sk, sv, mq, gates = jnp.split(proj, split_idx, axis=-1)

        qkv = jax.nn.silu(_causal_depthwise_conv(jnp.concatenate([gq, gk, gv], axis=-1), w_conv[l]))
        cq, ck, cv = jnp.split(qkv, [GDN_QK, 2 * GDN_QK], axis=-1)
        q = _l2norm(_heads(cq, GDN_HEADS).astype(jnp.float32)) * (GDN_DK ** -0.5)
        k = _l2norm(_heads(ck, GDN_HEADS).astype(jnp.float32))
        v = _heads(cv, GDN_HEADS).astype(jnp.float32)
        log_decay = -jnp.exp(a_log[l]) * jax.nn.softplus(ga.astype(jnp.float32) + dt_bias[l])
        beta = jax.nn.sigmoid(gb.astype(jnp.float32))
        o = _gated_delta_rule(q, k, v, log_decay.transpose(0, 2, 1), beta.transpose(0, 2, 1))
        o = o * lax.rsqrt(jnp.mean(o * o, -1, keepdims=True) + NORM_EPS) * gdn_norm_w[l].astype(jnp.float32)
        z = gz.reshape(b, s, GDN_HEADS, GDN_DV).astype(jnp.float32)
        y_gdn = (o.transpose(0, 2, 1, 3) * jax.nn.silu(z)).reshape(b, s, GDN_V).astype(x.dtype)

        y_sb = _stick_breaking_attention(_heads(sq, SB_HEADS), _heads(sk, SB_HEADS), _heads(sv, SB_HEADS))
        y_sb = y_sb.transpose(0, 2, 1, 3).reshape(b, s, SB_W)

        mk, mv = jnp.split(mem @ w_mem_kv[l], 2, axis=-1)
        y_mem = _memory_attention(_heads(mq, MEM_HEADS), _heads(mk, MEM_HEADS), _heads(mv, MEM_HEADS))
        y_mem = y_mem.transpose(0, 2, 1, 3).reshape(b, s, MEM_W)

        g = jax.nn.sigmoid(gates.reshape(b, s, N_BRANCHES, d))
        mixed = (g[:, :, 0] * (y_gdn @ w_p_gdn[l]) + g[:, :, 1] * (y_sb @ w_p_sb[l])
                 + g[:, :, 2] * (y_mem @ w_p_mem[l]))
        x = _layer_norm(DEEPNORM_ALPHA * x + mixed @ w_o[l], ln1_g[l], ln1_b[l])

        y_moe = _moe(x, w_router[l], b_router[l], w_gate_up[l], b_gate_up[l], w_down[l], b_down[l])
        x = _layer_norm(DEEPNORM_ALPHA * x + y_moe, ln2_g[l], ln2_b[l])
    return x
```

```cpp
#define NAIVE_P1 0
#define NAIVE_GDN 1
#define NAIVE_ATTN 1
#define NAIVE_P5 0
#define NAIVE_P6 0
#define NAIVE_MOE 0
#define MK_SPLIT 0
#define NAIVE_ANY (NAIVE_P1 || NAIVE_P6)
#include <hip/hip_runtime.h>
#include <hip/hip_cooperative_groups.h>
#include <cstdio>
#include <cstdint>
namespace cg = cooperative_groups;

#define DI __device__ __forceinline__
#define LAS __attribute__((address_space(3)))
typedef unsigned short bf16_t;
typedef short bf16x8 __attribute__((ext_vector_type(8)));
typedef float f32x2 __attribute__((ext_vector_type(2)));
typedef float f32x4 __attribute__((ext_vector_type(4)));
typedef float f32x16 __attribute__((ext_vector_type(16)));
typedef unsigned u32x2 __attribute__((ext_vector_type(2)));
typedef unsigned u32x4 __attribute__((ext_vector_type(4)));
typedef __bf16 bf16x2_t __attribute__((ext_vector_type(2)));

constexpr int NB = 16, SEQ = 2048, DM = 1024, TT = NB * SEQ;
constexpr int MEMLEN = 256, NEXP = 32, TOPK = 4, DFF = 1024;
constexpr int NPROJ = 7168;
constexpr int C_GQ = 0, C_GK = 512, C_GV = 1024, C_GZ = 1536, C_SQ = 2048, C_SK = 2560, C_SV = 3072, C_MQ = 3584, C_GATE = 4096;
constexpr float LN_EPS = 1e-5f, NORM_EPS = 1e-6f;
constexpr float DN_ALPHA = 1.189207115002721f;
constexpr float SWIGLU_LIMIT = 7.0f, SWIGLU_ALPHA = 1.702f;
constexpr int ECAP = 32768;

constexpr size_t MiB = 1u << 20;
constexpr size_t WS_MISC = 0;
constexpr size_t WS_WDN = 3 * MiB, WS_WGU = 67 * MiB, WS_WIN = 195 * MiB, WS_WMKV = 209 * MiB, WS_WP = 211 * MiB, WS_WO = 214 * MiB;
constexpr size_t WS_XB = 216 * MiB, WS_MEMB = 280 * MiB, WS_MKV = 288 * MiB, WS_PROJ = 296 * MiB, WS_GDN = 744 * MiB, WS_YCAT = 888 * MiB, WS_RINFO = 1016 * MiB;
constexpr size_t WS_MIXED = WS_XB, WS_H = WS_GDN, WS_X1 = WS_YCAT, WS_X1B = WS_PROJ, WS_ACT = 360 * MiB, WS_YPAIR = 67 * MiB;
constexpr size_t WS_NEED = 1024 * MiB;
constexpr size_t GDN_CHUNK_BYTES = 73728;
constexpr int LDS_BYTES = 147456;

struct Params { const float* in[22]; float* out; unsigned char* ws; int ph_lo, ph_hi; };
enum { I_X = 0, I_MEM, I_WIN, I_WCONV, I_ALOG, I_DTB, I_GNW, I_WMKV, I_WPG, I_WPS, I_WPM, I_WO, I_LN1G, I_LN1B, I_WR, I_BR, I_WGU, I_BGU, I_WDN, I_BDN, I_LN2G, I_LN2B };

DI float bf2f(bf16_t v) { return __uint_as_float((unsigned)v << 16); }
DI unsigned pk_bf16(float a, float b) { f32x2 v = {a, b}; bf16x2_t r = __builtin_convertvector(v, bf16x2_t); return __builtin_bit_cast(unsigned, r); }
DI bf16_t f2bf(float a) { return (bf16_t)(pk_bf16(a, 0.f) & 0xffffu); }
DI float bflo(unsigned w) { return __uint_as_float(w << 16); }
DI float bfhi(unsigned w) { return __uint_as_float(w & 0xffff0000u); }
DI float sigmoidf_(float x) { return 1.0f / (1.0f + __expf(-x)); }
DI float softplusf_(float x) { return x > 20.f ? x : log1pf(__expf(x)); }
DI float wave_sum(float v) {
#pragma unroll
  for (int o = 1; o < 64; o <<= 1) v += __shfl_xor(v, o);
  return v;
}
DI float wave_max(float v) {
#pragma unroll
  for (int o = 1; o < 64; o <<= 1) v = fmaxf(v, __shfl_xor(v, o));
  return v;
}
#define LDS_WAIT() asm volatile("s_waitcnt lgkmcnt(0)" ::: "memory")
#define VM_WAIT() asm volatile("s_waitcnt vmcnt(0)" ::: "memory")
#define MFMA32(a, b, c) __builtin_amdgcn_mfma_f32_32x32x16_bf16((a), (b), (c), 0, 0, 0)
DI int crow(int reg, int h) { return (reg & 3) + 8 * (reg >> 2) + 4 * h; }
DI int swap23(int k) { return (k & ~12) | ((k & 4) << 1) | ((k & 8) >> 1); }

struct Ctx {
  LAS unsigned char* lds;
  int tid, lane, wave, G, bid, gw, ngw;
  Params p;
};
namespace pg8 {
constexpr int BM = 256, BK = 64, HALF = 128, HTB = HALF * BK * 2  , STAGE_BYTES = 8 * HTB, NXCD = 8, WGM = 8;
DI int lds_byte(int r, int c) { const int st = (r >> 4) * 2 + (c >> 5), rr = r & 15, cc = c & 31, ob = rr * 64 + cc * 2; return st * 1024 + (ob ^ (((ob >> 9) & 1) << 5)); }
DI void stage_rc(int b, int& R, int& C) { const int st = b / 1024, sb = b % 1024, swz = sb ^ (((sb >> 9) & 1) << 5); R = (st >> 1) * 16 + swz / 64; C = (st & 1) * 32 + (swz % 64) / 2; }
DI int perm32(int rho) { const int n = rho >> 4, i = rho & 15; return 8 * (i >> 2) + 4 * n + (i & 3); }

struct Unit { int pm, pn; };
struct Gemm { const bf16_t* A; const bf16_t* Bt; int K; };

struct StaticOrder {
  int nM, nN, nwg, G, c;
  DI void init(int M, int N, int G_, int c_) { nM = M / BM; nN = N / BM; nwg = nM * nN; G = G_; c = c_; }
  DI bool next(int i, Unit& u) const {
    const long L = (long)i * G + c; if (L >= nwg) return false;
    int wgid = (int)L; { const int q = nwg / NXCD, r = nwg % NXCD, xcd = wgid % NXCD, off = wgid / NXCD; wgid = (xcd < r ? xcd * (q + 1) : r * (q + 1) + (xcd - r) * q) + off; }
    const int nig = WGM * nN, gid = wgid / nig, fm = gid * WGM, gsz = (nM - fm) < WGM ? (nM - fm) : WGM;
    u.pm = fm + ((wgid % nig) % gsz); u.pn = (wgid % nig) / gsz; return true;
  }
  DI int arow(const Unit& u, int r) const { return u.pm * BM + r; }
};
struct GroupOrder {
  const LAS int* tab; const u32x2* rinfo; int ntn, G, c, gather;
  DI bool next(int i, Unit& u) const {
    const int L = i * G + c, NT = tab[65]; if (L >= NT * ntn) return false;
    const int tile = L / ntn, pnl = L - tile * ntn; u.pm = tile; u.pn = tab[96 + tile] * ntn + pnl; return true;
  }
  DI int arow(const Unit& u, int r) const {
    if (!gather) return u.pm * BM + r;
    const int e = tab[96 + u.pm], local = u.pm * BM + r - tab[32 + e];
    return local < tab[e] ? (int)(rinfo[(size_t)e * ECAP + local].x >> 2) : 0;
  }
};

template <class Epi, class Sched, bool ALIGN_EPI>
DI void gemm_phase(LAS unsigned char* lds, const Gemm g, const Sched& S, const Epi& E) {
  const int tid = threadIdx.x, wid = __builtin_amdgcn_readfirstlane(tid >> 6), lane = tid & 63, wr = wid >> 2, wc = wid & 3, fr = lane & 15, fq = lane >> 4;
  const int K = g.K, nt = K / BK;
  int RA[2], CA[2]; unsigned voffB[2];
#pragma unroll
  for (int i = 0; i < 2; ++i) { int R, C; stage_rc(tid * 16 + i * 8192, R, C); const int Rb = Epi::PERM ? ((R & ~31) + perm32(R & 31)) : R; RA[i] = R; CA[i] = C; voffB[i] = (unsigned)(Rb * K + C) * 2u; }
  const size_t kstep = (size_t)(BK * 2);
  const size_t hstep = (size_t)HALF * K * 2;
  const size_t tstep = 2 * hstep;
  const unsigned ldsw = (unsigned)wid * 1024u;
  const int aoff = lds_byte(wr * 64 + fr, fq * 8), boff = lds_byte(wc * 32 + fr, fq * 8);
  const char* Ab = (const char*)g.A;
#define PG8_SA(b, h) (((b) * 2 + (h)) * HTB)
#define PG8_SB(b, h) ((4 + (b) * 2 + (h)) * HTB)
#define PG8_STAGE(bufoff, gbase, voff) do { _Pragma("unroll") for (int _i = 0; _i < 2; ++_i) \
    __builtin_amdgcn_global_load_lds((const unsigned*)((const char*)(gbase) + (voff)[_i]), (LAS unsigned*)(lds + (bufoff) + ldsw + _i * 8192), 16, 0, 0); } while (0)
#define PG8_LDA(dst, b, h) do { _Pragma("unroll") for (int m = 0; m < 4; ++m) _Pragma("unroll") for (int k = 0; k < 2; ++k) dst[m][k] = *(const LAS bf16x8*)(lds + PG8_SA(b, h) + aoff + m * 2048 + k * 1024); } while (0)
#define PG8_LDB(dst, b, h) do { _Pragma("unroll") for (int n = 0; n < 2; ++n) _Pragma("unroll") for (int k = 0; k < 2; ++k) dst[n][k] = *(const LAS bf16x8*)(lds + PG8_SB(b, h) + boff + n * 2048 + k * 1024); } while (0)
#define PG8_MMA(ai, bj, At, Bt) do { __builtin_amdgcn_s_setprio(1); _Pragma("unroll") for (int m = 0; m < 4; ++m) _Pragma("unroll") for (int n = 0; n < 2; ++n) _Pragma("unroll") for (int k = 0; k < 2; ++k) \
    acc[ai][bj][m][n] = __builtin_amdgcn_mfma_f32_16x16x32_bf16(Bt[n][k], At[m][k], acc[ai][bj][m][n], 0, 0, 0); __builtin_amdgcn_s_setprio(0); } while (0)
#define PG8_WAIT_V(n) asm volatile("s_waitcnt vmcnt(" #n ")" ::: "memory")
#define PG8_WAIT_L(n) asm volatile("s_waitcnt lgkmcnt(" #n ")" ::: "memory")
#define PG8_BAR __builtin_amdgcn_s_barrier()
#define PG8_SCHED __builtin_amdgcn_sched_barrier(0)
  Unit cur, nxt; int ui = 0;
  if (!S.next(0, cur)) return;
  f32x4 acc[2][2][4][2];
#pragma unroll
  for (int a = 0; a < 2; ++a)
#pragma unroll
    for (int b = 0; b < 2; ++b)
#pragma unroll
      for (int m = 0; m < 4; ++m)
#pragma unroll
        for (int n = 0; n < 2; ++n) acc[a][b][m][n] = (f32x4){0.f, 0.f, 0.f, 0.f};
  bf16x8 At[4][2], B0[2][2], B1[2][2];
  unsigned cvo0[2], cvo1[2], nvo0[2], nvo1[2];
#pragma unroll
  for (int i = 0; i < 2; ++i) { cvo0[i] = ((unsigned)S.arow(cur, RA[i]) * (unsigned)K + (unsigned)CA[i]) * 2u; cvo1[i] = ((unsigned)S.arow(cur, HALF + RA[i]) * (unsigned)K + (unsigned)CA[i]) * 2u; }
  const char* cB = (const char*)g.Bt + (size_t)cur.pn * tstep;
  PG8_STAGE(PG8_SB(0, 0), cB, voffB); PG8_STAGE(PG8_SB(0, 1), cB + hstep, voffB); PG8_STAGE(PG8_SA(0, 0), Ab, cvo0); PG8_STAGE(PG8_SA(0, 1), Ab, cvo1);
  if (wr == 1) PG8_BAR;
  PG8_WAIT_V(2); PG8_BAR;
  PG8_STAGE(PG8_SB(1, 0), cB + kstep, voffB); PG8_STAGE(PG8_SA(1, 0), Ab + kstep, cvo0); PG8_STAGE(PG8_SB(1, 1), cB + hstep + kstep, voffB);
  PG8_WAIT_V(6); PG8_BAR;
  for (;;) {
    const bool has_next = S.next(ui + 1, nxt);
    if (!has_next) nxt = cur;
#pragma unroll
    for (int i = 0; i < 2; ++i) { nvo0[i] = ((unsigned)S.arow(nxt, RA[i]) * (unsigned)K + (unsigned)CA[i]) * 2u; nvo1[i] = ((unsigned)S.arow(nxt, HALF + RA[i]) * (unsigned)K + (unsigned)CA[i]) * 2u; }
    const char* nB = (const char*)g.Bt + (size_t)nxt.pn * tstep;
    for (int t = 0; t < nt; t += 2) {
      const bool last = (t == nt - 2);
      if constexpr (Epi::MIDHOOK) { if (t == 8 || t == 16) E.mid(acc, cur, (t >> 3) - 1, wr, wc, fr, fq); }
      const char* a1 = Ab + (size_t)(t + 1) * kstep;
      const char* a2 = last ? Ab : Ab + (size_t)(t + 2) * kstep; const char* b2 = last ? nB : cB + (size_t)(t + 2) * kstep;
      const char* a3 = a2 + kstep; const char* b3 = b2 + kstep;
      unsigned vo0[2], vo1[2];
#pragma unroll
      for (int i = 0; i < 2; ++i) { vo0[i] = last ? nvo0[i] : cvo0[i]; vo1[i] = last ? nvo1[i] : cvo1[i]; }
      PG8_LDB(B0, 0, 0); PG8_LDB(B1, 0, 1); PG8_SCHED; PG8_LDA(At, 0, 0); PG8_STAGE(PG8_SA(1, 1), a1, cvo1);
      PG8_WAIT_V(8); PG8_WAIT_L(0); PG8_BAR; PG8_MMA(0, 0, At, B0); PG8_MMA(0, 1, At, B1); PG8_BAR; PG8_SCHED;
      PG8_LDA(At, 0, 1); PG8_STAGE(PG8_SB(0, 0), b2, voffB); PG8_STAGE(PG8_SB(0, 1), b2 + hstep, voffB); PG8_STAGE(PG8_SA(0, 0), a2, vo0);
      PG8_WAIT_V(8); PG8_WAIT_L(0); PG8_BAR; PG8_MMA(1, 0, At, B0); PG8_MMA(1, 1, At, B1); PG8_BAR; PG8_SCHED;
      PG8_LDB(B0, 1, 0); PG8_LDB(B1, 1, 1); PG8_SCHED; PG8_LDA(At, 1, 0); PG8_STAGE(PG8_SA(0, 1), a2, vo1);
      PG8_WAIT_V(8); PG8_WAIT_L(0); PG8_BAR; PG8_MMA(0, 0, At, B0); PG8_MMA(0, 1, At, B1); PG8_BAR; PG8_SCHED;
      PG8_LDA(At, 1, 1); PG8_STAGE(PG8_SB(1, 0), b3, voffB); PG8_STAGE(PG8_SB(1, 1), b3 + hstep, voffB); PG8_STAGE(PG8_SA(1, 0), a3, vo0);
      PG8_WAIT_V(8); PG8_WAIT_L(0); PG8_BAR; PG8_MMA(1, 0, At, B0); PG8_MMA(1, 1, At, B1); PG8_BAR; PG8_SCHED;
    }
    if constexpr (ALIGN_EPI) { if (wr == 0) PG8_BAR; }
    E(acc, cur, wr, wc, fr, fq);
    if (!has_next) break;
#pragma unroll
    for (int a = 0; a < 2; ++a)
#pragma unroll
      for (int b = 0; b < 2; ++b)
#pragma unroll
        for (int m = 0; m < 4; ++m)
#pragma unroll
          for (int n = 0; n < 2; ++n) acc[a][b][m][n] = (f32x4){0.f, 0.f, 0.f, 0.f};
    cur = nxt; cB = nB; ++ui;
#pragma unroll
    for (int i = 0; i < 2; ++i) { cvo0[i] = nvo0[i]; cvo1[i] = nvo1[i]; }
    if constexpr (ALIGN_EPI) { if (wr == 1) PG8_BAR; }
  }
  PG8_WAIT_V(0);
  if constexpr (!ALIGN_EPI) { if (wr == 0) PG8_BAR; }
  PG8_BAR;
#undef PG8_SA
#undef PG8_SB
#undef PG8_STAGE
#undef PG8_LDA
#undef PG8_LDB
#undef PG8_MMA
#undef PG8_WAIT_V
#undef PG8_WAIT_L
#undef PG8_BAR
#undef PG8_SCHED
}

struct EpiStoreBf16 {
  static constexpr bool PERM = true, MIDHOOK = false;
  bf16_t* O; int ldc;
  DI void operator()(const f32x4 (&acc)[2][2][4][2], const Unit& u, int wr, int wc, int fr, int fq) const {
    const int row0 = u.pm * BM + wr * 64 + fr, col0 = u.pn * BM + wc * 32 + 8 * fq;
#pragma unroll
    for (int ai = 0; ai < 2; ++ai)
#pragma unroll
      for (int m = 0; m < 4; ++m) { bf16_t* rowp = O + (size_t)(row0 + ai * HALF + m * 16) * ldc + col0;
#pragma unroll
        for (int bj = 0; bj < 2; ++bj) { const f32x4 v0 = acc[ai][bj][m][0], v1 = acc[ai][bj][m][1];
          u32x4 w; w.x = pk_bf16(v0[0], v0[1]); w.y = pk_bf16(v0[2], v0[3]); w.z = pk_bf16(v1[0], v1[1]); w.w = pk_bf16(v1[2], v1[3]);
          *(u32x4*)(rowp + bj * HALF) = w; } }
  }
};
struct EpiMixed {
  static constexpr bool PERM = true, MIDHOOK = true;
  const bf16_t* proj; bf16_t* O;
  DI static float e_neg(float a) { return __expf(-fminf(fmaxf(a, -40.f), 40.f)); }
  DI void mid(f32x4 (&acc)[2][2][4][2], const Unit& u, int b, int wr, int wc, int fr, int fq) const {
    int row0 = u.pm * BM + wr * 64 + fr; const int col0 = u.pn * BM + wc * 32 + 8 * fq;
    asm volatile("" : "+v"(row0));
#pragma unroll
    for (int ai = 0; ai < 2; ++ai)
#pragma unroll
      for (int m = 0; m < 4; ++m) { const bf16_t* gp = proj + (size_t)(row0 + ai * HALF + m * 16) * NPROJ + C_GATE + b * DM + col0;
#pragma unroll
        for (int bj = 0; bj < 2; ++bj) { const u32x4 ga = *(const u32x4*)(gp + bj * HALF), gb = *(const u32x4*)(gp + DM + bj * HALF);
#pragma unroll
          for (int q = 0; q < 4; ++q) {
            const float r0 = (1.f + e_neg(bflo(gb[q]))) * __frcp_rn(1.f + e_neg(bflo(ga[q])));
            const float r1 = (1.f + e_neg(bfhi(gb[q]))) * __frcp_rn(1.f + e_neg(bfhi(ga[q])));
            acc[ai][bj][m][q >> 1][(q & 1) * 2] *= r0; acc[ai][bj][m][q >> 1][(q & 1) * 2 + 1] *= r1; }
          asm volatile("" ::: "memory"); } }
  }
  DI void operator()(const f32x4 (&acc)[2][2][4][2], const Unit& u, int wr, int wc, int fr, int fq) const {
    const int row0 = u.pm * BM + wr * 64 + fr, col0 = u.pn * BM + wc * 32 + 8 * fq;
#pragma unroll
    for (int ai = 0; ai < 2; ++ai)
#pragma unroll
      for (int m = 0; m < 4; ++m) { const int row = row0 + ai * HALF + m * 16; const bf16_t* gp = proj + (size_t)row * NPROJ + C_GATE + 2 * DM + col0;
#pragma unroll
        for (int bj = 0; bj < 2; ++bj) { const u32x4 ga = *(const u32x4*)(gp + bj * HALF); float o[8];
#pragma unroll
          for (int q = 0; q < 4; ++q) {
            o[2 * q] = acc[ai][bj][m][q >> 1][(q & 1) * 2] * __frcp_rn(1.f + e_neg(bflo(ga[q])));
            o[2 * q + 1] = acc[ai][bj][m][q >> 1][(q & 1) * 2 + 1] * __frcp_rn(1.f + e_neg(bfhi(ga[q]))); }
          u32x4 w; w.x = pk_bf16(o[0], o[1]); w.y = pk_bf16(o[2], o[3]); w.z = pk_bf16(o[4], o[5]); w.w = pk_bf16(o[6], o[7]);
          *(u32x4*)(O + (size_t)row * DM + col0 + bj * HALF) = w; asm volatile("" ::: "memory"); } }
  }
};
struct EpiH {
  static constexpr bool PERM = false, MIDHOOK = false;
  const float* x; float* h;
  DI void operator()(const f32x4 (&acc)[2][2][4][2], const Unit& u, int wr, int wc, int fr, int fq) const {
    const int row0 = u.pm * BM + wr * 64 + fr, col0 = u.pn * BM + wc * 32 + 4 * fq;
#pragma unroll
    for (int ai = 0; ai < 2; ++ai)
#pragma unroll
      for (int m = 0; m < 4; ++m) { const size_t off = (size_t)(row0 + ai * HALF + m * 16) * DM + col0;
#pragma unroll
        for (int bj = 0; bj < 2; ++bj)
#pragma unroll
          for (int n = 0; n < 2; ++n) { const f32x4 xv = *(const f32x4*)(x + off + bj * HALF + n * 16); *(f32x4*)(h + off + bj * HALF + n * 16) = xv * DN_ALPHA + acc[ai][bj][m][n]; }
        asm volatile("" ::: "memory"); }
  }
};
struct EpiGateUp {
  static constexpr bool PERM = true, MIDHOOK = false;
  const float* bgu; bf16_t* act;
  DI void operator()(const f32x4 (&acc)[2][2][4][2], const Unit& u, int wr, int wc, int fr, int fq) const {
    const int e = u.pn >> 3, pnl = u.pn & 7, row0 = u.pm * BM + wr * 64 + fr, j0 = pnl * 128 + wc * 32 + 8 * fq;
    f32x4 bg[2], bl[2];
#pragma unroll
    for (int n = 0; n < 2; ++n) { bg[n] = *(const f32x4*)(bgu + (size_t)e * 2048 + j0 + 4 * n); bl[n] = *(const f32x4*)(bgu + (size_t)e * 2048 + 1024 + j0 + 4 * n); }
#pragma unroll
    for (int ai = 0; ai < 2; ++ai)
#pragma unroll
      for (int m = 0; m < 4; ++m) { float o[8];
#pragma unroll
        for (int n = 0; n < 2; ++n)
#pragma unroll
          for (int j = 0; j < 4; ++j) { const float glu = fminf(acc[ai][0][m][n][j] + bg[n][j], SWIGLU_LIMIT); const float lin = fminf(fmaxf(acc[ai][1][m][n][j] + bl[n][j], -SWIGLU_LIMIT), SWIGLU_LIMIT);
            o[4 * n + j] = glu * __frcp_rn(1.f + __expf(-SWIGLU_ALPHA * glu)) * (lin + 1.f); }
        u32x4 w; w.x = pk_bf16(o[0], o[1]); w.y = pk_bf16(o[2], o[3]); w.z = pk_bf16(o[4], o[5]); w.w = pk_bf16(o[6], o[7]);
        *(u32x4*)(act + (size_t)(row0 + ai * HALF + m * 16) * DFF + j0) = w; }
  }
};
struct EpiDown {
  static constexpr bool PERM = true, MIDHOOK = false;
  const float* bdn; const LAS int* tab; const u32x2* rinfo; bf16_t* ypair;
  DI void operator()(const f32x4 (&acc)[2][2][4][2], const Unit& u, int wr, int wc, int fr, int fq) const {
    const int e = u.pn >> 2, pnl = u.pn & 3, col0 = pnl * BM + wc * 32 + 8 * fq;
    const int local0 = u.pm * BM - tab[32 + e] + wr * 64 + fr, cnt = tab[e];
    f32x4 bv[2][2];
#pragma unroll
    for (int bj = 0; bj < 2; ++bj)
#pragma unroll
      for (int n = 0; n < 2; ++n) bv[bj][n] = *(const f32x4*)(bdn + (size_t)e * DM + col0 + bj * HALF + 4 * n);
#pragma unroll
    for (int ai = 0; ai < 2; ++ai)
#pragma unroll
      for (int m = 0; m < 4; ++m) { const int local = local0 + ai * HALF + m * 16;
        if (local < cnt) { const u32x2 info = rinfo[(size_t)e * ECAP + local]; const float gate = __uint_as_float(info.y); bf16_t* rowp = ypair + (size_t)info.x * DM + col0;
#pragma unroll
          for (int bj = 0; bj < 2; ++bj) { const f32x4 v0 = (acc[ai][bj][m][0] + bv[bj][0]) * gate, v1 = (acc[ai][bj][m][1] + bv[bj][1]) * gate;
            u32x4 w; w.x = pk_bf16(v0[0], v0[1]); w.y = pk_bf16(v0[2], v0[3]); w.z = pk_bf16(v1[0], v1[1]); w.w = pk_bf16(v1[2], v1[3]);
            *(u32x4*)(rowp + bj * HALF) = w; } } }
  }
};
}
#if NAIVE_ANY
template <class F> DI void naive_gemm(const Ctx& c, const bf16_t* A, int lda, const bf16_t* Bt, int ldb, int M, int N, int K, F epi) {
  const int r = c.lane & 31, h = c.lane >> 5, tn_n = N / 32, tiles = (M / 32) * tn_n;
  for (int tile = c.gw; tile < tiles; tile += c.ngw) {
    const int tm = tile / tn_n, tn = tile - tm * tn_n;
    const bf16_t* ap = A + (size_t)(tm * 32 + r) * lda + 8 * h; const bf16_t* bp = Bt + (size_t)(tn * 32 + r) * ldb + 8 * h;
    f32x16 acc; for (int i = 0; i < 16; ++i) acc[i] = 0.f;
    for (int k0 = 0; k0 < K; k0 += 16) { const bf16x8 a = *(const bf16x8*)(ap + k0), b = *(const bf16x8*)(bp + k0); acc = MFMA32(a, b, acc); }
#pragma unroll
    for (int i = 0; i < 16; ++i) epi(tm * 32 + crow(i, h), tn * 32 + r, acc[i]);
  }
}
#endif

#if NAIVE_GDN
DI void naive_gdn_prep(const Ctx& c) {
  const bf16_t* proj = (const bf16_t*)(c.p.ws + WS_PROJ); bf16_t* qkv = (bf16_t*)(c.p.ws + WS_GDN); const float* wc = c.p.in[I_WCONV];
  for (int it = c.gw; it < TT * 4; it += c.ngw) {
    const int t = it >> 2, hh = it & 3, tl = t & (SEQ - 1);
    float val[3][2];
#pragma unroll
    for (int part = 0; part < 3; ++part)
#pragma unroll
      for (int e = 0; e < 2; ++e) { const int ch = part * 512 + hh * 128 + 2 * c.lane + e; float a = 0.f;
#pragma unroll
        for (int j = 0; j < 4; ++j) { const int ts = tl - 3 + j; if (ts >= 0) a += wc[j * 1536 + ch] * bf2f(proj[(size_t)(t - 3 + j) * NPROJ + ch]); }
        val[part][e] = a * sigmoidf_(a); }
    const float sq = wave_sum(val[0][0] * val[0][0] + val[0][1] * val[0][1]), sk = wave_sum(val[1][0] * val[1][0] + val[1][1] * val[1][1]);
    const float rq = rsqrtf(sq + NORM_EPS) * 0.08838834764831845f, rk = rsqrtf(sk + NORM_EPS);
    bf16_t* o = qkv + ((size_t)t * 4 + hh) * 384 + 2 * c.lane;
    *(unsigned*)(o) = pk_bf16(val[0][0] * rq, val[0][1] * rq); *(unsigned*)(o + 128) = pk_bf16(val[1][0] * rk, val[1][1] * rk); *(unsigned*)(o + 256) = pk_bf16(val[2][0], val[2][1]);
  }
}
DI void naive_gdn_scan(const Ctx& c) {
  if (c.bid >= 64) return;
  const int b = c.bid >> 2, hh = c.bid & 3, j = c.tid;
  const bf16_t* qkv = (const bf16_t*)(c.p.ws + WS_GDN); const float* gbeta = (const float*)(c.p.ws + WS_MISC); bf16_t* ycat = (bf16_t*)(c.p.ws + WS_YCAT);
  LAS float* sq = (LAS float*)c.lds; LAS float* sk = sq + 8 * 128;
  float S[128];
#pragma unroll
  for (int d = 0; d < 128; ++d) S[d] = 0.f;
  for (int t0 = 0; t0 < SEQ; t0 += 8) {
    __syncthreads();
    for (int i = c.tid; i < 8 * 256; i += 512) { const int tt = i >> 8, d = i & 255; const size_t t = (size_t)b * SEQ + t0 + tt;
      const float v = bf2f(qkv[(t * 4 + hh) * 384 + d]); if (d < 128) sq[tt * 128 + d] = v; else sk[tt * 128 + d - 128] = v; }
    __syncthreads();
    if (j < 128) {
      for (int tt = 0; tt < 8; ++tt) { const size_t t = (size_t)b * SEQ + t0 + tt;
        const float g = gbeta[t * 8 + hh], beta = gbeta[t * 8 + 4 + hh], dec = __expf(g), vt = bf2f(qkv[(t * 4 + hh) * 384 + 256 + j]);
        float ks = 0.f;
#pragma unroll
        for (int d = 0; d < 128; ++d) ks += sk[tt * 128 + d] * S[d];
        const float vn = beta * (vt - dec * ks); float o = 0.f;
#pragma unroll
        for (int d = 0; d < 128; ++d) { S[d] = dec * S[d] + sk[tt * 128 + d] * vn; o += sq[tt * 128 + d] * S[d]; }
        ycat[t * 1536 + hh * 128 + j] = f2bf(o); }
    }
  }
}
#endif

#if NAIVE_ATTN
DI void naive_sb(const Ctx& c) {
  const bf16_t* proj = (const bf16_t*)(c.p.ws + WS_PROJ); bf16_t* ycat = (bf16_t*)(c.p.ws + WS_YCAT);
  LAS float* wl = (LAS float*)c.lds + c.wave * 64;
  for (int it = c.gw; it < NB * 8 * SEQ; it += c.ngw) {
    const int tq = it & (SEQ - 1), hh = (it >> 11) & 7, b = it >> 14; const size_t trow = (size_t)b * SEQ + tq;
    float q[64];
    { const bf16_t* qp = proj + trow * NPROJ + C_SQ + hh * 64;
#pragma unroll
      for (int d8 = 0; d8 < 8; ++d8) { const u32x4 w = *(const u32x4*)(qp + 8 * d8);
#pragma unroll
        for (int e = 0; e < 4; ++e) { q[8 * d8 + 2 * e] = bflo(w[e]); q[8 * d8 + 2 * e + 1] = bfhi(w[e]); } } }
    float carry = 0.f, o = 0.f;
    for (int kt = (tq - 1) >> 6; kt >= 0 && tq > 0; --kt) {
      const int s = kt * 64 + c.lane; const bool valid = s < tq; const size_t srow = (size_t)b * SEQ + (valid ? s : 0);
      const bf16_t* kp = proj + srow * NPROJ + C_SK + hh * 64; float z = 0.f;
#pragma unroll
      for (int d8 = 0; d8 < 8; ++d8) { const u32x4 w = *(const u32x4*)(kp + 8 * d8);
#pragma unroll
        for (int e = 0; e < 4; ++e) z += q[8 * d8 + 2 * e] * bflo(w[e]) + q[8 * d8 + 2 * e + 1] * bfhi(w[e]); }
      z *= 0.125f;
      const float sp = valid ? softplusf_(z) : 0.f;
      float suf = sp;
#pragma unroll
      for (int off = 1; off < 64; off <<= 1) { const float o2 = __shfl_down(suf, off); if (c.lane + off < 64) suf += o2; }
      const float w = valid ? __expf(z - (carry + suf)) : 0.f;
      carry += __shfl(suf, 0);
      LDS_WAIT(); wl[c.lane] = w; LDS_WAIT();
      const int smax = min(64, tq - kt * 64);
      for (int ss = 0; ss < smax; ++ss) o += wl[ss] * bf2f(proj[((size_t)b * SEQ + kt * 64 + ss) * NPROJ + C_SV + hh * 64 + c.lane]);
      LDS_WAIT();
    }
    ycat[trow * 1536 + 512 + hh * 64 + c.lane] = f2bf(o);
  }
}
DI void naive_mem(const Ctx& c) {
  const bf16_t* proj = (const bf16_t*)(c.p.ws + WS_PROJ); const bf16_t* mkv = (const bf16_t*)(c.p.ws + WS_MKV); bf16_t* ycat = (bf16_t*)(c.p.ws + WS_YCAT);
  LAS float* pl = (LAS float*)(c.lds + 4096) + c.wave * 256;
  for (int it = c.gw; it < NB * 4 * SEQ; it += c.ngw) {
    const int tq = it & (SEQ - 1), hh = (it >> 11) & 3, b = it >> 13; const size_t trow = (size_t)b * SEQ + tq;
    const bf16_t* qp = proj + trow * NPROJ + C_MQ + hh * 128;
    float sc[4];
#pragma unroll
    for (int kt = 0; kt < 4; ++kt) { const bf16_t* kp = mkv + (size_t)(b * MEMLEN + kt * 64 + c.lane) * 1024 + hh * 128; float z = 0.f;
      for (int d8 = 0; d8 < 16; ++d8) { const u32x4 w = *(const u32x4*)(kp + 8 * d8), qw = *(const u32x4*)(qp + 8 * d8);
#pragma unroll
        for (int e = 0; e < 4; ++e) z += bflo(qw[e]) * bflo(w[e]) + bfhi(qw[e]) * bfhi(w[e]); }
      sc[kt] = z * 0.08838834764831845f; }
    const float mx = wave_max(fmaxf(fmaxf(sc[0], sc[1]), fmaxf(sc[2], sc[3])));
    float pe[4], ssum = 0.f;
#pragma unroll
    for (int kt = 0; kt < 4; ++kt) { pe[kt] = __expf(sc[kt] - mx); ssum += pe[kt]; }
    ssum = wave_sum(ssum);
    LDS_WAIT();
#pragma unroll
    for (int kt = 0; kt < 4; ++kt) pl[kt * 64 + c.lane] = pe[kt] / ssum;
    LDS_WAIT();
    float o0 = 0.f, o1 = 0.f;
    for (int s = 0; s < 256; ++s) { const unsigned vv = *(const unsigned*)(mkv + (size_t)(b * MEMLEN + s) * 1024 + 512 + hh * 128 + 2 * c.lane); const float pw = pl[s]; o0 += pw * bflo(vv); o1 += pw * bfhi(vv); }
    LDS_WAIT();
    *(unsigned*)(ycat + trow * 1536 + 1024 + hh * 128 + 2 * c.lane) = pk_bf16(o0, o1);
  }
}
#endif
DI void tr_item(const float* src, int ldw, bf16_t* dst, int ldd, LAS float* scr, int lane) {
#pragma unroll
  for (int i = 0; i < 8; ++i) { const int kk = 8 * i + (lane >> 3); const f32x4 v = *(const f32x4*)(src + (size_t)kk * ldw + 4 * (lane & 7));
    LAS float* s = scr + kk * 33 + 4 * (lane & 7); s[0] = v.x; s[1] = v.y; s[2] = v.z; s[3] = v.w; }
  LDS_WAIT();
  const int cc = lane & 7;
#pragma unroll
  for (int j = 0; j < 4; ++j) { const int n = (lane >> 3) + 8 * j; const LAS float* s = scr + (8 * cc) * 33 + n;
    u32x4 o; o.x = pk_bf16(s[0 * 33], s[1 * 33]); o.y = pk_bf16(s[2 * 33], s[3 * 33]); o.z = pk_bf16(s[4 * 33], s[5 * 33]); o.w = pk_bf16(s[6 * 33], s[7 * 33]);
    *(u32x4*)(dst + (size_t)n * ldd + 8 * cc) = o; }
  LDS_WAIT();
}
DI void phase0(const Ctx& c) {
  unsigned char* ws = c.p.ws;
  if (c.bid == 0 && c.tid < 32) ((int*)(ws + WS_MISC + MiB))[c.tid] = 0;
  {
    LAS float* scr = (LAS float*)(c.lds + c.wave * 8448);
    for (int r = c.gw; r < 16 * 224; r += c.ngw) { const int kb = r / 224, nb = r % 224; const int n0 = 32 * nb + (nb >= 64 ? 8 : 0);
      tr_item(c.p.in[I_WIN] + (size_t)(64 * kb) * 7176 + n0, 7176, (bf16_t*)(ws + WS_WIN) + (size_t)(32 * nb) * 1024 + 64 * kb, 1024, scr, c.lane); }
    for (int r = (c.gw + 512) % c.ngw; r < 16 * 32; r += c.ngw) { const int kb = r / 32, nb = r % 32;
      tr_item(c.p.in[I_WMKV] + (size_t)(64 * kb) * 1024 + 32 * nb, 1024, (bf16_t*)(ws + WS_WMKV) + (size_t)(32 * nb) * 1024 + 64 * kb, 1024, scr, c.lane); }
    for (int r = (c.gw + 1024) % c.ngw; r < 8 * 32; r += c.ngw) { const int kb = r / 32, nb = r % 32;
      tr_item(c.p.in[I_WPG] + (size_t)(64 * kb) * 1024 + 32 * nb, 1024, (bf16_t*)(ws + WS_WP) + (size_t)(32 * nb) * 1536 + 0 * 512 + 64 * kb, 1536, scr, c.lane); }
    for (int r = (c.gw + 1280) % c.ngw; r < 8 * 32; r += c.ngw) { const int kb = r / 32, nb = r % 32;
      tr_item(c.p.in[I_WPS] + (size_t)(64 * kb) * 1024 + 32 * nb, 1024, (bf16_t*)(ws + WS_WP) + (size_t)(32 * nb) * 1536 + 1 * 512 + 64 * kb, 1536, scr, c.lane); }
    for (int r = (c.gw + 1536) % c.ngw; r < 8 * 32; r += c.ngw) { const int kb = r / 32, nb = r % 32;
      tr_item(c.p.in[I_WPM] + (size_t)(64 * kb) * 1024 + 32 * nb, 1024, (bf16_t*)(ws + WS_WP) + (size_t)(32 * nb) * 1536 + 2 * 512 + 64 * kb, 1536, scr, c.lane); }
    for (int r = (c.gw + 1792) % c.ngw; r < 16 * 32; r += c.ngw) { const int kb = r / 32, nb = r % 32;
      tr_item(c.p.in[I_WO] + (size_t)(64 * kb) * 1024 + 32 * nb, 1024, (bf16_t*)(ws + WS_WO) + (size_t)(32 * nb) * 1024 + 64 * kb, 1024, scr, c.lane); }
    for (int r = c.gw; r < 32 * 16 * 64; r += c.ngw) { const int e = r / 1024, q = r % 1024, kb = q / 64, nb = q % 64; const int r0 = 32 * nb, n0 = ((r0 >> 7) & 1) * 1024 + (r0 >> 8) * 128 + (r0 & 127);
      tr_item(c.p.in[I_WGU] + (size_t)e * 1024 * 2048 + (size_t)(64 * kb) * 2048 + n0, 2048, (bf16_t*)(ws + WS_WGU) + ((size_t)e * 2048 + r0) * 1024 + 64 * kb, 1024, scr, c.lane); }
    for (int r = c.gw; r < 32 * 16 * 32; r += c.ngw) { const int e = r / 512, q = r % 512, kb = q / 32, nb = q % 32;
      tr_item(c.p.in[I_WDN] + (size_t)e * 1024 * 1024 + (size_t)(64 * kb) * 1024 + 32 * nb, 1024, (bf16_t*)(ws + WS_WDN) + ((size_t)e * 1024 + 32 * nb) * 1024 + 64 * kb, 1024, scr, c.lane); }
  }
  { const f32x4* src = (const f32x4*)c.p.in[I_MEM]; u32x2* dst = (u32x2*)(ws + WS_MEMB);
    for (int i = c.bid * 512 + c.tid; i < NB * MEMLEN * DM / 4; i += c.G * 512) { const f32x4 v = src[i]; u32x2 o; o.x = pk_bf16(v.x, v.y); o.y = pk_bf16(v.z, v.w); dst[i] = o; } }
  {
    float wab[4][4][8];
#pragma unroll
    for (int j = 0; j < 4; ++j)
#pragma unroll
      for (int i = 0; i < 4; ++i) { const float* wp = c.p.in[I_WIN] + (size_t)(256 * j + 4 * c.lane + i) * 7176 + 2048; const f32x4 a = *(const f32x4*)wp, b = *(const f32x4*)(wp + 4);
        wab[j][i][0] = a.x; wab[j][i][1] = a.y; wab[j][i][2] = a.z; wab[j][i][3] = a.w; wab[j][i][4] = b.x; wab[j][i][5] = b.y; wab[j][i][6] = b.z; wab[j][i][7] = b.w; }
    const int hh = c.lane & 3; const float nega = -__expf(c.p.in[I_ALOG][hh]), dtb = c.p.in[I_DTB][hh];
    float* gbeta = (float*)(ws + WS_MISC);
    for (int m = c.gw; m < TT; m += c.ngw) {
      const f32x4* xr = (const f32x4*)(c.p.in[I_X] + (size_t)m * DM) + c.lane; u32x2* xo = (u32x2*)(ws + WS_XB + (size_t)m * DM * 2) + c.lane;
      float s[8];
#pragma unroll
      for (int q = 0; q < 8; ++q) s[q] = 0.f;
#pragma unroll
      for (int j = 0; j < 4; ++j) { const f32x4 v = xr[64 * j]; u32x2 o; o.x = pk_bf16(v.x, v.y); o.y = pk_bf16(v.z, v.w); xo[64 * j] = o;
#pragma unroll
        for (int q = 0; q < 8; ++q) s[q] += v.x * wab[j][0][q] + v.y * wab[j][1][q] + v.z * wab[j][2][q] + v.w * wab[j][3][q]; }
#pragma unroll
      for (int q = 0; q < 8; ++q) s[q] = wave_sum(s[q]);
      if (c.lane < 8) {
        float pre = s[0];
#pragma unroll
        for (int q = 1; q < 8; ++q) pre = (c.lane == q) ? s[q] : pre;
        const float val = c.lane < 4 ? nega * softplusf_(pre + dtb) : sigmoidf_(pre);
        gbeta[(size_t)m * 8 + c.lane] = val;
      }
    }
  }
}

DI void phase_gdn_norm(const Ctx& c) {
  bf16_t* ycat = (bf16_t*)(c.p.ws + WS_YCAT); const bf16_t* proj = (const bf16_t*)(c.p.ws + WS_PROJ); const float* nw = c.p.in[I_GNW];
  const float w0 = nw[2 * c.lane], w1 = nw[2 * c.lane + 1];
  for (int it = c.gw; it < TT * 4; it += c.ngw) {
    const int t = it >> 2, hh = it & 3;
    unsigned* op = (unsigned*)(ycat + (size_t)t * 1536 + hh * 128) + c.lane; const unsigned ov = *op, zv = *((const unsigned*)(proj + (size_t)t * NPROJ + C_GZ + hh * 128) + c.lane);
    const float o0 = bflo(ov), o1 = bfhi(ov), z0 = bflo(zv), z1 = bfhi(zv);
    const float rs = rsqrtf(wave_sum(o0 * o0 + o1 * o1) * (1.f / 128.f) + NORM_EPS);
    *op = pk_bf16(o0 * rs * w0 * (z0 * sigmoidf_(z0)), o1 * rs * w1 * (z1 * sigmoidf_(z1)));
  }
}

DI void phase_router(const Ctx& c) {
  unsigned char* ws = c.p.ws;
  const float* h = (const float*)(ws + WS_H); float* x1 = (float*)(ws + WS_X1); bf16_t* x1b = (bf16_t*)(ws + WS_X1B);
  const float* wr = c.p.in[I_WR]; int* gcount = (int*)(ws + WS_MISC + MiB); u32x2* rinfo = (u32x2*)(ws + WS_RINFO);
  LAS float* xs = (LAS float*)(c.lds + c.wave * 16384);
  LAS int* wcnt = (LAS int*)(c.lds + 131072);
  LAS int* bbase = wcnt + 256;
  const int e = c.lane & 31, half = c.lane >> 5;
  f32x4 gam[4], bet[4];
#pragma unroll
  for (int j = 0; j < 4; ++j) { gam[j] = ((const f32x4*)c.p.in[I_LN1G])[64 * j + c.lane]; bet[j] = ((const f32x4*)c.p.in[I_LN1B])[64 * j + c.lane]; }
  const float brv = c.p.in[I_BR][e];
  int mycnt = 0;
  LAS int* sel_e = bbase + 32 + c.wave * 64; LAS int* sel_pos = sel_e + 512; LAS float* sel_g = (LAS float*)(sel_e + 1024);
  for (int gi = c.bid; gi < TT / 128; gi += c.G) {
    const int tok0 = gi * 128 + c.wave * 16;
#pragma unroll
    for (int qd = 0; qd < 4; ++qd) {
      LDS_WAIT();
#pragma unroll
      for (int tt = 0; tt < 4; ++tt) {
        const size_t t = (size_t)tok0 + qd * 4 + tt;
        const f32x4* hr = (const f32x4*)(h + t * DM) + c.lane; f32x4 v[4]; float s = 0.f;
#pragma unroll
        for (int j = 0; j < 4; ++j) { v[j] = hr[64 * j]; s += (v[j].x + v[j].y) + (v[j].z + v[j].w); }
        const float mean = wave_sum(s) * (1.f / DM); float s2 = 0.f;
#pragma unroll
        for (int j = 0; j < 4; ++j) { v[j] = v[j] - mean; s2 += (v[j].x * v[j].x + v[j].y * v[j].y) + (v[j].z * v[j].z + v[j].w * v[j].w); }
        const float rstd = rsqrtf(wave_sum(s2) * (1.f / DM) + LN_EPS);
#pragma unroll
        for (int j = 0; j < 4; ++j) { const f32x4 y = v[j] * rstd * gam[j] + bet[j];
          ((f32x4*)(x1 + t * DM))[64 * j + c.lane] = y; u32x2 o; o.x = pk_bf16(y.x, y.y); o.y = pk_bf16(y.z, y.w); ((u32x2*)(x1b + t * DM))[64 * j + c.lane] = o;
          *(LAS f32x4*)(xs + tt * 1024 + 256 * j + 4 * c.lane) = y; }
      }
      LDS_WAIT();
      float lg[4] = {0.f, 0.f, 0.f, 0.f};
      const float* wp = wr + (size_t)(512 * half) * 32 + e; const LAS float* xp = xs + 512 * half;
      for (int k = 0; k < 512; k += 4) {
        const float w0 = wp[(k + 0) * 32], w1 = wp[(k + 1) * 32], w2 = wp[(k + 2) * 32], w3 = wp[(k + 3) * 32];
#pragma unroll
        for (int tt = 0; tt < 4; ++tt) { const f32x4 xv = *(const LAS f32x4*)(xp + tt * 1024 + k); lg[tt] += (xv.x * w0 + xv.y * w1) + (xv.z * w2 + xv.w * w3); }
      }
#pragma unroll
      for (int tt = 0; tt < 4; ++tt) {
        float logit = lg[tt] + __shfl_xor(lg[tt], 32) + brv;
        float tv[4]; int ti[4];
#pragma unroll
        for (int k = 0; k < 4; ++k) {
          float bv = logit; int bi = e;
#pragma unroll
          for (int o = 1; o < 32; o <<= 1) { const float ov = __shfl_xor(bv, o); const int oi = __shfl_xor(bi, o); if (ov > bv || (ov == bv && oi < bi)) { bv = ov; bi = oi; } }
          tv[k] = bv; ti[k] = bi; if (e == bi) logit = -INFINITY;
        }
        const float e1 = __expf(tv[1] - tv[0]), e2 = __expf(tv[2] - tv[0]), e3 = __expf(tv[3] - tv[0]), inv = 1.f / (1.f + e1 + e2 + e3);
        const float gk = (c.lane == 0 ? 1.f : c.lane == 1 ? e1 : c.lane == 2 ? e2 : e3) * inv;
        const int ek = c.lane == 0 ? ti[0] : c.lane == 1 ? ti[1] : c.lane == 2 ? ti[2] : ti[3];
        const int cnt_e = __shfl(mycnt, ek);
        const bool chosen = (e == ti[0]) | (e == ti[1]) | (e == ti[2]) | (e == ti[3]);
        if (c.lane < 32 && chosen) mycnt += 1;
        if (c.lane < 4) { sel_e[(qd * 4 + tt) * 4 + c.lane] = ek; sel_pos[(qd * 4 + tt) * 4 + c.lane] = cnt_e; sel_g[(qd * 4 + tt) * 4 + c.lane] = gk; }
      }
    }
    if (c.lane < 32) wcnt[c.wave * 32 + c.lane] = mycnt;
    __syncthreads();
    if (c.tid < 32) { int tot = 0;
#pragma unroll
      for (int w = 0; w < 8; ++w) tot += wcnt[w * 32 + c.tid];
      bbase[c.tid] = tot ? atomicAdd(gcount + c.tid, tot) : 0; }
    __syncthreads();
    if (c.lane < 4) {
#pragma unroll
      for (int i = 0; i < 16; ++i) { const int ek = sel_e[i * 4 + c.lane]; int base = bbase[ek];
        for (int w = 0; w < c.wave; ++w) base += wcnt[w * 32 + ek];
        u32x2 info; info.x = (unsigned)((tok0 + i) * 4 + c.lane); info.y = __float_as_uint(sel_g[i * 4 + c.lane]);
        rinfo[(size_t)ek * ECAP + base + sel_pos[i * 4 + c.lane]] = info; }
    }
    __syncthreads();
    mycnt = 0;
  }
}

DI void build_group_tab(const Ctx& c, LAS int* tab) {
  const int* gcount = (const int*)(c.p.ws + WS_MISC + MiB);
  __syncthreads();
  if (c.tid == 0) { int ps = 0;
    for (int e = 0; e < 32; ++e) { const int cnt = gcount[e]; tab[e] = cnt; tab[32 + e] = ps; const int nt_ = (cnt + 255) >> 8; for (int q = 0; q < nt_; ++q) tab[96 + (ps >> 8) + q] = e; ps += nt_ << 8; }
    tab[64] = ps; tab[65] = ps >> 8; }
  __syncthreads();
}

DI void phase_final(const Ctx& c) {
  const float* x1 = (const float*)(c.p.ws + WS_X1); const bf16_t* yp = (const bf16_t*)(c.p.ws + WS_YPAIR);
  f32x4 gam[4], bet[4];
#pragma unroll
  for (int j = 0; j < 4; ++j) { gam[j] = ((const f32x4*)c.p.in[I_LN2G])[64 * j + c.lane]; bet[j] = ((const f32x4*)c.p.in[I_LN2B])[64 * j + c.lane]; }
  for (int t = c.gw; t < TT; t += c.ngw) {
    f32x4 v[4]; float s = 0.f;
#pragma unroll
    for (int j = 0; j < 4; ++j) { v[j] = ((const f32x4*)(x1 + (size_t)t * DM))[64 * j + c.lane] * DN_ALPHA;
#pragma unroll
      for (int k = 0; k < 4; ++k) { const u32x2 w = ((const u32x2*)(yp + ((size_t)t * 4 + k) * DM))[64 * j + c.lane]; v[j].x += bflo(w.x); v[j].y += bfhi(w.x); v[j].z += bflo(w.y); v[j].w += bfhi(w.y); }
      s += (v[j].x + v[j].y) + (v[j].z + v[j].w); }
    const float mean = wave_sum(s) * (1.f / DM); float s2 = 0.f;
#pragma unroll
    for (int j = 0; j < 4; ++j) { v[j] = v[j] - mean; s2 += (v[j].x * v[j].x + v[j].y * v[j].y) + (v[j].z * v[j].z + v[j].w * v[j].w); }
    const float rstd = rsqrtf(wave_sum(s2) * (1.f / DM) + LN_EPS);
#pragma unroll
    for (int j = 0; j < 4; ++j) ((f32x4*)(c.p.out + (size_t)t * DM))[64 * j + c.lane] = v[j] * rstd * gam[j] + bet[j];
  }
}
#if NAIVE_P5
DI void naive_mixed(const Ctx& c) {
  const bf16_t* ycat = (const bf16_t*)(c.p.ws + WS_YCAT); const bf16_t* wp = (const bf16_t*)(c.p.ws + WS_WP); const bf16_t* proj = (const bf16_t*)(c.p.ws + WS_PROJ); bf16_t* mixed = (bf16_t*)(c.p.ws + WS_MIXED);
  const int r = c.lane & 31, h = c.lane >> 5;
  for (int tile = c.gw; tile < (TT / 32) * 32; tile += c.ngw) {
    const int tm = tile >> 5, tn = tile & 31; float res[16];
#pragma unroll
    for (int i = 0; i < 16; ++i) res[i] = 0.f;
    for (int b = 0; b < 3; ++b) {
      const bf16_t* ap = ycat + (size_t)(tm * 32 + r) * 1536 + b * 512 + 8 * h; const bf16_t* bp = wp + (size_t)(tn * 32 + r) * 1536 + b * 512 + 8 * h;
      f32x16 acc; for (int i = 0; i < 16; ++i) acc[i] = 0.f;
      for (int k0 = 0; k0 < 512; k0 += 16) acc = MFMA32(*(const bf16x8*)(ap + k0), *(const bf16x8*)(bp + k0), acc);
#pragma unroll
      for (int i = 0; i < 16; ++i) res[i] += acc[i] * sigmoidf_(bf2f(proj[(size_t)(tm * 32 + crow(i, h)) * NPROJ + C_GATE + b * 1024 + tn * 32 + r]));
    }
#pragma unroll
    for (int i = 0; i < 16; ++i) mixed[(size_t)(tm * 32 + crow(i, h)) * DM + tn * 32 + r] = f2bf(res[i]);
  }
}
#endif
#if NAIVE_MOE
DI void naive_gateup(const Ctx& c, const LAS int* tab) {
  const bf16_t* x1b = (const bf16_t*)(c.p.ws + WS_X1B); const bf16_t* wgu = (const bf16_t*)(c.p.ws + WS_WGU); bf16_t* act = (bf16_t*)(c.p.ws + WS_ACT); const u32x2* rinfo = (const u32x2*)(c.p.ws + WS_RINFO);
  const float* bgu = c.p.in[I_BGU];
  const int r = c.lane & 31, h = c.lane >> 5, ntile = (tab[64] >> 5) * 32;
  for (int tile = c.gw; tile < ntile; tile += c.ngw) {
    const int tm = tile >> 5, tj = tile & 31, e = tab[96 + (tm >> 3)], local = tm * 32 + r - tab[32 + e];
    const int tok = local < tab[e] ? (int)(rinfo[(size_t)e * ECAP + local].x >> 2) : 0;
    const int j0 = tj * 32, wrow = (j0 >> 7) * 256 + (j0 & 127);
    const bf16_t* ap = x1b + (size_t)tok * DM + 8 * h; const bf16_t* bg = wgu + ((size_t)e * 2048 + wrow + r) * DM + 8 * h; const bf16_t* bl = bg + (size_t)128 * DM;
    f32x16 ag, al; for (int i = 0; i < 16; ++i) { ag[i] = 0.f; al[i] = 0.f; }
    for (int k0 = 0; k0 < DM; k0 += 16) { const bf16x8 a = *(const bf16x8*)(ap + k0); ag = MFMA32(a, *(const bf16x8*)(bg + k0), ag); al = MFMA32(a, *(const bf16x8*)(bl + k0), al); }
    const float bgv = bgu[(size_t)e * 2048 + j0 + r], blv = bgu[(size_t)e * 2048 + 1024 + j0 + r];
#pragma unroll
    for (int i = 0; i < 16; ++i) { const float glu = fminf(ag[i] + bgv, SWIGLU_LIMIT), lin = fminf(fmaxf(al[i] + blv, -SWIGLU_LIMIT), SWIGLU_LIMIT);
      act[(size_t)(tm * 32 + crow(i, h)) * DFF + j0 + r] = f2bf(glu * sigmoidf_(SWIGLU_ALPHA * glu) * (lin + 1.f)); }
  }
}
DI void naive_down(const Ctx& c, const LAS int* tab) {
  const bf16_t* act = (const bf16_t*)(c.p.ws + WS_ACT); const bf16_t* wdn = (const bf16_t*)(c.p.ws + WS_WDN); bf16_t* yp = (bf16_t*)(c.p.ws + WS_YPAIR); const u32x2* rinfo = (const u32x2*)(c.p.ws + WS_RINFO);
  const float* bdn = c.p.in[I_BDN];
  const int r = c.lane & 31, h = c.lane >> 5, ntile = (tab[64] >> 5) * 32;
  for (int tile = c.gw; tile < ntile; tile += c.ngw) {
    const int tm = tile >> 5, tn = tile & 31, e = tab[96 + (tm >> 3)];
    const bf16_t* ap = act + (size_t)(tm * 32 + r) * DFF + 8 * h; const bf16_t* bp = wdn + ((size_t)e * DM + tn * 32 + r) * DFF + 8 * h;
    f32x16 acc; for (int i = 0; i < 16; ++i) acc[i] = 0.f;
    for (int k0 = 0; k0 < DFF; k0 += 16) acc = MFMA32(*(const bf16x8*)(ap + k0), *(const bf16x8*)(bp + k0), acc);
    const float bv = bdn[(size_t)e * DM + tn * 32 + r];
#pragma unroll
    for (int i = 0; i < 16; ++i) { const int local = tm * 32 + crow(i, h) - tab[32 + e];
      if (local < tab[e]) { const u32x2 info = rinfo[(size_t)e * ECAP + local]; yp[(size_t)info.x * DM + tn * 32 + r] = f2bf((acc[i] + bv) * __uint_as_float(info.y)); } }
  }
}
#endif

__global__ void __launch_bounds__(512, 2) mega(Params p) {
  extern __shared__ __attribute__((aligned(16))) unsigned char lds_raw[];
  cg::grid_group grid = cg::this_grid();
  Ctx c; c.lds = (LAS unsigned char*)lds_raw; c.tid = threadIdx.x; c.lane = c.tid & 63; c.wave = __builtin_amdgcn_readfirstlane(c.tid >> 6);
  c.G = gridDim.x; c.bid = blockIdx.x; c.gw = c.bid * 8 + c.wave; c.ngw = c.G * 8; c.p = p;
  unsigned char* ws = p.ws;
  LAS int* gtab = (LAS int*)(c.lds + 131072);
#define IN(k) (p.ph_lo <= (k) && (k) < p.ph_hi)
#define SEAM(k) do { if ((k) + 1 < p.ph_hi) grid.sync(); } while (0)

  if (IN(0)) { phase0(c); SEAM(0); }
  if (IN(1)) {
#if NAIVE_P1
    { bf16_t* proj = (bf16_t*)(ws + WS_PROJ); naive_gemm(c, (const bf16_t*)(ws + WS_XB), DM, (const bf16_t*)(ws + WS_WIN), DM, TT, NPROJ, DM, [&](int r, int cc, float v) { proj[(size_t)r * NPROJ + cc] = f2bf(v); }); }
    { bf16_t* mkv = (bf16_t*)(ws + WS_MKV); naive_gemm(c, (const bf16_t*)(ws + WS_MEMB), DM, (const bf16_t*)(ws + WS_WMKV), DM, NB * MEMLEN, DM, DM, [&](int r, int cc, float v) { mkv[(size_t)r * DM + cc] = f2bf(v); }); }
#else
    { pg8::Gemm g{(const bf16_t*)(ws + WS_XB), (const bf16_t*)(ws + WS_WIN), DM}; pg8::StaticOrder S; S.init(TT, NPROJ, c.G, c.bid); pg8::EpiStoreBf16 E{(bf16_t*)(ws + WS_PROJ), NPROJ};
      pg8::gemm_phase<pg8::EpiStoreBf16, pg8::StaticOrder, true>(c.lds, g, S, E); }
    { pg8::Gemm g{(const bf16_t*)(ws + WS_MEMB), (const bf16_t*)(ws + WS_WMKV), DM}; pg8::StaticOrder S; S.init(NB * MEMLEN, DM, c.G, c.bid); pg8::EpiStoreBf16 E{(bf16_t*)(ws + WS_MKV), DM};
      pg8::gemm_phase<pg8::EpiStoreBf16, pg8::StaticOrder, true>(c.lds, g, S, E); }
#endif
    SEAM(1);
  }
  if (IN(2)) {
#if NAIVE_GDN
    naive_gdn_prep(c);
#else
    phase_gdn_chunk(c);
#endif
#if NAIVE_ATTN
    naive_sb(c); naive_mem(c);
#else
    phase_attn(c);
#endif
    SEAM(2);
  }
  if (IN(3)) {
#if NAIVE_GDN
    naive_gdn_scan(c);
#else
    phase_gdn_scan(c);
#endif
    SEAM(3);
  }
  if (IN(4)) { phase_gdn_norm(c); SEAM(4); }
  if (IN(5)) {
#if NAIVE_P5
    naive_mixed(c);
#else
    pg8::Gemm g{(const bf16_t*)(ws + WS_YCAT), (const bf16_t*)(ws + WS_WP), 1536}; pg8::StaticOrder S; S.init(TT, DM, c.G, c.bid); pg8::EpiMixed E{(const bf16_t*)(ws + WS_PROJ), (bf16_t*)(ws + WS_MIXED)};
    pg8::gemm_phase<pg8::EpiMixed, pg8::StaticOrder, true>(c.lds, g, S, E);
#endif
    SEAM(5);
  }
  if (IN(6)) {
#if NAIVE_P6
    { const float* x = p.in[I_X]; float* hh = (float*)(ws + WS_H);
      naive_gemm(c, (const bf16_t*)(ws + WS_MIXED), DM, (const bf16_t*)(ws + WS_WO), DM, TT, DM, DM, [&](int r, int cc, float v) { hh[(size_t)r * DM + cc] = DN_ALPHA * x[(size_t)r * DM + cc] + v; }); }
#else
    pg8::Gemm g{(const bf16_t*)(ws + WS_MIXED), (const bf16_t*)(ws + WS_WO), DM}; pg8::StaticOrder S; S.init(TT, DM, c.G, c.bid); pg8::EpiH E{p.in[I_X], (float*)(ws + WS_H)};
    pg8::gemm_phase<pg8::EpiH, pg8::StaticOrder, true>(c.lds, g, S, E);
#endif
    SEAM(6);
  }
  if (IN(7)) { phase_router(c); SEAM(7); }
  if (IN(8)) {
    build_group_tab(c, gtab);
#if NAIVE_MOE
    naive_gateup(c, gtab);
#else
    pg8::Gemm g{(const bf16_t*)(ws + WS_X1B), (const bf16_t*)(ws + WS_WGU), DM}; pg8::GroupOrder S{gtab, (const u32x2*)(ws + WS_RINFO), 8, c.G, c.bid, 1}; pg8::EpiGateUp E{p.in[I_BGU], (bf16_t*)(ws + WS_ACT)};
    pg8::gemm_phase<pg8::EpiGateUp, pg8::GroupOrder, true>(c.lds, g, S, E);
#endif
    SEAM(8);
  }
  if (IN(9)) {
    build_group_tab(c, gtab);
#if NAIVE_MOE
    naive_down(c, gtab);
#else
    pg8::Gemm g{(const bf16_t*)(ws + WS_ACT), (const bf16_t*)(ws + WS_WDN), DFF}; pg8::GroupOrder S{gtab, (const u32x2*)(ws + WS_RINFO), 4, c.G, c.bid, 0};
    pg8::EpiDown E{p.in[I_BDN], gtab, (const u32x2*)(ws + WS_RINFO), (bf16_t*)(ws + WS_YPAIR)};
    pg8::gemm_phase<pg8::EpiDown, pg8::GroupOrder, true>(c.lds, g, S, E);
#endif
    SEAM(9);
  }
  if (IN(10)) { phase_final(c); }
#undef IN
#undef SEAM
}

extern "C" void kernel_launch(void* const* d_in, const int* in_sizes, int n_in, void* d_out, int out_size, void* d_ws, size_t ws_size, hipStream_t stream) {
  static int grid_blocks = 0;
  if (grid_blocks == 0) {
    if (n_in != 22 || in_sizes[0] != TT * DM || out_size != TT * DM || ws_size < WS_NEED) {
      fprintf(stderr, "kernel_launch: built for 22 inputs, x/out of %d floats and >= %zu bytes of workspace; got n_in %d in0 %d out %d ws %zu; nothing launched\n", TT * DM, (size_t)WS_NEED, n_in, n_in > 0 ? in_sizes[0] : -1, out_size, ws_size);
      grid_blocks = -1; return; }
    int dev = 0, cus = 0, per_cu = 0;
    if (hipGetDevice(&dev) != hipSuccess || hipDeviceGetAttribute(&cus, hipDeviceAttributeMultiprocessorCount, dev) != hipSuccess) { grid_blocks = -1; return; }
    if (hipFuncSetAttribute((const void*)mega, hipFuncAttributeMaxDynamicSharedMemorySize, LDS_BYTES) != hipSuccess) { fprintf(stderr, "kernel_launch: hipFuncSetAttribute failed\n"); grid_blocks = -1; return; }
    if (hipOccupancyMaxActiveBlocksPerMultiprocessor(&per_cu, (const void*)mega, 512, LDS_BYTES) != hipSuccess || per_cu < 1) { fprintf(stderr, "kernel_launch: occupancy query says %d\n", per_cu); (void)hipGetLastError(); grid_blocks = -1; return; }
    grid_blocks = cus;
    fprintf(stderr, "kernel_launch: grid %d (cus %d, per_cu %d), ws %zu\n", grid_blocks, cus, per_cu, ws_size);
  }
  if (grid_blocks < 0) return;
  Params p{};
  for (int i = 0; i < 22; ++i) p.in[i] = (const float*)d_in[i];
  p.out = (float*)d_out; p.ws = (unsigned char*)d_ws;
#if MK_SPLIT
  for (int ph = 0; ph < 11; ++ph) { p.ph_lo = ph; p.ph_hi = ph + 1; void* args[] = {&p};
    hipError_t e = hipLaunchCooperativeKernel((const void*)mega, dim3(grid_blocks), dim3(512), args, LDS_BYTES, stream);
    if (e != hipSuccess) { fprintf(stderr, "kernel_launch: launch of phase %d failed: %s\n", ph, hipGetErrorString(e)); break; } }
#else
  p.ph_lo = 0; p.ph_hi = 11; void* args[] = {&p};
  hipError_t e = hipLaunchCooperativeKernel((const void*)mega, dim3(grid_blocks), dim3(512), args, LDS_BYTES, stream);
  if (e != hipSuccess) fprintf(stderr, "kernel_launch: cooperative launch failed: %s (grid %d)\n", hipGetErrorString(e), grid_blocks);
#endif
}
```

```cpp
#define NAIVE_P1 0
#define NAIVE_GDN 0
#define NAIVE_ATTN 0
#define NAIVE_P5 0
#define NAIVE_P6 0
#define NAIVE_MOE 0
#define MK_SPLIT 0
#define NAIVE_ANY (NAIVE_P1 || NAIVE_P6)
#include <hip/hip_runtime.h>
#include <hip/hip_cooperative_groups.h>
#include <cstdio>
#include <cstdint>
namespace cg = cooperative_groups;

#define DI __device__ __forceinline__
#define LAS __attribute__((address_space(3)))
typedef unsigned short bf16_t;
typedef short bf16x8 __attribute__((ext_vector_type(8)));
typedef float f32x2 __attribute__((ext_vector_type(2)));
typedef float f32x4 __attribute__((ext_vector_type(4)));
typedef float f32x16 __attribute__((ext_vector_type(16)));
typedef unsigned u32x2 __attribute__((ext_vector_type(2)));
typedef unsigned u32x4 __attribute__((ext_vector_type(4)));
typedef __bf16 bf16x2_t __attribute__((ext_vector_type(2)));

constexpr int NB = 16, SEQ = 2048, DM = 1024, TT = NB * SEQ;
constexpr int MEMLEN = 256, NEXP = 32, TOPK = 4, DFF = 1024;
constexpr int NPROJ = 7168;
constexpr int C_GQ = 0, C_GK = 512, C_GV = 1024, C_GZ = 1536, C_SQ = 2048, C_SK = 2560, C_SV = 3072, C_MQ = 3584, C_GATE = 4096;
constexpr float LN_EPS = 1e-5f, NORM_EPS = 1e-6f;
constexpr float DN_ALPHA = 1.189207115002721f;
constexpr float SWIGLU_LIMIT = 7.0f, SWIGLU_ALPHA = 1.702f;
constexpr int ECAP = 32768;

constexpr size_t MiB = 1u << 20;
constexpr size_t WS_MISC = 0;
constexpr size_t WS_WDN = 3 * MiB, WS_WGU = 67 * MiB, WS_WIN = 195 * MiB, WS_WMKV = 209 * MiB, WS_WP = 211 * MiB, WS_WO = 214 * MiB;
constexpr size_t WS_XB = 216 * MiB, WS_MEMB = 280 * MiB, WS_MKV = 288 * MiB, WS_PROJ = 296 * MiB, WS_GDN = 744 * MiB, WS_YCAT = 888 * MiB, WS_RINFO = 1016 * MiB;
constexpr size_t WS_MIXED = WS_XB, WS_H = WS_GDN, WS_X1 = WS_YCAT, WS_X1B = WS_PROJ, WS_ACT = 360 * MiB, WS_YPAIR = 67 * MiB;
constexpr size_t WS_NEED = 1024 * MiB;
constexpr size_t GDN_CHUNK_BYTES = 73728;
constexpr int LDS_BYTES = 147456;

struct Params { const float* in[22]; float* out; unsigned char* ws; int ph_lo, ph_hi; };
enum { I_X = 0, I_MEM, I_WIN, I_WCONV, I_ALOG, I_DTB, I_GNW, I_WMKV, I_WPG, I_WPS, I_WPM, I_WO, I_LN1G, I_LN1B, I_WR, I_BR, I_WGU, I_BGU, I_WDN, I_BDN, I_LN2G, I_LN2B };

DI float bf2f(bf16_t v) { return __uint_as_float((unsigned)v << 16); }
DI unsigned pk_bf16(float a, float b) { f32x2 v = {a, b}; bf16x2_t r = __builtin_convertvector(v, bf16x2_t); return __builtin_bit_cast(unsigned, r); }
DI bf16_t f2bf(float a) { return (bf16_t)(pk_bf16(a, 0.f) & 0xffffu); }
DI float bflo(unsigned w) { return __uint_as_float(w << 16); }
DI float bfhi(unsigned w) { return __uint_as_float(w & 0xffff0000u); }
DI float sigmoidf_(float x) { return 1.0f / (1.0f + __expf(-x)); }
DI float softplusf_(float x) { return x > 20.f ? x : log1pf(__expf(x)); }
DI float wave_sum(float v) {
#pragma unroll
  for (int o = 1; o < 64; o <<= 1) v += __shfl_xor(v, o);
  return v;
}
DI float wave_max(float v) {
#pragma unroll
  for (int o = 1; o < 64; o <<= 1) v = fmaxf(v, __shfl_xor(v, o));
  return v;
}
#define LDS_WAIT() asm volatile("s_waitcnt lgkmcnt(0)" ::: "memory")
#define VM_WAIT() asm volatile("s_waitcnt vmcnt(0)" ::: "memory")
#define MFMA32(a, b, c) __builtin_amdgcn_mfma_f32_32x32x16_bf16((a), (b), (c), 0, 0, 0)
DI int crow(int reg, int h) { return (reg & 3) + 8 * (reg >> 2) + 4 * h; }
DI int swap23(int k) { return (k & ~12) | ((k & 4) << 1) | ((k & 8) >> 1); }

struct Ctx {
  LAS unsigned char* lds;
  int tid, lane, wave, G, bid, gw, ngw;
  Params p;
};
namespace pg8 {
constexpr int BM = 256, BK = 64, HALF = 128, HTB = HALF * BK * 2  , STAGE_BYTES = 8 * HTB, NXCD = 8, WGM = 8;
DI int lds_byte(int r, int c) { const int st = (r >> 4) * 2 + (c >> 5), rr = r & 15, cc = c & 31, ob = rr * 64 + cc * 2; return st * 1024 + (ob ^ (((ob >> 9) & 1) << 5)); }
DI void stage_rc(int b, int& R, int& C) { const int st = b / 1024, sb = b % 1024, swz = sb ^ (((sb >> 9) & 1) << 5); R = (st >> 1) * 16 + swz / 64; C = (st & 1) * 32 + (swz % 64) / 2; }
DI int perm32(int rho) { const int n = rho >> 4, i = rho & 15; return 8 * (i >> 2) + 4 * n + (i & 3); }

struct Unit { int pm, pn; };
struct Gemm { const bf16_t* A; const bf16_t* Bt; int K; };

struct StaticOrder {
  int nM, nN, nwg, G, c;
  DI void init(int M, int N, int G_, int c_) { nM = M / BM; nN = N / BM; nwg = nM * nN; G = G_; c = c_; }
  DI bool next(int i, Unit& u) const {
    const long L = (long)i * G + c; if (L >= nwg) return false;
    int wgid = (int)L; { const int q = nwg / NXCD, r = nwg % NXCD, xcd = wgid % NXCD, off = wgid / NXCD; wgid = (xcd < r ? xcd * (q + 1) : r * (q + 1) + (xcd - r) * q) + off; }
    const int nig = WGM * nN, gid = wgid / nig, fm = gid * WGM, gsz = (nM - fm) < WGM ? (nM - fm) : WGM;
    u.pm = fm + ((wgid % nig) % gsz); u.pn = (wgid % nig) / gsz; return true;
  }
  DI int arow(const Unit& u, int r) const { return u.pm * BM + r; }
};
struct GroupOrder {
  const LAS int* tab; const u32x2* rinfo; int ntn, G, c, gather;
  DI bool next(int i, Unit& u) const {
    const int L = i * G + c, NT = tab[65]; if (L >= NT * ntn) return false;
    const int tile = L / ntn, pnl = L - tile * ntn; u.pm = tile; u.pn = tab[96 + tile] * ntn + pnl; return true;
  }
  DI int arow(const Unit& u, int r) const {
    if (!gather) return u.pm * BM + r;
    const int e = tab[96 + u.pm], local = u.pm * BM + r - tab[32 + e];
    return local < tab[e] ? (int)(rinfo[(size_t)e * ECAP + local].x >> 2) : 0;
  }
};

template <class Epi, class Sched, bool ALIGN_EPI>
DI void gemm_phase(LAS unsigned char* lds, const Gemm g, const Sched& S, const Epi& E) {
  const int tid = threadIdx.x, wid = __builtin_amdgcn_readfirstlane(tid >> 6), lane = tid & 63, wr = wid >> 2, wc = wid & 3, fr = lane & 15, fq = lane >> 4;
  const int K = g.K, nt = K / BK;
  int RA[2], CA[2]; unsigned voffB[2];
#pragma unroll
  for (int i = 0; i < 2; ++i) { int R, C; stage_rc(tid * 16 + i * 8192, R, C); const int Rb = Epi::PERM ? ((R & ~31) + perm32(R & 31)) : R; RA[i] = R; CA[i] = C; voffB[i] = (unsigned)(Rb * K + C) * 2u; }
  const size_t kstep = (size_t)(BK * 2);
  const size_t hstep = (size_t)HALF * K * 2;
  const size_t tstep = 2 * hstep;
  const unsigned ldsw = (unsigned)wid * 1024u;
  const int aoff = lds_byte(wr * 64 + fr, fq * 8), boff = lds_byte(wc * 32 + fr, fq * 8);
  const char* Ab = (const char*)g.A;
#define PG8_SA(b, h) (((b) * 2 + (h)) * HTB)
#define PG8_SB(b, h) ((4 + (b) * 2 + (h)) * HTB)
#define PG8_STAGE(bufoff, gbase, voff) do { _Pragma("unroll") for (int _i = 0; _i < 2; ++_i) \
    __builtin_amdgcn_global_load_lds((const unsigned*)((const char*)(gbase) + (voff)[_i]), (LAS unsigned*)(lds + (bufoff) + ldsw + _i * 8192), 16, 0, 0); } while (0)
#define PG8_LDA(dst, b, h) do { _Pragma("unroll") for (int m = 0; m < 4; ++m) _Pragma("unroll") for (int k = 0; k < 2; ++k) dst[m][k] = *(const LAS bf16x8*)(lds + PG8_SA(b, h) + aoff + m * 2048 + k * 1024); } while (0)
#define PG8_LDB(dst, b, h) do { _Pragma("unroll") for (int n = 0; n < 2; ++n) _Pragma("unroll") for (int k = 0; k < 2; ++k) dst[n][k] = *(const LAS bf16x8*)(lds + PG8_SB(b, h) + boff + n * 2048 + k * 1024); } while (0)
#define PG8_MMA(ai, bj, At, Bt) do { __builtin_amdgcn_s_setprio(1); _Pragma("unroll") for (int m = 0; m < 4; ++m) _Pragma("unroll") for (int n = 0; n < 2; ++n) _Pragma("unroll") for (int k = 0; k < 2; ++k) \
    acc[ai][bj][m][n] = __builtin_amdgcn_mfma_f32_16x16x32_bf16(Bt[n][k], At[m][k], acc[ai][bj][m][n], 0, 0, 0); __builtin_amdgcn_s_setprio(0); } while (0)
#define PG8_WAIT_V(n) asm volatile("s_waitcnt vmcnt(" #n ")" ::: "memory")
#define PG8_WAIT_L(n) asm volatile("s_waitcnt lgkmcnt(" #n ")" ::: "memory")
#define PG8_BAR __builtin_amdgcn_s_barrier()
#define PG8_SCHED __builtin_amdgcn_sched_barrier(0)
  Unit cur, nxt; int ui = 0;
  if (!S.next(0, cur)) return;
  f32x4 acc[2][2][4][2];
#pragma unroll
  for (int a = 0; a < 2; ++a)
#pragma unroll
    for (int b = 0; b < 2; ++b)
#pragma unroll
      for (int m = 0; m < 4; ++m)
#pragma unroll
        for (int n = 0; n < 2; ++n) acc[a][b][m][n] = (f32x4){0.f, 0.f, 0.f, 0.f};
  bf16x8 At[4][2], B0[2][2], B1[2][2];
  unsigned cvo0[2], cvo1[2], nvo0[2], nvo1[2];
#pragma unroll
  for (int i = 0; i < 2; ++i) { cvo0[i] = ((unsigned)S.arow(cur, RA[i]) * (unsigned)K + (unsigned)CA[i]) * 2u; cvo1[i] = ((unsigned)S.arow(cur, HALF + RA[i]) * (unsigned)K + (unsigned)CA[i]) * 2u; }
  const char* cB = (const char*)g.Bt + (size_t)cur.pn * tstep;
  PG8_STAGE(PG8_SB(0, 0), cB, voffB); PG8_STAGE(PG8_SB(0, 1), cB + hstep, voffB); PG8_STAGE(PG8_SA(0, 0), Ab, cvo0); PG8_STAGE(PG8_SA(0, 1), Ab, cvo1);
  if (wr == 1) PG8_BAR;
  PG8_WAIT_V(2); PG8_BAR;
  PG8_STAGE(PG8_SB(1, 0), cB + kstep, voffB); PG8_STAGE(PG8_SA(1, 0), Ab + kstep, cvo0); PG8_STAGE(PG8_SB(1, 1), cB + hstep + kstep, voffB);
  PG8_WAIT_V(6); PG8_BAR;
  for (;;) {
    const bool has_next = S.next(ui + 1, nxt);
    if (!has_next) nxt = cur;
#pragma unroll
    for (int i = 0; i < 2; ++i) { nvo0[i] = ((unsigned)S.arow(nxt, RA[i]) * (unsigned)K + (unsigned)CA[i]) * 2u; nvo1[i] = ((unsigned)S.arow(nxt, HALF + RA[i]) * (unsigned)K + (unsigned)CA[i]) * 2u; }
    const char* nB = (const char*)g.Bt + (size_t)nxt.pn * tstep;
    for (int t = 0; t < nt; t += 2) {
      const bool last = (t == nt - 2);
      if constexpr (Epi::MIDHOOK) { if (t == 8 || t == 16) E.mid(acc, cur, (t >> 3) - 1, wr, wc, fr, fq); }
      const char* a1 = Ab + (size_t)(t + 1) * kstep;
      const char* a2 = last ? Ab : Ab + (size_t)(t + 2) * kstep; const char* b2 = last ? nB : cB + (size_t)(t + 2) * kstep;
      const char* a3 = a2 + kstep; const char* b3 = b2 + kstep;
      unsigned vo0[2], vo1[2];
#pragma unroll
      for (int i = 0; i < 2; ++i) { vo0[i] = last ? nvo0[i] : cvo0[i]; vo1[i] = last ? nvo1[i] : cvo1[i]; }
      PG8_LDB(B0, 0, 0); PG8_LDB(B1, 0, 1); PG8_SCHED; PG8_LDA(At, 0, 0); PG8_STAGE(PG8_SA(1, 1), a1, cvo1);
      PG8_WAIT_V(8); PG8_WAIT_L(0); PG8_BAR; PG8_MMA(0, 0, At, B0); PG8_MMA(0, 1, At, B1); PG8_BAR; PG8_SCHED;
      PG8_LDA(At, 0, 1); PG8_STAGE(PG8_SB(0, 0), b2, voffB); PG8_STAGE(PG8_SB(0, 1), b2 + hstep, voffB); PG8_STAGE(PG8_SA(0, 0), a2, vo0);
      PG8_WAIT_V(8); PG8_WAIT_L(0); PG8_BAR; PG8_MMA(1, 0, At, B0); PG8_MMA(1, 1, At, B1); PG8_BAR; PG8_SCHED;
      PG8_LDB(B0, 1, 0); PG8_LDB(B1, 1, 1); PG8_SCHED; PG8_LDA(At, 1, 0); PG8_STAGE(PG8_SA(0, 1), a2, vo1);
      PG8_WAIT_V(8); PG8_WAIT_L(0); PG8_BAR; PG8_MMA(0, 0, At, B0); PG8_MMA(0, 1, At, B1); PG8_BAR; PG8_SCHED;
      PG8_LDA(At, 1, 1); PG8_STAGE(PG8_SB(1, 0), b3, voffB); PG8_STAGE(PG8_SB(1, 1), b3 + hstep, voffB); PG8_STAGE(PG8_SA(1, 0), a3, vo0);
      PG8_WAIT_V(8); PG8_WAIT_L(0); PG8_BAR; PG8_MMA(1, 0, At, B0); PG8_MMA(1, 1, At, B1); PG8_BAR; PG8_SCHED;
    }
    if constexpr (ALIGN_EPI) { if (wr == 0) PG8_BAR; }
    E(acc, cur, wr, wc, fr, fq);
    if (!has_next) break;
#pragma unroll
    for (int a = 0; a < 2; ++a)
#pragma unroll
      for (int b = 0; b < 2; ++b)
#pragma unroll
        for (int m = 0; m < 4; ++m)
#pragma unroll
          for (int n = 0; n < 2; ++n) acc[a][b][m][n] = (f32x4){0.f, 0.f, 0.f, 0.f};
    cur = nxt; cB = nB; ++ui;
#pragma unroll
    for (int i = 0; i < 2; ++i) { cvo0[i] = nvo0[i]; cvo1[i] = nvo1[i]; }
    if constexpr (ALIGN_EPI) { if (wr == 1) PG8_BAR; }
  }
  PG8_WAIT_V(0);
  if constexpr (!ALIGN_EPI) { if (wr == 0) PG8_BAR; }
  PG8_BAR;
#undef PG8_SA
#undef PG8_SB
#undef PG8_STAGE
#undef PG8_LDA
#undef PG8_LDB
#undef PG8_MMA
#undef PG8_WAIT_V
#undef PG8_WAIT_L
#undef PG8_BAR
#undef PG8_SCHED
}

struct EpiStoreBf16 {
  static constexpr bool PERM = true, MIDHOOK = false;
  bf16_t* O; int ldc;
  DI void operator()(const f32x4 (&acc)[2][2][4][2], const Unit& u, int wr, int wc, int fr, int fq) const {
    const int row0 = u.pm * BM + wr * 64 + fr, col0 = u.pn * BM + wc * 32 + 8 * fq;
#pragma unroll
    for (int ai = 0; ai < 2; ++ai)
#pragma unroll
      for (int m = 0; m < 4; ++m) { bf16_t* rowp = O + (size_t)(row0 + ai * HALF + m * 16) * ldc + col0;
#pragma unroll
        for (int bj = 0; bj < 2; ++bj) { const f32x4 v0 = acc[ai][bj][m][0], v1 = acc[ai][bj][m][1];
          u32x4 w; w.x = pk_bf16(v0[0], v0[1]); w.y = pk_bf16(v0[2], v0[3]); w.z = pk_bf16(v1[0], v1[1]); w.w = pk_bf16(v1[2], v1[3]);
          *(u32x4*)(rowp + bj * HALF) = w; } }
  }
};
struct EpiMixed {
  static constexpr bool PERM = true, MIDHOOK = true;
  const bf16_t* proj; bf16_t* O;
  DI static float e_neg(float a) { return __expf(-fminf(fmaxf(a, -40.f), 40.f)); }
  DI void mid(f32x4 (&acc)[2][2][4][2], const Unit& u, int b, int wr, int wc, int fr, int fq) const {
    int row0 = u.pm * BM + wr * 64 + fr; const int col0 = u.pn * BM + wc * 32 + 8 * fq;
    asm volatile("" : "+v"(row0));
#pragma unroll
    for (int ai = 0; ai < 2; ++ai)
#pragma unroll
      for (int m = 0; m < 4; ++m) { const bf16_t* gp = proj + (size_t)(row0 + ai * HALF + m * 16) * NPROJ + C_GATE + b * DM + col0;
#pragma unroll
        for (int bj = 0; bj < 2; ++bj) { const u32x4 ga = *(const u32x4*)(gp + bj * HALF), gb = *(const u32x4*)(gp + DM + bj * HALF);
#pragma unroll
          for (int q = 0; q < 4; ++q) {
            const float r0 = (1.f + e_neg(bflo(gb[q]))) * __frcp_rn(1.f + e_neg(bflo(ga[q])));
            const float r1 = (1.f + e_neg(bfhi(gb[q]))) * __frcp_rn(1.f + e_neg(bfhi(ga[q])));
            acc[ai][bj][m][q >> 1][(q & 1) * 2] *= r0; acc[ai][bj][m][q >> 1][(q & 1) * 2 + 1] *= r1; }
          asm volatile("" ::: "memory"); } }
  }
  DI void operator()(const f32x4 (&acc)[2][2][4][2], const Unit& u, int wr, int wc, int fr, int fq) const {
    const int row0 = u.pm * BM + wr * 64 + fr, col0 = u.pn * BM + wc * 32 + 8 * fq;
#pragma unroll
    for (int ai = 0; ai < 2; ++ai)
#pragma unroll
      for (int m = 0; m < 4; ++m) { const int row = row0 + ai * HALF + m * 16; const bf16_t* gp = proj + (size_t)row * NPROJ + C_GATE + 2 * DM + col0;
#pragma unroll
        for (int bj = 0; bj < 2; ++bj) { const u32x4 ga = *(const u32x4*)(gp + bj * HALF); float o[8];
#pragma unroll
          for (int q = 0; q < 4; ++q) {
            o[2 * q] = acc[ai][bj][m][q >> 1][(q & 1) * 2] * __frcp_rn(1.f + e_neg(bflo(ga[q])));
            o[2 * q + 1] = acc[ai][bj][m][q >> 1][(q & 1) * 2 + 1] * __frcp_rn(1.f + e_neg(bfhi(ga[q]))); }
          u32x4 w; w.x = pk_bf16(o[0], o[1]); w.y = pk_bf16(o[2], o[3]); w.z = pk_bf16(o[4], o[5]); w.w = pk_bf16(o[6], o[7]);
          *(u32x4*)(O + (size_t)row * DM + col0 + bj * HALF) = w; asm volatile("" ::: "memory"); } }
  }
};
struct EpiH {
  static constexpr bool PERM = false, MIDHOOK = false;
  const float* x; float* h;
  DI void operator()(const f32x4 (&acc)[2][2][4][2], const Unit& u, int wr, int wc, int fr, int fq) const {
    const int row0 = u.pm * BM + wr * 64 + fr, col0 = u.pn * BM + wc * 32 + 4 * fq;
#pragma unroll
    for (int ai = 0; ai < 2; ++ai)
#pragma unroll
      for (int m = 0; m < 4; ++m) { const size_t off = (size_t)(row0 + ai * HALF + m * 16) * DM + col0;
#pragma unroll
        for (int bj = 0; bj < 2; ++bj)
#pragma unroll
          for (int n = 0; n < 2; ++n) { const f32x4 xv = *(const f32x4*)(x + off + bj * HALF + n * 16); *(f32x4*)(h + off + bj * HALF + n * 16) = xv * DN_ALPHA + acc[ai][bj][m][n]; }
        asm volatile("" ::: "memory"); }
  }
};
struct EpiGateUp {
  static constexpr bool PERM = true, MIDHOOK = false;
  const float* bgu; bf16_t* act;
  DI void operator()(const f32x4 (&acc)[2][2][4][2], const Unit& u, int wr, int wc, int fr, int fq) const {
    const int e = u.pn >> 3, pnl = u.pn & 7, row0 = u.pm * BM + wr * 64 + fr, j0 = pnl * 128 + wc * 32 + 8 * fq;
    f32x4 bg[2], bl[2];
#pragma unroll
    for (int n = 0; n < 2; ++n) { bg[n] = *(const f32x4*)(bgu + (size_t)e * 2048 + j0 + 4 * n); bl[n] = *(const f32x4*)(bgu + (size_t)e * 2048 + 1024 + j0 + 4 * n); }
#pragma unroll
    for (int ai = 0; ai < 2; ++ai)
#pragma unroll
      for (int m = 0; m < 4; ++m) { float o[8];
#pragma unroll
        for (int n = 0; n < 2; ++n)
#pragma unroll
          for (int j = 0; j < 4; ++j) { const float glu = fminf(acc[ai][0][m][n][j] + bg[n][j], SWIGLU_LIMIT); const float lin = fminf(fmaxf(acc[ai][1][m][n][j] + bl[n][j], -SWIGLU_LIMIT), SWIGLU_LIMIT);
            o[4 * n + j] = glu * __frcp_rn(1.f + __expf(-SWIGLU_ALPHA * glu)) * (lin + 1.f); }
        u32x4 w; w.x = pk_bf16(o[0], o[1]); w.y = pk_bf16(o[2], o[3]); w.z = pk_bf16(o[4], o[5]); w.w = pk_bf16(o[6], o[7]);
        *(u32x4*)(act + (size_t)(row0 + ai * HALF + m * 16) * DFF + j0) = w; }
  }
};
struct EpiDown {
  static constexpr bool PERM = true, MIDHOOK = false;
  const float* bdn; const LAS int* tab; const u32x2* rinfo; bf16_t* ypair;
  DI void operator()(const f32x4 (&acc)[2][2][4][2], const Unit& u, int wr, int wc, int fr, int fq) const {
    const int e = u.pn >> 2, pnl = u.pn & 3, col0 = pnl * BM + wc * 32 + 8 * fq;
    const int local0 = u.pm * BM - tab[32 + e] + wr * 64 + fr, cnt = tab[e];
    f32x4 bv[2][2];
#pragma unroll
    for (int bj = 0; bj < 2; ++bj)
#pragma unroll
      for (int n = 0; n < 2; ++n) bv[bj][n] = *(const f32x4*)(bdn + (size_t)e * DM + col0 + bj * HALF + 4 * n);
#pragma unroll
    for (int ai = 0; ai < 2; ++ai)
#pragma unroll
      for (int m = 0; m < 4; ++m) { const int local = local0 + ai * HALF + m * 16;
        if (local < cnt) { const u32x2 info = rinfo[(size_t)e * ECAP + local]; const float gate = __uint_as_float(info.y); bf16_t* rowp = ypair + (size_t)info.x * DM + col0;
#pragma unroll
          for (int bj = 0; bj < 2; ++bj) { const f32x4 v0 = (acc[ai][bj][m][0] + bv[bj][0]) * gate, v1 = (acc[ai][bj][m][1] + bv[bj][1]) * gate;
            u32x4 w; w.x = pk_bf16(v0[0], v0[1]); w.y = pk_bf16(v0[2], v0[3]); w.z = pk_bf16(v1[0], v1[1]); w.w = pk_bf16(v1[2], v1[3]);
            *(u32x4*)(rowp + bj * HALF) = w; } } }
  }
};
}
#if NAIVE_ANY
template <class F> DI void naive_gemm(const Ctx& c, const bf16_t* A, int lda, const bf16_t* Bt, int ldb, int M, int N, int K, F epi) {
  const int r = c.lane & 31, h = c.lane >> 5, tn_n = N / 32, tiles = (M / 32) * tn_n;
  for (int tile = c.gw; tile < tiles; tile += c.ngw) {
    const int tm = tile / tn_n, tn = tile - tm * tn_n;
    const bf16_t* ap = A + (size_t)(tm * 32 + r) * lda + 8 * h; const bf16_t* bp = Bt + (size_t)(tn * 32 + r) * ldb + 8 * h;
    f32x16 acc; for (int i = 0; i < 16; ++i) acc[i] = 0.f;
    for (int k0 = 0; k0 < K; k0 += 16) { const bf16x8 a = *(const bf16x8*)(ap + k0), b = *(const bf16x8*)(bp + k0); acc = MFMA32(a, b, acc); }
#pragma unroll
    for (int i = 0; i < 16; ++i) epi(tm * 32 + crow(i, h), tn * 32 + r, acc[i]);
  }
}
#endif

#if NAIVE_GDN
DI void naive_gdn_prep(const Ctx& c) {
  const bf16_t* proj = (const bf16_t*)(c.p.ws + WS_PROJ); bf16_t* qkv = (bf16_t*)(c.p.ws + WS_GDN); const float* wc = c.p.in[I_WCONV];
  for (int it = c.gw; it < TT * 4; it += c.ngw) {
    const int t = it >> 2, hh = it & 3, tl = t & (SEQ - 1);
    float val[3][2];
#pragma unroll
    for (int part = 0; part < 3; ++part)
#pragma unroll
      for (int e = 0; e < 2; ++e) { const int ch = part * 512 + hh * 128 + 2 * c.lane + e; float a = 0.f;
#pragma unroll
        for (int j = 0; j < 4; ++j) { const int ts = tl - 3 + j; if (ts >= 0) a += wc[j * 1536 + ch] * bf2f(proj[(size_t)(t - 3 + j) * NPROJ + ch]); }
        val[part][e] = a * sigmoidf_(a); }
    const float sq = wave_sum(val[0][0] * val[0][0] + val[0][1] * val[0][1]), sk = wave_sum(val[1][0] * val[1][0] + val[1][1] * val[1][1]);
    const float rq = rsqrtf(sq + NORM_EPS) * 0.08838834764831845f, rk = rsqrtf(sk + NORM_EPS);
    bf16_t* o = qkv + ((size_t)t * 4 + hh) * 384 + 2 * c.lane;
    *(unsigned*)(o) = pk_bf16(val[0][0] * rq, val[0][1] * rq); *(unsigned*)(o + 128) = pk_bf16(val[1][0] * rk, val[1][1] * rk); *(unsigned*)(o + 256) = pk_bf16(val[2][0], val[2][1]);
  }
}
DI void naive_gdn_scan(const Ctx& c) {
  if (c.bid >= 64) return;
  const int b = c.bid >> 2, hh = c.bid & 3, j = c.tid;
  const bf16_t* qkv = (const bf16_t*)(c.p.ws + WS_GDN); const float* gbeta = (const float*)(c.p.ws + WS_MISC); bf16_t* ycat = (bf16_t*)(c.p.ws + WS_YCAT);
  LAS float* sq = (LAS float*)c.lds; LAS float* sk = sq + 8 * 128;
  float S[128];
#pragma unroll
  for (int d = 0; d < 128; ++d) S[d] = 0.f;
  for (int t0 = 0; t0 < SEQ; t0 += 8) {
    __syncthreads();
    for (int i = c.tid; i < 8 * 256; i += 512) { const int tt = i >> 8, d = i & 255; const size_t t = (size_t)b * SEQ + t0 + tt;
      const float v = bf2f(qkv[(t * 4 + hh) * 384 + d]); if (d < 128) sq[tt * 128 + d] = v; else sk[tt * 128 + d - 128] = v; }
    __syncthreads();
    if (j < 128) {
      for (int tt = 0; tt < 8; ++tt) { const size_t t = (size_t)b * SEQ + t0 + tt;
        const float g = gbeta[t * 8 + hh], beta = gbeta[t * 8 + 4 + hh], dec = __expf(g), vt = bf2f(qkv[(t * 4 + hh) * 384 + 256 + j]);
        float ks = 0.f;
#pragma unroll
        for (int d = 0; d < 128; ++d) ks += sk[tt * 128 + d] * S[d];
        const float vn = beta * (vt - dec * ks); float o = 0.f;
#pragma unroll
        for (int d = 0; d < 128; ++d) { S[d] = dec * S[d] + sk[tt * 128 + d] * vn; o += sq[tt * 128 + d] * S[d]; }
        ycat[t * 1536 + hh * 128 + j] = f2bf(o); }
    }
  }
}
#endif

#if NAIVE_ATTN
DI void naive_sb(const Ctx& c) {
  const bf16_t* proj = (const bf16_t*)(c.p.ws + WS_PROJ); bf16_t* ycat = (bf16_t*)(c.p.ws + WS_YCAT);
  LAS float* wl = (LAS float*)c.lds + c.wave * 64;
  for (int it = c.gw; it < NB * 8 * SEQ; it += c.ngw) {
    const int tq = it & (SEQ - 1), hh = (it >> 11) & 7, b = it >> 14; const size_t trow = (size_t)b * SEQ + tq;
    float q[64];
    { const bf16_t* qp = proj + trow * NPROJ + C_SQ + hh * 64;
#pragma unroll
      for (int d8 = 0; d8 < 8; ++d8) { const u32x4 w = *(const u32x4*)(qp + 8 * d8);
#pragma unroll
        for (int e = 0; e < 4; ++e) { q[8 * d8 + 2 * e] = bflo(w[e]); q[8 * d8 + 2 * e + 1] = bfhi(w[e]); } } }
    float carry = 0.f, o = 0.f;
    for (int kt = (tq - 1) >> 6; kt >= 0 && tq > 0; --kt) {
      const int s = kt * 64 + c.lane; const bool valid = s < tq; const size_t srow = (size_t)b * SEQ + (valid ? s : 0);
      const bf16_t* kp = proj + srow * NPROJ + C_SK + hh * 64; float z = 0.f;
#pragma unroll
      for (int d8 = 0; d8 < 8; ++d8) { const u32x4 w = *(const u32x4*)(kp + 8 * d8);
#pragma unroll
        for (int e = 0; e < 4; ++e) z += q[8 * d8 + 2 * e] * bflo(w[e]) + q[8 * d8 + 2 * e + 1] * bfhi(w[e]); }
      z *= 0.125f;
      const float sp = valid ? softplusf_(z) : 0.f;
      float suf = sp;
#pragma unroll
      for (int off = 1; off < 64; off <<= 1) { const float o2 = __shfl_down(suf, off); if (c.lane + off < 64) suf += o2; }
      const float w = valid ? __expf(z - (carry + suf)) : 0.f;
      carry += __shfl(suf, 0);
      LDS_WAIT(); wl[c.lane] = w; LDS_WAIT();
      const int smax = min(64, tq - kt * 64);
      for (int ss = 0; ss < smax; ++ss) o += wl[ss] * bf2f(proj[((size_t)b * SEQ + kt * 64 + ss) * NPROJ + C_SV + hh * 64 + c.lane]);
      LDS_WAIT();
    }
    ycat[trow * 1536 + 512 + hh * 64 + c.lane] = f2bf(o);
  }
}
DI void naive_mem(const Ctx& c) {
  const bf16_t* proj = (const bf16_t*)(c.p.ws + WS_PROJ); const bf16_t* mkv = (const bf16_t*)(c.p.ws + WS_MKV); bf16_t* ycat = (bf16_t*)(c.p.ws + WS_YCAT);
  LAS float* pl = (LAS float*)(c.lds + 4096) + c.wave * 256;
  for (int it = c.gw; it < NB * 4 * SEQ; it += c.ngw) {
    const int tq = it & (SEQ - 1), hh = (it >> 11) & 3, b = it >> 13; const size_t trow = (size_t)b * SEQ + tq;
    const bf16_t* qp = proj + trow * NPROJ + C_MQ + hh * 128;
    float sc[4];
#pragma unroll
    for (int kt = 0; kt < 4; ++kt) { const bf16_t* kp = mkv + (size_t)(b * MEMLEN + kt * 64 + c.lane) * 1024 + hh * 128; float z = 0.f;
      for (int d8 = 0; d8 < 16; ++d8) { const u32x4 w = *(const u32x4*)(kp + 8 * d8), qw = *(const u32x4*)(qp + 8 * d8);
#pragma unroll
        for (int e = 0; e < 4; ++e) z += bflo(qw[e]) * bflo(w[e]) + bfhi(qw[e]) * bfhi(w[e]); }
      sc[kt] = z * 0.08838834764831845f; }
    const float mx = wave_max(fmaxf(fmaxf(sc[0], sc[1]), fmaxf(sc[2], sc[3])));
    float pe[4], ssum = 0.f;
#pragma unroll
    for (int kt = 0; kt < 4; ++kt) { pe[kt] = __expf(sc[kt] - mx); ssum += pe[kt]; }
    ssum = wave_sum(ssum);
    LDS_WAIT();
#pragma unroll
    for (int kt = 0; kt < 4; ++kt) pl[kt * 64 + c.lane] = pe[kt] / ssum;
    LDS_WAIT();
    float o0 = 0.f, o1 = 0.f;
    for (int s = 0; s < 256; ++s) { const unsigned vv = *(const unsigned*)(mkv + (size_t)(b * MEMLEN + s) * 1024 + 512 + hh * 128 + 2 * c.lane); const float pw = pl[s]; o0 += pw * bflo(vv); o1 += pw * bfhi(vv); }
    LDS_WAIT();
    *(unsigned*)(ycat + trow * 1536 + 1024 + hh * 128 + 2 * c.lane) = pk_bf16(o0, o1);
  }
}
#endif
DI void tr_item(const float* src, int ldw, bf16_t* dst, int ldd, LAS float* scr, int lane) {
#pragma unroll
  for (int i = 0; i < 8; ++i) { const int kk = 8 * i + (lane >> 3); const f32x4 v = *(const f32x4*)(src + (size_t)kk * ldw + 4 * (lane & 7));
    LAS float* s = scr + kk * 33 + 4 * (lane & 7); s[0] = v.x; s[1] = v.y; s[2] = v.z; s[3] = v.w; }
  LDS_WAIT();
  const int cc = lane & 7;
#pragma unroll
  for (int j = 0; j < 4; ++j) { const int n = (lane >> 3) + 8 * j; const LAS float* s = scr + (8 * cc) * 33 + n;
    u32x4 o; o.x = pk_bf16(s[0 * 33], s[1 * 33]); o.y = pk_bf16(s[2 * 33], s[3 * 33]); o.z = pk_bf16(s[4 * 33], s[5 * 33]); o.w = pk_bf16(s[6 * 33], s[7 * 33]);
    *(u32x4*)(dst + (size_t)n * ldd + 8 * cc) = o; }
  LDS_WAIT();
}
DI void phase0(const Ctx& c) {
  unsigned char* ws = c.p.ws;
  if (c.bid == 0 && c.tid < 32) ((int*)(ws + WS_MISC + MiB))[c.tid] = 0;
  {
    LAS float* scr = (LAS float*)(c.lds + c.wave * 8448);
    for (int r = c.gw; r < 16 * 224; r += c.ngw) { const int kb = r / 224, nb = r % 224; const int n0 = 32 * nb + (nb >= 64 ? 8 : 0);
      tr_item(c.p.in[I_WIN] + (size_t)(64 * kb) * 7176 + n0, 7176, (bf16_t*)(ws + WS_WIN) + (size_t)(32 * nb) * 1024 + 64 * kb, 1024, scr, c.lane); }
    for (int r = (c.gw + 512) % c.ngw; r < 16 * 32; r += c.ngw) { const int kb = r / 32, nb = r % 32;
      tr_item(c.p.in[I_WMKV] + (size_t)(64 * kb) * 1024 + 32 * nb, 1024, (bf16_t*)(ws + WS_WMKV) + (size_t)(32 * nb) * 1024 + 64 * kb, 1024, scr, c.lane); }
    for (int r = (c.gw + 1024) % c.ngw; r < 8 * 32; r += c.ngw) { const int kb = r / 32, nb = r % 32;
      tr_item(c.p.in[I_WPG] + (size_t)(64 * kb) * 1024 + 32 * nb, 1024, (bf16_t*)(ws + WS_WP) + (size_t)(32 * nb) * 1536 + 0 * 512 + 64 * kb, 1536, scr, c.lane); }
    for (int r = (c.gw + 1280) % c.ngw; r < 8 * 32; r += c.ngw) { const int kb = r / 32, nb = r % 32;
      tr_item(c.p.in[I_WPS] + (size_t)(64 * kb) * 1024 + 32 * nb, 1024, (bf16_t*)(ws + WS_WP) + (size_t)(32 * nb) * 1536 + 1 * 512 + 64 * kb, 1536, scr, c.lane); }
    for (int r = (c.gw + 1536) % c.ngw; r < 8 * 32; r += c.ngw) { const int kb = r / 32, nb = r % 32;
      tr_item(c.p.in[I_WPM] + (size_t)(64 * kb) * 1024 + 32 * nb, 1024, (bf16_t*)(ws + WS_WP) + (size_t)(32 * nb) * 1536 + 2 * 512 + 64 * kb, 1536, scr, c.lane); }
    for (int r = (c.gw + 1792) % c.ngw; r < 16 * 32; r += c.ngw) { const int kb = r / 32, nb = r % 32;
      tr_item(c.p.in[I_WO] + (size_t)(64 * kb) * 1024 + 32 * nb, 1024, (bf16_t*)(ws + WS_WO) + (size_t)(32 * nb) * 1024 + 64 * kb, 1024, scr, c.lane); }
    for (int r = c.gw; r < 32 * 16 * 64; r += c.ngw) { const int e = r / 1024, q = r % 1024, kb = q / 64, nb = q % 64; const int r0 = 32 * nb, n0 = ((r0 >> 7) & 1) * 1024 + (r0 >> 8) * 128 + (r0 & 127);
      tr_item(c.p.in[I_WGU] + (size_t)e * 1024 * 2048 + (size_t)(64 * kb) * 2048 + n0, 2048, (bf16_t*)(ws + WS_WGU) + ((size_t)e * 2048 + r0) * 1024 + 64 * kb, 1024, scr, c.lane); }
    for (int r = c.gw; r < 32 * 16 * 32; r += c.ngw) { const int e = r / 512, q = r % 512, kb = q / 32, nb = q % 32;
      tr_item(c.p.in[I_WDN] + (size_t)e * 1024 * 1024 + (size_t)(64 * kb) * 1024 + 32 * nb, 1024, (bf16_t*)(ws + WS_WDN) + ((size_t)e * 1024 + 32 * nb) * 1024 + 64 * kb, 1024, scr, c.lane); }
  }
  { const f32x4* src = (const f32x4*)c.p.in[I_MEM]; u32x2* dst = (u32x2*)(ws + WS_MEMB);
    for (int i = c.bid * 512 + c.tid; i < NB * MEMLEN * DM / 4; i += c.G * 512) { const f32x4 v = src[i]; u32x2 o; o.x = pk_bf16(v.x, v.y); o.y = pk_bf16(v.z, v.w); dst[i] = o; } }
  {
    float wab[4][4][8];
#pragma unroll
    for (int j = 0; j < 4; ++j)
#pragma unroll
      for (int i = 0; i < 4; ++i) { const float* wp = c.p.in[I_WIN] + (size_t)(256 * j + 4 * c.lane + i) * 7176 + 2048; const f32x4 a = *(const f32x4*)wp, b = *(const f32x4*)(wp + 4);
        wab[j][i][0] = a.x; wab[j][i][1] = a.y; wab[j][i][2] = a.z; wab[j][i][3] = a.w; wab[j][i][4] = b.x; wab[j][i][5] = b.y; wab[j][i][6] = b.z; wab[j][i][7] = b.w; }
    const int hh = c.lane & 3; const float nega = -__expf(c.p.in[I_ALOG][hh]), dtb = c.p.in[I_DTB][hh];
    float* gbeta = (float*)(ws + WS_MISC);
    for (int m = c.gw; m < TT; m += c.ngw) {
      const f32x4* xr = (const f32x4*)(c.p.in[I_X] + (size_t)m * DM) + c.lane; u32x2* xo = (u32x2*)(ws + WS_XB + (size_t)m * DM * 2) + c.lane;
      float s[8];
#pragma unroll
      for (int q = 0; q < 8; ++q) s[q] = 0.f;
#pragma unroll
      for (int j = 0; j < 4; ++j) { const f32x4 v = xr[64 * j]; u32x2 o; o.x = pk_bf16(v.x, v.y); o.y = pk_bf16(v.z, v.w); xo[64 * j] = o;
#pragma unroll
        for (int q = 0; q < 8; ++q) s[q] += v.x * wab[j][0][q] + v.y * wab[j][1][q] + v.z * wab[j][2][q] + v.w * wab[j][3][q]; }
#pragma unroll
      for (int q = 0; q < 8; ++q) s[q] = wave_sum(s[q]);
      if (c.lane < 8) {
        float pre = s[0];
#pragma unroll
        for (int q = 1; q < 8; ++q) pre = (c.lane == q) ? s[q] : pre;
        const float val = c.lane < 4 ? nega * softplusf_(pre + dtb) : sigmoidf_(pre);
        gbeta[(size_t)m * 8 + c.lane] = val;
      }
    }
  }
}

DI void phase_gdn_norm(const Ctx& c) {
  bf16_t* ycat = (bf16_t*)(c.p.ws + WS_YCAT); const bf16_t* proj = (const bf16_t*)(c.p.ws + WS_PROJ); const float* nw = c.p.in[I_GNW];
  const float w0 = nw[2 * c.lane], w1 = nw[2 * c.lane + 1];
  for (int it = c.gw; it < TT * 4; it += c.ngw) {
    const int t = it >> 2, hh = it & 3;
    unsigned* op = (unsigned*)(ycat + (size_t)t * 1536 + hh * 128) + c.lane; const unsigned ov = *op, zv = *((const unsigned*)(proj + (size_t)t * NPROJ + C_GZ + hh * 128) + c.lane);
    const float o0 = bflo(ov), o1 = bfhi(ov), z0 = bflo(zv), z1 = bfhi(zv);
    const float rs = rsqrtf(wave_sum(o0 * o0 + o1 * o1) * (1.f / 128.f) + NORM_EPS);
    *op = pk_bf16(o0 * rs * w0 * (z0 * sigmoidf_(z0)), o1 * rs * w1 * (z1 * sigmoidf_(z1)));
  }
}

DI void phase_router(const Ctx& c) {
  unsigned char* ws = c.p.ws;
  const float* h = (const float*)(ws + WS_H); float* x1 = (float*)(ws + WS_X1); bf16_t* x1b = (bf16_t*)(ws + WS_X1B);
  const float* wr = c.p.in[I_WR]; int* gcount = (int*)(ws + WS_MISC + MiB); u32x2* rinfo = (u32x2*)(ws + WS_RINFO);
  LAS float* xs = (LAS float*)(c.lds + c.wave * 16384);
  LAS int* wcnt = (LAS int*)(c.lds + 131072);
  LAS int* bbase = wcnt + 256;
  const int e = c.lane & 31, half = c.lane >> 5;
  f32x4 gam[4], bet[4];
#pragma unroll
  for (int j = 0; j < 4; ++j) { gam[j] = ((const f32x4*)c.p.in[I_LN1G])[64 * j + c.lane]; bet[j] = ((const f32x4*)c.p.in[I_LN1B])[64 * j + c.lane]; }
  const float brv = c.p.in[I_BR][e];
  int mycnt = 0;
  LAS int* sel_e = bbase + 32 + c.wave * 64; LAS int* sel_pos = sel_e + 512; LAS float* sel_g = (LAS float*)(sel_e + 1024);
  for (int gi = c.bid; gi < TT / 128; gi += c.G) {
    const int tok0 = gi * 128 + c.wave * 16;
#pragma unroll
    for (int qd = 0; qd < 4; ++qd) {
      LDS_WAIT();
#pragma unroll
      for (int tt = 0; tt < 4; ++tt) {
        const size_t t = (size_t)tok0 + qd * 4 + tt;
        const f32x4* hr = (const f32x4*)(h + t * DM) + c.lane; f32x4 v[4]; float s = 0.f;
#pragma unroll
        for (int j = 0; j < 4; ++j) { v[j] = hr[64 * j]; s += (v[j].x + v[j].y) + (v[j].z + v[j].w); }
        const float mean = wave_sum(s) * (1.f / DM); float s2 = 0.f;
#pragma unroll
        for (int j = 0; j < 4; ++j) { v[j] = v[j] - mean; s2 += (v[j].x * v[j].x + v[j].y * v[j].y) + (v[j].z * v[j].z + v[j].w * v[j].w); }
        const float rstd = rsqrtf(wave_sum(s2) * (1.f / DM) + LN_EPS);
#pragma unroll
        for (int j = 0; j < 4; ++j) { const f32x4 y = v[j] * rstd * gam[j] + bet[j];
          ((f32x4*)(x1 + t * DM))[64 * j + c.lane] = y; u32x2 o; o.x = pk_bf16(y.x, y.y); o.y = pk_bf16(y.z, y.w); ((u32x2*)(x1b + t * DM))[64 * j + c.lane] = o;
          *(LAS f32x4*)(xs + tt * 1024 + 256 * j + 4 * c.lane) = y; }
      }
      LDS_WAIT();
      float lg[4] = {0.f, 0.f, 0.f, 0.f};
      const float* wp = wr + (size_t)(512 * half) * 32 + e; const LAS float* xp = xs + 512 * half;
      for (int k = 0; k < 512; k += 4) {
        const float w0 = wp[(k + 0) * 32], w1 = wp[(k + 1) * 32], w2 = wp[(k + 2) * 32], w3 = wp[(k + 3) * 32];
#pragma unroll
        for (int tt = 0; tt < 4; ++tt) { const f32x4 xv = *(const LAS f32x4*)(xp + tt * 1024 + k); lg[tt] += (xv.x * w0 + xv.y * w1) + (xv.z * w2 + xv.w * w3); }
      }
#pragma unroll
      for (int tt = 0; tt < 4; ++tt) {
        float logit = lg[tt] + __shfl_xor(lg[tt], 32) + brv;
        float tv[4]; int ti[4];
#pragma unroll
        for (int k = 0; k < 4; ++k) {
          float bv = logit; int bi = e;
#pragma unroll
          for (int o = 1; o < 32; o <<= 1) { const float ov = __shfl_xor(bv, o); const int oi = __shfl_xor(bi, o); if (ov > bv || (ov == bv && oi < bi)) { bv = ov; bi = oi; } }
          tv[k] = bv; ti[k] = bi; if (e == bi) logit = -INFINITY;
        }
        const float e1 = __expf(tv[1] - tv[0]), e2 = __expf(tv[2] - tv[0]), e3 = __expf(tv[3] - tv[0]), inv = 1.f / (1.f + e1 + e2 + e3);
        const float gk = (c.lane == 0 ? 1.f : c.lane == 1 ? e1 : c.lane == 2 ? e2 : e3) * inv;
        const int ek = c.lane == 0 ? ti[0] : c.lane == 1 ? ti[1] : c.lane == 2 ? ti[2] : ti[3];
        const int cnt_e = __shfl(mycnt, ek);
        const bool chosen = (e == ti[0]) | (e == ti[1]) | (e == ti[2]) | (e == ti[3]);
        if (c.lane < 32 && chosen) mycnt += 1;
        if (c.lane < 4) { sel_e[(qd * 4 + tt) * 4 + c.lane] = ek; sel_pos[(qd * 4 + tt) * 4 + c.lane] = cnt_e; sel_g[(qd * 4 + tt) * 4 + c.lane] = gk; }
      }
    }
    if (c.lane < 32) wcnt[c.wave * 32 + c.lane] = mycnt;
    __syncthreads();
    if (c.tid < 32) { int tot = 0;
#pragma unroll
      for (int w = 0; w < 8; ++w) tot += wcnt[w * 32 + c.tid];
      bbase[c.tid] = tot ? atomicAdd(gcount + c.tid, tot) : 0; }
    __syncthreads();
    if (c.lane < 4) {
#pragma unroll
      for (int i = 0; i < 16; ++i) { const int ek = sel_e[i * 4 + c.lane]; int base = bbase[ek];
        for (int w = 0; w < c.wave; ++w) base += wcnt[w * 32 + ek];
        u32x2 info; info.x = (unsigned)((tok0 + i) * 4 + c.lane); info.y = __float_as_uint(sel_g[i * 4 + c.lane]);
        rinfo[(size_t)ek * ECAP + base + sel_pos[i * 4 + c.lane]] = info; }
    }
    __syncthreads();
    mycnt = 0;
  }
}

DI void build_group_tab(const Ctx& c, LAS int* tab) {
  const int* gcount = (const int*)(c.p.ws + WS_MISC + MiB);
  __syncthreads();
  if (c.tid == 0) { int ps = 0;
    for (int e = 0; e < 32; ++e) { const int cnt = gcount[e]; tab[e] = cnt; tab[32 + e] = ps; const int nt_ = (cnt + 255) >> 8; for (int q = 0; q < nt_; ++q) tab[96 + (ps >> 8) + q] = e; ps += nt_ << 8; }
    tab[64] = ps; tab[65] = ps >> 8; }
  __syncthreads();
}

DI void phase_final(const Ctx& c) {
  const float* x1 = (const float*)(c.p.ws + WS_X1); const bf16_t* yp = (const bf16_t*)(c.p.ws + WS_YPAIR);
  f32x4 gam[4], bet[4];
#pragma unroll
  for (int j = 0; j < 4; ++j) { gam[j] = ((const f32x4*)c.p.in[I_LN2G])[64 * j + c.lane]; bet[j] = ((const f32x4*)c.p.in[I_LN2B])[64 * j + c.lane]; }
  for (int t = c.gw; t < TT; t += c.ngw) {
    f32x4 v[4]; float s = 0.f;
#pragma unroll
    for (int j = 0; j < 4; ++j) { v[j] = ((const f32x4*)(x1 + (size_t)t * DM))[64 * j + c.lane] * DN_ALPHA;
#pragma unroll
      for (int k = 0; k < 4; ++k) { const u32x2 w = ((const u32x2*)(yp + ((size_t)t * 4 + k) * DM))[64 * j + c.lane]; v[j].x += bflo(w.x); v[j].y += bfhi(w.x); v[j].z += bflo(w.y); v[j].w += bfhi(w.y); }
      s += (v[j].x + v[j].y) + (v[j].z + v[j].w); }
    const float mean = wave_sum(s) * (1.f / DM); float s2 = 0.f;
#pragma unroll
    for (int j = 0; j < 4; ++j) { v[j] = v[j] - mean; s2 += (v[j].x * v[j].x + v[j].y * v[j].y) + (v[j].z * v[j].z + v[j].w * v[j].w); }
    const float rstd = rsqrtf(wave_sum(s2) * (1.f / DM) + LN_EPS);
#pragma unroll
    for (int j = 0; j < 4; ++j) ((f32x4*)(c.p.out + (size_t)t * DM))[64 * j + c.lane] = v[j] * rstd * gam[j] + bet[j];
  }
}
DI bf16x8 pack8(const f32x16& x, int s) {
  u32x4 p; p.x = pk_bf16(x[8 * s + 0], x[8 * s + 1]); p.y = pk_bf16(x[8 * s + 2], x[8 * s + 3]); p.z = pk_bf16(x[8 * s + 4], x[8 * s + 5]); p.w = pk_bf16(x[8 * s + 6], x[8 * s + 7]);
  return __builtin_bit_cast(bf16x8, p);
}
DI void store8(bf16_t* dst, const f32x16& x, int s, float sc) {
  u32x4 p; p.x = pk_bf16(x[8 * s + 0] * sc, x[8 * s + 1] * sc); p.y = pk_bf16(x[8 * s + 2] * sc, x[8 * s + 3] * sc); p.z = pk_bf16(x[8 * s + 4] * sc, x[8 * s + 5] * sc); p.w = pk_bf16(x[8 * s + 6] * sc, x[8 * s + 7] * sc);
  *(u32x4*)dst = p;
}

#if !NAIVE_GDN
DI void phase_gdn_chunk(const Ctx& c) {
  unsigned char* ws = c.p.ws;
  const bf16_t* proj = (const bf16_t*)(ws + WS_PROJ); const float* gbeta = (const float*)(ws + WS_MISC); const float* wcv = c.p.in[I_WCONV];
  float* egl = (float*)(ws + WS_MISC + MiB + 4096);
  const int team = c.wave >> 2, tw = c.wave & 3, ttid = c.tid & 255, r = c.lane & 31, hf = c.lane >> 5;
  LAS unsigned char* tl = c.lds + team * 71680;
  LAS bf16_t* ks = (LAS bf16_t*)tl; LAS bf16_t* qs = (LAS bf16_t*)(tl + 17408); LAS bf16_t* kT = (LAS bf16_t*)(tl + 34816); LAS bf16_t* vT = (LAS bf16_t*)(tl + 53248);
  LAS float* Am = (LAS float*)(tl + 17408); LAS bf16_t* T1 = (LAS bf16_t*)tl; LAS bf16_t* T2 = (LAS bf16_t*)(tl + 9216);
  LAS float* sc = (LAS float*)(c.lds + 143360 + team * 1024);
  float wc[3][2][4];
  const int nchunk = NB * 4 * 32, niter = (nchunk + 2 * c.G - 1) / (2 * c.G);
  for (int itr = 0; itr < niter; ++itr) {
    const int ci_raw = (itr * c.G + c.bid) * 2 + team; const bool live = ci_raw < nchunk; const int ci = live ? ci_raw : 0;
    const int n = ci & 31, hh = (ci >> 5) & 3, b = ci >> 7; const int tok0 = b * SEQ + n * 64;
    unsigned char* cb = ws + WS_GDN + (size_t)ci * GDN_CHUNK_BYTES;
#pragma unroll
    for (int part = 0; part < 3; ++part)
#pragma unroll
      for (int e = 0; e < 2; ++e)
#pragma unroll
        for (int j = 0; j < 4; ++j) wc[part][e][j] = wcv[j * 1536 + part * 512 + hh * 128 + 2 * c.lane + e];
    const float gl = gbeta[(size_t)(tok0 + c.lane) * 8 + hh], bt = gbeta[(size_t)(tok0 + c.lane) * 8 + 4 + hh];
    float gc = gl;
#pragma unroll
    for (int off = 1; off < 64; off <<= 1) { const float o2 = __shfl_up(gc, off); if (c.lane >= off) gc += o2; }
    const float glast = __shfl(gc, 63);
    if (tw == 0) { sc[c.lane] = gc; sc[64 + c.lane] = bt; sc[128 + c.lane] = __expf(glast - gc); if (c.lane == 0 && live) egl[ci] = __expf(glast); }
    for (int i = 0; i < 16; ++i) {
      const int cc = tw * 16 + i, t = tok0 + cc, tloc = n * 64 + cc; float val[3][2];
#pragma unroll
      for (int part = 0; part < 3; ++part) { float a0 = 0.f, a1 = 0.f;
#pragma unroll
        for (int j = 0; j < 4; ++j) { if (tloc - 3 + j >= 0) { const unsigned pv = *(const unsigned*)(proj + (size_t)(t - 3 + j) * NPROJ + part * 512 + hh * 128 + 2 * c.lane); a0 += wc[part][0][j] * bflo(pv); a1 += wc[part][1][j] * bfhi(pv); } }
        val[part][0] = a0 * sigmoidf_(a0); val[part][1] = a1 * sigmoidf_(a1); }
      const float sq = wave_sum(val[0][0] * val[0][0] + val[0][1] * val[0][1]), sk = wave_sum(val[1][0] * val[1][0] + val[1][1] * val[1][1]);
      const float rq = rsqrtf(sq + NORM_EPS) * 0.08838834764831845f, rk = rsqrtf(sk + NORM_EPS);
      const float q0 = val[0][0] * rq, q1 = val[0][1] * rq, k0 = val[1][0] * rk, k1 = val[1][1] * rk;
      const unsigned kp = pk_bf16(k0, k1), vp = pk_bf16(val[2][0], val[2][1]);
      *(LAS unsigned*)(qs + cc * 136 + 2 * c.lane) = pk_bf16(q0, q1); *(LAS unsigned*)(ks + cc * 136 + 2 * c.lane) = kp;
      kT[(2 * c.lane) * 72 + cc] = (bf16_t)(kp & 0xffffu); kT[(2 * c.lane + 1) * 72 + cc] = (bf16_t)(kp >> 16);
      vT[(2 * c.lane) * 72 + cc] = (bf16_t)(vp & 0xffffu); vT[(2 * c.lane + 1) * 72 + cc] = (bf16_t)(vp >> 16);
      const float eg = __expf(__shfl(gc, cc));
      if (live) *(unsigned*)(cb + 16384 + (size_t)cc * 256 + 2 * swap23(2 * c.lane)) = pk_bf16(q0 * eg, q1 * eg);
    }
    __syncthreads();
    const int mi = tw >> 1, ni = tw & 1;
    f32x16 akk, aat;
#pragma unroll
    for (int i = 0; i < 16; ++i) { akk[i] = 0.f; aat[i] = 0.f; }
#pragma unroll
    for (int s = 0; s < 8; ++s) { const bf16x8 ka = *(const LAS bf16x8*)(ks + (32 * mi + r) * 136 + 16 * s + 8 * hf);
      akk = MFMA32(ka, *(const LAS bf16x8*)(ks + (32 * ni + r) * 136 + 16 * s + 8 * hf), akk);
      aat = MFMA32(ka, *(const LAS bf16x8*)(qs + (32 * ni + r) * 136 + 16 * s + 8 * hf), aat); }
    {
      const int cout = 32 * ni + r; const float gco = sc[cout];
#pragma unroll
      for (int i = 0; i < 16; ++i) { const int cr = 32 * mi + crow(i, hf); aat[i] = cout >= cr ? aat[i] * __expf(gco - sc[cr]) : 0.f; }
      if (live) { store8((bf16_t*)(cb + 65536 + (size_t)cout * 128) + 32 * mi + 8 * hf, aat, 0, 1.f); store8((bf16_t*)(cb + 65536 + (size_t)cout * 128) + 32 * mi + 16 + 8 * hf, aat, 1, 1.f); }
    }
    __syncthreads();
    { const int j = 32 * ni + r; const float gcj = sc[j];
#pragma unroll
      for (int i = 0; i < 16; ++i) { const int cr = 32 * mi + crow(i, hf); Am[cr * 64 + j] = cr > j ? akk[i] * __expf(sc[cr] - gcj) * sc[64 + cr] : 0.f; } }
    __syncthreads();
    if (tw == 0) {
      float t[64];
#pragma unroll
      for (int i = 0; i < 64; ++i) {
        float a0 = 0.f, a1 = 0.f, a2 = 0.f, a3 = 0.f;
#pragma unroll
        for (int m4 = 0; m4 < i; m4 += 4) { const f32x4 av = *(const LAS f32x4*)(Am + i * 64 + m4);
          a0 += av.x * t[m4]; if (m4 + 1 < i) a1 += av.y * t[m4 + 1]; if (m4 + 2 < i) a2 += av.z * t[m4 + 2]; if (m4 + 3 < i) a3 += av.w * t[m4 + 3]; }
        t[i] = (c.lane == i ? 1.f : 0.f) - ((a0 + a1) + (a2 + a3));
      }
      LDS_WAIT();
      const float bj = sc[64 + c.lane], bej = bj * __expf(sc[c.lane]);
#pragma unroll
      for (int i = 0; i < 64; ++i) { T1[i * 72 + c.lane] = f2bf(t[i] * bj); T2[i * 72 + c.lane] = f2bf(t[i] * bej); }
    } else {
      for (int it = ttid - 64; it < 1024; it += 192) { const int dk = it >> 3, s = (it >> 1) & 3, h2 = it & 1;
        const u32x2 lo = *(const LAS u32x2*)(kT + dk * 72 + 16 * s + 4 * h2), hi = *(const LAS u32x2*)(kT + dk * 72 + 16 * s + 8 + 4 * h2);
        const LAS float* e0 = sc + 128 + 16 * s + 4 * h2; const LAS float* e1 = e0 + 8;
        u32x4 o; o.x = pk_bf16(bflo(lo.x) * e0[0], bfhi(lo.x) * e0[1]); o.y = pk_bf16(bflo(lo.y) * e0[2], bfhi(lo.y) * e0[3]);
        o.z = pk_bf16(bflo(hi.x) * e1[0], bfhi(hi.x) * e1[1]); o.w = pk_bf16(bflo(hi.y) * e1[2], bfhi(hi.y) * e1[3]);
        if (live) *(u32x4*)(cb + 32768 + (size_t)dk * 128 + 2 * (16 * s + 8 * h2)) = o; }
    }
    __syncthreads();
#pragma unroll
    for (int q = 0; q < 2; ++q) {
      const int job = tw * 2 + q;
      const int mu = job & 1, nu = job >> 1, mw = job >> 1, nw = job & 1;
      f32x16 au, aw;
#pragma unroll
      for (int i = 0; i < 16; ++i) { au[i] = 0.f; aw[i] = 0.f; }
#pragma unroll
      for (int s = 0; s < 4; ++s) {
        au = MFMA32(*(const LAS bf16x8*)(T1 + (32 * mu + r) * 72 + 16 * s + 8 * hf), *(const LAS bf16x8*)(vT + (32 * nu + r) * 72 + 16 * s + 8 * hf), au);
        aw = MFMA32(*(const LAS bf16x8*)(kT + (32 * mw + r) * 72 + 16 * s + 8 * hf), *(const LAS bf16x8*)(T2 + (32 * nw + r) * 72 + 16 * s + 8 * hf), aw); }
      if (live) {
        bf16_t* up = (bf16_t*)(cb + 49152 + (size_t)(32 * nu + r) * 128) + 32 * mu + 8 * hf; store8(up, au, 0, 1.f); store8(up + 16, au, 1, 1.f);
        bf16_t* wp = (bf16_t*)(cb + (size_t)(32 * nw + r) * 256) + 32 * mw + 8 * hf; store8(wp, aw, 0, 1.f); store8(wp + 16, aw, 1, 1.f); }
    }
    __syncthreads();
  }
}

DI void phase_gdn_scan(const Ctx& c) {
  if (c.bid >= 64 || c.wave >= 4) return;
  const int b = c.bid >> 2, hh = c.bid & 3, dv0 = c.wave * 32, r = c.lane & 31, hf = c.lane >> 5;
  const unsigned char* ws = c.p.ws; const float* egl = (const float*)(ws + WS_MISC + MiB + 4096); bf16_t* ycat = (bf16_t*)(c.p.ws + WS_YCAT);
  f32x16 S[4];
#pragma unroll
  for (int m = 0; m < 4; ++m)
#pragma unroll
    for (int i = 0; i < 16; ++i) S[m][i] = 0.f;
  for (int n = 0; n < 32; ++n) {
    const int ci = (b * 4 + hh) * 32 + n; const unsigned char* cb = ws + WS_GDN + (size_t)ci * GDN_CHUNK_BYTES;
    const bf16_t* wP = (const bf16_t*)cb + (size_t)r * 128 + 8 * hf; const bf16_t* qP = (const bf16_t*)(cb + 16384) + (size_t)r * 128 + 8 * hf;
    const bf16_t* kP = (const bf16_t*)(cb + 32768) + (size_t)r * 64 + 8 * hf; const bf16_t* uP = (const bf16_t*)(cb + 49152) + (size_t)(dv0 + r) * 64 + 8 * hf;
    const bf16_t* aP = (const bf16_t*)(cb + 65536) + (size_t)r * 64 + 8 * hf;
    const float eg = egl[ci];
    bf16x8 Sb[8];
#pragma unroll
    for (int s = 0; s < 8; ++s) Sb[s] = pack8(S[s >> 1], s & 1);
    f32x16 vn[2], o[2];
#pragma unroll
    for (int m = 0; m < 2; ++m) {
#pragma unroll
      for (int i = 0; i < 16; ++i) { vn[m][i] = 0.f; o[m][i] = 0.f; }
#pragma unroll
      for (int s = 0; s < 8; ++s) { vn[m] = MFMA32(*(const bf16x8*)(wP + (size_t)m * 32 * 128 + 16 * s), Sb[s], vn[m]); o[m] = MFMA32(*(const bf16x8*)(qP + (size_t)m * 32 * 128 + 16 * s), Sb[s], o[m]); }
    }
#pragma unroll
    for (int m = 0; m < 2; ++m)
#pragma unroll
      for (int s2 = 0; s2 < 2; ++s2) { const u32x4 uv = *(const u32x4*)(uP + 16 * (2 * m + s2));
#pragma unroll
        for (int q = 0; q < 4; ++q) { vn[m][8 * s2 + 2 * q] = bflo(uv[q]) - vn[m][8 * s2 + 2 * q]; vn[m][8 * s2 + 2 * q + 1] = bfhi(uv[q]) - vn[m][8 * s2 + 2 * q + 1]; } }
    bf16x8 vb[4];
#pragma unroll
    for (int s = 0; s < 4; ++s) vb[s] = pack8(vn[s >> 1], s & 1);
#pragma unroll
    for (int m = 0; m < 2; ++m)
#pragma unroll
      for (int s = 0; s < 4; ++s) o[m] = MFMA32(*(const bf16x8*)(aP + (size_t)m * 32 * 64 + 16 * s), vb[s], o[m]);
#pragma unroll
    for (int m = 0; m < 4; ++m) {
#pragma unroll
      for (int i = 0; i < 16; ++i) S[m][i] *= eg;
#pragma unroll
      for (int s = 0; s < 4; ++s) S[m] = MFMA32(*(const bf16x8*)(kP + (size_t)m * 32 * 64 + 16 * s), vb[s], S[m]);
    }
    bf16_t* yp = ycat + (size_t)(b * SEQ + n * 64) * 1536 + hh * 128 + dv0 + r;
#pragma unroll
    for (int m = 0; m < 2; ++m)
#pragma unroll
      for (int i = 0; i < 16; ++i) yp[(size_t)(32 * m + crow(i, hf)) * 1536] = f2bf(o[m][i]);
  }
}
#endif

#if !NAIVE_ATTN
template <int DH> DI void load_v_tile(LAS bf16_t* vl, const bf16_t* vsrc, size_t ld, int lane) {
#pragma unroll
  for (int i = 0; i < DH / 16; ++i) { const int q = lane + 64 * i, key = q / (DH / 8), col = (q % (DH / 8)) * 8; *(LAS u32x4*)(vl + key * DH + col) = *(const u32x4*)(vsrc + (size_t)key * ld + col); }
}
DI bf16x8 gather_vt(const LAS bf16_t* vl, int DHs, int d, int s, int hf) {
  const LAS bf16_t* p0 = vl + (16 * s + 4 * hf) * DHs + d; const LAS bf16_t* p1 = p0 + 8 * DHs;
  u32x4 w; w.x = (unsigned)p0[0] | ((unsigned)p0[DHs] << 16); w.y = (unsigned)p0[2 * DHs] | ((unsigned)p0[3 * DHs] << 16);
  w.z = (unsigned)p1[0] | ((unsigned)p1[DHs] << 16); w.w = (unsigned)p1[2 * DHs] | ((unsigned)p1[3 * DHs] << 16);
  return __builtin_bit_cast(bf16x8, w);
}
constexpr float SB_EXIT = 110.f;
DI void sb_unit(const Ctx& c, int u, LAS bf16_t* vl) {
  const bf16_t* proj = (const bf16_t*)(c.p.ws + WS_PROJ); bf16_t* ycat = (bf16_t*)(c.p.ws + WS_YCAT);
  const int qt = 63 - (u & 63), hh = (u >> 6) & 7, b = u >> 9, r = c.lane & 31, hf = c.lane >> 5;
  const size_t tok0 = (size_t)b * SEQ + 32 * qt;
  bf16x8 Qf[4];
#pragma unroll
  for (int s = 0; s < 4; ++s) Qf[s] = *(const bf16x8*)(proj + (tok0 + r) * NPROJ + C_SQ + hh * 64 + 16 * s + 8 * hf);
  f32x16 O[2];
#pragma unroll
  for (int m = 0; m < 2; ++m)
#pragma unroll
    for (int i = 0; i < 16; ++i) O[m][i] = 0.f;
  float carry = 0.f;
  for (int kt = qt; kt >= 0; --kt) {
    const size_t key0 = (size_t)b * SEQ + 32 * kt;
    f32x16 z;
#pragma unroll
    for (int i = 0; i < 16; ++i) z[i] = 0.f;
#pragma unroll
    for (int s = 0; s < 4; ++s) z = MFMA32(*(const bf16x8*)(proj + (key0 + r) * NPROJ + C_SK + hh * 64 + 16 * s + 8 * hf), Qf[s], z);
    LDS_WAIT();
    load_v_tile<64>(vl, proj + key0 * NPROJ + C_SV + hh * 64, NPROJ, c.lane);
    float sp[16];
#pragma unroll
    for (int i = 0; i < 16; ++i) { z[i] *= 0.125f; const bool valid = (kt < qt) || (crow(i, hf) < r); sp[i] = valid ? softplusf_(z[i]) : 0.f; }
    float mine[4], oth[4], both[4];
#pragma unroll
    for (int g = 0; g < 4; ++g) { mine[g] = (sp[4 * g] + sp[4 * g + 1]) + (sp[4 * g + 2] + sp[4 * g + 3]); oth[g] = __shfl_xor(mine[g], 32); both[g] = mine[g] + oth[g]; }
    float tail[4]; tail[3] = 0.f; tail[2] = both[3]; tail[1] = both[3] + both[2]; tail[0] = tail[1] + both[1];
#pragma unroll
    for (int g = 0; g < 4; ++g) {
      float run = carry + tail[g] + (hf == 0 ? oth[g] : 0.f);
#pragma unroll
      for (int q = 3; q >= 0; --q) { const int i = 4 * g + q; run += sp[i]; const bool valid = (kt < qt) || (crow(i, hf) < r); z[i] = valid ? __expf(z[i] - run) : 0.f; }
    }
    carry += tail[0] + both[0];
    const bf16x8 w0 = pack8(z, 0), w1 = pack8(z, 1);
    LDS_WAIT();
#pragma unroll
    for (int m = 0; m < 2; ++m) { O[m] = MFMA32(gather_vt(vl, 64, 32 * m + r, 0, hf), w0, O[m]); O[m] = MFMA32(gather_vt(vl, 64, 32 * m + r, 1, hf), w1, O[m]); }
    if (__all(carry > SB_EXIT)) break;
  }
  bf16_t* yp = ycat + (tok0 + r) * 1536 + 512 + hh * 64;
#pragma unroll
  for (int m = 0; m < 2; ++m)
#pragma unroll
    for (int g = 0; g < 4; ++g) { u32x2 w; w.x = pk_bf16(O[m][4 * g], O[m][4 * g + 1]); w.y = pk_bf16(O[m][4 * g + 2], O[m][4 * g + 3]); *(u32x2*)(yp + 32 * m + 8 * g + 4 * hf) = w; }
}
DI void mem_unit(const Ctx& c, int u, LAS bf16_t* vl) {
  const bf16_t* proj = (const bf16_t*)(c.p.ws + WS_PROJ); const bf16_t* mkv = (const bf16_t*)(c.p.ws + WS_MKV); bf16_t* ycat = (bf16_t*)(c.p.ws + WS_YCAT);
  const int qt = u & 63, hh = (u >> 6) & 3, b = u >> 8, r = c.lane & 31, hf = c.lane >> 5;
  const size_t tok0 = (size_t)b * SEQ + 32 * qt;
  bf16x8 Qf[8];
#pragma unroll
  for (int s = 0; s < 8; ++s) Qf[s] = *(const bf16x8*)(proj + (tok0 + r) * NPROJ + C_MQ + hh * 128 + 16 * s + 8 * hf);
  f32x16 O[4];
#pragma unroll
  for (int m = 0; m < 4; ++m)
#pragma unroll
    for (int i = 0; i < 16; ++i) O[m][i] = 0.f;
  float mx = -INFINITY, l = 0.f;
  for (int kt = 0; kt < 8; ++kt) {
    const size_t key0 = (size_t)b * MEMLEN + 32 * kt;
    f32x16 z;
#pragma unroll
    for (int i = 0; i < 16; ++i) z[i] = 0.f;
#pragma unroll
    for (int s = 0; s < 8; ++s) z = MFMA32(*(const bf16x8*)(mkv + (key0 + r) * 1024 + hh * 128 + 16 * s + 8 * hf), Qf[s], z);
    LDS_WAIT();
    load_v_tile<128>(vl, mkv + key0 * 1024 + 512 + hh * 128, 1024, c.lane);
    float tm = -INFINITY;
#pragma unroll
    for (int i = 0; i < 16; ++i) { z[i] *= 0.08838834764831845f; tm = fmaxf(tm, z[i]); }
    tm = fmaxf(tm, __shfl_xor(tm, 32));
    const float mn = fmaxf(mx, tm), al = __expf(mx - mn); float ps = 0.f;
#pragma unroll
    for (int i = 0; i < 16; ++i) { z[i] = __expf(z[i] - mn); ps += z[i]; }
    ps += __shfl_xor(ps, 32); l = l * al + ps; mx = mn;
#pragma unroll
    for (int m = 0; m < 4; ++m)
#pragma unroll
      for (int i = 0; i < 16; ++i) O[m][i] *= al;
    const bf16x8 w0 = pack8(z, 0), w1 = pack8(z, 1);
    LDS_WAIT();
#pragma unroll
    for (int m = 0; m < 4; ++m) { O[m] = MFMA32(gather_vt(vl, 128, 32 * m + r, 0, hf), w0, O[m]); O[m] = MFMA32(gather_vt(vl, 128, 32 * m + r, 1, hf), w1, O[m]); }
  }
  const float il = 1.f / l;
  bf16_t* yp = ycat + (tok0 + r) * 1536 + 1024 + hh * 128;
#pragma unroll
  for (int m = 0; m < 4; ++m)
#pragma unroll
    for (int g = 0; g < 4; ++g) { u32x2 w; w.x = pk_bf16(O[m][4 * g] * il, O[m][4 * g + 1] * il); w.y = pk_bf16(O[m][4 * g + 2] * il, O[m][4 * g + 3] * il); *(u32x2*)(yp + 32 * m + 8 * g + 4 * hf) = w; }
}
DI void phase_attn(const Ctx& c) {
  LAS bf16_t* vl = (LAS bf16_t*)(c.lds + c.wave * 8192);
  __syncthreads();
  for (int u = c.gw; u < NB * 8 * 64; u += c.ngw) sb_unit(c, u, vl);
  for (int u = c.gw; u < NB * 4 * 64; u += c.ngw) mem_unit(c, u, vl);
}
#endif
#if NAIVE_P5
DI void naive_mixed(const Ctx& c) {
  const bf16_t* ycat = (const bf16_t*)(c.p.ws + WS_YCAT); const bf16_t* wp = (const bf16_t*)(c.p.ws + WS_WP); const bf16_t* proj = (const bf16_t*)(c.p.ws + WS_PROJ); bf16_t* mixed = (bf16_t*)(c.p.ws + WS_MIXED);
  const int r = c.lane & 31, h = c.lane >> 5;
  for (int tile = c.gw; tile < (TT / 32) * 32; tile += c.ngw) {
    const int tm = tile >> 5, tn = tile & 31; float res[16];
#pragma unroll
    for (int i = 0; i < 16; ++i) res[i] = 0.f;
    for (int b = 0; b < 3; ++b) {
      const bf16_t* ap = ycat + (size_t)(tm * 32 + r) * 1536 + b * 512 + 8 * h; const bf16_t* bp = wp + (size_t)(tn * 32 + r) * 1536 + b * 512 + 8 * h;
      f32x16 acc; for (int i = 0; i < 16; ++i) acc[i] = 0.f;
      for (int k0 = 0; k0 < 512; k0 += 16) acc = MFMA32(*(const bf16x8*)(ap + k0), *(const bf16x8*)(bp + k0), acc);
#pragma unroll
      for (int i = 0; i < 16; ++i) res[i] += acc[i] * sigmoidf_(bf2f(proj[(size_t)(tm * 32 + crow(i, h)) * NPROJ + C_GATE + b * 1024 + tn * 32 + r]));
    }
#pragma unroll
    for (int i = 0; i < 16; ++i) mixed[(size_t)(tm * 32 + crow(i, h)) * DM + tn * 32 + r] = f2bf(res[i]);
  }
}
#endif
#if NAIVE_MOE
DI void naive_gateup(const Ctx& c, const LAS int* tab) {
  const bf16_t* x1b = (const bf16_t*)(c.p.ws + WS_X1B); const bf16_t* wgu = (const bf16_t*)(c.p.ws + WS_WGU); bf16_t* act = (bf16_t*)(c.p.ws + WS_ACT); const u32x2* rinfo = (const u32x2*)(c.p.ws + WS_RINFO);
  const float* bgu = c.p.in[I_BGU];
  const int r = c.lane & 31, h = c.lane >> 5, ntile = (tab[64] >> 5) * 32;
  for (int tile = c.gw; tile < ntile; tile += c.ngw) {
    const int tm = tile >> 5, tj = tile & 31, e = tab[96 + (tm >> 3)], local = tm * 32 + r - tab[32 + e];
    const int tok = local < tab[e] ? (int)(rinfo[(size_t)e * ECAP + local].x >> 2) : 0;
    const int j0 = tj * 32, wrow = (j0 >> 7) * 256 + (j0 & 127);
    const bf16_t* ap = x1b + (size_t)tok * DM + 8 * h; const bf16_t* bg = wgu + ((size_t)e * 2048 + wrow + r) * DM + 8 * h; const bf16_t* bl = bg + (size_t)128 * DM;
    f32x16 ag, al; for (int i = 0; i < 16; ++i) { ag[i] = 0.f; al[i] = 0.f; }
    for (int k0 = 0; k0 < DM; k0 += 16) { const bf16x8 a = *(const bf16x8*)(ap + k0); ag = MFMA32(a, *(const bf16x8*)(bg + k0), ag); al = MFMA32(a, *(const bf16x8*)(bl + k0), al); }
    const float bgv = bgu[(size_t)e * 2048 + j0 + r], blv = bgu[(size_t)e * 2048 + 1024 + j0 + r];
#pragma unroll
    for (int i = 0; i < 16; ++i) { const float glu = fminf(ag[i] + bgv, SWIGLU_LIMIT), lin = fminf(fmaxf(al[i] + blv, -SWIGLU_LIMIT), SWIGLU_LIMIT);
      act[(size_t)(tm * 32 + crow(i, h)) * DFF + j0 + r] = f2bf(glu * sigmoidf_(SWIGLU_ALPHA * glu) * (lin + 1.f)); }
  }
}
DI void naive_down(const Ctx& c, const LAS int* tab) {
  const bf16_t* act = (const bf16_t*)(c.p.ws + WS_ACT); const bf16_t* wdn = (const bf16_t*)(c.p.ws + WS_WDN); bf16_t* yp = (bf16_t*)(c.p.ws + WS_YPAIR); const u32x2* rinfo = (const u32x2*)(c.p.ws + WS_RINFO);
  const float* bdn = c.p.in[I_BDN];
  const int r = c.lane & 31, h = c.lane >> 5, ntile = (tab[64] >> 5) * 32;
  for (int tile = c.gw; tile < ntile; tile += c.ngw) {
    const int tm = tile >> 5, tn = tile & 31, e = tab[96 + (tm >> 3)];
    const bf16_t* ap = act + (size_t)(tm * 32 + r) * DFF + 8 * h; const bf16_t* bp = wdn + ((size_t)e * DM + tn * 32 + r) * DFF + 8 * h;
    f32x16 acc; for (int i = 0; i < 16; ++i) acc[i] = 0.f;
    for (int k0 = 0; k0 < DFF; k0 += 16) acc = MFMA32(*(const bf16x8*)(ap + k0), *(const bf16x8*)(bp + k0), acc);
    const float bv = bdn[(size_t)e * DM + tn * 32 + r];
#pragma unroll
    for (int i = 0; i < 16; ++i) { const int local = tm * 32 + crow(i, h) - tab[32 + e];
      if (local < tab[e]) { const u32x2 info = rinfo[(size_t)e * ECAP + local]; yp[(size_t)info.x * DM + tn * 32 + r] = f2bf((acc[i] + bv) * __uint_as_float(info.y)); } }
  }
}
#endif

__global__ void __launch_bounds__(512, 2) mega(Params p) {
  extern __shared__ __attribute__((aligned(16))) unsigned char lds_raw[];
  cg::grid_group grid = cg::this_grid();
  Ctx c; c.lds = (LAS unsigned char*)lds_raw; c.tid = threadIdx.x; c.lane = c.tid & 63; c.wave = __builtin_amdgcn_readfirstlane(c.tid >> 6);
  c.G = gridDim.x; c.bid = blockIdx.x; c.gw = c.bid * 8 + c.wave; c.ngw = c.G * 8; c.p = p;
  unsigned char* ws = p.ws;
  LAS int* gtab = (LAS int*)(c.lds + 131072);
#define IN(k) (p.ph_lo <= (k) && (k) < p.ph_hi)
#define SEAM(k) do { if ((k) + 1 < p.ph_hi) grid.sync(); } while (0)

  if (IN(0)) { phase0(c); SEAM(0); }
  if (IN(1)) {
#if NAIVE_P1
    { bf16_t* proj = (bf16_t*)(ws + WS_PROJ); naive_gemm(c, (const bf16_t*)(ws + WS_XB), DM, (const bf16_t*)(ws + WS_WIN), DM, TT, NPROJ, DM, [&](int r, int cc, float v) { proj[(size_t)r * NPROJ + cc] = f2bf(v); }); }
    { bf16_t* mkv = (bf16_t*)(ws + WS_MKV); naive_gemm(c, (const bf16_t*)(ws + WS_MEMB), DM, (const bf16_t*)(ws + WS_WMKV), DM, NB * MEMLEN, DM, DM, [&](int r, int cc, float v) { mkv[(size_t)r * DM + cc] = f2bf(v); }); }
#else
    { pg8::Gemm g{(const bf16_t*)(ws + WS_XB), (const bf16_t*)(ws + WS_WIN), DM}; pg8::StaticOrder S; S.init(TT, NPROJ, c.G, c.bid); pg8::EpiStoreBf16 E{(bf16_t*)(ws + WS_PROJ), NPROJ};
      pg8::gemm_phase<pg8::EpiStoreBf16, pg8::StaticOrder, true>(c.lds, g, S, E); }
    { pg8::Gemm g{(const bf16_t*)(ws + WS_MEMB), (const bf16_t*)(ws + WS_WMKV), DM}; pg8::StaticOrder S; S.init(NB * MEMLEN, DM, c.G, c.bid); pg8::EpiStoreBf16 E{(bf16_t*)(ws + WS_MKV), DM};
      pg8::gemm_phase<pg8::EpiStoreBf16, pg8::StaticOrder, true>(c.lds, g, S, E); }
#endif
    SEAM(1);
  }
  if (IN(2)) {
#if NAIVE_GDN
    naive_gdn_prep(c);
#else
    phase_gdn_chunk(c);
#endif
#if NAIVE_ATTN
    naive_sb(c); naive_mem(c);
#else
    phase_attn(c);
#endif
    SEAM(2);
  }
  if (IN(3)) {
#if NAIVE_GDN
    naive_gdn_scan(c);
#else
    phase_gdn_scan(c);
#endif
    SEAM(3);
  }
  if (IN(4)) { phase_gdn_norm(c); SEAM(4); }
  if (IN(5)) {
#if NAIVE_P5
    naive_mixed(c);
#else
    pg8::Gemm g{(const bf16_t*)(ws + WS_YCAT), (const bf16_t*)(ws + WS_WP), 1536}; pg8::StaticOrder S; S.init(TT, DM, c.G, c.bid); pg8::EpiMixed E{(const bf16_t*)(ws + WS_PROJ), (bf16_t*)(ws + WS_MIXED)};
    pg8::gemm_phase<pg8::EpiMixed, pg8::StaticOrder, true>(c.lds, g, S, E);
#endif
    SEAM(5);
  }
  if (IN(6)) {
#if NAIVE_P6
    { const float* x = p.in[I_X]; float* hh = (float*)(ws + WS_H);
      naive_gemm(c, (const bf16_t*)(ws + WS_MIXED), DM, (const bf16_t*)(ws + WS_WO), DM, TT, DM, DM, [&](int r, int cc, float v) { hh[(size_t)r * DM + cc] = DN_ALPHA * x[(size_t)r * DM + cc] + v; }); }
#else
    pg8::Gemm g{(const bf16_t*)(ws + WS_MIXED), (const bf16_t*)(ws + WS_WO), DM}; pg8::StaticOrder S; S.init(TT, DM, c.G, c.bid); pg8::EpiH E{p.in[I_X], (float*)(ws + WS_H)};
    pg8::gemm_phase<pg8::EpiH, pg8::StaticOrder, true>(c.lds, g, S, E);
#endif
    SEAM(6);
  }
  if (IN(7)) { phase_router(c); SEAM(7); }
  if (IN(8)) {
    build_group_tab(c, gtab);
#if NAIVE_MOE
    naive_gateup(c, gtab);
#else
    pg8::Gemm g{(const bf16_t*)(ws + WS_X1B), (const bf16_t*)(ws + WS_WGU), DM}; pg8::GroupOrder S{gtab, (const u32x2*)(ws + WS_RINFO), 8, c.G, c.bid, 1}; pg8::EpiGateUp E{p.in[I_BGU], (bf16_t*)(ws + WS_ACT)};
    pg8::gemm_phase<pg8::EpiGateUp, pg8::GroupOrder, true>(c.lds, g, S, E);
#endif
    SEAM(8);
  }
  if (IN(9)) {
    build_group_tab(c, gtab);
#if NAIVE_MOE
    naive_down(c, gtab);
#else
    pg8::Gemm g{(const bf16_t*)(ws + WS_ACT), (const bf16_t*)(ws + WS_WDN), DFF}; pg8::GroupOrder S{gtab, (const u32x2*)(ws + WS_RINFO), 4, c.G, c.bid, 0};
    pg8::EpiDown E{p.in[I_BDN], gtab, (const u32x2*)(ws + WS_RINFO), (bf16_t*)(ws + WS_YPAIR)};
    pg8::gemm_phase<pg8::EpiDown, pg8::GroupOrder, true>(c.lds, g, S, E);
#endif
    SEAM(9);
  }
  if (IN(10)) { phase_final(c); }
#undef IN
#undef SEAM
}

extern "C" void kernel_launch(void* const* d_in, const int* in_sizes, int n_in, void* d_out, int out_size, void* d_ws, size_t ws_size, hipStream_t stream) {
  static int grid_blocks = 0;
  if (grid_blocks == 0) {
    if (n_in != 22 || in_sizes[0] != TT * DM || out_size != TT * DM || ws_size < WS_NEED) {
      fprintf(stderr, "kernel_launch: built for 22 inputs, x/out of %d floats and >= %zu bytes of workspace; got n_in %d in0 %d out %d ws %zu; nothing launched\n", TT * DM, (size_t)WS_NEED, n_in, n_in > 0 ? in_sizes[0] : -1, out_size, ws_size);
      grid_blocks = -1; return; }
    int dev = 0, cus = 0, per_cu = 0;
    if (hipGetDevice(&dev) != hipSuccess || hipDeviceGetAttribute(&cus, hipDeviceAttributeMultiprocessorCount, dev) != hipSuccess) { grid_blocks = -1; return; }
    if (hipFuncSetAttribute((const void*)mega, hipFuncAttributeMaxDynamicSharedMemorySize, LDS_BYTES) != hipSuccess) { fprintf(stderr, "kernel_launch: hipFuncSetAttribute failed\n"); grid_blocks = -1; return; }
    if (hipOccupancyMaxActiveBlocksPerMultiprocessor(&per_cu, (const void*)mega, 512, LDS_BYTES) != hipSuccess || per_cu < 1) { fprintf(stderr, "kernel_launch: occupancy query says %d\n", per_cu); (void)hipGetLastError(); grid_blocks = -1; return; }
    grid_blocks = cus;
    fprintf(stderr, "kernel_launch: grid %d (cus %d, per_cu %d), ws %zu\n", grid_blocks, cus, per_cu, ws_size);
  }
  if (grid_blocks < 0) return;
  Params p{};
  for (int i = 0; i < 22; ++i) p.in[i] = (const float*)d_in[i];
  p.out = (float*)d_out; p.ws = (unsigned char*)d_ws;
#if MK_SPLIT
  for (int ph = 0; ph < 11; ++ph) { p.ph_lo = ph; p.ph_hi = ph + 1; void* args[] = {&p};
    hipError_t e = hipLaunchCooperativeKernel((const void*)mega, dim3(grid_blocks), dim3(512), args, LDS_BYTES, stream);
    if (e != hipSuccess) { fprintf(stderr, "kernel_launch: launch of phase %d failed: %s\n", ph, hipGetErrorString(e)); break; } }
#else
  p.ph_lo = 0; p.ph_hi = 11; void* args[] = {&p};
  hipError_t e = hipLaunchCooperativeKernel((const void*)mega, dim3(grid_blocks), dim3(512), args, LDS_BYTES, stream);
  if (e != hipSuccess) fprintf(stderr, "kernel_launch: cooperative launch failed: %s (grid %d)\n", hipGetErrorString(e), grid_blocks);
#endif
}
```

```cpp
#define NAIVE_P1 0
#define NAIVE_GDN 0
#define NAIVE_ATTN 0
#define NAIVE_P5 0
#define NAIVE_P6 0
#define NAIVE_MOE 0
#define MK_SPLIT 0
#define REPEAT_PH -1
#define SPLIT_ONLY 0
#define REPEAT_FLAGS 0
#define USE_CG_ALL 0
#define NAIVE_ANY (NAIVE_P1 || NAIVE_P6)
#include <hip/hip_runtime.h>
#include <hip/hip_cooperative_groups.h>
#include <cstdio>
#include <cstdint>
namespace cg = cooperative_groups;

#define DI __device__ __forceinline__
#define LAS __attribute__((address_space(3)))
typedef unsigned short bf16_t;
typedef short bf16x8 __attribute__((ext_vector_type(8)));
typedef float f32x2 __attribute__((ext_vector_type(2)));
typedef float f32x4 __attribute__((ext_vector_type(4)));
typedef float f32x16 __attribute__((ext_vector_type(16)));
typedef unsigned u32x2 __attribute__((ext_vector_type(2)));
typedef unsigned u32x4 __attribute__((ext_vector_type(4)));
typedef __bf16 bf16x2_t __attribute__((ext_vector_type(2)));

constexpr int NB = 16, SEQ = 2048, DM = 1024, TT = NB * SEQ;
constexpr int MEMLEN = 256, NEXP = 32, TOPK = 4, DFF = 1024;
constexpr int NPROJ = 7168;
constexpr int C_GQ = 0, C_GK = 512, C_GV = 1024, C_GZ = 1536, C_SQ = 2048, C_SK = 2560, C_SV = 3072, C_MQ = 3584, C_GATE = 4096;
constexpr float LN_EPS = 1e-5f, NORM_EPS = 1e-6f;
constexpr float DN_ALPHA = 1.189207115002721f;
constexpr float SWIGLU_LIMIT = 7.0f, SWIGLU_ALPHA = 1.702f;
constexpr int ECAP = 32768;

constexpr size_t MiB = 1u << 20;
constexpr size_t WS_MISC = 0;
constexpr size_t WS_WDN = 3 * MiB, WS_WGU = 67 * MiB, WS_WIN = 195 * MiB, WS_WMKV = 209 * MiB, WS_WP = 211 * MiB, WS_WO = 214 * MiB;
constexpr size_t WS_XB = 216 * MiB, WS_MEMB = 280 * MiB, WS_MKV = 288 * MiB, WS_PROJ = 296 * MiB, WS_GDN = 744 * MiB, WS_YCAT = 888 * MiB, WS_RINFO = 1016 * MiB;
constexpr size_t WS_MIXED = WS_XB, WS_H = WS_GDN, WS_X1 = WS_YCAT, WS_X1B = WS_PROJ, WS_ACT = 360 * MiB, WS_YPAIR = 67 * MiB;
constexpr size_t WS_NEED = 1024 * MiB;
constexpr size_t GDN_CHUNK_BYTES = 73728;
constexpr int LDS_BYTES = 147456;

struct Params { const float* in[22]; float* out; unsigned char* ws; int ph_lo, ph_hi, flags, pad; };
enum { I_X = 0, I_MEM, I_WIN, I_WCONV, I_ALOG, I_DTB, I_GNW, I_WMKV, I_WPG, I_WPS, I_WPM, I_WO, I_LN1G, I_LN1B, I_WR, I_BR, I_WGU, I_BGU, I_WDN, I_BDN, I_LN2G, I_LN2B };

DI float bf2f(bf16_t v) { return __uint_as_float((unsigned)v << 16); }
DI unsigned pk_bf16(float a, float b) { f32x2 v = {a, b}; bf16x2_t r = __builtin_convertvector(v, bf16x2_t); return __builtin_bit_cast(unsigned, r); }
DI bf16_t f2bf(float a) { return (bf16_t)(pk_bf16(a, 0.f) & 0xffffu); }
DI float bflo(unsigned w) { return __uint_as_float(w << 16); }
DI float bfhi(unsigned w) { return __uint_as_float(w & 0xffff0000u); }
DI float sigmoidf_(float x) { return 1.0f / (1.0f + __expf(-x)); }
DI float softplusf_(float x) { return x > 20.f ? x : log1pf(__expf(x)); }
DI float softplus_fast(float x) { return fmaxf(x, 0.f) + __logf(1.f + __expf(-fabsf(x))); }
typedef short s16x4 __attribute__((ext_vector_type(4)));
DI float wave_sum(float v) {
#pragma unroll
  for (int o = 1; o < 64; o <<= 1) v += __shfl_xor(v, o);
  return v;
}
DI float wave_max(float v) {
#pragma unroll
  for (int o = 1; o < 64; o <<= 1) v = fmaxf(v, __shfl_xor(v, o));
  return v;
}
#define LDS_WAIT() asm volatile("s_waitcnt lgkmcnt(0)" ::: "memory")
#define VM_WAIT() asm volatile("s_waitcnt vmcnt(0)" ::: "memory")
#define MFMA32(a, b, c) __builtin_amdgcn_mfma_f32_32x32x16_bf16((a), (b), (c), 0, 0, 0)
DI int crow(int reg, int h) { return (reg & 3) + 8 * (reg >> 2) + 4 * h; }
DI int swap23(int k) { return (k & ~12) | ((k & 4) << 1) | ((k & 8) >> 1); }

#define XB_TMO      128
#define XB_XCNT(j)  (256  + 64 * (j))
#define XB_XSUB(j)  (1280 + 64 * (j))
#define XB_XGEN(j)  (2304 + 64 * (j))
#define XB_TOP      3328
#define XB_TOPGEN   3392
#define XCD_BAR_WORDS 3456
#define XB_SPIN_CAP (1u << 18)
DI unsigned xb_ld(unsigned* p)              { return __hip_atomic_load(p, __ATOMIC_RELAXED, __HIP_MEMORY_SCOPE_AGENT); }
DI unsigned xb_add(unsigned* p, unsigned v) { return __hip_atomic_fetch_add(p, v, __ATOMIC_RELAXED, __HIP_MEMORY_SCOPE_AGENT); }
DI unsigned xb_xcc_id() { return (unsigned)__builtin_amdgcn_s_getreg((3 << 11) | 20) & 0xFu; }
#define XB_SPIN(cond, bar) do { unsigned _sp = 0; while (cond) { __builtin_amdgcn_s_sleep(1); \
    if ((++_sp & 255u) == 0u) { if (xb_ld(&(bar)[XB_TMO])) break; if (_sp > XB_SPIN_CAP) { atomicAdd(&(bar)[XB_TMO], 1u); break; } } } } while (0)
struct XcdBarrier { unsigned* bar; unsigned x; volatile LAS unsigned* st; };
DI XcdBarrier xcd_barrier_post(unsigned* bar, volatile LAS unsigned* st) {
  XcdBarrier b; b.bar = bar; b.x = xb_xcc_id(); b.st = st;
  if (threadIdx.x == 0) (void)xb_add(&bar[XB_XCNT(b.x)], 1u);
  return b;
}
DI void xcd_barrier_complete(unsigned* bar, unsigned x, unsigned& nloc, unsigned& nx) {
  const unsigned G = gridDim.x * gridDim.y * gridDim.z;
  unsigned sum, cnt, mine, sp = 0u;
  for (;;) {
    sum = 0u; cnt = 0u; mine = 0u;
#pragma unroll
    for (unsigned j = 0; j < 16; ++j) { const unsigned c = xb_ld(&bar[XB_XCNT(j)]); sum += c; cnt += (c > 0u) ? 1u : 0u; mine = (j == x) ? c : mine; }
    if (sum == G) break;
    __builtin_amdgcn_s_sleep(1);
    if ((++sp & 255u) == 0u) { if (xb_ld(&bar[XB_TMO])) break; if (sp > XB_SPIN_CAP) { atomicAdd(&bar[XB_TMO], 1u); break; } }
  }
  nloc = mine > 0u ? mine : 1u; nx = cnt > 0u ? cnt : 1u;
}
DI void xcd_barrier(const XcdBarrier& b) {
  asm volatile("s_waitcnt vmcnt(0)" ::: "memory");
  __syncthreads();
  if (threadIdx.x == 0) {
    unsigned* bar = b.bar;
    __builtin_amdgcn_s_waitcnt(0);
    unsigned nloc = b.st[0], nx = b.st[1];
    if (nloc == 0u) { xcd_barrier_complete(bar, b.x, nloc, nx); b.st[0] = nloc; b.st[1] = nx; }
    const unsigned old = xb_add(&bar[XB_XSUB(b.x)], 1u);
    const unsigned gen = old / nloc;
    if (old + 1u == (gen + 1u) * nloc) {
      __builtin_amdgcn_fence(__ATOMIC_RELEASE, "agent");
      asm volatile("s_waitcnt vmcnt(0)" ::: "memory");
      const unsigned og = xb_add(&bar[XB_TOP], 1u);
      const unsigned tg = og / nx;
      if (og + 1u == (tg + 1u) * nx) xb_add(&bar[XB_TOPGEN], 1u);
      else XB_SPIN(xb_ld(&bar[XB_TOPGEN]) == tg, bar);
      __builtin_amdgcn_fence(__ATOMIC_ACQUIRE, "agent");
      xb_add(&bar[XB_XGEN(b.x)], 1u);
      asm volatile("s_waitcnt vmcnt(0)" ::: "memory");
    } else {
      XB_SPIN(xb_ld(&bar[XB_XGEN(b.x)]) == gen, bar);
      __builtin_amdgcn_fence(__ATOMIC_ACQUIRE, "agent");
      asm volatile("s_waitcnt vmcnt(0)" ::: "memory");
    }
  }
  __syncthreads();
}
constexpr size_t WS_BAR = 2 * MiB;

struct Ctx {
  LAS unsigned char* lds;
  int tid, lane, wave, G, bid, gw, ngw;
  Params p;
};
namespace pg8 {
constexpr int BM = 256, BK = 64, HALF = 128, HTB = HALF * BK * 2  , STAGE_BYTES = 8 * HTB, NXCD = 8, WGM = 8;
DI int lds_byte(int r, int c) { const int st = (r >> 4) * 2 + (c >> 5), rr = r & 15, cc = c & 31, ob = rr * 64 + cc * 2; return st * 1024 + (ob ^ (((ob >> 9) & 1) << 5)); }
DI void stage_rc(int b, int& R, int& C) { const int st = b / 1024, sb = b % 1024, swz = sb ^ (((sb >> 9) & 1) << 5); R = (st >> 1) * 16 + swz / 64; C = (st & 1) * 32 + (swz % 64) / 2; }
DI int perm32(int rho) { const int n = rho >> 4, i = rho & 15; return 8 * (i >> 2) + 4 * n + (i & 3); }

struct Unit { int pm, pn; };
struct Gemm { const bf16_t* A; const bf16_t* Bt; int K; };

struct StaticOrder {
  int nM, nN, nwg, G, c;
  DI void init(int M, int N, int G_, int c_) { nM = M / BM; nN = N / BM; nwg = nM * nN; G = G_; c = c_; }
  DI bool next(int i, Unit& u) const {
    const long L = (long)i * G + c; if (L >= nwg) return false;
    int wgid = (int)L; { const int q = nwg / NXCD, r = nwg % NXCD, xcd = wgid % NXCD, off = wgid / NXCD; wgid = (xcd < r ? xcd * (q + 1) : r * (q + 1) + (xcd - r) * q) + off; }
    const int nig = WGM * nN, gid = wgid / nig, fm = gid * WGM, gsz = (nM - fm) < WGM ? (nM - fm) : WGM;
    u.pm = fm + ((wgid % nig) % gsz); u.pn = (wgid % nig) / gsz; return true;
  }
  DI int arow(const Unit& u, int r) const { return u.pm * BM + r; }
};
struct GroupOrder {
  const LAS int* tab; const u32x2* rinfo; int ntn, G, c, gather;
  DI bool next(int i, Unit& u) const {
    const int L = i * G + c, NT = tab[65]; if (L >= NT * ntn) return false;
    const int tile = L / ntn, pnl = L - tile * ntn; u.pm = tile; u.pn = tab[96 + tile] * ntn + pnl; return true;
  }
  DI int arow(const Unit& u, int r) const {
    if (!gather) return u.pm * BM + r;
    const int e = tab[96 + u.pm], local = u.pm * BM + r - tab[32 + e];
    return local < tab[e] ? (int)(rinfo[(size_t)e * ECAP + local].x >> 2) : 0;
  }
};

template <class Epi, class Sched, bool ALIGN_EPI>
DI void gemm_phase(LAS unsigned char* lds, const Gemm g, const Sched& S, const Epi& E) {
  const int tid = threadIdx.x, wid = __builtin_amdgcn_readfirstlane(tid >> 6), lane = tid & 63, wr = wid >> 2, wc = wid & 3, fr = lane & 15, fq = lane >> 4;
  const int K = g.K, nt = K / BK;
  int RA[2], CA[2]; unsigned voffB[2];
#pragma unroll
  for (int i = 0; i < 2; ++i) { int R, C; stage_rc(tid * 16 + i * 8192, R, C); const int Rb = Epi::PERM ? ((R & ~31) + perm32(R & 31)) : R; RA[i] = R; CA[i] = C; voffB[i] = (unsigned)(Rb * K + C) * 2u; }
  const size_t kstep = (size_t)(BK * 2);
  const size_t hstep = (size_t)HALF * K * 2;
  const size_t tstep = 2 * hstep;
  const unsigned ldsw = (unsigned)wid * 1024u;
  const int aoff = lds_byte(wr * 64 + fr, fq * 8), boff = lds_byte(wc * 32 + fr, fq * 8);
  const char* Ab = (const char*)g.A;
#define PG8_SA(b, h) (((b) * 2 + (h)) * HTB)
#define PG8_SB(b, h) ((4 + (b) * 2 + (h)) * HTB)
#define PG8_STAGE(bufoff, gbase, voff) do { _Pragma("unroll") for (int _i = 0; _i < 2; ++_i) \
    __builtin_amdgcn_global_load_lds((const unsigned*)((const char*)(gbase) + (voff)[_i]), (LAS unsigned*)(lds + (bufoff) + ldsw + _i * 8192), 16, 0, 0); } while (0)
#define PG8_LDA(dst, b, h) do { _Pragma("unroll") for (int m = 0; m < 4; ++m) _Pragma("unroll") for (int k = 0; k < 2; ++k) dst[m][k] = *(const LAS bf16x8*)(lds + PG8_SA(b, h) + aoff + m * 2048 + k * 1024); } while (0)
#define PG8_LDB(dst, b, h) do { _Pragma("unroll") for (int n = 0; n < 2; ++n) _Pragma("unroll") for (int k = 0; k < 2; ++k) dst[n][k] = *(const LAS bf16x8*)(lds + PG8_SB(b, h) + boff + n * 2048 + k * 1024); } while (0)
#define PG8_MMA(ai, bj, At, Bt) do { __builtin_amdgcn_s_setprio(1); _Pragma("unroll") for (int m = 0; m < 4; ++m) _Pragma("unroll") for (int n = 0; n < 2; ++n) _Pragma("unroll") for (int k = 0; k < 2; ++k) \
    acc[ai][bj][m][n] = __builtin_amdgcn_mfma_f32_16x16x32_bf16(Bt[n][k], At[m][k], acc[ai][bj][m][n], 0, 0, 0); __builtin_amdgcn_s_setprio(0); } while (0)
#define PG8_WAIT_V(n) asm volatile("s_waitcnt vmcnt(" #n ")" ::: "memory")
#define PG8_WAIT_L(n) asm volatile("s_waitcnt lgkmcnt(" #n ")" ::: "memory")
#define PG8_BAR __builtin_amdgcn_s_barrier()
#define PG8_SCHED __builtin_amdgcn_sched_barrier(0)
  Unit cur, nxt; int ui = 0;
  if (!S.next(0, cur)) return;
  f32x4 acc[2][2][4][2];
#pragma unroll
  for (int a = 0; a < 2; ++a)
#pragma unroll
    for (int b = 0; b < 2; ++b)
#pragma unroll
      for (int m = 0; m < 4; ++m)
#pragma unroll
        for (int n = 0; n < 2; ++n) acc[a][b][m][n] = (f32x4){0.f, 0.f, 0.f, 0.f};
  bf16x8 At[4][2], B0[2][2], B1[2][2];
  unsigned cvo0[2], cvo1[2], nvo0[2], nvo1[2];
#pragma unroll
  for (int i = 0; i < 2; ++i) { cvo0[i] = ((unsigned)S.arow(cur, RA[i]) * (unsigned)K + (unsigned)CA[i]) * 2u; cvo1[i] = ((unsigned)S.arow(cur, HALF + RA[i]) * (unsigned)K + (unsigned)CA[i]) * 2u; }
  const char* cB = (const char*)g.Bt + (size_t)cur.pn * tstep;
  PG8_STAGE(PG8_SB(0, 0), cB, voffB); PG8_STAGE(PG8_SB(0, 1), cB + hstep, voffB); PG8_STAGE(PG8_SA(0, 0), Ab, cvo0); PG8_STAGE(PG8_SA(0, 1), Ab, cvo1);
  if (wr == 1) PG8_BAR;
  PG8_WAIT_V(2); PG8_BAR;
  PG8_STAGE(PG8_SB(1, 0), cB + kstep, voffB); PG8_STAGE(PG8_SA(1, 0), Ab + kstep, cvo0); PG8_STAGE(PG8_SB(1, 1), cB + hstep + kstep, voffB);
  PG8_WAIT_V(6); PG8_BAR;
  for (;;) {
    const bool has_next = S.next(ui + 1, nxt);
    if (!has_next) nxt = cur;
#pragma unroll
    for (int i = 0; i < 2; ++i) { nvo0[i] = ((unsigned)S.arow(nxt, RA[i]) * (unsigned)K + (unsigned)CA[i]) * 2u; nvo1[i] = ((unsigned)S.arow(nxt, HALF + RA[i]) * (unsigned)K + (unsigned)CA[i]) * 2u; }
    const char* nB = (const char*)g.Bt + (size_t)nxt.pn * tstep;
    for (int t = 0; t < nt; t += 2) {
      const bool last = (t == nt - 2);
      if constexpr (Epi::MIDHOOK) { if (t == 8 || t == 16) E.mid(acc, cur, (t >> 3) - 1, wr, wc, fr, fq); }
      const char* a1 = Ab + (size_t)(t + 1) * kstep;
      const char* a2 = last ? Ab : Ab + (size_t)(t + 2) * kstep; const char* b2 = last ? nB : cB + (size_t)(t + 2) * kstep;
      const char* a3 = a2 + kstep; const char* b3 = b2 + kstep;
      unsigned vo0[2], vo1[2];
#pragma unroll
      for (int i = 0; i < 2; ++i) { vo0[i] = last ? nvo0[i] : cvo0[i]; vo1[i] = last ? nvo1[i] : cvo1[i]; }
      PG8_LDB(B0, 0, 0); PG8_LDB(B1, 0, 1); PG8_SCHED; PG8_LDA(At, 0, 0); PG8_STAGE(PG8_SA(1, 1), a1, cvo1);
      PG8_WAIT_V(8); PG8_WAIT_L(0); PG8_BAR; PG8_MMA(0, 0, At, B0); PG8_MMA(0, 1, At, B1); PG8_BAR; PG8_SCHED;
      PG8_LDA(At, 0, 1); PG8_STAGE(PG8_SB(0, 0), b2, voffB); PG8_STAGE(PG8_SB(0, 1), b2 + hstep, voffB); PG8_STAGE(PG8_SA(0, 0), a2, vo0);
      PG8_WAIT_V(8); PG8_WAIT_L(0); PG8_BAR; PG8_MMA(1, 0, At, B0); PG8_MMA(1, 1, At, B1); PG8_BAR; PG8_SCHED;
      PG8_LDB(B0, 1, 0); PG8_LDB(B1, 1, 1); PG8_SCHED; PG8_LDA(At, 1, 0); PG8_STAGE(PG8_SA(0, 1), a2, vo1);
      PG8_WAIT_V(8); PG8_WAIT_L(0); PG8_BAR; PG8_MMA(0, 0, At, B0); PG8_MMA(0, 1, At, B1); PG8_BAR; PG8_SCHED;
      PG8_LDA(At, 1, 1); PG8_STAGE(PG8_SB(1, 0), b3, voffB); PG8_STAGE(PG8_SB(1, 1), b3 + hstep, voffB); PG8_STAGE(PG8_SA(1, 0), a3, vo0);
      PG8_WAIT_V(8); PG8_WAIT_L(0); PG8_BAR; PG8_MMA(1, 0, At, B0); PG8_MMA(1, 1, At, B1); PG8_BAR; PG8_SCHED;
    }
    if constexpr (ALIGN_EPI) { if (wr == 0) PG8_BAR; }
    E(acc, cur, wr, wc, fr, fq);
    if (!has_next) break;
#pragma unroll
    for (int a = 0; a < 2; ++a)
#pragma unroll
      for (int b = 0; b < 2; ++b)
#pragma unroll
        for (int m = 0; m < 4; ++m)
#pragma unroll
          for (int n = 0; n < 2; ++n) acc[a][b][m][n] = (f32x4){0.f, 0.f, 0.f, 0.f};
    cur = nxt; cB = nB; ++ui;
#pragma unroll
    for (int i = 0; i < 2; ++i) { cvo0[i] = nvo0[i]; cvo1[i] = nvo1[i]; }
    if constexpr (ALIGN_EPI) { if (wr == 1) PG8_BAR; }
  }
  PG8_WAIT_V(0);
  if constexpr (!ALIGN_EPI) { if (wr == 0) PG8_BAR; }
  PG8_BAR;
#undef PG8_SA
#undef PG8_SB
#undef PG8_STAGE
#undef PG8_LDA
#undef PG8_LDB
#undef PG8_MMA
#undef PG8_WAIT_V
#undef PG8_WAIT_L
#undef PG8_BAR
#undef PG8_SCHED
}

struct EpiStoreBf16 {
  static constexpr bool PERM = true, MIDHOOK = false;
  bf16_t* O; int ldc;
  DI void operator()(const f32x4 (&acc)[2][2][4][2], const Unit& u, int wr, int wc, int fr, int fq) const {
    const int row0 = u.pm * BM + wr * 64 + fr, col0 = u.pn * BM + wc * 32 + 8 * fq;
#pragma unroll
    for (int ai = 0; ai < 2; ++ai)
#pragma unroll
      for (int m = 0; m < 4; ++m) { bf16_t* rowp = O + (size_t)(row0 + ai * HALF + m * 16) * ldc + col0;
#pragma unroll
        for (int bj = 0; bj < 2; ++bj) { const f32x4 v0 = acc[ai][bj][m][0], v1 = acc[ai][bj][m][1];
          u32x4 w; w.x = pk_bf16(v0[0], v0[1]); w.y = pk_bf16(v0[2], v0[3]); w.z = pk_bf16(v1[0], v1[1]); w.w = pk_bf16(v1[2], v1[3]);
          *(u32x4*)(rowp + bj * HALF) = w; } }
  }
};
struct EpiMixed {
  static constexpr bool PERM = true, MIDHOOK = true;
  const bf16_t* proj; bf16_t* O;
  DI static float e_neg(float a) { return __expf(-fminf(fmaxf(a, -40.f), 40.f)); }
  DI void mid(f32x4 (&acc)[2][2][4][2], const Unit& u, int b, int wr, int wc, int fr, int fq) const {
    int row0 = u.pm * BM + wr * 64 + fr; const int col0 = u.pn * BM + wc * 32 + 8 * fq;
    asm volatile("" : "+v"(row0));
#pragma unroll
    for (int ai = 0; ai < 2; ++ai) {
      u32x4 ga[4][2], gb[4][2];
#pragma unroll
      for (int m = 0; m < 4; ++m) { const bf16_t* gp = proj + (size_t)(row0 + ai * HALF + m * 16) * NPROJ + C_GATE + b * DM + col0;
#pragma unroll
        for (int bj = 0; bj < 2; ++bj) { ga[m][bj] = *(const u32x4*)(gp + bj * HALF); gb[m][bj] = *(const u32x4*)(gp + DM + bj * HALF); } }
#pragma unroll
      for (int m = 0; m < 4; ++m)
#pragma unroll
        for (int bj = 0; bj < 2; ++bj)
#pragma unroll
          for (int q = 0; q < 4; ++q) {
            const float r0 = (1.f + e_neg(bflo(gb[m][bj][q]))) * __frcp_rn(1.f + e_neg(bflo(ga[m][bj][q])));
            const float r1 = (1.f + e_neg(bfhi(gb[m][bj][q]))) * __frcp_rn(1.f + e_neg(bfhi(ga[m][bj][q])));
            acc[ai][bj][m][q >> 1][(q & 1) * 2] *= r0; acc[ai][bj][m][q >> 1][(q & 1) * 2 + 1] *= r1; }
      asm volatile("" ::: "memory");
    }
  }
  DI void operator()(const f32x4 (&acc)[2][2][4][2], const Unit& u, int wr, int wc, int fr, int fq) const {
    const int row0 = u.pm * BM + wr * 64 + fr, col0 = u.pn * BM + wc * 32 + 8 * fq;
#pragma unroll
    for (int ai = 0; ai < 2; ++ai) {
      u32x4 ga[4][2];
#pragma unroll
      for (int m = 0; m < 4; ++m) { const bf16_t* gp = proj + (size_t)(row0 + ai * HALF + m * 16) * NPROJ + C_GATE + 2 * DM + col0;
#pragma unroll
        for (int bj = 0; bj < 2; ++bj) ga[m][bj] = *(const u32x4*)(gp + bj * HALF); }
#pragma unroll
      for (int m = 0; m < 4; ++m) { const int row = row0 + ai * HALF + m * 16;
#pragma unroll
        for (int bj = 0; bj < 2; ++bj) { float o[8];
#pragma unroll
          for (int q = 0; q < 4; ++q) {
            o[2 * q] = acc[ai][bj][m][q >> 1][(q & 1) * 2] * __frcp_rn(1.f + e_neg(bflo(ga[m][bj][q])));
            o[2 * q + 1] = acc[ai][bj][m][q >> 1][(q & 1) * 2 + 1] * __frcp_rn(1.f + e_neg(bfhi(ga[m][bj][q]))); }
          u32x4 w; w.x = pk_bf16(o[0], o[1]); w.y = pk_bf16(o[2], o[3]); w.z = pk_bf16(o[4], o[5]); w.w = pk_bf16(o[6], o[7]);
          *(u32x4*)(O + (size_t)row * DM + col0 + bj * HALF) = w; } }
      asm volatile("" ::: "memory");
    }
  }
};
struct EpiH {
  static constexpr bool PERM = false, MIDHOOK = false;
  const float* x; float* h;
  DI void operator()(const f32x4 (&acc)[2][2][4][2], const Unit& u, int wr, int wc, int fr, int fq) const {
    const int row0 = u.pm * BM + wr * 64 + fr, col0 = u.pn * BM + wc * 32 + 4 * fq;
#pragma unroll
    for (int ai = 0; ai < 2; ++ai)
#pragma unroll
      for (int m = 0; m < 4; ++m) { const size_t off = (size_t)(row0 + ai * HALF + m * 16) * DM + col0;
#pragma unroll
        for (int bj = 0; bj < 2; ++bj)
#pragma unroll
          for (int n = 0; n < 2; ++n) { const f32x4 xv = *(const f32x4*)(x + off + bj * HALF + n * 16); *(f32x4*)(h + off + bj * HALF + n * 16) = xv * DN_ALPHA + acc[ai][bj][m][n]; }
        asm volatile("" ::: "memory"); }
  }
};
struct EpiGateUp {
  static constexpr bool PERM = true, MIDHOOK = false;
  const float* bgu; bf16_t* act;
  DI void operator()(const f32x4 (&acc)[2][2][4][2], const Unit& u, int wr, int wc, int fr, int fq) const {
    const int e = u.pn >> 3, pnl = u.pn & 7, row0 = u.pm * BM + wr * 64 + fr, j0 = pnl * 128 + wc * 32 + 8 * fq;
    f32x4 bg[2], bl[2];
#pragma unroll
    for (int n = 0; n < 2; ++n) { bg[n] = *(const f32x4*)(bgu + (size_t)e * 2048 + j0 + 4 * n); bl[n] = *(const f32x4*)(bgu + (size_t)e * 2048 + 1024 + j0 + 4 * n); }
#pragma unroll
    for (int ai = 0; ai < 2; ++ai)
#pragma unroll
      for (int m = 0; m < 4; ++m) { float o[8];
#pragma unroll
        for (int n = 0; n < 2; ++n)
#pragma unroll
          for (int j = 0; j < 4; ++j) { const float glu = fminf(acc[ai][0][m][n][j] + bg[n][j], SWIGLU_LIMIT); const float lin = fminf(fmaxf(acc[ai][1][m][n][j] + bl[n][j], -SWIGLU_LIMIT), SWIGLU_LIMIT);
            o[4 * n + j] = glu * __frcp_rn(1.f + __expf(-SWIGLU_ALPHA * glu)) * (lin + 1.f); }
        u32x4 w; w.x = pk_bf16(o[0], o[1]); w.y = pk_bf16(o[2], o[3]); w.z = pk_bf16(o[4], o[5]); w.w = pk_bf16(o[6], o[7]);
        *(u32x4*)(act + (size_t)(row0 + ai * HALF + m * 16) * DFF + j0) = w; }
  }
};
struct EpiDown {
  static constexpr bool PERM = true, MIDHOOK = false;
  const float* bdn; const LAS int* tab; const u32x2* rinfo; bf16_t* ypair;
  DI void operator()(const f32x4 (&acc)[2][2][4][2], const Unit& u, int wr, int wc, int fr, int fq) const {
    const int e = u.pn >> 2, pnl = u.pn & 3, col0 = pnl * BM + wc * 32 + 8 * fq;
    const int local0 = u.pm * BM - tab[32 + e] + wr * 64 + fr, cnt = tab[e];
    f32x4 bv[2][2];
#pragma unroll
    for (int bj = 0; bj < 2; ++bj)
#pragma unroll
      for (int n = 0; n < 2; ++n) bv[bj][n] = *(const f32x4*)(bdn + (size_t)e * DM + col0 + bj * HALF + 4 * n);
#pragma unroll
    for (int ai = 0; ai < 2; ++ai)
#pragma unroll
      for (int m = 0; m < 4; ++m) { const int local = local0 + ai * HALF + m * 16;
        if (local < cnt) { const u32x2 info = rinfo[(size_t)e * ECAP + local]; const float gate = __uint_as_float(info.y); bf16_t* rowp = ypair + (size_t)info.x * DM + col0;
#pragma unroll
          for (int bj = 0; bj < 2; ++bj) { const f32x4 v0 = (acc[ai][bj][m][0] + bv[bj][0]) * gate, v1 = (acc[ai][bj][m][1] + bv[bj][1]) * gate;
            u32x4 w; w.x = pk_bf16(v0[0], v0[1]); w.y = pk_bf16(v0[2], v0[3]); w.z = pk_bf16(v1[0], v1[1]); w.w = pk_bf16(v1[2], v1[3]);
            *(u32x4*)(rowp + bj * HALF) = w; } } }
  }
};
}
#if NAIVE_ANY
template <class F> DI void naive_gemm(const Ctx& c, const bf16_t* A, int lda, const bf16_t* Bt, int ldb, int M, int N, int K, F epi) {
  const int r = c.lane & 31, h = c.lane >> 5, tn_n = N / 32, tiles = (M / 32) * tn_n;
  for (int tile = c.gw; tile < tiles; tile += c.ngw) {
    const int tm = tile / tn_n, tn = tile - tm * tn_n;
    const bf16_t* ap = A + (size_t)(tm * 32 + r) * lda + 8 * h; const bf16_t* bp = Bt + (size_t)(tn * 32 + r) * ldb + 8 * h;
    f32x16 acc; for (int i = 0; i < 16; ++i) acc[i] = 0.f;
    for (int k0 = 0; k0 < K; k0 += 16) { const bf16x8 a = *(const bf16x8*)(ap + k0), b = *(const bf16x8*)(bp + k0); acc = MFMA32(a, b, acc); }
#pragma unroll
    for (int i = 0; i < 16; ++i) epi(tm * 32 + crow(i, h), tn * 32 + r, acc[i]);
  }
}
#endif

#if NAIVE_GDN
DI void naive_gdn_prep(const Ctx& c) {
  const bf16_t* proj = (const bf16_t*)(c.p.ws + WS_PROJ); bf16_t* qkv = (bf16_t*)(c.p.ws + WS_GDN); const float* wc = c.p.in[I_WCONV];
  for (int it = c.gw; it < TT * 4; it += c.ngw) {
    const int t = it >> 2, hh = it & 3, tl = t & (SEQ - 1);
    float val[3][2];
#pragma unroll
    for (int part = 0; part < 3; ++part)
#pragma unroll
      for (int e = 0; e < 2; ++e) { const int ch = part * 512 + hh * 128 + 2 * c.lane + e; float a = 0.f;
#pragma unroll
        for (int j = 0; j < 4; ++j) { const int ts = tl - 3 + j; if (ts >= 0) a += wc[j * 1536 + ch] * bf2f(proj[(size_t)(t - 3 + j) * NPROJ + ch]); }
        val[part][e] = a * sigmoidf_(a); }
    const float sq = wave_sum(val[0][0] * val[0][0] + val[0][1] * val[0][1]), sk = wave_sum(val[1][0] * val[1][0] + val[1][1] * val[1][1]);
    const float rq = rsqrtf(sq + NORM_EPS) * 0.08838834764831845f, rk = rsqrtf(sk + NORM_EPS);
    bf16_t* o = qkv + ((size_t)t * 4 + hh) * 384 + 2 * c.lane;
    *(unsigned*)(o) = pk_bf16(val[0][0] * rq, val[0][1] * rq); *(unsigned*)(o + 128) = pk_bf16(val[1][0] * rk, val[1][1] * rk); *(unsigned*)(o + 256) = pk_bf16(val[2][0], val[2][1]);
  }
}
DI void naive_gdn_scan(const Ctx& c) {
  if (c.bid >= 64) return;
  const int b = c.bid >> 2, hh = c.bid & 3, j = c.tid;
  const bf16_t* qkv = (const bf16_t*)(c.p.ws + WS_GDN); const float* gbeta = (const float*)(c.p.ws + WS_MISC); bf16_t* ycat = (bf16_t*)(c.p.ws + WS_YCAT);
  LAS float* sq = (LAS float*)c.lds; LAS float* sk = sq + 8 * 128;
  float S[128];
#pragma unroll
  for (int d = 0; d < 128; ++d) S[d] = 0.f;
  for (int t0 = 0; t0 < SEQ; t0 += 8) {
    __syncthreads();
    for (int i = c.tid; i < 8 * 256; i += 512) { const int tt = i >> 8, d = i & 255; const size_t t = (size_t)b * SEQ + t0 + tt;
      const float v = bf2f(qkv[(t * 4 + hh) * 384 + d]); if (d < 128) sq[tt * 128 + d] = v; else sk[tt * 128 + d - 128] = v; }
    __syncthreads();
    if (j < 128) {
      for (int tt = 0; tt < 8; ++tt) { const size_t t = (size_t)b * SEQ + t0 + tt;
        const float g = gbeta[t * 8 + hh], beta = gbeta[t * 8 + 4 + hh], dec = __expf(g), vt = bf2f(qkv[(t * 4 + hh) * 384 + 256 + j]);
        float ks = 0.f;
#pragma unroll
        for (int d = 0; d < 128; ++d) ks += sk[tt * 128 + d] * S[d];
        const float vn = beta * (vt - dec * ks); float o = 0.f;
#pragma unroll
        for (int d = 0; d < 128; ++d) { S[d] = dec * S[d] + sk[tt * 128 + d] * vn; o += sq[tt * 128 + d] * S[d]; }
        ycat[t * 1536 + hh * 128 + j] = f2bf(o); }
    }
  }
}
#endif

#if NAIVE_ATTN
DI void naive_sb(const Ctx& c) {
  const bf16_t* proj = (const bf16_t*)(c.p.ws + WS_PROJ); bf16_t* ycat = (bf16_t*)(c.p.ws + WS_YCAT);
  LAS float* wl = (LAS float*)c.lds + c.wave * 64;
  for (int it = c.gw; it < NB * 8 * SEQ; it += c.ngw) {
    const int tq = it & (SEQ - 1), hh = (it >> 11) & 7, b = it >> 14; const size_t trow = (size_t)b * SEQ + tq;
    float q[64];
    { const bf16_t* qp = proj + trow * NPROJ + C_SQ + hh * 64;
#pragma unroll
      for (int d8 = 0; d8 < 8; ++d8) { const u32x4 w = *(const u32x4*)(qp + 8 * d8);
#pragma unroll
        for (int e = 0; e < 4; ++e) { q[8 * d8 + 2 * e] = bflo(w[e]); q[8 * d8 + 2 * e + 1] = bfhi(w[e]); } } }
    float carry = 0.f, o = 0.f;
    for (int kt = (tq - 1) >> 6; kt >= 0 && tq > 0; --kt) {
      const int s = kt * 64 + c.lane; const bool valid = s < tq; const size_t srow = (size_t)b * SEQ + (valid ? s : 0);
      const bf16_t* kp = proj + srow * NPROJ + C_SK + hh * 64; float z = 0.f;
#pragma unroll
      for (int d8 = 0; d8 < 8; ++d8) { const u32x4 w = *(const u32x4*)(kp + 8 * d8);
#pragma unroll
        for (int e = 0; e < 4; ++e) z += q[8 * d8 + 2 * e] * bflo(w[e]) + q[8 * d8 + 2 * e + 1] * bfhi(w[e]); }
      z *= 0.125f;
      const float sp = valid ? softplusf_(z) : 0.f;
      float suf = sp;
#pragma unroll
      for (int off = 1; off < 64; off <<= 1) { const float o2 = __shfl_down(suf, off); if (c.lane + off < 64) suf += o2; }
      const float w = valid ? __expf(z - (carry + suf)) : 0.f;
      carry += __shfl(suf, 0);
      LDS_WAIT(); wl[c.lane] = w; LDS_WAIT();
      const int smax = min(64, tq - kt * 64);
      for (int ss = 0; ss < smax; ++ss) o += wl[ss] * bf2f(proj[((size_t)b * SEQ + kt * 64 + ss) * NPROJ + C_SV + hh * 64 + c.lane]);
      LDS_WAIT();
    }
    ycat[trow * 1536 + 512 + hh * 64 + c.lane] = f2bf(o);
  }
}
DI void naive_mem(const Ctx& c) {
  const bf16_t* proj = (const bf16_t*)(c.p.ws + WS_PROJ); const bf16_t* mkv = (const bf16_t*)(c.p.ws + WS_MKV); bf16_t* ycat = (bf16_t*)(c.p.ws + WS_YCAT);
  LAS float* pl = (LAS float*)(c.lds + 4096) + c.wave * 256;
  for (int it = c.gw; it < NB * 4 * SEQ; it += c.ngw) {
    const int tq = it & (SEQ - 1), hh = (it >> 11) & 3, b = it >> 13; const size_t trow = (size_t)b * SEQ + tq;
    const bf16_t* qp = proj + trow * NPROJ + C_MQ + hh * 128;
    float sc[4];
#pragma unroll
    for (int kt = 0; kt < 4; ++kt) { const bf16_t* kp = mkv + (size_t)(b * MEMLEN + kt * 64 + c.lane) * 1024 + hh * 128; float z = 0.f;
      for (int d8 = 0; d8 < 16; ++d8) { const u32x4 w = *(const u32x4*)(kp + 8 * d8), qw = *(const u32x4*)(qp + 8 * d8);
#pragma unroll
        for (int e = 0; e < 4; ++e) z += bflo(qw[e]) * bflo(w[e]) + bfhi(qw[e]) * bfhi(w[e]); }
      sc[kt] = z * 0.08838834764831845f; }
    const float mx = wave_max(fmaxf(fmaxf(sc[0], sc[1]), fmaxf(sc[2], sc[3])));
    float pe[4], ssum = 0.f;
#pragma unroll
    for (int kt = 0; kt < 4; ++kt) { pe[kt] = __expf(sc[kt] - mx); ssum += pe[kt]; }
    ssum = wave_sum(ssum);
    LDS_WAIT();
#pragma unroll
    for (int kt = 0; kt < 4; ++kt) pl[kt * 64 + c.lane] = pe[kt] / ssum;
    LDS_WAIT();
    float o0 = 0.f, o1 = 0.f;
    for (int s = 0; s < 256; ++s) { const unsigned vv = *(const unsigned*)(mkv + (size_t)(b * MEMLEN + s) * 1024 + 512 + hh * 128 + 2 * c.lane); const float pw = pl[s]; o0 += pw * bflo(vv); o1 += pw * bfhi(vv); }
    LDS_WAIT();
    *(unsigned*)(ycat + trow * 1536 + 1024 + hh * 128 + 2 * c.lane) = pk_bf16(o0, o1);
  }
}
#endif
DI void tr_item(const float* src, int ldw, bf16_t* dst, int ldd, LAS float* scr, int lane) {
#pragma unroll
  for (int i = 0; i < 8; ++i) { const int kk = 8 * i + (lane >> 3); const f32x4 v = *(const f32x4*)(src + (size_t)kk * ldw + 4 * (lane & 7));
    LAS float* s = scr + kk * 33 + 4 * (lane & 7); s[0] = v.x; s[1] = v.y; s[2] = v.z; s[3] = v.w; }
  LDS_WAIT();
  const int cc = lane & 7;
#pragma unroll
  for (int j = 0; j < 4; ++j) { const int n = (lane >> 3) + 8 * j; const LAS float* s = scr + (8 * cc) * 33 + n;
    u32x4 o; o.x = pk_bf16(s[0 * 33], s[1 * 33]); o.y = pk_bf16(s[2 * 33], s[3 * 33]); o.z = pk_bf16(s[4 * 33], s[5 * 33]); o.w = pk_bf16(s[6 * 33], s[7 * 33]);
    *(u32x4*)(dst + (size_t)n * ldd + 8 * cc) = o; }
  LDS_WAIT();
}
DI void phase0(const Ctx& c) {
  unsigned char* ws = c.p.ws;
  if (c.bid == 0 && c.tid < 32) ((int*)(ws + WS_MISC + MiB))[c.tid] = 0;
  {
    LAS float* scr = (LAS float*)(c.lds + c.wave * 8448);
    for (int r = c.gw; r < 16 * 224; r += c.ngw) { const int kb = r / 224, nb = r % 224; const int n0 = 32 * nb + (nb >= 64 ? 8 : 0);
      tr_item(c.p.in[I_WIN] + (size_t)(64 * kb) * 7176 + n0, 7176, (bf16_t*)(ws + WS_WIN) + (size_t)(32 * nb) * 1024 + 64 * kb, 1024, scr, c.lane); }
    for (int r = (c.gw + 512) % c.ngw; r < 16 * 32; r += c.ngw) { const int kb = r / 32, nb = r % 32;
      tr_item(c.p.in[I_WMKV] + (size_t)(64 * kb) * 1024 + 32 * nb, 1024, (bf16_t*)(ws + WS_WMKV) + (size_t)(32 * nb) * 1024 + 64 * kb, 1024, scr, c.lane); }
    for (int r = (c.gw + 1024) % c.ngw; r < 8 * 32; r += c.ngw) { const int kb = r / 32, nb = r % 32;
      tr_item(c.p.in[I_WPG] + (size_t)(64 * kb) * 1024 + 32 * nb, 1024, (bf16_t*)(ws + WS_WP) + (size_t)(32 * nb) * 1536 + 0 * 512 + 64 * kb, 1536, scr, c.lane); }
    for (int r = (c.gw + 1280) % c.ngw; r < 8 * 32; r += c.ngw) { const int kb = r / 32, nb = r % 32;
      tr_item(c.p.in[I_WPS] + (size_t)(64 * kb) * 1024 + 32 * nb, 1024, (bf16_t*)(ws + WS_WP) + (size_t)(32 * nb) * 1536 + 1 * 512 + 64 * kb, 1536, scr, c.lane); }
    for (int r = (c.gw + 1536) % c.ngw; r < 8 * 32; r += c.ngw) { const int kb = r / 32, nb = r % 32;
      tr_item(c.p.in[I_WPM] + (size_t)(64 * kb) * 1024 + 32 * nb, 1024, (bf16_t*)(ws + WS_WP) + (size_t)(32 * nb) * 1536 + 2 * 512 + 64 * kb, 1536, scr, c.lane); }
    for (int r = (c.gw + 1792) % c.ngw; r < 16 * 32; r += c.ngw) { const int kb = r / 32, nb = r % 32;
      tr_item(c.p.in[I_WO] + (size_t)(64 * kb) * 1024 + 32 * nb, 1024, (bf16_t*)(ws + WS_WO) + (size_t)(32 * nb) * 1024 + 64 * kb, 1024, scr, c.lane); }
    for (int r = c.gw; r < 32 * 16 * 64; r += c.ngw) { const int e = r / 1024, q = r % 1024, kb = q / 64, nb = q % 64; const int r0 = 32 * nb, n0 = ((r0 >> 7) & 1) * 1024 + (r0 >> 8) * 128 + (r0 & 127);
      tr_item(c.p.in[I_WGU] + (size_t)e * 1024 * 2048 + (size_t)(64 * kb) * 2048 + n0, 2048, (bf16_t*)(ws + WS_WGU) + ((size_t)e * 2048 + r0) * 1024 + 64 * kb, 1024, scr, c.lane); }
    for (int r = c.gw; r < 32 * 16 * 32; r += c.ngw) { const int e = r / 512, q = r % 512, kb = q / 32, nb = q % 32;
      tr_item(c.p.in[I_WDN] + (size_t)e * 1024 * 1024 + (size_t)(64 * kb) * 1024 + 32 * nb, 1024, (bf16_t*)(ws + WS_WDN) + ((size_t)e * 1024 + 32 * nb) * 1024 + 64 * kb, 1024, scr, c.lane); }
  }
  { const f32x4* src = (const f32x4*)c.p.in[I_MEM]; u32x2* dst = (u32x2*)(ws + WS_MEMB);
    for (int i = c.bid * 512 + c.tid; i < NB * MEMLEN * DM / 4; i += c.G * 512) { const f32x4 v = src[i]; u32x2 o; o.x = pk_bf16(v.x, v.y); o.y = pk_bf16(v.z, v.w); dst[i] = o; } }
  {
    float wab[4][4][8];
#pragma unroll
    for (int j = 0; j < 4; ++j)
#pragma unroll
      for (int i = 0; i < 4; ++i) { const float* wp = c.p.in[I_WIN] + (size_t)(256 * j + 4 * c.lane + i) * 7176 + 2048; const f32x4 a = *(const f32x4*)wp, b = *(const f32x4*)(wp + 4);
        wab[j][i][0] = a.x; wab[j][i][1] = a.y; wab[j][i][2] = a.z; wab[j][i][3] = a.w; wab[j][i][4] = b.x; wab[j][i][5] = b.y; wab[j][i][6] = b.z; wab[j][i][7] = b.w; }
    const int hh = c.lane & 3; const float nega = -__expf(c.p.in[I_ALOG][hh]), dtb = c.p.in[I_DTB][hh];
    float* gbeta = (float*)(ws + WS_MISC);
    for (int m = c.gw; m < TT; m += c.ngw) {
      const f32x4* xr = (const f32x4*)(c.p.in[I_X] + (size_t)m * DM) + c.lane; u32x2* xo = (u32x2*)(ws + WS_XB + (size_t)m * DM * 2) + c.lane;
      float s[8];
#pragma unroll
      for (int q = 0; q < 8; ++q) s[q] = 0.f;
#pragma unroll
      for (int j = 0; j < 4; ++j) { const f32x4 v = xr[64 * j]; u32x2 o; o.x = pk_bf16(v.x, v.y); o.y = pk_bf16(v.z, v.w); xo[64 * j] = o;
#pragma unroll
        for (int q = 0; q < 8; ++q) s[q] += v.x * wab[j][0][q] + v.y * wab[j][1][q] + v.z * wab[j][2][q] + v.w * wab[j][3][q]; }
#pragma unroll
      for (int q = 0; q < 8; ++q) s[q] = wave_sum(s[q]);
      if (c.lane < 8) {
        float pre = s[0];
#pragma unroll
        for (int q = 1; q < 8; ++q) pre = (c.lane == q) ? s[q] : pre;
        const float val = c.lane < 4 ? nega * softplusf_(pre + dtb) : sigmoidf_(pre);
        gbeta[(size_t)m * 8 + c.lane] = val;
      }
    }
  }
}

DI void phase_gdn_norm(const Ctx& c) {
  bf16_t* ycat = (bf16_t*)(c.p.ws + WS_YCAT); const bf16_t* proj = (const bf16_t*)(c.p.ws + WS_PROJ); const float* nw = c.p.in[I_GNW];
  const float w0 = nw[2 * c.lane], w1 = nw[2 * c.lane + 1];
  for (int it = c.gw; it < TT * 4; it += c.ngw) {
    const int t = it >> 2, hh = it & 3;
    unsigned* op = (unsigned*)(ycat + (size_t)t * 1536 + hh * 128) + c.lane; const unsigned ov = *op, zv = *((const unsigned*)(proj + (size_t)t * NPROJ + C_GZ + hh * 128) + c.lane);
    const float o0 = bflo(ov), o1 = bfhi(ov), z0 = bflo(zv), z1 = bfhi(zv);
    const float rs = rsqrtf(wave_sum(o0 * o0 + o1 * o1) * (1.f / 128.f) + NORM_EPS);
    *op = pk_bf16(o0 * rs * w0 * (z0 * sigmoidf_(z0)), o1 * rs * w1 * (z1 * sigmoidf_(z1)));
  }
}

DI void phase_router(const Ctx& c) {
  unsigned char* ws = c.p.ws;
  const float* h = (const float*)(ws + WS_H); float* x1 = (float*)(ws + WS_X1); bf16_t* x1b = (bf16_t*)(ws + WS_X1B);
  const float* wr = c.p.in[I_WR]; int* gcount = (int*)(ws + WS_MISC + MiB); u32x2* rinfo = (u32x2*)(ws + WS_RINFO);
  LAS float* xs = (LAS float*)(c.lds + c.wave * 16384);
  LAS int* wcnt = (LAS int*)(c.lds + 131072);
  LAS int* bbase = wcnt + 256;
  const int e = c.lane & 31, half = c.lane >> 5;
  f32x4 gam[4], bet[4];
#pragma unroll
  for (int j = 0; j < 4; ++j) { gam[j] = ((const f32x4*)c.p.in[I_LN1G])[64 * j + c.lane]; bet[j] = ((const f32x4*)c.p.in[I_LN1B])[64 * j + c.lane]; }
  const float brv = c.p.in[I_BR][e];
  int mycnt = 0;
  LAS int* sel_e = bbase + 32 + c.wave * 64; LAS int* sel_pos = sel_e + 512; LAS float* sel_g = (LAS float*)(sel_e + 1024);
  for (int gi = c.bid; gi < TT / 128; gi += c.G) {
    const int tok0 = gi * 128 + c.wave * 16;
#pragma unroll
    for (int qd = 0; qd < 4; ++qd) {
      LDS_WAIT();
#pragma unroll
      for (int tt = 0; tt < 4; ++tt) {
        const size_t t = (size_t)tok0 + qd * 4 + tt;
        const f32x4* hr = (const f32x4*)(h + t * DM) + c.lane; f32x4 v[4]; float s = 0.f;
#pragma unroll
        for (int j = 0; j < 4; ++j) { v[j] = hr[64 * j]; s += (v[j].x + v[j].y) + (v[j].z + v[j].w); }
        const float mean = wave_sum(s) * (1.f / DM); float s2 = 0.f;
#pragma unroll
        for (int j = 0; j < 4; ++j) { v[j] = v[j] - mean; s2 += (v[j].x * v[j].x + v[j].y * v[j].y) + (v[j].z * v[j].z + v[j].w * v[j].w); }
        const float rstd = rsqrtf(wave_sum(s2) * (1.f / DM) + LN_EPS);
#pragma unroll
        for (int j = 0; j < 4; ++j) { const f32x4 y = v[j] * rstd * gam[j] + bet[j];
          ((f32x4*)(x1 + t * DM))[64 * j + c.lane] = y; u32x2 o; o.x = pk_bf16(y.x, y.y); o.y = pk_bf16(y.z, y.w); ((u32x2*)(x1b + t * DM))[64 * j + c.lane] = o;
          *(LAS f32x4*)(xs + tt * 1024 + 256 * j + 4 * c.lane) = y; }
      }
      LDS_WAIT();
      float lg[4] = {0.f, 0.f, 0.f, 0.f};
      const float* wp = wr + (size_t)(512 * half) * 32 + e; const LAS float* xp = xs + 512 * half;
      for (int k = 0; k < 512; k += 4) {
        const float w0 = wp[(k + 0) * 32], w1 = wp[(k + 1) * 32], w2 = wp[(k + 2) * 32], w3 = wp[(k + 3) * 32];
#pragma unroll
        for (int tt = 0; tt < 4; ++tt) { const f32x4 xv = *(const LAS f32x4*)(xp + tt * 1024 + k); lg[tt] += (xv.x * w0 + xv.y * w1) + (xv.z * w2 + xv.w * w3); }
      }
#pragma unroll
      for (int tt = 0; tt < 4; ++tt) {
        float logit = lg[tt] + __shfl_xor(lg[tt], 32) + brv;
        float tv[4]; int ti[4];
#pragma unroll
        for (int k = 0; k < 4; ++k) {
          float bv = logit; int bi = e;
#pragma unroll
          for (int o = 1; o < 32; o <<= 1) { const float ov = __shfl_xor(bv, o); const int oi = __shfl_xor(bi, o); if (ov > bv || (ov == bv && oi < bi)) { bv = ov; bi = oi; } }
          tv[k] = bv; ti[k] = bi; if (e == bi) logit = -INFINITY;
        }
        const float e1 = __expf(tv[1] - tv[0]), e2 = __expf(tv[2] - tv[0]), e3 = __expf(tv[3] - tv[0]), inv = 1.f / (1.f + e1 + e2 + e3);
        const float gk = (c.lane == 0 ? 1.f : c.lane == 1 ? e1 : c.lane == 2 ? e2 : e3) * inv;
        const int ek = c.lane == 0 ? ti[0] : c.lane == 1 ? ti[1] : c.lane == 2 ? ti[2] : ti[3];
        const int cnt_e = __shfl(mycnt, ek);
        const bool chosen = (e == ti[0]) | (e == ti[1]) | (e == ti[2]) | (e == ti[3]);
        if (c.lane < 32 && chosen) mycnt += 1;
        if (c.lane < 4) { sel_e[(qd * 4 + tt) * 4 + c.lane] = ek; sel_pos[(qd * 4 + tt) * 4 + c.lane] = cnt_e; sel_g[(qd * 4 + tt) * 4 + c.lane] = gk; }
      }
    }
    if (c.lane < 32) wcnt[c.wave * 32 + c.lane] = mycnt;
    __syncthreads();
    if (c.tid < 32) { int tot = 0;
#pragma unroll
      for (int w = 0; w < 8; ++w) tot += wcnt[w * 32 + c.tid];
      bbase[c.tid] = (tot && !(c.p.flags & 16)) ? atomicAdd(gcount + c.tid, tot) : 0; }
    __syncthreads();
    if (c.lane < 4 && !(c.p.flags & 16)) {
#pragma unroll
      for (int i = 0; i < 16; ++i) { const int ek = sel_e[i * 4 + c.lane]; int base = bbase[ek];
        for (int w = 0; w < c.wave; ++w) base += wcnt[w * 32 + ek];
        u32x2 info; info.x = (unsigned)((tok0 + i) * 4 + c.lane); info.y = __float_as_uint(sel_g[i * 4 + c.lane]);
        rinfo[(size_t)ek * ECAP + base + sel_pos[i * 4 + c.lane]] = info; }
    }
    __syncthreads();
    mycnt = 0;
  }
}

DI void build_group_tab(const Ctx& c, LAS int* tab) {
  const int* gcount = (const int*)(c.p.ws + WS_MISC + MiB);
  __syncthreads();
  if (c.tid == 0) { int ps = 0;
    for (int e = 0; e < 32; ++e) { const int cnt = gcount[e]; tab[e] = cnt; tab[32 + e] = ps; const int nt_ = (cnt + 255) >> 8; for (int q = 0; q < nt_; ++q) tab[96 + (ps >> 8) + q] = e; ps += nt_ << 8; }
    tab[64] = ps; tab[65] = ps >> 8; }
  __syncthreads();
}

DI void phase_final(const Ctx& c) {
  const float* x1 = (const float*)(c.p.ws + WS_X1); const bf16_t* yp = (const bf16_t*)(c.p.ws + WS_YPAIR);
  f32x4 gam[4], bet[4];
#pragma unroll
  for (int j = 0; j < 4; ++j) { gam[j] = ((const f32x4*)c.p.in[I_LN2G])[64 * j + c.lane]; bet[j] = ((const f32x4*)c.p.in[I_LN2B])[64 * j + c.lane]; }
  for (int t = c.gw; t < TT; t += c.ngw) {
    f32x4 v[4]; float s = 0.f;
#pragma unroll
    for (int j = 0; j < 4; ++j) { v[j] = ((const f32x4*)(x1 + (size_t)t * DM))[64 * j + c.lane] * DN_ALPHA;
#pragma unroll
      for (int k = 0; k < 4; ++k) { const u32x2 w = ((const u32x2*)(yp + ((size_t)t * 4 + k) * DM))[64 * j + c.lane]; v[j].x += bflo(w.x); v[j].y += bfhi(w.x); v[j].z += bflo(w.y); v[j].w += bfhi(w.y); }
      s += (v[j].x + v[j].y) + (v[j].z + v[j].w); }
    const float mean = wave_sum(s) * (1.f / DM); float s2 = 0.f;
#pragma unroll
    for (int j = 0; j < 4; ++j) { v[j] = v[j] - mean; s2 += (v[j].x * v[j].x + v[j].y * v[j].y) + (v[j].z * v[j].z + v[j].w * v[j].w); }
    const float rstd = rsqrtf(wave_sum(s2) * (1.f / DM) + LN_EPS);
#pragma unroll
    for (int j = 0; j < 4; ++j) ((f32x4*)(c.p.out + (size_t)t * DM))[64 * j + c.lane] = v[j] * rstd * gam[j] + bet[j];
  }
}
DI bf16x8 pack8(const f32x16& x, int s) {
  u32x4 p; p.x = pk_bf16(x[8 * s + 0], x[8 * s + 1]); p.y = pk_bf16(x[8 * s + 2], x[8 * s + 3]); p.z = pk_bf16(x[8 * s + 4], x[8 * s + 5]); p.w = pk_bf16(x[8 * s + 6], x[8 * s + 7]);
  return __builtin_bit_cast(bf16x8, p);
}
DI void store8(bf16_t* dst, const f32x16& x, int s, float sc) {
  u32x4 p; p.x = pk_bf16(x[8 * s + 0] * sc, x[8 * s + 1] * sc); p.y = pk_bf16(x[8 * s + 2] * sc, x[8 * s + 3] * sc); p.z = pk_bf16(x[8 * s + 4] * sc, x[8 * s + 5] * sc); p.w = pk_bf16(x[8 * s + 6] * sc, x[8 * s + 7] * sc);
  *(u32x4*)dst = p;
}

#if !NAIVE_GDN
DI void phase_gdn_chunk(const Ctx& c) {
  unsigned char* ws = c.p.ws;
  const bf16_t* proj = (const bf16_t*)(ws + WS_PROJ); const float* gbeta = (const float*)(ws + WS_MISC); const float* wcv = c.p.in[I_WCONV];
  float* egl = (float*)(ws + WS_MISC + MiB + 4096);
  const int team = c.wave >> 2, tw = c.wave & 3, ttid = c.tid & 255, r = c.lane & 31, hf = c.lane >> 5;
  LAS unsigned char* tl = c.lds + team * 71680;
  LAS bf16_t* ks = (LAS bf16_t*)tl; LAS bf16_t* qs = (LAS bf16_t*)(tl + 17408); LAS bf16_t* kT = (LAS bf16_t*)(tl + 34816); LAS bf16_t* vT = (LAS bf16_t*)(tl + 53248);
  LAS float* Am = (LAS float*)(tl + 17408); LAS bf16_t* T1 = (LAS bf16_t*)tl; LAS bf16_t* T2 = (LAS bf16_t*)(tl + 9216);
  LAS float* sc = (LAS float*)(c.lds + 143360 + team * 1024);
  float wc[3][2][4];
  const int nchunk = NB * 4 * 32, niter = (nchunk + 2 * c.G - 1) / (2 * c.G);
  for (int itr = 0; itr < niter; ++itr) {
    const int ci_raw = (itr * c.G + c.bid) * 2 + team; const bool live = ci_raw < nchunk; const int ci = live ? ci_raw : 0;
    const int n = ci & 31, hh = (ci >> 5) & 3, b = ci >> 7; const int tok0 = b * SEQ + n * 64;
    unsigned char* cb = ws + WS_GDN + (size_t)ci * GDN_CHUNK_BYTES;
#pragma unroll
    for (int part = 0; part < 3; ++part)
#pragma unroll
      for (int e = 0; e < 2; ++e)
#pragma unroll
        for (int j = 0; j < 4; ++j) wc[part][e][j] = wcv[j * 1536 + part * 512 + hh * 128 + 2 * c.lane + e];
    const float gl = gbeta[(size_t)(tok0 + c.lane) * 8 + hh], bt = gbeta[(size_t)(tok0 + c.lane) * 8 + 4 + hh];
    float gc = gl;
#pragma unroll
    for (int off = 1; off < 64; off <<= 1) { const float o2 = __shfl_up(gc, off); if (c.lane >= off) gc += o2; }
    const float glast = __shfl(gc, 63);
    if (tw == 0) { sc[c.lane] = gc; sc[64 + c.lane] = bt; sc[128 + c.lane] = __expf(glast - gc); if (c.lane == 0 && live) egl[ci] = __expf(glast); }
    for (int i4 = 0; i4 < 16; i4 += 4) {
    unsigned pv[3][7];
#pragma unroll
    for (int part = 0; part < 3; ++part)
#pragma unroll
      for (int rr = 0; rr < 7; ++rr) { const int tl2 = n * 64 + tw * 16 + i4 - 3 + rr; pv[part][rr] = tl2 >= 0 ? *(const unsigned*)(proj + (size_t)(tok0 + tw * 16 + i4 - 3 + rr) * NPROJ + part * 512 + hh * 128 + 2 * c.lane) : 0u; }
#pragma unroll
    for (int ii = 0; ii < 4; ++ii) {
      const int cc = tw * 16 + i4 + ii; float val[3][2];
#pragma unroll
      for (int part = 0; part < 3; ++part) { float a0 = 0.f, a1 = 0.f;
#pragma unroll
        for (int j = 0; j < 4; ++j) { a0 += wc[part][0][j] * bflo(pv[part][ii + j]); a1 += wc[part][1][j] * bfhi(pv[part][ii + j]); }
        val[part][0] = a0 * sigmoidf_(a0); val[part][1] = a1 * sigmoidf_(a1); }
      const float sq = wave_sum(val[0][0] * val[0][0] + val[0][1] * val[0][1]), sk = wave_sum(val[1][0] * val[1][0] + val[1][1] * val[1][1]);
      const float rq = rsqrtf(sq + NORM_EPS) * 0.08838834764831845f, rk = rsqrtf(sk + NORM_EPS);
      const float q0 = val[0][0] * rq, q1 = val[0][1] * rq, k0 = val[1][0] * rk, k1 = val[1][1] * rk;
      const unsigned kp = pk_bf16(k0, k1), vp = pk_bf16(val[2][0], val[2][1]);
      *(LAS unsigned*)(qs + cc * 136 + 2 * c.lane) = pk_bf16(q0, q1); *(LAS unsigned*)(ks + cc * 136 + 2 * c.lane) = kp;
      kT[(2 * c.lane) * 72 + cc] = (bf16_t)(kp & 0xffffu); kT[(2 * c.lane + 1) * 72 + cc] = (bf16_t)(kp >> 16);
      vT[(2 * c.lane) * 72 + cc] = (bf16_t)(vp & 0xffffu); vT[(2 * c.lane + 1) * 72 + cc] = (bf16_t)(vp >> 16);
      const float eg = __expf(__shfl(gc, cc));
      { const int pos = swap23(2 * c.lane); if (live) *(unsigned*)(cb + 16384 + (size_t)cc * 256 + 16 * ((pos >> 3) ^ (cc & 15)) + 2 * (pos & 7)) = pk_bf16(q0 * eg, q1 * eg); }
    }
    }
    __syncthreads();
    if (c.p.flags & 4) continue;
    const int mi = tw >> 1, ni = tw & 1;
    f32x16 akk, aat;
#pragma unroll
    for (int i = 0; i < 16; ++i) { akk[i] = 0.f; aat[i] = 0.f; }
#pragma unroll
    for (int s = 0; s < 8; ++s) { const bf16x8 ka = *(const LAS bf16x8*)(ks + (32 * mi + r) * 136 + 16 * s + 8 * hf);
      akk = MFMA32(ka, *(const LAS bf16x8*)(ks + (32 * ni + r) * 136 + 16 * s + 8 * hf), akk);
      aat = MFMA32(ka, *(const LAS bf16x8*)(qs + (32 * ni + r) * 136 + 16 * s + 8 * hf), aat); }
    {
      const int cout = 32 * ni + r; const float gco = sc[cout];
#pragma unroll
      for (int i = 0; i < 16; ++i) { const int cr = 32 * mi + crow(i, hf); aat[i] = cout >= cr ? aat[i] * __expf(gco - sc[cr]) : 0.f; }
      if (live) { unsigned char* rp = cb + 49152 + (size_t)cout * 128; const int sw = (cout >> 1) & 7; store8((bf16_t*)(rp + 16 * ((4 * mi + hf) ^ sw)), aat, 0, 1.f); store8((bf16_t*)(rp + 16 * ((4 * mi + 2 + hf) ^ sw)), aat, 1, 1.f); }
    }
    __syncthreads();
    { const int j = 32 * ni + r; const float gcj = sc[j];
#pragma unroll
      for (int i = 0; i < 16; ++i) { const int cr = 32 * mi + crow(i, hf); Am[cr * 64 + j] = cr > j ? akk[i] * __expf(sc[cr] - gcj) * sc[64 + cr] : 0.f; } }
    __syncthreads();
    if (c.p.flags & 8) continue;
    if (tw == 0) {
      float t[64];
#pragma unroll
      for (int i = 0; i < 64; ++i) {
        float a0 = 0.f, a1 = 0.f, a2 = 0.f, a3 = 0.f;
#pragma unroll
        for (int m4 = 0; m4 < i; m4 += 4) { const f32x4 av = *(const LAS f32x4*)(Am + i * 64 + m4);
          a0 += av.x * t[m4]; if (m4 + 1 < i) a1 += av.y * t[m4 + 1]; if (m4 + 2 < i) a2 += av.z * t[m4 + 2]; if (m4 + 3 < i) a3 += av.w * t[m4 + 3]; }
        t[i] = (c.lane == i ? 1.f : 0.f) - ((a0 + a1) + (a2 + a3));
      }
      LDS_WAIT();
      const float bj = sc[64 + c.lane], bej = bj * __expf(sc[c.lane]);
#pragma unroll
      for (int i = 0; i < 64; ++i) { T1[i * 72 + c.lane] = f2bf(t[i] * bj); T2[i * 72 + c.lane] = f2bf(t[i] * bej); }
    } else {
      for (int it = ttid - 64; it < 1024; it += 192) { const int dk = it >> 3, s = (it >> 1) & 3, h2 = it & 1;
        const u32x2 lo = *(const LAS u32x2*)(kT + dk * 72 + 16 * s + 4 * h2), hi = *(const LAS u32x2*)(kT + dk * 72 + 16 * s + 8 + 4 * h2);
        const LAS float* e0 = sc + 128 + 16 * s + 4 * h2; const LAS float* e1 = e0 + 8;
        u32x4 o; o.x = pk_bf16(bflo(lo.x) * e0[0], bfhi(lo.x) * e0[1]); o.y = pk_bf16(bflo(lo.y) * e0[2], bfhi(lo.y) * e0[3]);
        o.z = pk_bf16(bflo(hi.x) * e1[0], bfhi(hi.x) * e1[1]); o.w = pk_bf16(bflo(hi.y) * e1[2], bfhi(hi.y) * e1[3]);
        if (live) *(u32x4*)(cb + 32768 + (size_t)dk * 128 + 16 * ((2 * s + h2) ^ ((dk >> 1) & 7))) = o; }
    }
    __syncthreads();
#pragma unroll
    for (int q = 0; q < 2; ++q) {
      const int job = tw * 2 + q;
      const int mu = job & 1, nu = job >> 1, mw = job >> 1, nw = job & 1;
      f32x16 au, aw;
#pragma unroll
      for (int i = 0; i < 16; ++i) { au[i] = 0.f; aw[i] = 0.f; }
#pragma unroll
      for (int s = 0; s < 4; ++s) {
        au = MFMA32(*(const LAS bf16x8*)(T1 + (32 * mu + r) * 72 + 16 * s + 8 * hf), *(const LAS bf16x8*)(vT + (32 * nu + r) * 72 + 16 * s + 8 * hf), au);
        aw = MFMA32(*(const LAS bf16x8*)(kT + (32 * mw + r) * 72 + 16 * s + 8 * hf), *(const LAS bf16x8*)(T2 + (32 * nw + r) * 72 + 16 * s + 8 * hf), aw); }
      if (live) {
        bf16_t* up = (bf16_t*)(cb + 57344 + (size_t)(32 * nu + r) * 128) + 32 * mu + 8 * hf; store8(up, au, 0, 1.f); store8(up + 16, au, 1, 1.f);
        unsigned char* wp = cb + (size_t)(32 * nw + r) * 256; const int sw = (32 * nw + r) & 15; store8((bf16_t*)(wp + 16 * ((4 * mw + hf) ^ sw)), aw, 0, 1.f); store8((bf16_t*)(wp + 16 * ((4 * mw + 2 + hf) ^ sw)), aw, 1, 1.f); }
    }
    __syncthreads();
  }
}

DI void scan_unit(const Ctx& c, LAS unsigned char* sl) {
  const int bh = c.bid & 63, dv0 = (c.bid >> 6) * 32, b = bh >> 2, hh = bh & 3, r = c.lane & 31, hf = c.lane >> 5;
  const unsigned char* ws = c.p.ws; const float* egl = (const float*)(ws + WS_MISC + MiB + 4096); bf16_t* ycat = (bf16_t*)(c.p.ws + WS_YCAT);
  const unsigned char* cb0 = ws + WS_GDN + (size_t)(bh * 32) * GDN_CHUNK_BYTES;
  f32x16 S[4];
#pragma unroll
  for (int m = 0; m < 4; ++m)
#pragma unroll
    for (int i = 0; i < 16; ++i) S[m][i] = 0.f;
  const int sw16 = r & 15, sw8 = (r >> 1) & 7;
#define SCAN_DMA(buf, chunk) do { const unsigned char* _g = cb0 + (size_t)(chunk) * GDN_CHUNK_BYTES + c.lane * 16; LAS unsigned char* _l = sl + (buf) * 57344; \
    _Pragma("unroll") for (int _i = 0; _i < 56; ++_i) __builtin_amdgcn_global_load_lds((const unsigned*)(_g + _i * 1024), (LAS unsigned*)(_l + _i * 1024), 16, 0, 0); } while (0)
  SCAN_DMA(0, 0);
  u32x4 un[4];
#pragma unroll
  for (int q = 0; q < 4; ++q) un[q] = *(const u32x4*)(cb0 + 57344 + (size_t)(dv0 + r) * 128 + 32 * q + 16 * hf);
  for (int n = 0; n < 32; ++n) {
    asm volatile("s_waitcnt vmcnt(0)" ::: "memory");
    u32x4 uc[4];
#pragma unroll
    for (int q = 0; q < 4; ++q) uc[q] = un[q];
    const int nn = n < 31 ? n + 1 : 31;
    SCAN_DMA((n + 1) & 1, nn);
#pragma unroll
    for (int q = 0; q < 4; ++q) un[q] = *(const u32x4*)(cb0 + (size_t)nn * GDN_CHUNK_BYTES + 57344 + (size_t)(dv0 + r) * 128 + 32 * q + 16 * hf);
    const float eg = egl[bh * 32 + n];
    const LAS unsigned char* L = sl + (n & 1) * 57344;
    const LAS unsigned char* wL = L + r * 256; const LAS unsigned char* qL = L + 16384 + r * 256; const LAS unsigned char* kL = L + 32768 + r * 128; const LAS unsigned char* aL = L + 49152 + r * 128;
    bf16x8 Sb[8];
#pragma unroll
    for (int s = 0; s < 8; ++s) Sb[s] = pack8(S[s >> 1], s & 1);
    f32x16 vn[2], o[2];
#pragma unroll
    for (int m = 0; m < 2; ++m) {
#pragma unroll
      for (int i = 0; i < 16; ++i) { vn[m][i] = 0.f; o[m][i] = 0.f; }
#pragma unroll
      for (int s = 0; s < 8; ++s) { vn[m] = MFMA32(*(const LAS bf16x8*)(wL + m * 8192 + 16 * ((2 * s + hf) ^ sw16)), Sb[s], vn[m]); o[m] = MFMA32(*(const LAS bf16x8*)(qL + m * 8192 + 16 * ((2 * s + hf) ^ sw16)), Sb[s], o[m]); }
    }
#pragma unroll
    for (int m = 0; m < 2; ++m)
#pragma unroll
      for (int s2 = 0; s2 < 2; ++s2) { const u32x4 uv = uc[2 * m + s2];
#pragma unroll
        for (int q = 0; q < 4; ++q) { vn[m][8 * s2 + 2 * q] = bflo(uv[q]) - vn[m][8 * s2 + 2 * q]; vn[m][8 * s2 + 2 * q + 1] = bfhi(uv[q]) - vn[m][8 * s2 + 2 * q + 1]; } }
    bf16x8 vb[4];
#pragma unroll
    for (int s = 0; s < 4; ++s) vb[s] = pack8(vn[s >> 1], s & 1);
#pragma unroll
    for (int m = 0; m < 2; ++m)
#pragma unroll
      for (int s = 0; s < 4; ++s) o[m] = MFMA32(*(const LAS bf16x8*)(aL + m * 4096 + 16 * ((2 * s + hf) ^ sw8)), vb[s], o[m]);
#pragma unroll
    for (int m = 0; m < 4; ++m) {
#pragma unroll
      for (int i = 0; i < 16; ++i) S[m][i] *= eg;
#pragma unroll
      for (int s = 0; s < 4; ++s) S[m] = MFMA32(*(const LAS bf16x8*)(kL + m * 4096 + 16 * ((2 * s + hf) ^ sw8)), vb[s], S[m]);
    }
    bf16_t* yp = ycat + (size_t)(b * SEQ + n * 64) * 1536 + hh * 128 + dv0 + r;
#pragma unroll
    for (int m = 0; m < 2; ++m)
#pragma unroll
      for (int i = 0; i < 16; ++i) yp[(size_t)(32 * m + crow(i, hf)) * 1536] = f2bf(o[m][i]);
  }
  asm volatile("s_waitcnt vmcnt(0)" ::: "memory");
#undef SCAN_DMA
}
#endif

#if !NAIVE_ATTN
DI void load_v64(u32x4 (&vr)[4], const bf16_t* vsrc, size_t ld, int lane) {
#pragma unroll
  for (int i = 0; i < 4; ++i) { const int q = lane + 64 * i; vr[i] = *(const u32x4*)(vsrc + (size_t)(q >> 3) * ld + (q & 7) * 8); }
}
DI void put_v64(LAS bf16_t* vl, const u32x4 (&vr)[4], int lane) {
#pragma unroll
  for (int i = 0; i < 4; ++i) { const int q = lane + 64 * i; *(LAS u32x4*)(vl + (q >> 3) * 64 + (q & 7) * 8) = vr[i]; }
}
DI bf16x8 gather_vt(const LAS bf16_t* vl, int m, int s, int lane) {
  const int i16 = lane & 15, q = i16 >> 2, pp = i16 & 3, g16 = (lane >> 4) & 1, hf = lane >> 5;
  const LAS bf16_t* a0 = vl + (16 * s + 4 * hf + q) * 64 + 32 * m + 16 * g16 + 4 * pp;
  const s16x4 lo = __builtin_amdgcn_ds_read_tr16_b64_v4i16((LAS s16x4*)a0), hi = __builtin_amdgcn_ds_read_tr16_b64_v4i16((LAS s16x4*)(a0 + 8 * 64));
  return __builtin_shufflevector(lo, hi, 0, 1, 2, 3, 4, 5, 6, 7);
}
constexpr float SB_EXIT = 110.f;
DI void sb_unit(const Ctx& c, int u, LAS bf16_t* vl) {
  const bf16_t* proj = (const bf16_t*)(c.p.ws + WS_PROJ); bf16_t* ycat = (bf16_t*)(c.p.ws + WS_YCAT);
  const int qt = 63 - (u & 63), hh = (u >> 6) & 7, b = u >> 9, r = c.lane & 31, hf = c.lane >> 5;
  const size_t tok0 = (size_t)b * SEQ + 32 * qt;
  const bf16_t* kbase = proj + ((size_t)b * SEQ + r) * NPROJ + C_SK + hh * 64 + 8 * hf; const bf16_t* vbase = proj + (size_t)b * SEQ * NPROJ + C_SV + hh * 64;
  bf16x8 Qf[4], Kn[4]; u32x4 Vn[4];
#pragma unroll
  for (int s = 0; s < 4; ++s) { Qf[s] = *(const bf16x8*)(proj + (tok0 + r) * NPROJ + C_SQ + hh * 64 + 16 * s + 8 * hf); Kn[s] = *(const bf16x8*)(kbase + (size_t)(32 * qt) * NPROJ + 16 * s); }
  load_v64(Vn, vbase + (size_t)(32 * qt) * NPROJ, NPROJ, c.lane);
  f32x16 O[2];
#pragma unroll
  for (int m = 0; m < 2; ++m)
#pragma unroll
    for (int i = 0; i < 16; ++i) O[m][i] = 0.f;
  float carry = 0.f;
  for (int kt = qt; kt >= 0; --kt) {
    f32x16 z;
#pragma unroll
    for (int i = 0; i < 16; ++i) z[i] = 0.f;
#pragma unroll
    for (int s = 0; s < 4; ++s) z = MFMA32(Kn[s], Qf[s], z);
    LDS_WAIT();
    put_v64(vl, Vn, c.lane);
    { const int kp = kt > 0 ? kt - 1 : 0;
#pragma unroll
      for (int s = 0; s < 4; ++s) Kn[s] = *(const bf16x8*)(kbase + (size_t)(32 * kp) * NPROJ + 16 * s);
      load_v64(Vn, vbase + (size_t)(32 * kp) * NPROJ, NPROJ, c.lane); }
    float sp[16];
#pragma unroll
    for (int i = 0; i < 16; ++i) { z[i] *= 0.125f; const bool valid = (kt < qt) || (crow(i, hf) < r); sp[i] = valid ? softplus_fast(z[i]) : 0.f; }
    float mine[4], oth[4], both[4];
#pragma unroll
    for (int g = 0; g < 4; ++g) { mine[g] = (sp[4 * g] + sp[4 * g + 1]) + (sp[4 * g + 2] + sp[4 * g + 3]); oth[g] = __shfl_xor(mine[g], 32); both[g] = mine[g] + oth[g]; }
    float tail[4]; tail[3] = 0.f; tail[2] = both[3]; tail[1] = both[3] + both[2]; tail[0] = tail[1] + both[1];
#pragma unroll
    for (int g = 0; g < 4; ++g) {
      float run = carry + tail[g] + (hf == 0 ? oth[g] : 0.f);
#pragma unroll
      for (int q = 3; q >= 0; --q) { const int i = 4 * g + q; run += sp[i]; const bool valid = (kt < qt) || (crow(i, hf) < r); z[i] = valid ? __expf(z[i] - run) : 0.f; }
    }
    carry += tail[0] + both[0];
    const bf16x8 w0 = pack8(z, 0), w1 = pack8(z, 1);
    LDS_WAIT();
#pragma unroll
    for (int m = 0; m < 2; ++m) { O[m] = MFMA32(gather_vt(vl, m, 0, c.lane), w0, O[m]); O[m] = MFMA32(gather_vt(vl, m, 1, c.lane), w1, O[m]); }
    if (__all(carry > SB_EXIT)) break;
  }
  bf16_t* yp = ycat + (tok0 + r) * 1536 + 512 + hh * 64;
#pragma unroll
  for (int m = 0; m < 2; ++m)
#pragma unroll
    for (int g = 0; g < 4; ++g) { u32x2 w; w.x = pk_bf16(O[m][4 * g], O[m][4 * g + 1]); w.y = pk_bf16(O[m][4 * g + 2], O[m][4 * g + 3]); *(u32x2*)(yp + 32 * m + 8 * g + 4 * hf) = w; }
}
DI void mem_unit(const Ctx& c, int u, LAS bf16_t* vl) {
  const bf16_t* proj = (const bf16_t*)(c.p.ws + WS_PROJ); const bf16_t* mkv = (const bf16_t*)(c.p.ws + WS_MKV); bf16_t* ycat = (bf16_t*)(c.p.ws + WS_YCAT);
  const int qt = u & 63, hh = (u >> 6) & 3, b = u >> 8, r = c.lane & 31, hf = c.lane >> 5;
  const size_t tok0 = (size_t)b * SEQ + 32 * qt;
  const bf16_t* kbase = mkv + ((size_t)b * MEMLEN + r) * 1024 + hh * 128 + 8 * hf; const bf16_t* vbase = mkv + (size_t)b * MEMLEN * 1024 + 512 + hh * 128;
  bf16x8 Qf[8], Kn[8]; u32x4 Vn0[4], Vn1[4];
#pragma unroll
  for (int s = 0; s < 8; ++s) { Qf[s] = *(const bf16x8*)(proj + (tok0 + r) * NPROJ + C_MQ + hh * 128 + 16 * s + 8 * hf); Kn[s] = *(const bf16x8*)(kbase + 16 * s); }
  load_v64(Vn0, vbase, 1024, c.lane); load_v64(Vn1, vbase + 64, 1024, c.lane);
  f32x16 O[4];
#pragma unroll
  for (int m = 0; m < 4; ++m)
#pragma unroll
    for (int i = 0; i < 16; ++i) O[m][i] = 0.f;
  float mx = -INFINITY, l = 0.f;
  for (int kt = 0; kt < 8; ++kt) {
    f32x16 z;
#pragma unroll
    for (int i = 0; i < 16; ++i) z[i] = 0.f;
#pragma unroll
    for (int s = 0; s < 8; ++s) z = MFMA32(Kn[s], Qf[s], z);
    const int kp = kt < 7 ? kt + 1 : 7;
#pragma unroll
    for (int s = 0; s < 8; ++s) Kn[s] = *(const bf16x8*)(kbase + (size_t)(32 * kp) * 1024 + 16 * s);
    LDS_WAIT();
    put_v64(vl, Vn0, c.lane);
    load_v64(Vn0, vbase + (size_t)(32 * kp) * 1024, 1024, c.lane);
    float tm = -INFINITY;
#pragma unroll
    for (int i = 0; i < 16; ++i) { z[i] *= 0.08838834764831845f; tm = fmaxf(tm, z[i]); }
    tm = fmaxf(tm, __shfl_xor(tm, 32));
    const float mn = fmaxf(mx, tm), al = __expf(mx - mn); float ps = 0.f;
#pragma unroll
    for (int i = 0; i < 16; ++i) { z[i] = __expf(z[i] - mn); ps += z[i]; }
    ps += __shfl_xor(ps, 32); l = l * al + ps; mx = mn;
#pragma unroll
    for (int m = 0; m < 4; ++m)
#pragma unroll
      for (int i = 0; i < 16; ++i) O[m][i] *= al;
    const bf16x8 w0 = pack8(z, 0), w1 = pack8(z, 1);
    LDS_WAIT();
#pragma unroll
    for (int m = 0; m < 2; ++m) { O[m] = MFMA32(gather_vt(vl, m, 0, c.lane), w0, O[m]); O[m] = MFMA32(gather_vt(vl, m, 1, c.lane), w1, O[m]); }
    LDS_WAIT();
    put_v64(vl, Vn1, c.lane);
    load_v64(Vn1, vbase + (size_t)(32 * kp) * 1024 + 64, 1024, c.lane);
    LDS_WAIT();
#pragma unroll
    for (int m = 0; m < 2; ++m) { O[2 + m] = MFMA32(gather_vt(vl, m, 0, c.lane), w0, O[2 + m]); O[2 + m] = MFMA32(gather_vt(vl, m, 1, c.lane), w1, O[2 + m]); }
  }
  const float il = 1.f / l;
  bf16_t* yp = ycat + (tok0 + r) * 1536 + 1024 + hh * 128;
#pragma unroll
  for (int m = 0; m < 4; ++m)
#pragma unroll
    for (int g = 0; g < 4; ++g) { u32x2 w; w.x = pk_bf16(O[m][4 * g] * il, O[m][4 * g + 1] * il); w.y = pk_bf16(O[m][4 * g + 2] * il, O[m][4 * g + 3] * il); *(u32x2*)(yp + 32 * m + 8 * g + 4 * hf) = w; }
}
DI void phase_attn_scan(const Ctx& c) {
  __syncthreads();
#if !NAIVE_GDN
  if (c.wave == 0) { if (!(c.p.flags & 1)) scan_unit(c, c.lds); return; }
#else
  if (c.wave == 0) return;
#endif
  LAS bf16_t* vl = (LAS bf16_t*)(c.lds + 114688 + (c.wave - 1) * 4096);
  if (c.p.flags & 2) return;
  const int aw = c.bid * 7 + c.wave - 1, naw = c.G * 7;
  for (int u = aw; u < NB * 8 * 64 + NB * 4 * 64; u += naw) { if (u < NB * 8 * 64) sb_unit(c, u, vl); else mem_unit(c, u - NB * 8 * 64, vl); }
}
#endif
#if NAIVE_P5
DI void naive_mixed(const Ctx& c) {
  const bf16_t* ycat = (const bf16_t*)(c.p.ws + WS_YCAT); const bf16_t* wp = (const bf16_t*)(c.p.ws + WS_WP); const bf16_t* proj = (const bf16_t*)(c.p.ws + WS_PROJ); bf16_t* mixed = (bf16_t*)(c.p.ws + WS_MIXED);
  const int r = c.lane & 31, h = c.lane >> 5;
  for (int tile = c.gw; tile < (TT / 32) * 32; tile += c.ngw) {
    const int tm = tile >> 5, tn = tile & 31; float res[16];
#pragma unroll
    for (int i = 0; i < 16; ++i) res[i] = 0.f;
    for (int b = 0; b < 3; ++b) {
      const bf16_t* ap = ycat + (size_t)(tm * 32 + r) * 1536 + b * 512 + 8 * h; const bf16_t* bp = wp + (size_t)(tn * 32 + r) * 1536 + b * 512 + 8 * h;
      f32x16 acc; for (int i = 0; i < 16; ++i) acc[i] = 0.f;
      for (int k0 = 0; k0 < 512; k0 += 16) acc = MFMA32(*(const bf16x8*)(ap + k0), *(const bf16x8*)(bp + k0), acc);
#pragma unroll
      for (int i = 0; i < 16; ++i) res[i] += acc[i] * sigmoidf_(bf2f(proj[(size_t)(tm * 32 + crow(i, h)) * NPROJ + C_GATE + b * 1024 + tn * 32 + r]));
    }
#pragma unroll
    for (int i = 0; i < 16; ++i) mixed[(size_t)(tm * 32 + crow(i, h)) * DM + tn * 32 + r] = f2bf(res[i]);
  }
}
#endif
#if NAIVE_MOE
DI void naive_gateup(const Ctx& c, const LAS int* tab) {
  const bf16_t* x1b = (const bf16_t*)(c.p.ws + WS_X1B); const bf16_t* wgu = (const bf16_t*)(c.p.ws + WS_WGU); bf16_t* act = (bf16_t*)(c.p.ws + WS_ACT); const u32x2* rinfo = (const u32x2*)(c.p.ws + WS_RINFO);
  const float* bgu = c.p.in[I_BGU];
  const int r = c.lane & 31, h = c.lane >> 5, ntile = (tab[64] >> 5) * 32;
  for (int tile = c.gw; tile < ntile; tile += c.ngw) {
    const int tm = tile >> 5, tj = tile & 31, e = tab[96 + (tm >> 3)], local = tm * 32 + r - tab[32 + e];
    const int tok = local < tab[e] ? (int)(rinfo[(size_t)e * ECAP + local].x >> 2) : 0;
    const int j0 = tj * 32, wrow = (j0 >> 7) * 256 + (j0 & 127);
    const bf16_t* ap = x1b + (size_t)tok * DM + 8 * h; const bf16_t* bg = wgu + ((size_t)e * 2048 + wrow + r) * DM + 8 * h; const bf16_t* bl = bg + (size_t)128 * DM;
    f32x16 ag, al; for (int i = 0; i < 16; ++i) { ag[i] = 0.f; al[i] = 0.f; }
    for (int k0 = 0; k0 < DM; k0 += 16) { const bf16x8 a = *(const bf16x8*)(ap + k0); ag = MFMA32(a, *(const bf16x8*)(bg + k0), ag); al = MFMA32(a, *(const bf16x8*)(bl + k0), al); }
    const float bgv = bgu[(size_t)e * 2048 + j0 + r], blv = bgu[(size_t)e * 2048 + 1024 + j0 + r];
#pragma unroll
    for (int i = 0; i < 16; ++i) { const float glu = fminf(ag[i] + bgv, SWIGLU_LIMIT), lin = fminf(fmaxf(al[i] + blv, -SWIGLU_LIMIT), SWIGLU_LIMIT);
      act[(size_t)(tm * 32 + crow(i, h)) * DFF + j0 + r] = f2bf(glu * sigmoidf_(SWIGLU_ALPHA * glu) * (lin + 1.f)); }
  }
}
DI void naive_down(const Ctx& c, const LAS int* tab) {
  const bf16_t* act = (const bf16_t*)(c.p.ws + WS_ACT); const bf16_t* wdn = (const bf16_t*)(c.p.ws + WS_WDN); bf16_t* yp = (bf16_t*)(c.p.ws + WS_YPAIR); const u32x2* rinfo = (const u32x2*)(c.p.ws + WS_RINFO);
  const float* bdn = c.p.in[I_BDN];
  const int r = c.lane & 31, h = c.lane >> 5, ntile = (tab[64] >> 5) * 32;
  for (int tile = c.gw; tile < ntile; tile += c.ngw) {
    const int tm = tile >> 5, tn = tile & 31, e = tab[96 + (tm >> 3)];
    const bf16_t* ap = act + (size_t)(tm * 32 + r) * DFF + 8 * h; const bf16_t* bp = wdn + ((size_t)e * DM + tn * 32 + r) * DFF + 8 * h;
    f32x16 acc; for (int i = 0; i < 16; ++i) acc[i] = 0.f;
    for (int k0 = 0; k0 < DFF; k0 += 16) acc = MFMA32(*(const bf16x8*)(ap + k0), *(const bf16x8*)(bp + k0), acc);
    const float bv = bdn[(size_t)e * DM + tn * 32 + r];
#pragma unroll
    for (int i = 0; i < 16; ++i) { const int local = tm * 32 + crow(i, h) - tab[32 + e];
      if (local < tab[e]) { const u32x2 info = rinfo[(size_t)e * ECAP + local]; yp[(size_t)info.x * DM + tn * 32 + r] = f2bf((acc[i] + bv) * __uint_as_float(info.y)); } }
  }
}
#endif

__global__ void __launch_bounds__(512, 2) mega(Params p) {
  extern __shared__ __attribute__((aligned(16))) unsigned char lds_raw[];
  cg::grid_group grid = cg::this_grid();
  Ctx c; c.lds = (LAS unsigned char*)lds_raw; c.tid = threadIdx.x; c.lane = c.tid & 63; c.wave = __builtin_amdgcn_readfirstlane(c.tid >> 6);
  c.G = gridDim.x; c.bid = blockIdx.x; c.gw = c.bid * 8 + c.wave; c.ngw = c.G * 8; c.p = p;
  unsigned char* ws = p.ws;
  LAS int* gtab = (LAS int*)(c.lds + 131072);
#define IN(k) (p.ph_lo <= (k) && (k) < p.ph_hi)
  { volatile LAS unsigned* st = (volatile LAS unsigned*)(c.lds + 147440); if (c.tid < 4) st[c.tid] = 0u; }
  __syncthreads();
  const XcdBarrier xbar = xcd_barrier_post((unsigned*)(ws + WS_BAR) + p.pad * XCD_BAR_WORDS, (volatile LAS unsigned*)(c.lds + 147440));
#define SEAM(k) do { if ((k) + 1 < p.ph_hi) { if (USE_CG_ALL || (k) == 0) grid.sync(); else xcd_barrier(xbar); } } while (0)
#define REP(k)

  if (IN(0)) { REP(0) phase0(c); SEAM(0); }
  if (IN(1)) {
    REP(1) {
#if NAIVE_P1
    { bf16_t* proj = (bf16_t*)(ws + WS_PROJ); naive_gemm(c, (const bf16_t*)(ws + WS_XB), DM, (const bf16_t*)(ws + WS_WIN), DM, TT, NPROJ, DM, [&](int r, int cc, float v) { proj[(size_t)r * NPROJ + cc] = f2bf(v); }); }
    { bf16_t* mkv = (bf16_t*)(ws + WS_MKV); naive_gemm(c, (const bf16_t*)(ws + WS_MEMB), DM, (const bf16_t*)(ws + WS_WMKV), DM, NB * MEMLEN, DM, DM, [&](int r, int cc, float v) { mkv[(size_t)r * DM + cc] = f2bf(v); }); }
#else
    { pg8::Gemm g{(const bf16_t*)(ws + WS_XB), (const bf16_t*)(ws + WS_WIN), DM}; pg8::StaticOrder S; S.init(TT, NPROJ, c.G, c.bid); pg8::EpiStoreBf16 E{(bf16_t*)(ws + WS_PROJ), NPROJ};
      pg8::gemm_phase<pg8::EpiStoreBf16, pg8::StaticOrder, true>(c.lds, g, S, E); }
    { pg8::Gemm g{(const bf16_t*)(ws + WS_MEMB), (const bf16_t*)(ws + WS_WMKV), DM}; pg8::StaticOrder S; S.init(NB * MEMLEN, DM, c.G, c.bid); pg8::EpiStoreBf16 E{(bf16_t*)(ws + WS_MKV), DM};
      pg8::gemm_phase<pg8::EpiStoreBf16, pg8::StaticOrder, true>(c.lds, g, S, E); }
#endif
    }
    SEAM(1);
  }
  if (IN(2)) {
#if NAIVE_GDN
    naive_gdn_prep(c);
#else
    phase_gdn_chunk(c);
#endif
    SEAM(2);
  }
  if (IN(3)) {
#if NAIVE_GDN
    naive_gdn_scan(c);
#endif
#if NAIVE_ATTN
    naive_sb(c); naive_mem(c);
#else
    phase_attn_scan(c);
#endif
    SEAM(3);
  }
  if (IN(4)) { phase_gdn_norm(c); SEAM(4); }
  if (IN(5)) {
#if NAIVE_P5
    naive_mixed(c);
#else
    REP(5) {
    pg8::Gemm g{(const bf16_t*)(ws + WS_YCAT), (const bf16_t*)(ws + WS_WP), 1536}; pg8::StaticOrder S; S.init(TT, DM, c.G, c.bid); pg8::EpiMixed E{(const bf16_t*)(ws + WS_PROJ), (bf16_t*)(ws + WS_MIXED)};
    pg8::gemm_phase<pg8::EpiMixed, pg8::StaticOrder, true>(c.lds, g, S, E);
    }
#endif
    SEAM(5);
  }
  if (IN(6)) {
#if NAIVE_P6
    { const float* x = p.in[I_X]; float* hh = (float*)(ws + WS_H);
      naive_gemm(c, (const bf16_t*)(ws + WS_MIXED), DM, (const bf16_t*)(ws + WS_WO), DM, TT, DM, DM, [&](int r, int cc, float v) { hh[(size_t)r * DM + cc] = DN_ALPHA * x[(size_t)r * DM + cc] + v; }); }
#else
    REP(6) {
    pg8::Gemm g{(const bf16_t*)(ws + WS_MIXED), (const bf16_t*)(ws + WS_WO), DM}; pg8::StaticOrder S; S.init(TT, DM, c.G, c.bid); pg8::EpiH E{p.in[I_X], (float*)(ws + WS_H)};
    pg8::gemm_phase<pg8::EpiH, pg8::StaticOrder, true>(c.lds, g, S, E);
    }
#endif
    SEAM(6);
  }
  if (IN(7)) { phase_router(c); SEAM(7); }
  if (IN(8)) {
    build_group_tab(c, gtab);
#if NAIVE_MOE
    naive_gateup(c, gtab);
#else
    REP(8) {
    pg8::Gemm g{(const bf16_t*)(ws + WS_X1B), (const bf16_t*)(ws + WS_WGU), DM}; pg8::GroupOrder S{gtab, (const u32x2*)(ws + WS_RINFO), 8, c.G, c.bid, 1}; pg8::EpiGateUp E{p.in[I_BGU], (bf16_t*)(ws + WS_ACT)};
    pg8::gemm_phase<pg8::EpiGateUp, pg8::GroupOrder, true>(c.lds, g, S, E);
    }
#endif
    SEAM(8);
  }
  if (IN(9)) {
    build_group_tab(c, gtab);
#if NAIVE_MOE
    naive_down(c, gtab);
#else
    REP(9) {
    pg8::Gemm g{(const bf16_t*)(ws + WS_ACT), (const bf16_t*)(ws + WS_WDN), DFF}; pg8::GroupOrder S{gtab, (const u32x2*)(ws + WS_RINFO), 4, c.G, c.bid, 0};
    pg8::EpiDown E{p.in[I_BDN], gtab, (const u32x2*)(ws + WS_RINFO), (bf16_t*)(ws + WS_YPAIR)};
    pg8::gemm_phase<pg8::EpiDown, pg8::GroupOrder, true>(c.lds, g, S, E);
    }
#endif
    SEAM(9);
  }
  if (IN(10)) { REP(10) phase_final(c); }
#undef IN
#undef SEAM
}

extern "C" void kernel_launch(void* const* d_in, const int* in_sizes, int n_in, void* d_out, int out_size, void* d_ws, size_t ws_size, hipStream_t stream) {
  static int grid_blocks = 0;
  if (grid_blocks == 0) {
    if (n_in != 22 || in_sizes[0] != TT * DM || out_size != TT * DM || ws_size < WS_NEED) {
      fprintf(stderr, "kernel_launch: built for 22 inputs, x/out of %d floats and >= %zu bytes of workspace; got n_in %d in0 %d out %d ws %zu; nothing launched\n", TT * DM, (size_t)WS_NEED, n_in, n_in > 0 ? in_sizes[0] : -1, out_size, ws_size);
      grid_blocks = -1; return; }
    int dev = 0, cus = 0, per_cu = 0;
    if (hipGetDevice(&dev) != hipSuccess || hipDeviceGetAttribute(&cus, hipDeviceAttributeMultiprocessorCount, dev) != hipSuccess) { grid_blocks = -1; return; }
    if (hipFuncSetAttribute((const void*)mega, hipFuncAttributeMaxDynamicSharedMemorySize, LDS_BYTES) != hipSuccess) { fprintf(stderr, "kernel_launch: hipFuncSetAttribute failed\n"); grid_blocks = -1; return; }
    if (hipOccupancyMaxActiveBlocksPerMultiprocessor(&per_cu, (const void*)mega, 512, LDS_BYTES) != hipSuccess || per_cu < 1) { fprintf(stderr, "kernel_launch: occupancy query says %d\n", per_cu); (void)hipGetLastError(); grid_blocks = -1; return; }
    grid_blocks = cus;
    fprintf(stderr, "kernel_launch: grid %d (cus %d, per_cu %d), ws %zu\n", grid_blocks, cus, per_cu, ws_size);
  }
  if (grid_blocks < 0) return;
  if (hipMemsetAsync((char*)d_ws + WS_BAR, 0, 2 * XCD_BAR_WORDS * 4, stream) != hipSuccess) { fprintf(stderr, "kernel_launch: memset of the barrier words failed\n"); return; }
  Params p{};
  for (int i = 0; i < 22; ++i) p.in[i] = (const float*)d_in[i];
  p.out = (float*)d_out; p.ws = (unsigned char*)d_ws;
#if MK_SPLIT
  for (int ph = 0; ph < 11; ++ph) { p.ph_lo = ph; p.ph_hi = ph + 1; void* args[] = {&p};
    hipError_t e = hipLaunchCooperativeKernel((const void*)mega, dim3(grid_blocks), dim3(512), args, LDS_BYTES, stream);
    if (e != hipSuccess) { fprintf(stderr, "kernel_launch: launch of phase %d failed: %s\n", ph, hipGetErrorString(e)); break; } }
#elif REPEAT_PH >= 0
  for (int li = 0; li < 2; ++li) { p.ph_lo = li ? REPEAT_PH + SPLIT_ONLY : 0; p.ph_hi = li ? 11 : REPEAT_PH + 1; p.flags = li ? REPEAT_FLAGS : 0; p.pad = li; void* args[] = {&p};
    hipError_t e = hipLaunchCooperativeKernel((const void*)mega, dim3(grid_blocks), dim3(512), args, LDS_BYTES, stream);
    if (e != hipSuccess) { fprintf(stderr, "kernel_launch: launch %d failed: %s\n", li, hipGetErrorString(e)); break; } }
#else
  p.ph_lo = 0; p.ph_hi = 11; void* args[] = {&p};
  hipError_t e = hipLaunchCooperativeKernel((const void*)mega, dim3(grid_blocks), dim3(512), args, LDS_BYTES, stream);
  if (e != hipSuccess) fprintf(stderr, "kernel_launch: cooperative launch failed: %s (grid %d)\n", hipGetErrorString(e), grid_blocks);
#endif
}
```

```cpp
#define NAIVE_P1 0
#define NAIVE_GDN 0
#define NAIVE_ATTN 0
#define NAIVE_P5 0
#define NAIVE_P6 0
#define NAIVE_MOE 0
#define MK_SPLIT 0
#define REPEAT_PH -1
#define SPLIT_ONLY 0
#define REPEAT_FLAGS 0
#define USE_CG_ALL 0
#define ALIGN_MOE true
#define STAG_N 1
#define STAG_STEP 600
#define NT_STORE 1
#define MOE_I8 1
#define ROUTER_LDS 1
#define ATTN_SKIP_W4 1
#define NPROJ_LD 7168
#define W8_BESIDE_SCAN 1
#define GATE_I8 0
#define NAIVE_ANY (NAIVE_P1 || NAIVE_P6)
#include <hip/hip_runtime.h>
#include <hip/hip_cooperative_groups.h>
#include <cstdio>
#include <cstdint>
namespace cg = cooperative_groups;

#define DI __device__ __forceinline__
#define LAS __attribute__((address_space(3)))
typedef unsigned short bf16_t;
typedef short bf16x8 __attribute__((ext_vector_type(8)));
typedef float f32x2 __attribute__((ext_vector_type(2)));
typedef float f32x4 __attribute__((ext_vector_type(4)));
typedef float f32x16 __attribute__((ext_vector_type(16)));
typedef unsigned u32x2 __attribute__((ext_vector_type(2)));
typedef unsigned u32x4 __attribute__((ext_vector_type(4)));
typedef __bf16 bf16x2_t __attribute__((ext_vector_type(2)));

constexpr int NB = 16, SEQ = 2048, DM = 1024, TT = NB * SEQ;
constexpr int MEMLEN = 256, NEXP = 32, TOPK = 4, DFF = 1024;
constexpr int NPROJ_N = 7168;
constexpr int NPROJ = NPROJ_LD;
constexpr int C_GQ = 0, C_GK = 512, C_GV = 1024, C_GZ = 1536, C_SQ = 2048, C_SK = 2560, C_SV = 3072, C_MQ = 3584, C_GATE = 4096;
constexpr float LN_EPS = 1e-5f, NORM_EPS = 1e-6f;
constexpr float DN_ALPHA = 1.189207115002721f;
constexpr float SWIGLU_LIMIT = 7.0f, SWIGLU_ALPHA = 1.702f;
constexpr int ECAP = 32768;

constexpr size_t MiB = 1u << 20;
constexpr size_t WS_MISC = 0;
constexpr size_t WS_WDN = 3 * MiB, WS_WGU = 67 * MiB, WS_WIN = 195 * MiB, WS_WMKV = 209 * MiB, WS_WP = 211 * MiB, WS_WO = 214 * MiB;
constexpr size_t WS_XB = 216 * MiB, WS_MEMB = 280 * MiB, WS_MKV = 1016 * MiB  , WS_PROJ = 288 * MiB, WS_GDN = 744 * MiB, WS_YCAT = 888 * MiB, WS_RINFO = 1016 * MiB;
constexpr size_t WS_MIXED = WS_XB, WS_H = WS_GDN, WS_X1 = WS_YCAT, WS_X1B = WS_PROJ, WS_ACT = 360 * MiB, WS_YPAIR = 67 * MiB;
constexpr size_t WS_NEED = 1024 * MiB;
constexpr size_t GDN_CHUNK_BYTES = 73728;
constexpr int LDS_BYTES = 147456;

struct Params { const float* in[22]; float* out; unsigned char* ws; int ph_lo, ph_hi, flags, pad; };
enum { I_X = 0, I_MEM, I_WIN, I_WCONV, I_ALOG, I_DTB, I_GNW, I_WMKV, I_WPG, I_WPS, I_WPM, I_WO, I_LN1G, I_LN1B, I_WR, I_BR, I_WGU, I_BGU, I_WDN, I_BDN, I_LN2G, I_LN2B };

DI float bf2f(bf16_t v) { return __uint_as_float((unsigned)v << 16); }
DI unsigned pk_bf16(float a, float b) { f32x2 v = {a, b}; bf16x2_t r = __builtin_convertvector(v, bf16x2_t); return __builtin_bit_cast(unsigned, r); }
DI bf16_t f2bf(float a) { return (bf16_t)(pk_bf16(a, 0.f) & 0xffffu); }
DI float bflo(unsigned w) { return __uint_as_float(w << 16); }
DI float bfhi(unsigned w) { return __uint_as_float(w & 0xffff0000u); }
DI float sigmoidf_(float x) { return __frcp_rn(1.0f + __expf(-x)); }
DI float softplusf_(float x) { return x > 20.f ? x : log1pf(__expf(x)); }
DI float softplus_fast(float x) { return fmaxf(x, 0.f) + __logf(1.f + __expf(-fabsf(x))); }
typedef short s16x4 __attribute__((ext_vector_type(4)));
template <int CTRL, int RM> DI float dpp_mov0(float v) { return __builtin_bit_cast(float, __builtin_amdgcn_update_dpp(0, __builtin_bit_cast(int, v), CTRL, RM, 0xF, false)); }
DI float wave_sum(float v) {
  v += dpp_mov0<0xB1, 0xF>(v);
  v += dpp_mov0<0x4E, 0xF>(v);
  v += dpp_mov0<0x141, 0xF>(v);
  v += dpp_mov0<0x140, 0xF>(v);
  v += dpp_mov0<0x142, 0xA>(v);
  v += dpp_mov0<0x143, 0xC>(v);
  return __builtin_bit_cast(float, __builtin_amdgcn_readlane(__builtin_bit_cast(int, v), 63));
}
DI float wave_max(float v) {
  v = fmaxf(v, dpp_mov0<0xB1, 0xF>(v)); v = fmaxf(v, dpp_mov0<0x4E, 0xF>(v)); v = fmaxf(v, dpp_mov0<0x141, 0xF>(v)); v = fmaxf(v, dpp_mov0<0x140, 0xF>(v));
  v = fmaxf(v, dpp_mov0<0x142, 0xA>(v)); v = fmaxf(v, dpp_mov0<0x143, 0xC>(v));
  return __builtin_bit_cast(float, __builtin_amdgcn_readlane(__builtin_bit_cast(int, v), 63));
}
#define LDS_WAIT() asm volatile("s_waitcnt lgkmcnt(0)" ::: "memory")
#define VM_WAIT() asm volatile("s_waitcnt vmcnt(0)" ::: "memory")
#define MFMA32(a, b, c) __builtin_amdgcn_mfma_f32_32x32x16_bf16((a), (b), (c), 0, 0, 0)
DI int crow(int reg, int h) { return (reg & 3) + 8 * (reg >> 2) + 4 * h; }
DI int swap23(int k) { return (k & ~12) | ((k & 4) << 1) | ((k & 8) >> 1); }

#define XB_TMO      128
#define XB_XCNT(j)  (256  + 64 * (j))
#define XB_XSUB(j)  (1280 + 64 * (j))
#define XB_XGEN(j)  (2304 + 64 * (j))
#define XB_TOP      3328
#define XB_TOPGEN   3392
#define XCD_BAR_WORDS 3456
#define XB_SPIN_CAP (1u << 18)
DI unsigned xb_ld(unsigned* p)              { return __hip_atomic_load(p, __ATOMIC_RELAXED, __HIP_MEMORY_SCOPE_AGENT); }
DI unsigned xb_add(unsigned* p, unsigned v) { return __hip_atomic_fetch_add(p, v, __ATOMIC_RELAXED, __HIP_MEMORY_SCOPE_AGENT); }
DI unsigned xb_xcc_id() { return (unsigned)__builtin_amdgcn_s_getreg((3 << 11) | 20) & 0xFu; }
#define XB_SPIN(cond, bar) do { unsigned _sp = 0; while (cond) { __builtin_amdgcn_s_sleep(1); \
    if ((++_sp & 255u) == 0u) { if (xb_ld(&(bar)[XB_TMO])) break; if (_sp > XB_SPIN_CAP) { atomicAdd(&(bar)[XB_TMO], 1u); break; } } } } while (0)
struct XcdBarrier { unsigned* bar; unsigned x; volatile LAS unsigned* st; };
DI XcdBarrier xcd_barrier_post(unsigned* bar, volatile LAS unsigned* st) {
  XcdBarrier b; b.bar = bar; b.x = xb_xcc_id(); b.st = st;
  if (threadIdx.x == 0) (void)xb_add(&bar[XB_XCNT(b.x)], 1u);
  return b;
}
DI void xcd_barrier_complete(unsigned* bar, unsigned x, unsigned& nloc, unsigned& nx) {
  const unsigned G = gridDim.x * gridDim.y * gridDim.z;
  unsigned sum, cnt, mine, sp = 0u;
  for (;;) {
    sum = 0u; cnt = 0u; mine = 0u;
#pragma unroll
    for (unsigned j = 0; j < 16; ++j) { const unsigned c = xb_ld(&bar[XB_XCNT(j)]); sum += c; cnt += (c > 0u) ? 1u : 0u; mine = (j == x) ? c : mine; }
    if (sum == G) break;
    __builtin_amdgcn_s_sleep(1);
    if ((++sp & 255u) == 0u) { if (xb_ld(&bar[XB_TMO])) break; if (sp > XB_SPIN_CAP) { atomicAdd(&bar[XB_TMO], 1u); break; } }
  }
  nloc = mine > 0u ? mine : 1u; nx = cnt > 0u ? cnt : 1u;
}
DI void xcd_barrier(const XcdBarrier& b) {
  asm volatile("s_waitcnt vmcnt(0)" ::: "memory");
  __syncthreads();
  if (threadIdx.x == 0) {
    unsigned* bar = b.bar;
    __builtin_amdgcn_s_waitcnt(0);
    unsigned nloc = b.st[0], nx = b.st[1];
    if (nloc == 0u) { xcd_barrier_complete(bar, b.x, nloc, nx); b.st[0] = nloc; b.st[1] = nx; }
    const unsigned old = xb_add(&bar[XB_XSUB(b.x)], 1u);
    const unsigned gen = old / nloc;
    if (old + 1u == (gen + 1u) * nloc) {
      __builtin_amdgcn_fence(__ATOMIC_RELEASE, "agent");
      asm volatile("s_waitcnt vmcnt(0)" ::: "memory");
      const unsigned og = xb_add(&bar[XB_TOP], 1u);
      const unsigned tg = og / nx;
      if (og + 1u == (tg + 1u) * nx) xb_add(&bar[XB_TOPGEN], 1u);
      else XB_SPIN(xb_ld(&bar[XB_TOPGEN]) == tg, bar);
      __builtin_amdgcn_fence(__ATOMIC_ACQUIRE, "agent");
      xb_add(&bar[XB_XGEN(b.x)], 1u);
      asm volatile("s_waitcnt vmcnt(0)" ::: "memory");
    } else {
      XB_SPIN(xb_ld(&bar[XB_XGEN(b.x)]) == gen, bar);
      __builtin_amdgcn_fence(__ATOMIC_ACQUIRE, "agent");
      asm volatile("s_waitcnt vmcnt(0)" ::: "memory");
    }
  }
  __syncthreads();
}
constexpr size_t WS_WRT = 2 * MiB + 512 * 1024;
constexpr size_t WS_BAR = 2 * MiB;
constexpr size_t WS_CMAX = 2 * MiB + 64 * 1024;
constexpr size_t WS_ZERO_BYTES = 320 * 1024;
constexpr size_t WS_WSC = 1 * MiB + 64 * 1024;
constexpr size_t WS_TSC = 2 * MiB + 768 * 1024;
constexpr size_t WS_RSC = 872 * MiB;
constexpr size_t WS_XQ = 744 * MiB;
constexpr size_t WS_WG8 = 776 * MiB;
constexpr size_t WS_WGS = 1 * MiB + 512 * 1024;
constexpr size_t WS_X1Q = 296 * MiB;
typedef int i32x4 __attribute__((ext_vector_type(4)));

struct Ctx {
  LAS unsigned char* lds;
  int tid, lane, wave, G, bid, gw, ngw;
  Params p;
};
namespace pg8 {
#if NT_STORE
#define NTST(v, p) __builtin_nontemporal_store((v), (p))
#else
#define NTST(v, p) (*(p) = (v))
#endif
constexpr int BM = 256, BK = 64, HALF = 128, HTB = HALF * BK * 2  , STAGE_BYTES = 8 * HTB, NXCD = 8, WGM = 8;
DI int lds_byte(int r, int c) { const int st = (r >> 4) * 2 + (c >> 5), rr = r & 15, cc = c & 31, ob = rr * 64 + cc * 2; return st * 1024 + (ob ^ (((ob >> 9) & 1) << 5)); }
DI void stage_rc(int b, int& R, int& C) { const int st = b / 1024, sb = b % 1024, swz = sb ^ (((sb >> 9) & 1) << 5); R = (st >> 1) * 16 + swz / 64; C = (st & 1) * 32 + (swz % 64) / 2; }
DI int perm32(int rho) { const int n = rho >> 4, i = rho & 15; return 8 * (i >> 2) + 4 * n + (i & 3); }

struct Unit { int pm, pn; };
struct Gemm { const bf16_t* A; const bf16_t* Bt; int K; };

struct StaticOrder {
  static constexpr bool LOADS = true;
  int nM, nN, nwg, G, c;
  DI void init(int M, int N, int G_, int c_) { nM = M / BM; nN = N / BM; nwg = nM * nN; G = G_; c = c_; }
  DI bool next(int i, Unit& u) const {
    const long L = (long)i * G + c; if (L >= nwg) return false;
    int wgid = (int)L; { const int q = nwg / NXCD, r = nwg % NXCD, xcd = wgid % NXCD, off = wgid / NXCD; wgid = (xcd < r ? xcd * (q + 1) : r * (q + 1) + (xcd - r) * q) + off; }
    const int nig = WGM * nN, gid = wgid / nig, fm = gid * WGM, gsz = (nM - fm) < WGM ? (nM - fm) : WGM;
    u.pm = fm + ((wgid % nig) % gsz); u.pn = (wgid % nig) / gsz; return true;
  }
  DI int arow(const Unit& u, int r) const { return u.pm * BM + r; }
};
struct GroupOrder {
  static constexpr bool LOADS = true;
  const LAS int* tab; const u32x2* rinfo; int ntn, G, c, gather;
  DI bool next(int i, Unit& u) const {
    const int L = i * G + c, NT = tab[65]; if (L >= NT * ntn) return false;
    const int tile = L / ntn, pnl = L - tile * ntn; u.pm = tile; u.pn = tab[96 + tile] * ntn + pnl; return true;
  }
  DI int arow(const Unit& u, int r) const {
    if (!gather) return u.pm * BM + r;
    const int e = tab[96 + u.pm], local = u.pm * BM + r - tab[32 + e];
    return local < tab[e] ? (int)(rinfo[(size_t)e * ECAP + local].x >> 2) : 0;
  }
};

template <class Epi, class Sched, bool ALIGN_EPI, bool I8 = false>
DI void gemm_phase(LAS unsigned char* lds, const Gemm g, const Sched& S, const Epi& E) {
  const int tid = threadIdx.x, wid = __builtin_amdgcn_readfirstlane(tid >> 6), lane = tid & 63, wr = wid >> 2, wc = wid & 3, fr = lane & 15, fq = lane >> 4;
  const int K = I8 ? g.K / 2 : g.K, nt = K / BK;
  int RA[2], CA[2]; unsigned voffB[2];
#pragma unroll
  for (int i = 0; i < 2; ++i) { int R, C; stage_rc(tid * 16 + i * 8192, R, C); const int Rb = Epi::PERM ? ((R & ~31) + perm32(R & 31)) : R; RA[i] = R; CA[i] = C; voffB[i] = (unsigned)(Rb * K + C) * 2u; }
  const size_t kstep = (size_t)(BK * 2);
  const size_t hstep = (size_t)HALF * K * 2;
  const size_t tstep = 2 * hstep;
  const unsigned ldsw = (unsigned)wid * 1024u;
  const int aoff = lds_byte(wr * 64 + fr, fq * 8), boff = lds_byte(wc * 32 + fr, fq * 8);
  const char* Ab = (const char*)g.A;
#define PG8_SA(b, h) (((b) * 2 + (h)) * HTB)
#define PG8_SB(b, h) ((4 + (b) * 2 + (h)) * HTB)
#define PG8_STAGE(bufoff, gbase, voff) do { _Pragma("unroll") for (int _i = 0; _i < 2; ++_i) \
    __builtin_amdgcn_global_load_lds((const unsigned*)((const char*)(gbase) + (voff)[_i]), (LAS unsigned*)(lds + (bufoff) + ldsw + _i * 8192), 16, 0, 0); } while (0)
#define PG8_LDA(dst, b, h) do { _Pragma("unroll") for (int m = 0; m < 4; ++m) _Pragma("unroll") for (int k = 0; k < 2; ++k) dst[m][k] = *(const LAS bf16x8*)(lds + PG8_SA(b, h) + aoff + m * 2048 + k * 1024); } while (0)
#define PG8_LDB(dst, b, h) do { _Pragma("unroll") for (int n = 0; n < 2; ++n) _Pragma("unroll") for (int k = 0; k < 2; ++k) dst[n][k] = *(const LAS bf16x8*)(lds + PG8_SB(b, h) + boff + n * 2048 + k * 1024); } while (0)
#define PG8_MMA(ai, bj, At, Bt) do { __builtin_amdgcn_s_setprio(1); _Pragma("unroll") for (int m = 0; m < 4; ++m) _Pragma("unroll") for (int n = 0; n < 2; ++n) _Pragma("unroll") for (int k = 0; k < 2; ++k) { \
    if constexpr (I8) acc[ai][bj][m][n] = __builtin_bit_cast(AccT, __builtin_amdgcn_mfma_i32_16x16x64_i8(__builtin_bit_cast(i32x4, Bt[n][k]), __builtin_bit_cast(i32x4, At[m][k]), __builtin_bit_cast(i32x4, acc[ai][bj][m][n]), 0, 0, 0)); \
    else acc[ai][bj][m][n] = __builtin_bit_cast(AccT, __builtin_amdgcn_mfma_f32_16x16x32_bf16(Bt[n][k], At[m][k], __builtin_bit_cast(f32x4, acc[ai][bj][m][n]), 0, 0, 0)); } __builtin_amdgcn_s_setprio(0); } while (0)
#define PG8_WAIT_V(n) asm volatile("s_waitcnt vmcnt(" #n ")" ::: "memory")
#define PG8_WAIT_L(n) asm volatile("s_waitcnt lgkmcnt(" #n ")" ::: "memory")
#define PG8_BAR __builtin_amdgcn_s_barrier()
#define PG8_SCHED __builtin_amdgcn_sched_barrier(0)
  Unit cur, nxt; int ui = 0;
  if (!S.next(0, cur)) return;
  typedef typename Epi::AccT AccT;
  AccT acc[2][2][4][2];
#pragma unroll
  for (int a = 0; a < 2; ++a)
#pragma unroll
    for (int b = 0; b < 2; ++b)
#pragma unroll
      for (int m = 0; m < 4; ++m)
#pragma unroll
        for (int n = 0; n < 2; ++n) acc[a][b][m][n] = (AccT){0, 0, 0, 0};
  bf16x8 At[4][2], B0[2][2], B1[2][2];
  unsigned cvo0[2], cvo1[2], nvo0[2], nvo1[2];
#pragma unroll
  for (int i = 0; i < 2; ++i) { cvo0[i] = ((unsigned)S.arow(cur, RA[i]) * (unsigned)K + (unsigned)CA[i]) * 2u; cvo1[i] = ((unsigned)S.arow(cur, HALF + RA[i]) * (unsigned)K + (unsigned)CA[i]) * 2u; }
  const char* cB = (const char*)g.Bt + (size_t)cur.pn * tstep;
  PG8_STAGE(PG8_SB(0, 0), cB, voffB); PG8_STAGE(PG8_SB(0, 1), cB + hstep, voffB); PG8_STAGE(PG8_SA(0, 0), Ab, cvo0); PG8_STAGE(PG8_SA(0, 1), Ab, cvo1);
  if (wr == 1) PG8_BAR;
  PG8_WAIT_V(2); PG8_BAR;
  PG8_STAGE(PG8_SB(1, 0), cB + kstep, voffB); PG8_STAGE(PG8_SA(1, 0), Ab + kstep, cvo0); PG8_STAGE(PG8_SB(1, 1), cB + hstep + kstep, voffB);
  PG8_WAIT_V(6); PG8_BAR;
  for (;;) {
    const bool has_next = S.next(ui + 1, nxt);
    if (!has_next) nxt = cur;
#pragma unroll
    for (int i = 0; i < 2; ++i) { nvo0[i] = ((unsigned)S.arow(nxt, RA[i]) * (unsigned)K + (unsigned)CA[i]) * 2u; nvo1[i] = ((unsigned)S.arow(nxt, HALF + RA[i]) * (unsigned)K + (unsigned)CA[i]) * 2u; }
    const char* nB = (const char*)g.Bt + (size_t)nxt.pn * tstep;
    for (int t = 0; t < nt; t += 2) {
      const bool last = (t == nt - 2);
      if constexpr (Epi::MIDHOOK) { if (t == 8 || t == 16) E.mid(acc, cur, (t >> 3) - 1, wr, wc, fr, fq); }
      const char* a1 = Ab + (size_t)(t + 1) * kstep;
      const char* a2 = last ? Ab : Ab + (size_t)(t + 2) * kstep; const char* b2 = last ? nB : cB + (size_t)(t + 2) * kstep;
      const char* a3 = a2 + kstep; const char* b3 = b2 + kstep;
      unsigned vo0[2], vo1[2];
      if constexpr (Sched::LOADS) {
        if (last) {
#pragma unroll
          for (int i = 0; i < 2; ++i) { vo0[i] = nvo0[i]; vo1[i] = nvo1[i]; }
        } else {
#pragma unroll
          for (int i = 0; i < 2; ++i) { vo0[i] = cvo0[i]; vo1[i] = cvo1[i]; }
        }
      } else {
#pragma unroll
        for (int i = 0; i < 2; ++i) { vo0[i] = last ? nvo0[i] : cvo0[i]; vo1[i] = last ? nvo1[i] : cvo1[i]; }
      }
      PG8_LDB(B0, 0, 0); PG8_LDB(B1, 0, 1); PG8_SCHED; PG8_LDA(At, 0, 0); PG8_STAGE(PG8_SA(1, 1), a1, cvo1);
      PG8_WAIT_V(8); PG8_WAIT_L(0); PG8_BAR; PG8_MMA(0, 0, At, B0); PG8_MMA(0, 1, At, B1); PG8_BAR; PG8_SCHED;
      PG8_LDA(At, 0, 1); PG8_STAGE(PG8_SB(0, 0), b2, voffB); PG8_STAGE(PG8_SB(0, 1), b2 + hstep, voffB); PG8_STAGE(PG8_SA(0, 0), a2, vo0);
      PG8_WAIT_V(8); PG8_WAIT_L(0); PG8_BAR; PG8_MMA(1, 0, At, B0); PG8_MMA(1, 1, At, B1); PG8_BAR; PG8_SCHED;
      PG8_LDB(B0, 1, 0); PG8_LDB(B1, 1, 1); PG8_SCHED; PG8_LDA(At, 1, 0); PG8_STAGE(PG8_SA(0, 1), a2, vo1);
      PG8_WAIT_V(8); PG8_WAIT_L(0); PG8_BAR; PG8_MMA(0, 0, At, B0); PG8_MMA(0, 1, At, B1); PG8_BAR; PG8_SCHED;
      PG8_LDA(At, 1, 1); PG8_STAGE(PG8_SB(1, 0), b3, voffB); PG8_STAGE(PG8_SB(1, 1), b3 + hstep, voffB); PG8_STAGE(PG8_SA(1, 0), a3, vo0);
      PG8_WAIT_V(8); PG8_WAIT_L(0); PG8_BAR; PG8_MMA(1, 0, At, B0); PG8_MMA(1, 1, At, B1); PG8_BAR; PG8_SCHED;
    }
    if constexpr (ALIGN_EPI) { if (wr == 0) PG8_BAR; }
    E(acc, cur, wr, wc, fr, fq);
    if (!has_next) break;
#pragma unroll
    for (int a = 0; a < 2; ++a)
#pragma unroll
      for (int b = 0; b < 2; ++b)
#pragma unroll
        for (int m = 0; m < 4; ++m)
#pragma unroll
          for (int n = 0; n < 2; ++n) acc[a][b][m][n] = (AccT){0, 0, 0, 0};
    cur = nxt; cB = nB; ++ui;
#pragma unroll
    for (int i = 0; i < 2; ++i) { cvo0[i] = nvo0[i]; cvo1[i] = nvo1[i]; }
    if constexpr (ALIGN_EPI) { if (wr == 1) PG8_BAR; }
  }
  PG8_WAIT_V(0);
  if constexpr (!ALIGN_EPI) { if (wr == 0) PG8_BAR; }
  PG8_BAR;
#undef PG8_SA
#undef PG8_SB
#undef PG8_STAGE
#undef PG8_LDA
#undef PG8_LDB
#undef PG8_MMA
#undef PG8_WAIT_V
#undef PG8_WAIT_L
#undef PG8_BAR
#undef PG8_SCHED
}

struct EpiStoreBf16 {
  typedef f32x4 AccT;
  static constexpr bool PERM = true, MIDHOOK = false;
  bf16_t* O; int ldc; int skip; int gcol0;
  DI static unsigned q8(float v) { const float g = __frcp_rn(1.f + __expf(-v)); return (unsigned)fminf(fmaxf(rintf(g * 255.f), 1.f), 255.f); }
  DI void operator()(const f32x4 (&acc)[2][2][4][2], const Unit& u, int wr, int wc, int fr, int fq) const {
    if (skip) { asm volatile("" :: "v"(acc[0][0][0][0]), "v"(acc[1][1][3][1])); return; }
    const int row0 = u.pm * BM + wr * 64 + fr, col0 = u.pn * BM + wc * 32 + 8 * fq;
    if (u.pn * BM >= gcol0) {
#pragma unroll
      for (int ai = 0; ai < 2; ++ai)
#pragma unroll
        for (int m = 0; m < 4; ++m) { unsigned char* rowp = (unsigned char*)O + (size_t)(row0 + ai * HALF + m * 16) * ldc * 2 + (size_t)gcol0 * 2 + (col0 - gcol0);
#pragma unroll
          for (int bj = 0; bj < 2; ++bj) { const f32x4 v0 = acc[ai][bj][m][0], v1 = acc[ai][bj][m][1];
            u32x2 w; w.x = q8(v0[0]) | (q8(v0[1]) << 8) | (q8(v0[2]) << 16) | (q8(v0[3]) << 24); w.y = q8(v1[0]) | (q8(v1[1]) << 8) | (q8(v1[2]) << 16) | (q8(v1[3]) << 24);
            NTST(w, (u32x2*)(rowp + bj * HALF)); } }
      return;
    }
#pragma unroll
    for (int ai = 0; ai < 2; ++ai)
#pragma unroll
      for (int m = 0; m < 4; ++m) { bf16_t* rowp = O + (size_t)(row0 + ai * HALF + m * 16) * ldc + col0;
#pragma unroll
        for (int bj = 0; bj < 2; ++bj) { const f32x4 v0 = acc[ai][bj][m][0], v1 = acc[ai][bj][m][1];
          u32x4 w; w.x = pk_bf16(v0[0], v0[1]); w.y = pk_bf16(v0[2], v0[3]); w.z = pk_bf16(v1[0], v1[1]); w.w = pk_bf16(v1[2], v1[3]);
          NTST(w, (u32x4*)(rowp + bj * HALF)); } }
  }
};
struct EpiMixed {
  typedef f32x4 AccT;
  static constexpr bool PERM = true, MIDHOOK = true;
  const unsigned char* gate8; bf16_t* O;
  DI void mid(f32x4 (&acc)[2][2][4][2], const Unit& u, int b, int wr, int wc, int fr, int fq) const {
    int row0 = u.pm * BM + wr * 64 + fr; const int col0 = u.pn * BM + wc * 32 + 8 * fq;
    asm volatile("" : "+v"(row0));
#pragma unroll
    for (int ai = 0; ai < 2; ++ai) {
      u32x2 ga[4][2], gb[4][2];
#pragma unroll
      for (int m = 0; m < 4; ++m) { const unsigned char* gp = gate8 + (size_t)(row0 + ai * HALF + m * 16) * (NPROJ * 2) + C_GATE * 2 + b * DM + col0;
#pragma unroll
        for (int bj = 0; bj < 2; ++bj) { ga[m][bj] = *(const u32x2*)(gp + bj * HALF); gb[m][bj] = *(const u32x2*)(gp + DM + bj * HALF); } }
#pragma unroll
      for (int m = 0; m < 4; ++m)
#pragma unroll
        for (int bj = 0; bj < 2; ++bj)
#pragma unroll
          for (int j = 0; j < 8; ++j) { const float a = (float)((ga[m][bj][j >> 2] >> (8 * (j & 3))) & 0xffu), bb = (float)((gb[m][bj][j >> 2] >> (8 * (j & 3))) & 0xffu);
            acc[ai][bj][m][j >> 2][j & 3] *= a * __frcp_rn(bb); }
      asm volatile("" ::: "memory");
    }
  }
  DI void operator()(const f32x4 (&acc)[2][2][4][2], const Unit& u, int wr, int wc, int fr, int fq) const {
    const int row0 = u.pm * BM + wr * 64 + fr, col0 = u.pn * BM + wc * 32 + 8 * fq;
#pragma unroll
    for (int ai = 0; ai < 2; ++ai) {
      u32x2 ga[4][2];
#pragma unroll
      for (int m = 0; m < 4; ++m) { const unsigned char* gp = gate8 + (size_t)(row0 + ai * HALF + m * 16) * (NPROJ * 2) + C_GATE * 2 + 2 * DM + col0;
#pragma unroll
        for (int bj = 0; bj < 2; ++bj) ga[m][bj] = *(const u32x2*)(gp + bj * HALF); }
#pragma unroll
      for (int m = 0; m < 4; ++m) { const int row = row0 + ai * HALF + m * 16;
#pragma unroll
        for (int bj = 0; bj < 2; ++bj) { float o[8];
#pragma unroll
          for (int j = 0; j < 8; ++j) o[j] = acc[ai][bj][m][j >> 2][j & 3] * ((float)((ga[m][bj][j >> 2] >> (8 * (j & 3))) & 0xffu) * (1.f / 255.f));
          u32x4 w; w.x = pk_bf16(o[0], o[1]); w.y = pk_bf16(o[2], o[3]); w.z = pk_bf16(o[4], o[5]); w.w = pk_bf16(o[6], o[7]);
          *(u32x4*)(O + (size_t)row * DM + col0 + bj * HALF) = w; } }
      asm volatile("" ::: "memory");
    }
  }
};
struct EpiH {
  typedef f32x4 AccT;
  static constexpr bool PERM = false, MIDHOOK = false;
  const float* x; float* h;
  DI void operator()(const f32x4 (&acc)[2][2][4][2], const Unit& u, int wr, int wc, int fr, int fq) const {
    const int row0 = u.pm * BM + wr * 64 + fr, col0 = u.pn * BM + wc * 32 + 4 * fq;
#pragma unroll
    for (int ai = 0; ai < 2; ++ai)
#pragma unroll
      for (int m = 0; m < 4; ++m) { const size_t off = (size_t)(row0 + ai * HALF + m * 16) * DM + col0;
#pragma unroll
        for (int bj = 0; bj < 2; ++bj)
#pragma unroll
          for (int n = 0; n < 2; ++n) { const f32x4 xv = *(const f32x4*)(x + off + bj * HALF + n * 16); *(f32x4*)(h + off + bj * HALF + n * 16) = xv * DN_ALPHA + acc[ai][bj][m][n]; }
        asm volatile("" ::: "memory"); }
  }
};
struct EpiGateUp {
  typedef f32x4 AccT;
  static constexpr bool PERM = true, MIDHOOK = false;
  const float* bgu; bf16_t* act;
  DI void operator()(const f32x4 (&acc)[2][2][4][2], const Unit& u, int wr, int wc, int fr, int fq) const {
    const int e = u.pn >> 3, pnl = u.pn & 7, row0 = u.pm * BM + wr * 64 + fr, j0 = pnl * 128 + wc * 32 + 8 * fq;
    f32x4 bg[2], bl[2];
#pragma unroll
    for (int n = 0; n < 2; ++n) { bg[n] = *(const f32x4*)(bgu + (size_t)e * 2048 + j0 + 4 * n); bl[n] = *(const f32x4*)(bgu + (size_t)e * 2048 + 1024 + j0 + 4 * n); }
#pragma unroll
    for (int ai = 0; ai < 2; ++ai)
#pragma unroll
      for (int m = 0; m < 4; ++m) { float o[8];
#pragma unroll
        for (int n = 0; n < 2; ++n)
#pragma unroll
          for (int j = 0; j < 4; ++j) { const float glu = fminf(acc[ai][0][m][n][j] + bg[n][j], SWIGLU_LIMIT); const float lin = fminf(fmaxf(acc[ai][1][m][n][j] + bl[n][j], -SWIGLU_LIMIT), SWIGLU_LIMIT);
            o[4 * n + j] = glu * __frcp_rn(1.f + __expf(-SWIGLU_ALPHA * glu)) * (lin + 1.f); }
        u32x4 w; w.x = pk_bf16(o[0], o[1]); w.y = pk_bf16(o[2], o[3]); w.z = pk_bf16(o[4], o[5]); w.w = pk_bf16(o[6], o[7]);
        *(u32x4*)(act + (size_t)(row0 + ai * HALF + m * 16) * DFF + j0) = w; }
  }
};
struct EpiGateUpI8 {
  typedef i32x4 AccT;
  static constexpr bool PERM = true, MIDHOOK = false;
  const float* bgu; const float* wsc; const float* rsc; const LAS int* tab; bf16_t* act;
  DI void operator()(const i32x4 (&acc)[2][2][4][2], const Unit& u, int wr, int wc, int fr, int fq) const {
    const int e = u.pn >> 3, pnl = u.pn & 7, row0 = u.pm * BM + wr * 64 + fr, j0 = pnl * 128 + wc * 32 + 8 * fq, r0 = pnl * 256 + wc * 32 + 8 * fq;
    const int local0 = row0 - tab[32 + e], cnt = tab[e];
    f32x4 bg[2], bl[2], sg[2], sl[2];
#pragma unroll
    for (int n = 0; n < 2; ++n) { bg[n] = *(const f32x4*)(bgu + (size_t)e * 2048 + j0 + 4 * n); bl[n] = *(const f32x4*)(bgu + (size_t)e * 2048 + 1024 + j0 + 4 * n);
      sg[n] = *(const f32x4*)(wsc + (size_t)e * 2048 + r0 + 4 * n); sl[n] = *(const f32x4*)(wsc + (size_t)e * 2048 + r0 + 128 + 4 * n); }
#pragma unroll
    for (int ai = 0; ai < 2; ++ai)
#pragma unroll
      for (int m = 0; m < 4; ++m) { const int local = local0 + ai * HALF + m * 16;
        const float sa = local < cnt ? rsc[(size_t)e * ECAP + local] : 0.f; float o[8];
#pragma unroll
        for (int n = 0; n < 2; ++n)
#pragma unroll
          for (int j = 0; j < 4; ++j) { const float glu = fminf((float)acc[ai][0][m][n][j] * (sa * sg[n][j]) + bg[n][j], SWIGLU_LIMIT);
            const float lin = fminf(fmaxf((float)acc[ai][1][m][n][j] * (sa * sl[n][j]) + bl[n][j], -SWIGLU_LIMIT), SWIGLU_LIMIT);
            o[4 * n + j] = glu * __frcp_rn(1.f + __expf(-SWIGLU_ALPHA * glu)) * (lin + 1.f); }
        u32x4 w; w.x = pk_bf16(o[0], o[1]); w.y = pk_bf16(o[2], o[3]); w.z = pk_bf16(o[4], o[5]); w.w = pk_bf16(o[6], o[7]);
        *(u32x4*)(act + (size_t)(row0 + ai * HALF + m * 16) * DFF + j0) = w; }
  }
};
struct EpiGate8 {
  typedef i32x4 AccT;
  static constexpr bool PERM = true, MIDHOOK = false;
  unsigned char* O; int ldcb; int gbyte0; const float* xsc; const float* wgs;
  DI static unsigned q8(float v) { const float g = __frcp_rn(1.f + __expf(-v)); return (unsigned)fminf(fmaxf(rintf(g * 255.f), 1.f), 255.f); }
  DI void operator()(const i32x4 (&acc)[2][2][4][2], const Unit& u, int wr, int wc, int fr, int fq) const {
    const int row0 = u.pm * BM + wr * 64 + fr, col0 = u.pn * BM + wc * 32 + 8 * fq;
    f32x4 sw[2][2];
#pragma unroll
    for (int bj = 0; bj < 2; ++bj)
#pragma unroll
      for (int n = 0; n < 2; ++n) sw[bj][n] = *(const f32x4*)(wgs + col0 + bj * HALF + 4 * n);
#pragma unroll
    for (int ai = 0; ai < 2; ++ai)
#pragma unroll
      for (int m = 0; m < 4; ++m) { const int row = row0 + ai * HALF + m * 16; const float sx = xsc[row]; unsigned char* rowp = O + (size_t)row * ldcb + gbyte0 + col0;
#pragma unroll
        for (int bj = 0; bj < 2; ++bj) { u32x2 w; unsigned q[8];
#pragma unroll
          for (int j = 0; j < 8; ++j) q[j] = q8((float)acc[ai][bj][m][j >> 2][j & 3] * (sx * sw[bj][j >> 2][j & 3]));
          w.x = q[0] | (q[1] << 8) | (q[2] << 16) | (q[3] << 24); w.y = q[4] | (q[5] << 8) | (q[6] << 16) | (q[7] << 24);
          NTST(w, (u32x2*)(rowp + bj * HALF)); } }
  }
};
struct EpiDown {
  typedef f32x4 AccT;
  static constexpr bool PERM = true, MIDHOOK = false;
  const float* bdn; const LAS int* tab; const u32x2* rinfo; bf16_t* ypair;
  DI void operator()(const f32x4 (&acc)[2][2][4][2], const Unit& u, int wr, int wc, int fr, int fq) const {
    const int e = u.pn >> 2, pnl = u.pn & 3, col0 = pnl * BM + wc * 32 + 8 * fq;
    const int local0 = u.pm * BM - tab[32 + e] + wr * 64 + fr, cnt = tab[e];
    f32x4 bv[2][2];
#pragma unroll
    for (int bj = 0; bj < 2; ++bj)
#pragma unroll
      for (int n = 0; n < 2; ++n) bv[bj][n] = *(const f32x4*)(bdn + (size_t)e * DM + col0 + bj * HALF + 4 * n);
#pragma unroll
    for (int ai = 0; ai < 2; ++ai)
#pragma unroll
      for (int m = 0; m < 4; ++m) { const int local = local0 + ai * HALF + m * 16;
        if (local < cnt) { const u32x2 info = rinfo[(size_t)e * ECAP + local]; const float gate = __uint_as_float(info.y); bf16_t* rowp = ypair + (size_t)info.x * DM + col0;
#pragma unroll
          for (int bj = 0; bj < 2; ++bj) { const f32x4 v0 = (acc[ai][bj][m][0] + bv[bj][0]) * gate, v1 = (acc[ai][bj][m][1] + bv[bj][1]) * gate;
            u32x4 w; w.x = pk_bf16(v0[0], v0[1]); w.y = pk_bf16(v0[2], v0[3]); w.z = pk_bf16(v1[0], v1[1]); w.w = pk_bf16(v1[2], v1[3]);
            *(u32x4*)(rowp + bj * HALF) = w; } } }
  }
};
}
#if NAIVE_ANY
template <class F> DI void naive_gemm(const Ctx& c, const bf16_t* A, int lda, const bf16_t* Bt, int ldb, int M, int N, int K, F epi) {
  const int r = c.lane & 31, h = c.lane >> 5, tn_n = N / 32, tiles = (M / 32) * tn_n;
  for (int tile = c.gw; tile < tiles; tile += c.ngw) {
    const int tm = tile / tn_n, tn = tile - tm * tn_n;
    const bf16_t* ap = A + (size_t)(tm * 32 + r) * lda + 8 * h; const bf16_t* bp = Bt + (size_t)(tn * 32 + r) * ldb + 8 * h;
    f32x16 acc; for (int i = 0; i < 16; ++i) acc[i] = 0.f;
    for (int k0 = 0; k0 < K; k0 += 16) { const bf16x8 a = *(const bf16x8*)(ap + k0), b = *(const bf16x8*)(bp + k0); acc = MFMA32(a, b, acc); }
#pragma unroll
    for (int i = 0; i < 16; ++i) epi(tm * 32 + crow(i, h), tn * 32 + r, acc[i]);
  }
}
#endif

#if NAIVE_GDN
DI void naive_gdn_prep(const Ctx& c) {
  const bf16_t* proj = (const bf16_t*)(c.p.ws + WS_PROJ); bf16_t* qkv = (bf16_t*)(c.p.ws + WS_GDN); const float* wc = c.p.in[I_WCONV];
  for (int it = c.gw; it < TT * 4; it += c.ngw) {
    const int t = it >> 2, hh = it & 3, tl = t & (SEQ - 1);
    float val[3][2];
#pragma unroll
    for (int part = 0; part < 3; ++part)
#pragma unroll
      for (int e = 0; e < 2; ++e) { const int ch = part * 512 + hh * 128 + 2 * c.lane + e; float a = 0.f;
#pragma unroll
        for (int j = 0; j < 4; ++j) { const int ts = tl - 3 + j; if (ts >= 0) a += wc[j * 1536 + ch] * bf2f(proj[(size_t)(t - 3 + j) * NPROJ + ch]); }
        val[part][e] = a * sigmoidf_(a); }
    const float sq = wave_sum(val[0][0] * val[0][0] + val[0][1] * val[0][1]), sk = wave_sum(val[1][0] * val[1][0] + val[1][1] * val[1][1]);
    const float rq = rsqrtf(sq + NORM_EPS) * 0.08838834764831845f, rk = rsqrtf(sk + NORM_EPS);
    bf16_t* o = qkv + ((size_t)t * 4 + hh) * 384 + 2 * c.lane;
    *(unsigned*)(o) = pk_bf16(val[0][0] * rq, val[0][1] * rq); *(unsigned*)(o + 128) = pk_bf16(val[1][0] * rk, val[1][1] * rk); *(unsigned*)(o + 256) = pk_bf16(val[2][0], val[2][1]);
  }
}
DI void naive_gdn_scan(const Ctx& c) {
  if (c.bid >= 64) return;
  const int b = c.bid >> 2, hh = c.bid & 3, j = c.tid;
  const bf16_t* qkv = (const bf16_t*)(c.p.ws + WS_GDN); const float* gbeta = (const float*)(c.p.ws + WS_MISC); bf16_t* ycat = (bf16_t*)(c.p.ws + WS_YCAT);
  LAS float* sq = (LAS float*)c.lds; LAS float* sk = sq + 8 * 128;
  float S[128];
#pragma unroll
  for (int d = 0; d < 128; ++d) S[d] = 0.f;
  for (int t0 = 0; t0 < SEQ; t0 += 8) {
    __syncthreads();
    for (int i = c.tid; i < 8 * 256; i += 512) { const int tt = i >> 8, d = i & 255; const size_t t = (size_t)b * SEQ + t0 + tt;
      const float v = bf2f(qkv[(t * 4 + hh) * 384 + d]); if (d < 128) sq[tt * 128 + d] = v; else sk[tt * 128 + d - 128] = v; }
    __syncthreads();
    if (j < 128) {
      for (int tt = 0; tt < 8; ++tt) { const size_t t = (size_t)b * SEQ + t0 + tt;
        const float g = gbeta[t * 8 + hh], beta = gbeta[t * 8 + 4 + hh], dec = __expf(g), vt = bf2f(qkv[(t * 4 + hh) * 384 + 256 + j]);
        float ks = 0.f;
#pragma unroll
        for (int d = 0; d < 128; ++d) ks += sk[tt * 128 + d] * S[d];
        const float vn = beta * (vt - dec * ks); float o = 0.f;
#pragma unroll
        for (int d = 0; d < 128; ++d) { S[d] = dec * S[d] + sk[tt * 128 + d] * vn; o += sq[tt * 128 + d] * S[d]; }
        ycat[t * 1536 + hh * 128 + j] = f2bf(o); }
    }
  }
}
#endif

#if NAIVE_ATTN
DI void naive_sb(const Ctx& c) {
  const bf16_t* proj = (const bf16_t*)(c.p.ws + WS_PROJ); bf16_t* ycat = (bf16_t*)(c.p.ws + WS_YCAT);
  LAS float* wl = (LAS float*)c.lds + c.wave * 64;
  for (int it = c.gw; it < NB * 8 * SEQ; it += c.ngw) {
    const int tq = it & (SEQ - 1), hh = (it >> 11) & 7, b = it >> 14; const size_t trow = (size_t)b * SEQ + tq;
    float q[64];
    { const bf16_t* qp = proj + trow * NPROJ + C_SQ + hh * 64;
#pragma unroll
      for (int d8 = 0; d8 < 8; ++d8) { const u32x4 w = *(const u32x4*)(qp + 8 * d8);
#pragma unroll
        for (int e = 0; e < 4; ++e) { q[8 * d8 + 2 * e] = bflo(w[e]); q[8 * d8 + 2 * e + 1] = bfhi(w[e]); } } }
    float carry = 0.f, o = 0.f;
    for (int kt = (tq - 1) >> 6; kt >= 0 && tq > 0; --kt) {
      const int s = kt * 64 + c.lane; const bool valid = s < tq; const size_t srow = (size_t)b * SEQ + (valid ? s : 0);
      const bf16_t* kp = proj + srow * NPROJ + C_SK + hh * 64; float z = 0.f;
#pragma unroll
      for (int d8 = 0; d8 < 8; ++d8) { const u32x4 w = *(const u32x4*)(kp + 8 * d8);
#pragma unroll
        for (int e = 0; e < 4; ++e) z += q[8 * d8 + 2 * e] * bflo(w[e]) + q[8 * d8 + 2 * e + 1] * bfhi(w[e]); }
      z *= 0.125f;
      const float sp = valid ? softplusf_(z) : 0.f;
      float suf = sp;
#pragma unroll
      for (int off = 1; off < 64; off <<= 1) { const float o2 = __shfl_down(suf, off); if (c.lane + off < 64) suf += o2; }
      const float w = valid ? __expf(z - (carry + suf)) : 0.f;
      carry += __shfl(suf, 0);
      LDS_WAIT(); wl[c.lane] = w; LDS_WAIT();
      const int smax = min(64, tq - kt * 64);
      for (int ss = 0; ss < smax; ++ss) o += wl[ss] * bf2f(proj[((size_t)b * SEQ + kt * 64 + ss) * NPROJ + C_SV + hh * 64 + c.lane]);
      LDS_WAIT();
    }
    ycat[trow * 1536 + 512 + hh * 64 + c.lane] = f2bf(o);
  }
}
DI void naive_mem(const Ctx& c) {
  const bf16_t* proj = (const bf16_t*)(c.p.ws + WS_PROJ); const bf16_t* mkv = (const bf16_t*)(c.p.ws + WS_MKV); bf16_t* ycat = (bf16_t*)(c.p.ws + WS_YCAT);
  LAS float* pl = (LAS float*)(c.lds + 4096) + c.wave * 256;
  for (int it = c.gw; it < NB * 4 * SEQ; it += c.ngw) {
    const int tq = it & (SEQ - 1), hh = (it >> 11) & 3, b = it >> 13; const size_t trow = (size_t)b * SEQ + tq;
    const bf16_t* qp = proj + trow * NPROJ + C_MQ + hh * 128;
    float sc[4];
#pragma unroll
    for (int kt = 0; kt < 4; ++kt) { const bf16_t* kp = mkv + (size_t)(b * MEMLEN + kt * 64 + c.lane) * 1024 + hh * 128; float z = 0.f;
      for (int d8 = 0; d8 < 16; ++d8) { const u32x4 w = *(const u32x4*)(kp + 8 * d8), qw = *(const u32x4*)(qp + 8 * d8);
#pragma unroll
        for (int e = 0; e < 4; ++e) z += bflo(qw[e]) * bflo(w[e]) + bfhi(qw[e]) * bfhi(w[e]); }
      sc[kt] = z * 0.08838834764831845f; }
    const float mx = wave_max(fmaxf(fmaxf(sc[0], sc[1]), fmaxf(sc[2], sc[3])));
    float pe[4], ssum = 0.f;
#pragma unroll
    for (int kt = 0; kt < 4; ++kt) { pe[kt] = __expf(sc[kt] - mx); ssum += pe[kt]; }
    ssum = wave_sum(ssum);
    LDS_WAIT();
#pragma unroll
    for (int kt = 0; kt < 4; ++kt) pl[kt * 64 + c.lane] = pe[kt] / ssum;
    LDS_WAIT();
    float o0 = 0.f, o1 = 0.f;
    for (int s = 0; s < 256; ++s) { const unsigned vv = *(const unsigned*)(mkv + (size_t)(b * MEMLEN + s) * 1024 + 512 + hh * 128 + 2 * c.lane); const float pw = pl[s]; o0 += pw * bflo(vv); o1 += pw * bfhi(vv); }
    LDS_WAIT();
    *(unsigned*)(ycat + trow * 1536 + 1024 + hh * 128 + 2 * c.lane) = pk_bf16(o0, o1);
  }
}
#endif
DI void tr_item(const float* src, int ldw, bf16_t* dst, int ldd, LAS float* scr, int lane) {
#pragma unroll
  for (int i = 0; i < 8; ++i) { const int kk = 8 * i + (lane >> 3); const f32x4 v = *(const f32x4*)(src + (size_t)kk * ldw + 4 * (lane & 7));
    LAS float* s = scr + kk * 33 + 4 * (lane & 7); s[0] = v.x; s[1] = v.y; s[2] = v.z; s[3] = v.w; }
  LDS_WAIT();
  const int cc = lane & 7;
#pragma unroll
  for (int j = 0; j < 4; ++j) { const int n = (lane >> 3) + 8 * j; const LAS float* s = scr + (8 * cc) * 33 + n;
    u32x4 o; o.x = pk_bf16(s[0 * 33], s[1 * 33]); o.y = pk_bf16(s[2 * 33], s[3 * 33]); o.z = pk_bf16(s[4 * 33], s[5 * 33]); o.w = pk_bf16(s[6 * 33], s[7 * 33]);
    *(u32x4*)(dst + (size_t)n * ldd + 8 * cc) = o; }
  LDS_WAIT();
}
DI void phase0(const Ctx& c) {
  unsigned char* ws = c.p.ws;
  if (c.bid == 0 && c.tid < 32) ((int*)(ws + WS_MISC + MiB))[c.tid] = 0;
  {
    LAS float* scr = (LAS float*)(c.lds + c.wave * 8448);
    for (int r = c.gw; r < 16 * (GATE_I8 ? 128 : 224); r += c.ngw) { const int kb = r / (GATE_I8 ? 128 : 224), nb = r % (GATE_I8 ? 128 : 224); const int n0 = 32 * nb + (nb >= 64 ? 8 : 0);
      tr_item(c.p.in[I_WIN] + (size_t)(64 * kb) * 7176 + n0, 7176, (bf16_t*)(ws + WS_WIN) + (size_t)(32 * nb) * 1024 + 64 * kb, 1024, scr, c.lane); }
    for (int r = (c.gw + 512) % c.ngw; r < 16 * 32; r += c.ngw) { const int kb = r / 32, nb = r % 32;
      tr_item(c.p.in[I_WMKV] + (size_t)(64 * kb) * 1024 + 32 * nb, 1024, (bf16_t*)(ws + WS_WMKV) + (size_t)(32 * nb) * 1024 + 64 * kb, 1024, scr, c.lane); }
    for (int r = (c.gw + 1024) % c.ngw; r < 8 * 32; r += c.ngw) { const int kb = r / 32, nb = r % 32;
      tr_item(c.p.in[I_WPG] + (size_t)(64 * kb) * 1024 + 32 * nb, 1024, (bf16_t*)(ws + WS_WP) + (size_t)(32 * nb) * 1536 + 0 * 512 + 64 * kb, 1536, scr, c.lane); }
    for (int r = (c.gw + 1280) % c.ngw; r < 8 * 32; r += c.ngw) { const int kb = r / 32, nb = r % 32;
      tr_item(c.p.in[I_WPS] + (size_t)(64 * kb) * 1024 + 32 * nb, 1024, (bf16_t*)(ws + WS_WP) + (size_t)(32 * nb) * 1536 + 1 * 512 + 64 * kb, 1536, scr, c.lane); }
    for (int r = (c.gw + 1536) % c.ngw; r < 8 * 32; r += c.ngw) { const int kb = r / 32, nb = r % 32;
      tr_item(c.p.in[I_WPM] + (size_t)(64 * kb) * 1024 + 32 * nb, 1024, (bf16_t*)(ws + WS_WP) + (size_t)(32 * nb) * 1536 + 2 * 512 + 64 * kb, 1536, scr, c.lane); }
    for (int r = (c.gw + 1792) % c.ngw; r < 16 * 32; r += c.ngw) { const int kb = r / 32, nb = r % 32;
      tr_item(c.p.in[I_WO] + (size_t)(64 * kb) * 1024 + 32 * nb, 1024, (bf16_t*)(ws + WS_WO) + (size_t)(32 * nb) * 1024 + 64 * kb, 1024, scr, c.lane); }
#if MOE_I8
    { unsigned* cmax = (unsigned*)(ws + WS_CMAX);
      for (int r = c.gw; r < 32 * 16 * 4; r += c.ngw) { const int e = r >> 6, kb = (r >> 2) & 15, nq = r & 3;
        const float* src = c.p.in[I_WGU] + (size_t)e * 1024 * 2048 + (size_t)(64 * kb) * 2048 + 512 * nq + 8 * c.lane;
        f32x4 m0 = {0.f, 0.f, 0.f, 0.f}, m1 = {0.f, 0.f, 0.f, 0.f};
#pragma unroll 8
        for (int kk = 0; kk < 64; ++kk) { const f32x4 a = *(const f32x4*)(src + (size_t)kk * 2048), b = *(const f32x4*)(src + (size_t)kk * 2048 + 4);
          m0.x = fmaxf(m0.x, fabsf(a.x)); m0.y = fmaxf(m0.y, fabsf(a.y)); m0.z = fmaxf(m0.z, fabsf(a.z)); m0.w = fmaxf(m0.w, fabsf(a.w));
          m1.x = fmaxf(m1.x, fabsf(b.x)); m1.y = fmaxf(m1.y, fabsf(b.y)); m1.z = fmaxf(m1.z, fabsf(b.z)); m1.w = fmaxf(m1.w, fabsf(b.w)); }
        unsigned* cm = cmax + e * 2048 + 512 * nq + 8 * c.lane;
        atomicMax(cm + 0, __float_as_uint(m0.x)); atomicMax(cm + 1, __float_as_uint(m0.y)); atomicMax(cm + 2, __float_as_uint(m0.z)); atomicMax(cm + 3, __float_as_uint(m0.w));
        atomicMax(cm + 4, __float_as_uint(m1.x)); atomicMax(cm + 5, __float_as_uint(m1.y)); atomicMax(cm + 6, __float_as_uint(m1.z)); atomicMax(cm + 7, __float_as_uint(m1.w)); } }
#else
    for (int r = c.gw; r < 32 * 16 * 64; r += c.ngw) { const int e = r / 1024, q = r % 1024, kb = q / 64, nb = q % 64; const int r0 = 32 * nb, n0 = ((r0 >> 7) & 1) * 1024 + (r0 >> 8) * 128 + (r0 & 127);
      tr_item(c.p.in[I_WGU] + (size_t)e * 1024 * 2048 + (size_t)(64 * kb) * 2048 + n0, 2048, (bf16_t*)(ws + WS_WGU) + ((size_t)e * 2048 + r0) * 1024 + 64 * kb, 1024, scr, c.lane); }
#endif
#if !(MOE_I8 && W8_BESIDE_SCAN)
    for (int r = c.gw; r < 32 * 16 * 32; r += c.ngw) { const int e = r / 512, q = r % 512, kb = q / 32, nb = q % 32;
      tr_item(c.p.in[I_WDN] + (size_t)e * 1024 * 1024 + (size_t)(64 * kb) * 1024 + 32 * nb, 1024, (bf16_t*)(ws + WS_WDN) + ((size_t)e * 1024 + 32 * nb) * 1024 + 64 * kb, 1024, scr, c.lane); }
#endif
  }
#if GATE_I8
  for (int grp = c.gw; grp < 96; grp += c.ngw) {
    const int n = c.lane & 31, hk = c.lane >> 5; const float* src = c.p.in[I_WIN] + (size_t)(512 * hk) * 7176 + 4104 + 32 * grp + n;
    float am = 0.f;
#pragma unroll 16
    for (int k = 0; k < 512; ++k) am = fmaxf(am, fabsf(src[(size_t)k * 7176]));
    am = fmaxf(am, __shfl_xor(am, 32)); const float inv = am > 0.f ? 127.f / am : 0.f;
    if (hk == 0) ((float*)(ws + WS_WGS))[32 * grp + n] = am * (1.f / 127.f);
    signed char* dst = (signed char*)(ws + WS_WG8) + (size_t)(32 * grp + n) * 1024 + 512 * hk;
    for (int k0 = 0; k0 < 512; k0 += 16) { u32x4 o;
#pragma unroll
      for (int g = 0; g < 4; ++g) { unsigned w = 0;
#pragma unroll
        for (int b2 = 0; b2 < 4; ++b2) w |= ((unsigned)(int)rintf(src[(size_t)(k0 + 4 * g + b2) * 7176] * inv) & 0xffu) << (8 * b2);
        o[g] = w; }
      *(u32x4*)(dst + k0) = o; }
  }
#endif
  { const float* wr = c.p.in[I_WR]; float* wT = (float*)(ws + WS_WRT); for (int i = c.bid * 512 + c.tid; i < 32 * 1024; i += c.G * 512) wT[i] = wr[(i & 1023) * 32 + (i >> 10)]; }
  { const f32x4* src = (const f32x4*)c.p.in[I_MEM]; u32x2* dst = (u32x2*)(ws + WS_MEMB);
    for (int i = c.bid * 512 + c.tid; i < NB * MEMLEN * DM / 4; i += c.G * 512) { const f32x4 v = src[i]; u32x2 o; o.x = pk_bf16(v.x, v.y); o.y = pk_bf16(v.z, v.w); dst[i] = o; } }
  {
    float wab[4][4][8];
#pragma unroll
    for (int j = 0; j < 4; ++j)
#pragma unroll
      for (int i = 0; i < 4; ++i) { const float* wp = c.p.in[I_WIN] + (size_t)(256 * j + 4 * c.lane + i) * 7176 + 2048; const f32x4 a = *(const f32x4*)wp, b = *(const f32x4*)(wp + 4);
        wab[j][i][0] = a.x; wab[j][i][1] = a.y; wab[j][i][2] = a.z; wab[j][i][3] = a.w; wab[j][i][4] = b.x; wab[j][i][5] = b.y; wab[j][i][6] = b.z; wab[j][i][7] = b.w; }
    const int hh = c.lane & 3; const float nega = -__expf(c.p.in[I_ALOG][hh]), dtb = c.p.in[I_DTB][hh];
    float* gbeta = (float*)(ws + WS_MISC);
    for (int m = c.gw; m < TT; m += c.ngw) {
      const f32x4* xr = (const f32x4*)(c.p.in[I_X] + (size_t)m * DM) + c.lane; u32x2* xo = (u32x2*)(ws + WS_XB + (size_t)m * DM * 2) + c.lane;
      float s[8];
#pragma unroll
      for (int q = 0; q < 8; ++q) s[q] = 0.f;
      f32x4 xv[4];
#pragma unroll
      for (int j = 0; j < 4; ++j) { const f32x4 v = xr[64 * j]; xv[j] = v; u32x2 o; o.x = pk_bf16(v.x, v.y); o.y = pk_bf16(v.z, v.w); xo[64 * j] = o;
#pragma unroll
        for (int q = 0; q < 8; ++q) s[q] += v.x * wab[j][0][q] + v.y * wab[j][1][q] + v.z * wab[j][2][q] + v.w * wab[j][3][q]; }
#pragma unroll
      for (int q = 0; q < 8; ++q) s[q] = wave_sum(s[q]);
#if GATE_I8
      { float am = 0.f;
#pragma unroll
        for (int j = 0; j < 4; ++j) am = fmaxf(fmaxf(am, fmaxf(fabsf(xv[j].x), fabsf(xv[j].y))), fmaxf(fabsf(xv[j].z), fabsf(xv[j].w)));
        am = wave_max(am); const float qs = am > 0.f ? 127.f / am : 0.f;
        if (c.lane == 0) ((float*)(ws + WS_TSC))[m] = am * (1.f / 127.f);
#pragma unroll
        for (int j = 0; j < 4; ++j) ((unsigned*)(ws + WS_XQ + (size_t)m * DM))[64 * j + c.lane] = ((unsigned)(int)rintf(xv[j].x * qs) & 0xffu) | (((unsigned)(int)rintf(xv[j].y * qs) & 0xffu) << 8) | (((unsigned)(int)rintf(xv[j].z * qs) & 0xffu) << 16) | (((unsigned)(int)rintf(xv[j].w * qs) & 0xffu) << 24); }
#endif
      if (c.lane < 8) {
        float pre = s[0];
#pragma unroll
        for (int q = 1; q < 8; ++q) pre = (c.lane == q) ? s[q] : pre;
        const float val = c.lane < 4 ? nega * softplusf_(pre + dtb) : sigmoidf_(pre);
        gbeta[(size_t)m * 8 + c.lane] = val;
      }
    }
  }
}

#if MOE_I8
DI void phase0b(const Ctx& c) {
  unsigned char* ws = c.p.ws; const float* cmaxf = (const float*)(ws + WS_CMAX); float* wsc = (float*)(ws + WS_WSC); signed char* w8 = (signed char*)(ws + WS_WGU);
  LAS float* scr = (LAS float*)(c.lds + c.wave * 8448);
  for (int r = c.gw; r < 32 * 16 * 64; r += c.ngw) { const int e = r / 1024, q = r % 1024, kb = q / 64, nb = q % 64; const int r0 = 32 * nb, n0 = ((r0 >> 7) & 1) * 1024 + (r0 >> 8) * 128 + (r0 & 127);
    const float* src = c.p.in[I_WGU] + (size_t)e * 1024 * 2048 + (size_t)(64 * kb) * 2048 + n0;
#pragma unroll
    for (int i = 0; i < 8; ++i) { const int kk = 8 * i + (c.lane >> 3); const f32x4 v = *(const f32x4*)(src + (size_t)kk * 2048 + 4 * (c.lane & 7));
      LAS float* sp = scr + kk * 33 + 4 * (c.lane & 7); sp[0] = v.x; sp[1] = v.y; sp[2] = v.z; sp[3] = v.w; }
    LDS_WAIT();
    const int n = c.lane >> 1, hk = c.lane & 1; const float cm = cmaxf[e * 2048 + n0 + n], inv = cm > 0.f ? 127.f / cm : 0.f;
    if (kb == 0 && hk == 0) wsc[e * 2048 + r0 + n] = cm * (1.f / 127.f);
    u32x4 o[2];
#pragma unroll
    for (int g = 0; g < 8; ++g) { unsigned w = 0;
#pragma unroll
      for (int b = 0; b < 4; ++b) { const int qv = (int)rintf(scr[(32 * hk + 4 * g + b) * 33 + n] * inv); w |= ((unsigned)qv & 0xffu) << (8 * b); }
      o[g >> 2][g & 3] = w; }
    signed char* dst = w8 + ((size_t)e * 2048 + r0 + n) * 1024 + 64 * kb + 32 * hk;
    *(u32x4*)dst = o[0]; *(u32x4*)(dst + 16) = o[1];
    LDS_WAIT();
  }
}
#endif

#if MOE_I8
DI void phase0b_light(const Ctx& c, LAS unsigned char* scr8, int wi, int nw) {
  unsigned char* ws = c.p.ws; const float* cmaxf = (const float*)(ws + WS_CMAX); float* wsc = (float*)(ws + WS_WSC); signed char* w8 = (signed char*)(ws + WS_WGU);
  for (int r = wi; r < 32 * 16 * 64; r += nw) { const int e = r / 1024, q = r % 1024, kb = q / 64, nb = q % 64; const int r0 = 32 * nb, n0 = ((r0 >> 7) & 1) * 1024 + (r0 >> 8) * 128 + (r0 & 127);
    const float* src = c.p.in[I_WGU] + (size_t)e * 1024 * 2048 + (size_t)(64 * kb) * 2048 + n0;
    const int nq = 4 * (c.lane & 7);
    const f32x4 cm = *(const f32x4*)(cmaxf + e * 2048 + n0 + nq);
    const f32x4 inv = {cm.x > 0.f ? 127.f / cm.x : 0.f, cm.y > 0.f ? 127.f / cm.y : 0.f, cm.z > 0.f ? 127.f / cm.z : 0.f, cm.w > 0.f ? 127.f / cm.w : 0.f};
    if (kb == 0 && c.lane < 8) *(f32x4*)(wsc + e * 2048 + r0 + nq) = cm * (1.f / 127.f);
    f32x4 v[8];
#pragma unroll
    for (int i = 0; i < 8; ++i) v[i] = *(const f32x4*)(src + (size_t)(8 * i + (c.lane >> 3)) * 2048 + nq);
    LDS_WAIT();
#pragma unroll
    for (int i = 0; i < 8; ++i) { const int kk = 8 * i + (c.lane >> 3);
      scr8[(nq + 0) * 80 + kk] = (unsigned char)(int)rintf(v[i].x * inv.x); scr8[(nq + 1) * 80 + kk] = (unsigned char)(int)rintf(v[i].y * inv.y);
      scr8[(nq + 2) * 80 + kk] = (unsigned char)(int)rintf(v[i].z * inv.z); scr8[(nq + 3) * 80 + kk] = (unsigned char)(int)rintf(v[i].w * inv.w); }
    LDS_WAIT();
    const int n = c.lane >> 1, hk = c.lane & 1;
    const u32x4 o0 = *(const LAS u32x4*)(scr8 + n * 80 + 32 * hk), o1 = *(const LAS u32x4*)(scr8 + n * 80 + 32 * hk + 16);
    signed char* dst = w8 + ((size_t)e * 2048 + r0 + n) * 1024 + 64 * kb + 32 * hk;
    *(u32x4*)dst = o0; *(u32x4*)(dst + 16) = o1;
  }
}
#endif

DI void wdn_light(const Ctx& c, LAS bf16_t* scr, int wi, int nw) {
  unsigned char* ws = c.p.ws;
  for (int r = wi; r < 32 * 16 * 32; r += nw) { const int e = r / 512, q = r % 512, kb = q / 32, nb = q % 32;
    const float* src = c.p.in[I_WDN] + (size_t)e * 1024 * 1024 + (size_t)(64 * kb) * 1024 + 32 * nb; bf16_t* dst = (bf16_t*)(ws + WS_WDN) + ((size_t)e * 1024 + 32 * nb) * 1024 + 64 * kb;
    const int nq = 4 * (c.lane & 7); f32x4 v[8];
#pragma unroll
    for (int i = 0; i < 8; ++i) v[i] = *(const f32x4*)(src + (size_t)(8 * i + (c.lane >> 3)) * 1024 + nq);
    LDS_WAIT();
#pragma unroll
    for (int i = 0; i < 8; ++i) { const int kk = 8 * i + (c.lane >> 3); const unsigned a = pk_bf16(v[i].x, v[i].y), b = pk_bf16(v[i].z, v[i].w);
      scr[(nq + 0) * 72 + kk] = (bf16_t)(a & 0xffffu); scr[(nq + 1) * 72 + kk] = (bf16_t)(a >> 16); scr[(nq + 2) * 72 + kk] = (bf16_t)(b & 0xffffu); scr[(nq + 3) * 72 + kk] = (bf16_t)(b >> 16); }
    LDS_WAIT();
    const int n = c.lane >> 1, hk = c.lane & 1;
#pragma unroll
    for (int j = 0; j < 4; ++j) *(u32x4*)(dst + (size_t)n * 1024 + 32 * hk + 8 * j) = *(const LAS u32x4*)(scr + n * 72 + 32 * hk + 8 * j);
  }
}

DI void phase_gdn_norm(const Ctx& c) {
  bf16_t* ycat = (bf16_t*)(c.p.ws + WS_YCAT); const bf16_t* proj = (const bf16_t*)(c.p.ws + WS_PROJ); const float* nw = c.p.in[I_GNW];
  const float w0 = nw[2 * c.lane], w1 = nw[2 * c.lane + 1];
  for (int it = c.gw; it < TT * 4; it += c.ngw) {
    const int t = it >> 2, hh = it & 3;
    unsigned* op = (unsigned*)(ycat + (size_t)t * 1536 + hh * 128) + c.lane; const unsigned ov = *op, zv = *((const unsigned*)(proj + (size_t)t * NPROJ + C_GZ + hh * 128) + c.lane);
    const float o0 = bflo(ov), o1 = bfhi(ov), z0 = bflo(zv), z1 = bfhi(zv);
    const float rs = rsqrtf(wave_sum(o0 * o0 + o1 * o1) * (1.f / 128.f) + NORM_EPS);
    *op = pk_bf16(o0 * rs * w0 * (z0 * sigmoidf_(z0)), o1 * rs * w1 * (z1 * sigmoidf_(z1)));
  }
}

#if ROUTER_LDS
DI void phase_router(const Ctx& c) {
  unsigned char* ws = c.p.ws;
  const float* h = (const float*)(ws + WS_H); bf16_t* x1h = (bf16_t*)(ws + WS_X1);
  const float* wT = (const float*)(ws + WS_WRT); int* gcount = (int*)(ws + WS_MISC + MiB); u32x2* rinfo = (u32x2*)(ws + WS_RINFO);
  constexpr int XS = 1028;
  LAS float* xs = (LAS float*)c.lds;
  LAS int* wcnt = (LAS int*)(c.lds + 131584); LAS int* bbase = wcnt + 32; LAS float* tsl = (LAS float*)(bbase + 32);
  LAS int* sel_e = (LAS int*)(tsl + 128); LAS int* sel_pos = sel_e + 512; LAS float* sel_g = (LAS float*)(sel_e + 1024);
  const int e = c.lane & 31, hf = c.lane >> 5;
  f32x4 gam[4], bet[4];
#pragma unroll
  for (int j = 0; j < 4; ++j) { gam[j] = ((const f32x4*)c.p.in[I_LN1G])[64 * j + c.lane]; bet[j] = ((const f32x4*)c.p.in[I_LN1B])[64 * j + c.lane]; }
  for (int gi = c.bid; gi < TT / 128; gi += c.G) {
    const int tokg = gi * 128;
    if (c.tid < 32) wcnt[c.tid] = 0;
    f32x4 vn[4];
    { const f32x4* hr0 = (const f32x4*)(h + ((size_t)tokg + c.wave * 4) * DM) + c.lane;
#pragma unroll
      for (int j = 0; j < 4; ++j) vn[j] = hr0[64 * j]; }
    for (int sg = 0; sg < 4; ++sg) {
      for (int i = 0; i < 4; ++i) {
        const int r = c.wave * 4 + i; const size_t t = (size_t)tokg + sg * 32 + r; f32x4 v[4]; float s = 0.f;
#pragma unroll
        for (int j = 0; j < 4; ++j) { v[j] = vn[j]; s += (v[j].x + v[j].y) + (v[j].z + v[j].w); }
        { const int tn = (i < 3) ? (int)t + 1 : (sg < 3 ? tokg + (sg + 1) * 32 + c.wave * 4 : (int)t);
          const f32x4* hrn = (const f32x4*)(h + (size_t)tn * DM) + c.lane;
#pragma unroll
          for (int j = 0; j < 4; ++j) vn[j] = hrn[64 * j]; }
        const float mean = wave_sum(s) * (1.f / DM); float s2 = 0.f;
#pragma unroll
        for (int j = 0; j < 4; ++j) { v[j] = v[j] - mean; s2 += (v[j].x * v[j].x + v[j].y * v[j].y) + (v[j].z * v[j].z + v[j].w * v[j].w); }
        const float rstd = rsqrtf(wave_sum(s2) * (1.f / DM) + LN_EPS);
        f32x4 y[4]; float am = 0.f;
#pragma unroll
        for (int j = 0; j < 4; ++j) { y[j] = v[j] * rstd * gam[j] + bet[j]; *(LAS f32x4*)(xs + r * XS + 256 * j + 4 * c.lane) = y[j];
          u32x2 o; o.x = pk_bf16(y[j].x, y[j].y); o.y = pk_bf16(y[j].z, y[j].w); ((u32x2*)(x1h + t * DM))[64 * j + c.lane] = o;
          am = fmaxf(fmaxf(am, fmaxf(fabsf(y[j].x), fabsf(y[j].y))), fmaxf(fabsf(y[j].z), fabsf(y[j].w))); }
        am = wave_max(am); const float qs = am > 0.f ? 127.f / am : 0.f;
        if (c.lane == 0) tsl[sg * 32 + r] = am * (1.f / 127.f);
#pragma unroll
        for (int j = 0; j < 4; ++j) { const unsigned w = ((unsigned)(int)rintf(y[j].x * qs) & 0xffu) | (((unsigned)(int)rintf(y[j].y * qs) & 0xffu) << 8) | (((unsigned)(int)rintf(y[j].z * qs) & 0xffu) << 16) | (((unsigned)(int)rintf(y[j].w * qs) & 0xffu) << 24);
          ((unsigned*)(ws + WS_X1Q + t * DM))[64 * j + c.lane] = w; }
      }
      __syncthreads();
      f32x16 acc;
      if (c.wave < 4) {
        const float* ap = wT + (size_t)e * DM + 256 * c.wave + 128 * hf; const LAS float* bp = xs + e * XS + 256 * c.wave + 128 * hf;
#pragma unroll
        for (int i = 0; i < 16; ++i) acc[i] = 0.f;
        f32x4 a4 = *(const f32x4*)ap, a4n = *(const f32x4*)(ap + 4);
        for (int q = 0; q < 32; ++q) {
          const f32x4 a4nn = *(const f32x4*)(ap + 4 * (q + 2 < 32 ? q + 2 : 31)); const f32x4 b4 = *(const LAS f32x4*)(bp + 4 * q);
#pragma unroll
          for (int j = 0; j < 4; ++j) acc = __builtin_amdgcn_mfma_f32_32x32x2f32(a4[j], b4[j], acc, 0, 0, 0);
          a4 = a4n; a4n = a4nn;
        }
      }
      __syncthreads();
      if (c.wave < 4) {
#pragma unroll
        for (int rg = 0; rg < 16; ++rg) xs[(c.wave * 32 + crow(rg, hf)) * 32 + e] = acc[rg];
      }
      __syncthreads();
      if (c.wave == 4) {
        float L[32];
#pragma unroll
        for (int q = 0; q < 32; ++q) L[q] = ((xs[q * 32 + e] + xs[(32 + q) * 32 + e]) + (xs[(64 + q) * 32 + e] + xs[(96 + q) * 32 + e])) + c.p.in[I_BR][q];
        float tv[4]; int ti[4];
#pragma unroll
        for (int k = 0; k < 4; ++k) {
          float bv = L[0]; int bi = 0;
#pragma unroll
          for (int q = 1; q < 32; ++q) { const bool g = L[q] > bv; bv = g ? L[q] : bv; bi = g ? q : bi; }
          tv[k] = bv; ti[k] = bi;
#pragma unroll
          for (int q = 0; q < 32; ++q) L[q] = (q == bi) ? -INFINITY : L[q];
        }
        const float e1 = __expf(tv[1] - tv[0]), e2 = __expf(tv[2] - tv[0]), e3 = __expf(tv[3] - tv[0]), inv = 1.f / (1.f + e1 + e2 + e3);
        if (hf == 0) {
          const float gk[4] = {inv, e1 * inv, e2 * inv, e3 * inv};
#pragma unroll
          for (int k = 0; k < 4; ++k) { const int si = (sg * 32 + e) * 4 + k; sel_e[si] = ti[k]; sel_g[si] = gk[k]; sel_pos[si] = (int)__hip_atomic_fetch_add((LAS unsigned*)(wcnt + ti[k]), 1u, __ATOMIC_RELAXED, __HIP_MEMORY_SCOPE_WORKGROUP); }
        }
      }
      __syncthreads();
    }
    if (c.tid < 32) { const int tot = wcnt[c.tid]; bbase[c.tid] = (tot && !(c.p.flags & 16)) ? atomicAdd(gcount + c.tid, tot) : 0; }
    __syncthreads();
    if (!(c.p.flags & 16)) {
      const int ek = sel_e[c.tid];
      u32x2 info; info.x = (unsigned)(tokg * 4 + c.tid); info.y = __float_as_uint(sel_g[c.tid]);
      rinfo[(size_t)ek * ECAP + bbase[ek] + sel_pos[c.tid]] = info;
      ((float*)(ws + WS_RSC))[(size_t)ek * ECAP + bbase[ek] + sel_pos[c.tid]] = tsl[c.tid >> 2];
    }
    __syncthreads();
  }
}
#else
DI void phase_router(const Ctx& c) {
  unsigned char* ws = c.p.ws;
  const float* h = (const float*)(ws + WS_H); float* x1 = (float*)(ws + WS_X1); bf16_t* x1b = (bf16_t*)(ws + WS_X1B);
  const float* wT = (const float*)(ws + WS_WRT); int* gcount = (int*)(ws + WS_MISC + MiB); u32x2* rinfo = (u32x2*)(ws + WS_RINFO);
  LAS int* wcnt = (LAS int*)(c.lds);
  LAS int* bbase = wcnt + 256;
  LAS float* tsl = (LAS float*)(c.lds + 16384);
  LAS int* sel_e = bbase + 32; LAS int* sel_pos = sel_e + 512; LAS float* sel_g = (LAS float*)(sel_e + 1024);
  const int e = c.lane & 31, hf = c.lane >> 5;
  f32x4 gam[4], bet[4];
#pragma unroll
  for (int j = 0; j < 4; ++j) { gam[j] = ((const f32x4*)c.p.in[I_LN1G])[64 * j + c.lane]; bet[j] = ((const f32x4*)c.p.in[I_LN1B])[64 * j + c.lane]; }
  float brl[32];
#pragma unroll
  for (int q = 0; q < 32; ++q) brl[q] = c.p.in[I_BR][q];
  for (int gi = c.bid; gi < TT / 128; gi += c.G) {
    const int tokg = gi * 128;
    if (c.tid < 32) wcnt[c.tid] = 0;
    {
      const f32x4* hr0 = (const f32x4*)(h + ((size_t)tokg + c.wave * 16) * DM) + c.lane; f32x4 vn[4];
#pragma unroll
      for (int j = 0; j < 4; ++j) vn[j] = hr0[64 * j];
      for (int tt = 0; tt < 16; ++tt) {
        const size_t t = (size_t)tokg + c.wave * 16 + tt; f32x4 v[4]; float s = 0.f;
#pragma unroll
        for (int j = 0; j < 4; ++j) { v[j] = vn[j]; s += (v[j].x + v[j].y) + (v[j].z + v[j].w); }
        { const f32x4* hrn = (const f32x4*)(h + (t + (tt < 15 ? 1 : 0)) * DM) + c.lane;
#pragma unroll
          for (int j = 0; j < 4; ++j) vn[j] = hrn[64 * j]; }
        const float mean = wave_sum(s) * (1.f / DM); float s2 = 0.f;
#pragma unroll
        for (int j = 0; j < 4; ++j) { v[j] = v[j] - mean; s2 += (v[j].x * v[j].x + v[j].y * v[j].y) + (v[j].z * v[j].z + v[j].w * v[j].w); }
        const float rstd = rsqrtf(wave_sum(s2) * (1.f / DM) + LN_EPS);
#if MOE_I8
        f32x4 y[4]; float am = 0.f;
#pragma unroll
        for (int j = 0; j < 4; ++j) { y[j] = v[j] * rstd * gam[j] + bet[j]; ((f32x4*)(x1 + t * DM))[64 * j + c.lane] = y[j];
          am = fmaxf(fmaxf(am, fmaxf(fabsf(y[j].x), fabsf(y[j].y))), fmaxf(fabsf(y[j].z), fabsf(y[j].w))); }
        am = wave_max(am); const float qs = am > 0.f ? 127.f / am : 0.f;
        if (c.lane == 0) tsl[c.wave * 16 + tt] = am * (1.f / 127.f);
#pragma unroll
        for (int j = 0; j < 4; ++j) { const unsigned w = ((unsigned)(int)rintf(y[j].x * qs) & 0xffu) | (((unsigned)(int)rintf(y[j].y * qs) & 0xffu) << 8) | (((unsigned)(int)rintf(y[j].z * qs) & 0xffu) << 16) | (((unsigned)(int)rintf(y[j].w * qs) & 0xffu) << 24);
          ((unsigned*)(ws + WS_X1Q + t * DM))[64 * j + c.lane] = w; }
#else
#pragma unroll
        for (int j = 0; j < 4; ++j) { const f32x4 y = v[j] * rstd * gam[j] + bet[j];
          ((f32x4*)(x1 + t * DM))[64 * j + c.lane] = y; u32x2 o; o.x = pk_bf16(y.x, y.y); o.y = pk_bf16(y.z, y.w); ((u32x2*)(x1b + t * DM))[64 * j + c.lane] = o; }
#endif
      }
    }
    asm volatile("s_waitcnt vmcnt(0)" ::: "memory");
    __syncthreads();
    if (c.wave < 4) {
      const float* ap = wT + (size_t)e * DM + 512 * hf; const float* bp = x1 + ((size_t)tokg + c.wave * 32 + e) * DM + 512 * hf;
      f32x16 acc;
#pragma unroll
      for (int i = 0; i < 16; ++i) acc[i] = 0.f;
      f32x4 a4 = *(const f32x4*)ap, b4 = *(const f32x4*)bp, a4n = *(const f32x4*)(ap + 4), b4n = *(const f32x4*)(bp + 4);
      for (int q = 0; q < 128; ++q) {
        const int qn = q + 2 < 128 ? q + 2 : 127;
        const f32x4 a4nn = *(const f32x4*)(ap + 4 * qn), b4nn = *(const f32x4*)(bp + 4 * qn);
#pragma unroll
        for (int j = 0; j < 4; ++j) acc = __builtin_amdgcn_mfma_f32_32x32x2f32(a4[j], b4[j], acc, 0, 0, 0);
        a4 = a4n; b4 = b4n; a4n = a4nn; b4n = b4nn;
      }
      float L[32];
#pragma unroll
      for (int rg = 0; rg < 16; ++rg) { const float own = acc[rg], oth = __shfl_xor(own, 32); L[crow(rg, 0)] = (hf ? oth : own) + brl[crow(rg, 0)]; L[crow(rg, 1)] = (hf ? own : oth) + brl[crow(rg, 1)]; }
      float tv[4]; int ti[4];
#pragma unroll
      for (int k = 0; k < 4; ++k) {
        float bv = L[0]; int bi = 0;
#pragma unroll
        for (int q = 1; q < 32; ++q) { const bool g = L[q] > bv; bv = g ? L[q] : bv; bi = g ? q : bi; }
        tv[k] = bv; ti[k] = bi;
#pragma unroll
        for (int q = 0; q < 32; ++q) L[q] = (q == bi) ? -INFINITY : L[q];
      }
      const float e1 = __expf(tv[1] - tv[0]), e2 = __expf(tv[2] - tv[0]), e3 = __expf(tv[3] - tv[0]), inv = 1.f / (1.f + e1 + e2 + e3);
      if (hf == 0) {
        const float gk[4] = {inv, e1 * inv, e2 * inv, e3 * inv};
#pragma unroll
        for (int k = 0; k < 4; ++k) { const int si = (c.wave * 32 + e) * 4 + k; sel_e[si] = ti[k]; sel_g[si] = gk[k]; sel_pos[si] = (int)__hip_atomic_fetch_add((LAS unsigned*)(wcnt + ti[k]), 1u, __ATOMIC_RELAXED, __HIP_MEMORY_SCOPE_WORKGROUP); }
      }
    }
    __syncthreads();
    if (c.tid < 32) { const int tot = wcnt[c.tid]; bbase[c.tid] = (tot && !(c.p.flags & 16)) ? atomicAdd(gcount + c.tid, tot) : 0; }
    __syncthreads();
    if (!(c.p.flags & 16)) {
      const int ek = sel_e[c.tid];
      u32x2 info; info.x = (unsigned)(tokg * 4 + c.tid); info.y = __float_as_uint(sel_g[c.tid]);
      rinfo[(size_t)ek * ECAP + bbase[ek] + sel_pos[c.tid]] = info;
#if MOE_I8
      ((float*)(ws + WS_RSC))[(size_t)ek * ECAP + bbase[ek] + sel_pos[c.tid]] = tsl[c.tid >> 2];
#endif
    }
    __syncthreads();
  }
}

#endif

DI void build_group_tab(const Ctx& c, LAS int* tab) {
  const int* gcount = (const int*)(c.p.ws + WS_MISC + MiB);
  __syncthreads();
  if (c.tid == 0) { int ps = 0;
    for (int e = 0; e < 32; ++e) { const int cnt = gcount[e]; tab[e] = cnt; tab[32 + e] = ps; const int nt_ = (cnt + 255) >> 8; for (int q = 0; q < nt_; ++q) tab[96 + (ps >> 8) + q] = e; ps += nt_ << 8; }
    tab[64] = ps; tab[65] = ps >> 8; }
  __syncthreads();
}

DI void phase_final(const Ctx& c) {
  const float* x1 = (const float*)(c.p.ws + WS_X1); const bf16_t* yp = (const bf16_t*)(c.p.ws + WS_YPAIR);
  f32x4 gam[4], bet[4];
#pragma unroll
  for (int j = 0; j < 4; ++j) { gam[j] = ((const f32x4*)c.p.in[I_LN2G])[64 * j + c.lane]; bet[j] = ((const f32x4*)c.p.in[I_LN2B])[64 * j + c.lane]; }
  for (int t = c.gw; t < TT; t += c.ngw) {
    f32x4 v[4]; float s = 0.f;
#pragma unroll
    for (int j = 0; j < 4; ++j) {
#if ROUTER_LDS
      { const u32x2 xw = ((const u32x2*)((const bf16_t*)x1 + (size_t)t * DM))[64 * j + c.lane]; v[j] = (f32x4){bflo(xw.x), bfhi(xw.x), bflo(xw.y), bfhi(xw.y)} * DN_ALPHA; }
#else
      v[j] = ((const f32x4*)(x1 + (size_t)t * DM))[64 * j + c.lane] * DN_ALPHA;
#endif
#pragma unroll
      for (int k = 0; k < 4; ++k) { const u32x2 w = ((const u32x2*)(yp + ((size_t)t * 4 + k) * DM))[64 * j + c.lane]; v[j].x += bflo(w.x); v[j].y += bfhi(w.x); v[j].z += bflo(w.y); v[j].w += bfhi(w.y); }
      s += (v[j].x + v[j].y) + (v[j].z + v[j].w); }
    const float mean = wave_sum(s) * (1.f / DM); float s2 = 0.f;
#pragma unroll
    for (int j = 0; j < 4; ++j) { v[j] = v[j] - mean; s2 += (v[j].x * v[j].x + v[j].y * v[j].y) + (v[j].z * v[j].z + v[j].w * v[j].w); }
    const float rstd = rsqrtf(wave_sum(s2) * (1.f / DM) + LN_EPS);
#pragma unroll
    for (int j = 0; j < 4; ++j) ((f32x4*)(c.p.out + (size_t)t * DM))[64 * j + c.lane] = v[j] * rstd * gam[j] + bet[j];
  }
}
DI bf16x8 pack8(const f32x16& x, int s) {
  u32x4 p; p.x = pk_bf16(x[8 * s + 0], x[8 * s + 1]); p.y = pk_bf16(x[8 * s + 2], x[8 * s + 3]); p.z = pk_bf16(x[8 * s + 4], x[8 * s + 5]); p.w = pk_bf16(x[8 * s + 6], x[8 * s + 7]);
  return __builtin_bit_cast(bf16x8, p);
}
DI void store8(bf16_t* dst, const f32x16& x, int s, float sc) {
  u32x4 p; p.x = pk_bf16(x[8 * s + 0] * sc, x[8 * s + 1] * sc); p.y = pk_bf16(x[8 * s + 2] * sc, x[8 * s + 3] * sc); p.z = pk_bf16(x[8 * s + 4] * sc, x[8 * s + 5] * sc); p.w = pk_bf16(x[8 * s + 6] * sc, x[8 * s + 7] * sc);
  *(u32x4*)dst = p;
}

#if !NAIVE_GDN
DI void phase_gdn_chunk(const Ctx& c) {
  unsigned char* ws = c.p.ws;
  const bf16_t* proj = (const bf16_t*)(ws + WS_PROJ); const float* gbeta = (const float*)(ws + WS_MISC); const float* wcv = c.p.in[I_WCONV];
  float* egl = (float*)(ws + WS_MISC + MiB + 4096);
  const int team = c.wave >> 2, tw = c.wave & 3, ttid = c.tid & 255, r = c.lane & 31, hf = c.lane >> 5;
  LAS unsigned char* tl = c.lds + team * 71680;
  LAS bf16_t* ks = (LAS bf16_t*)tl; LAS bf16_t* qs = (LAS bf16_t*)(tl + 17408); LAS bf16_t* kT = (LAS bf16_t*)(tl + 34816); LAS bf16_t* vT = (LAS bf16_t*)(tl + 53248);
  LAS float* Am = (LAS float*)(tl + 17408); LAS bf16_t* T1 = (LAS bf16_t*)tl; LAS bf16_t* T2 = (LAS bf16_t*)(tl + 9216);
  LAS float* sc = (LAS float*)(c.lds + 143360 + team * 1024);
  float wc[3][2][4];
  const int nchunk = NB * 4 * 32, niter = (nchunk + 2 * c.G - 1) / (2 * c.G);
  for (int itr = 0; itr < niter; ++itr) {
    const int ci_raw = (itr * c.G + c.bid) * 2 + team; const int ci = ci_raw < nchunk ? ci_raw : 0;
    const int n = ci & 31, hh = (ci >> 5) & 3, b = ci >> 7; const int tok0 = b * SEQ + n * 64;
    unsigned char* cb = ws + WS_GDN + (size_t)ci * GDN_CHUNK_BYTES;
#pragma unroll
    for (int part = 0; part < 3; ++part)
#pragma unroll
      for (int e = 0; e < 2; ++e)
#pragma unroll
        for (int j = 0; j < 4; ++j) wc[part][e][j] = wcv[j * 1536 + part * 512 + hh * 128 + 2 * c.lane + e];
    const float gl = gbeta[(size_t)(tok0 + c.lane) * 8 + hh], bt = gbeta[(size_t)(tok0 + c.lane) * 8 + 4 + hh];
    float gc = gl;
#pragma unroll
    for (int off = 1; off < 64; off <<= 1) { const float o2 = __shfl_up(gc, off); if (c.lane >= off) gc += o2; }
    const float glast = __shfl(gc, 63);
    if (tw == 0) { sc[c.lane] = gc; sc[64 + c.lane] = bt; sc[128 + c.lane] = __expf(glast - gc); if (c.lane == 0) egl[ci] = __expf(glast); }
    unsigned pvn[3][7];
#pragma unroll
    for (int part = 0; part < 3; ++part)
#pragma unroll
      for (int rr = 0; rr < 7; ++rr) { const int tl2 = n * 64 + tw * 16 - 3 + rr; pvn[part][rr] = tl2 >= 0 ? *(const unsigned*)(proj + (size_t)(tok0 + tw * 16 - 3 + rr) * NPROJ + part * 512 + hh * 128 + 2 * c.lane) : 0u; }
    for (int i4 = 0; i4 < 16; i4 += 4) {
    unsigned pv[3][7];
#pragma unroll
    for (int part = 0; part < 3; ++part)
#pragma unroll
      for (int rr = 0; rr < 7; ++rr) pv[part][rr] = pvn[part][rr];
    if (i4 < 12) {
#pragma unroll
      for (int part = 0; part < 3; ++part)
#pragma unroll
        for (int rr = 0; rr < 7; ++rr) pvn[part][rr] = *(const unsigned*)(proj + (size_t)(tok0 + tw * 16 + i4 + 4 - 3 + rr) * NPROJ + part * 512 + hh * 128 + 2 * c.lane);
    }
    unsigned kprev = 0u, vprev = 0u;
#pragma unroll
    for (int ii = 0; ii < 4; ++ii) {
      const int cc = tw * 16 + i4 + ii; float val[3][2];
#pragma unroll
      for (int part = 0; part < 3; ++part) { float a0 = 0.f, a1 = 0.f;
#pragma unroll
        for (int j = 0; j < 4; ++j) { a0 += wc[part][0][j] * bflo(pv[part][ii + j]); a1 += wc[part][1][j] * bfhi(pv[part][ii + j]); }
        val[part][0] = a0 * sigmoidf_(a0); val[part][1] = a1 * sigmoidf_(a1); }
      const float sq = wave_sum(val[0][0] * val[0][0] + val[0][1] * val[0][1]), sk = wave_sum(val[1][0] * val[1][0] + val[1][1] * val[1][1]);
      const float rq = rsqrtf(sq + NORM_EPS) * 0.08838834764831845f, rk = rsqrtf(sk + NORM_EPS);
      const float q0 = val[0][0] * rq, q1 = val[0][1] * rq, k0 = val[1][0] * rk, k1 = val[1][1] * rk;
      const unsigned kp = pk_bf16(k0, k1), vp = pk_bf16(val[2][0], val[2][1]);
      *(LAS unsigned*)(qs + cc * 136 + 2 * c.lane) = pk_bf16(q0, q1); *(LAS unsigned*)(ks + cc * 136 + 2 * c.lane) = kp;
      if (ii & 1) {
        *(LAS unsigned*)(kT + (2 * c.lane) * 72 + cc - 1) = (kprev & 0xffffu) | (kp << 16); *(LAS unsigned*)(kT + (2 * c.lane + 1) * 72 + cc - 1) = (kprev >> 16) | (kp & 0xffff0000u);
        *(LAS unsigned*)(vT + (2 * c.lane) * 72 + cc - 1) = (vprev & 0xffffu) | (vp << 16); *(LAS unsigned*)(vT + (2 * c.lane + 1) * 72 + cc - 1) = (vprev >> 16) | (vp & 0xffff0000u);
      }
      kprev = kp; vprev = vp;
      const float eg = __expf(__shfl(gc, cc));
      { const int pos = swap23(2 * c.lane); *(unsigned*)(cb + 16384 + (size_t)cc * 256 + 16 * ((pos >> 3) ^ (cc & 15)) + 2 * (pos & 7)) = pk_bf16(q0 * eg, q1 * eg); }
    }
    }
    __syncthreads();
    if (c.p.flags & 4) continue;
    const int mi = tw >> 1, ni = tw & 1;
    f32x16 akk, aat;
#pragma unroll
    for (int i = 0; i < 16; ++i) { akk[i] = 0.f; aat[i] = 0.f; }
#pragma unroll
    for (int s = 0; s < 8; ++s) { const bf16x8 ka = *(const LAS bf16x8*)(ks + (32 * mi + r) * 136 + 16 * s + 8 * hf);
      akk = MFMA32(ka, *(const LAS bf16x8*)(ks + (32 * ni + r) * 136 + 16 * s + 8 * hf), akk);
      aat = MFMA32(ka, *(const LAS bf16x8*)(qs + (32 * ni + r) * 136 + 16 * s + 8 * hf), aat); }
    {
      const int cout = 32 * ni + r; const float gco = sc[cout];
#pragma unroll
      for (int i = 0; i < 16; ++i) { const int cr = 32 * mi + crow(i, hf); aat[i] = cout >= cr ? aat[i] * __expf(gco - sc[cr]) : 0.f; }
      { unsigned char* rp = cb + 49152 + (size_t)cout * 128; const int sw = (cout >> 1) & 7; store8((bf16_t*)(rp + 16 * ((4 * mi + hf) ^ sw)), aat, 0, 1.f); store8((bf16_t*)(rp + 16 * ((4 * mi + 2 + hf) ^ sw)), aat, 1, 1.f); }
    }
    __syncthreads();
    { const int j = 32 * ni + r; const float gcj = sc[j];
#pragma unroll
      for (int i = 0; i < 16; ++i) { const int cr = 32 * mi + crow(i, hf); Am[cr * 64 + j] = cr > j ? akk[i] * __expf(sc[cr] - gcj) * sc[64 + cr] : 0.f; } }
    __syncthreads();
    if (c.p.flags & 8) continue;
    {
      LAS float* Pt = (LAS float*)tl;
      if (c.lane < 16) {
        const int pb = tw, j = c.lane; float t[16];
#pragma unroll
        for (int i = 0; i < 16; ++i) {
          float a0 = 0.f, a1 = 0.f;
#pragma unroll
          for (int m4 = 0; m4 < i; m4 += 4) { const f32x4 av = *(const LAS f32x4*)(Am + (16 * pb + i) * 64 + 16 * pb + m4);
            a0 += av.x * t[m4]; if (m4 + 1 < i) a1 += av.y * t[m4 + 1]; if (m4 + 2 < i) a0 += av.z * t[m4 + 2]; if (m4 + 3 < i) a1 += av.w * t[m4 + 3]; }
          t[i] = (j == i ? 1.f : 0.f) - (a0 + a1);
        }
        LDS_WAIT();
#pragma unroll
        for (int i = 0; i < 16; ++i) Am[(16 * pb + i) * 64 + 16 * pb + j] = t[i];
      }
      for (int it = ttid; it < 1024; it += 256) { const int dk = it >> 3, s = (it >> 1) & 3, h2 = it & 1;
        const u32x2 lo = *(const LAS u32x2*)(kT + dk * 72 + 16 * s + 4 * h2), hi = *(const LAS u32x2*)(kT + dk * 72 + 16 * s + 8 + 4 * h2);
        const LAS float* e0 = sc + 128 + 16 * s + 4 * h2; const LAS float* e1 = e0 + 8;
        u32x4 o; o.x = pk_bf16(bflo(lo.x) * e0[0], bfhi(lo.x) * e0[1]); o.y = pk_bf16(bflo(lo.y) * e0[2], bfhi(lo.y) * e0[3]);
        o.z = pk_bf16(bflo(hi.x) * e1[0], bfhi(hi.x) * e1[1]); o.w = pk_bf16(bflo(hi.y) * e1[2], bfhi(hi.y) * e1[3]);
        *(u32x4*)(cb + 32768 + (size_t)dk * 128 + 16 * ((2 * s + h2) ^ ((dk >> 1) & 7))) = o; }
      __syncthreads();
      const int ii = ttid >> 4, jj = ttid & 15;
#pragma unroll
      for (int pb = 1; pb < 4; ++pb) {
#pragma unroll
        for (int q = 0; q < pb; ++q) {
          float acc = 0.f;
#pragma unroll
          for (int r2 = q; r2 < pb; ++r2)
#pragma unroll
            for (int m4 = 0; m4 < 16; m4 += 4) { const f32x4 av = *(const LAS f32x4*)(Am + (16 * pb + ii) * 64 + 16 * r2 + m4); const LAS float* tp = Am + (16 * r2 + m4) * 64 + 16 * q + jj;
              acc += av.x * tp[0] + av.y * tp[64] + av.z * tp[128] + av.w * tp[192]; }
          Pt[q * 256 + ii * 16 + jj] = acc;
        }
        __syncthreads();
#pragma unroll
        for (int q = 0; q < pb; ++q) {
          float acc = 0.f;
#pragma unroll
          for (int m4 = 0; m4 < 16; m4 += 4) { const f32x4 tv = *(const LAS f32x4*)(Am + (16 * pb + ii) * 64 + 16 * pb + m4); const LAS float* pp = Pt + q * 256 + m4 * 16 + jj;
            acc += tv.x * pp[0] + tv.y * pp[16] + tv.z * pp[32] + tv.w * pp[48]; }
          Am[(16 * pb + ii) * 64 + 16 * q + jj] = -acc;
        }
        __syncthreads();
      }
      float tv2[16];
#pragma unroll
      for (int k = 0; k < 16; ++k) tv2[k] = Am[(ttid >> 6) * 64 + k * 256 + (ttid & 63)];
      const float bj = sc[64 + (ttid & 63)], bej = bj * __expf(sc[ttid & 63]);
      __syncthreads();
#pragma unroll
      for (int k = 0; k < 16; ++k) { const int row = 4 * k + (ttid >> 6); T1[row * 72 + (ttid & 63)] = f2bf(tv2[k] * bj); T2[row * 72 + (ttid & 63)] = f2bf(tv2[k] * bej); }
    }
    __syncthreads();
#pragma unroll
    for (int q = 0; q < 2; ++q) {
      const int job = tw * 2 + q;
      const int mu = job & 1, nu = job >> 1, mw = job >> 1, nw = job & 1;
      f32x16 au, aw;
#pragma unroll
      for (int i = 0; i < 16; ++i) { au[i] = 0.f; aw[i] = 0.f; }
#pragma unroll
      for (int s = 0; s < 4; ++s) {
        au = MFMA32(*(const LAS bf16x8*)(T1 + (32 * mu + r) * 72 + 16 * s + 8 * hf), *(const LAS bf16x8*)(vT + (32 * nu + r) * 72 + 16 * s + 8 * hf), au);
        aw = MFMA32(*(const LAS bf16x8*)(kT + (32 * mw + r) * 72 + 16 * s + 8 * hf), *(const LAS bf16x8*)(T2 + (32 * nw + r) * 72 + 16 * s + 8 * hf), aw); }
      {
        bf16_t* up = (bf16_t*)(cb + 57344 + (size_t)(32 * nu + r) * 128) + 32 * mu + 8 * hf; store8(up, au, 0, 1.f); store8(up + 16, au, 1, 1.f);
        unsigned char* wp = cb + (size_t)(32 * nw + r) * 256; const int sw = (32 * nw + r) & 15; store8((bf16_t*)(wp + 16 * ((4 * mw + hf) ^ sw)), aw, 0, 1.f); store8((bf16_t*)(wp + 16 * ((4 * mw + 2 + hf) ^ sw)), aw, 1, 1.f); }
    }
    __syncthreads();
  }
}

DI void scan_unit(const Ctx& c, LAS unsigned char* sl) {
  const int bh = c.bid & 63, dv0 = (c.bid >> 6) * 32, b = bh >> 2, hh = bh & 3, r = c.lane & 31, hf = c.lane >> 5;
  const unsigned char* ws = c.p.ws; const float* egl = (const float*)(ws + WS_MISC + MiB + 4096); bf16_t* ycat = (bf16_t*)(c.p.ws + WS_YCAT);
  const unsigned char* cb0 = ws + WS_GDN + (size_t)(bh * 32) * GDN_CHUNK_BYTES;
  f32x16 S[4];
#pragma unroll
  for (int m = 0; m < 4; ++m)
#pragma unroll
    for (int i = 0; i < 16; ++i) S[m][i] = 0.f;
  const int sw16 = r & 15, sw8 = (r >> 1) & 7;
#define SCAN_DMA(buf, chunk) do { const unsigned char* _g = cb0 + (size_t)(chunk) * GDN_CHUNK_BYTES + c.lane * 16; LAS unsigned char* _l = sl + (buf) * 57344; \
    _Pragma("unroll") for (int _i = 0; _i < 56; ++_i) __builtin_amdgcn_global_load_lds((const unsigned*)(_g + _i * 1024), (LAS unsigned*)(_l + _i * 1024), 16, 0, 0); } while (0)
  SCAN_DMA(0, 0);
  u32x4 un[4];
#pragma unroll
  for (int q = 0; q < 4; ++q) un[q] = *(const u32x4*)(cb0 + 57344 + (size_t)(dv0 + r) * 128 + 32 * q + 16 * hf);
  for (int n = 0; n < 32; ++n) {
    asm volatile("s_waitcnt vmcnt(0)" ::: "memory");
    u32x4 uc[4];
#pragma unroll
    for (int q = 0; q < 4; ++q) uc[q] = un[q];
    const int nn = n < 31 ? n + 1 : 31;
    SCAN_DMA((n + 1) & 1, nn);
#pragma unroll
    for (int q = 0; q < 4; ++q) un[q] = *(const u32x4*)(cb0 + (size_t)nn * GDN_CHUNK_BYTES + 57344 + (size_t)(dv0 + r) * 128 + 32 * q + 16 * hf);
    const float eg = egl[bh * 32 + n];
    const LAS unsigned char* L = sl + (n & 1) * 57344;
    const LAS unsigned char* wL = L + r * 256; const LAS unsigned char* qL = L + 16384 + r * 256; const LAS unsigned char* kL = L + 32768 + r * 128; const LAS unsigned char* aL = L + 49152 + r * 128;
    bf16x8 Sb[8];
#pragma unroll
    for (int s = 0; s < 8; ++s) Sb[s] = pack8(S[s >> 1], s & 1);
    f32x16 vn[2], o[2];
#pragma unroll
    for (int m = 0; m < 2; ++m) {
#pragma unroll
      for (int i = 0; i < 16; ++i) { vn[m][i] = 0.f; o[m][i] = 0.f; }
#pragma unroll
      for (int s = 0; s < 8; ++s) { vn[m] = MFMA32(*(const LAS bf16x8*)(wL + m * 8192 + 16 * ((2 * s + hf) ^ sw16)), Sb[s], vn[m]); o[m] = MFMA32(*(const LAS bf16x8*)(qL + m * 8192 + 16 * ((2 * s + hf) ^ sw16)), Sb[s], o[m]); }
    }
#pragma unroll
    for (int m = 0; m < 2; ++m)
#pragma unroll
      for (int s2 = 0; s2 < 2; ++s2) { const u32x4 uv = uc[2 * m + s2];
#pragma unroll
        for (int q = 0; q < 4; ++q) { vn[m][8 * s2 + 2 * q] = bflo(uv[q]) - vn[m][8 * s2 + 2 * q]; vn[m][8 * s2 + 2 * q + 1] = bfhi(uv[q]) - vn[m][8 * s2 + 2 * q + 1]; } }
    bf16x8 vb[4];
#pragma unroll
    for (int s = 0; s < 4; ++s) vb[s] = pack8(vn[s >> 1], s & 1);
#pragma unroll
    for (int m = 0; m < 2; ++m)
#pragma unroll
      for (int s = 0; s < 4; ++s) o[m] = MFMA32(*(const LAS bf16x8*)(aL + m * 4096 + 16 * ((2 * s + hf) ^ sw8)), vb[s], o[m]);
#pragma unroll
    for (int m = 0; m < 4; ++m) {
#pragma unroll
      for (int i = 0; i < 16; ++i) S[m][i] *= eg;
#pragma unroll
      for (int s = 0; s < 4; ++s) S[m] = MFMA32(*(const LAS bf16x8*)(kL + m * 4096 + 16 * ((2 * s + hf) ^ sw8)), vb[s], S[m]);
    }
    bf16_t* yp = ycat + (size_t)(b * SEQ + n * 64) * 1536 + hh * 128 + dv0 + r;
#pragma unroll
    for (int m = 0; m < 2; ++m)
#pragma unroll
      for (int i = 0; i < 16; ++i) yp[(size_t)(32 * m + crow(i, hf)) * 1536] = f2bf(o[m][i]);
  }
  asm volatile("s_waitcnt vmcnt(0)" ::: "memory");
#undef SCAN_DMA
}
#endif

#if !NAIVE_ATTN
DI void load_v64(u32x4 (&vr)[4], const bf16_t* vsrc, size_t ld, int lane) {
#pragma unroll
  for (int i = 0; i < 4; ++i) { const int q = lane + 64 * i; vr[i] = *(const u32x4*)(vsrc + (size_t)(q >> 3) * ld + (q & 7) * 8); }
}
DI void put_v64(LAS bf16_t* vl, const u32x4 (&vr)[4], int lane) {
#pragma unroll
  for (int i = 0; i < 4; ++i) { const int q = lane + 64 * i; *(LAS u32x4*)(vl + (q >> 3) * 64 + (q & 7) * 8) = vr[i]; }
}
DI bf16x8 gather_vt(const LAS bf16_t* vl, int m, int s, int lane) {
  const int i16 = lane & 15, q = i16 >> 2, pp = i16 & 3, g16 = (lane >> 4) & 1, hf = lane >> 5;
  const LAS bf16_t* a0 = vl + (16 * s + 4 * hf + q) * 64 + 32 * m + 16 * g16 + 4 * pp;
  const s16x4 lo = __builtin_amdgcn_ds_read_tr16_b64_v4i16((LAS s16x4*)a0), hi = __builtin_amdgcn_ds_read_tr16_b64_v4i16((LAS s16x4*)(a0 + 8 * 64));
  return __builtin_shufflevector(lo, hi, 0, 1, 2, 3, 4, 5, 6, 7);
}
constexpr float SB_EXIT = 40.f;
#define SB_TILE(Kc, Vc, KT) do { \
    LDS_WAIT(); \
    put_v64(vl, Vc, c.lane); \
    _Pragma("unroll") for (int i = 0; i < 4; ++i) { const int q = c.lane + 64 * i; *(LAS u32x4*)(kl + (q >> 3) * 72 + (q & 7) * 8) = Kc[i]; } \
    { const int kp = (KT) - 3 > 0 ? (KT) - 3 : 0;          \
      load_v64(Kc, kbase + (size_t)(32 * kp) * NPROJ, NPROJ, c.lane); load_v64(Vc, vbase + (size_t)(32 * kp) * NPROJ, NPROJ, c.lane); } \
    LDS_WAIT(); \
    f32x16 z; \
    _Pragma("unroll") for (int i = 0; i < 16; ++i) z[i] = 0.f; \
    _Pragma("unroll") for (int s = 0; s < 4; ++s) z = MFMA32(*(const LAS bf16x8*)(kl + r * 72 + 16 * s + 8 * hf), Qf[s], z); \
    float sp[16]; \
    _Pragma("unroll") for (int i = 0; i < 16; ++i) { z[i] *= 0.125f; const bool valid = ((KT) < qt) || (crow(i, hf) < r); sp[i] = valid ? softplus_fast(z[i]) : 0.f; } \
    float mine[4], oth[4], both[4]; \
    _Pragma("unroll") for (int g = 0; g < 4; ++g) { mine[g] = (sp[4 * g] + sp[4 * g + 1]) + (sp[4 * g + 2] + sp[4 * g + 3]); oth[g] = __shfl_xor(mine[g], 32); both[g] = mine[g] + oth[g]; } \
    float tail[4]; tail[3] = 0.f; tail[2] = both[3]; tail[1] = both[3] + both[2]; tail[0] = tail[1] + both[1]; \
    _Pragma("unroll") for (int g = 0; g < 4; ++g) { \
      float run = carry + tail[g] + (hf == 0 ? oth[g] : 0.f); \
      _Pragma("unroll") for (int q = 3; q >= 0; --q) { const int i = 4 * g + q; run += sp[i]; const bool valid = ((KT) < qt) || (crow(i, hf) < r); z[i] = valid ? __expf(z[i] - run) : 0.f; } \
    } \
    carry += tail[0] + both[0]; \
    const bf16x8 w0 = pack8(z, 0), w1 = pack8(z, 1); \
    LDS_WAIT(); \
    _Pragma("unroll") for (int m = 0; m < 2; ++m) { O[m] = MFMA32(gather_vt(vl, m, 0, c.lane), w0, O[m]); O[m] = MFMA32(gather_vt(vl, m, 1, c.lane), w1, O[m]); } \
  } while (0)
DI void sb_unit(const Ctx& c, int u, LAS bf16_t* vl) {
  const bf16_t* proj = (const bf16_t*)(c.p.ws + WS_PROJ); bf16_t* ycat = (bf16_t*)(c.p.ws + WS_YCAT);
  const int qt = 63 - (u & 63), hh = (u >> 6) & 7, b = u >> 9, r = c.lane & 31, hf = c.lane >> 5;
  const size_t tok0 = (size_t)b * SEQ + 32 * qt;
  LAS bf16_t* kl = vl + 2048;
  const bf16_t* kbase = proj + (size_t)b * SEQ * NPROJ + C_SK + hh * 64; const bf16_t* vbase = proj + (size_t)b * SEQ * NPROJ + C_SV + hh * 64;
  bf16x8 Qf[4]; u32x4 K0[4], V0[4], K1[4], V1[4], K2[4], V2[4];
  { const int k1 = qt > 0 ? qt - 1 : 0, k2 = qt > 1 ? qt - 2 : 0;
    load_v64(K0, kbase + (size_t)(32 * qt) * NPROJ, NPROJ, c.lane); load_v64(V0, vbase + (size_t)(32 * qt) * NPROJ, NPROJ, c.lane);
#pragma unroll
    for (int s = 0; s < 4; ++s) Qf[s] = *(const bf16x8*)(proj + (tok0 + r) * NPROJ + C_SQ + hh * 64 + 16 * s + 8 * hf);
    load_v64(K1, kbase + (size_t)(32 * k1) * NPROJ, NPROJ, c.lane); load_v64(V1, vbase + (size_t)(32 * k1) * NPROJ, NPROJ, c.lane);
    load_v64(K2, kbase + (size_t)(32 * k2) * NPROJ, NPROJ, c.lane); load_v64(V2, vbase + (size_t)(32 * k2) * NPROJ, NPROJ, c.lane); }
  f32x16 O[2];
#pragma unroll
  for (int m = 0; m < 2; ++m)
#pragma unroll
    for (int i = 0; i < 16; ++i) O[m][i] = 0.f;
  float carry = 0.f;
  for (int kt = qt; kt >= 0; kt -= 3) {
    SB_TILE(K0, V0, kt);
    if (kt - 1 < 0 || __all(carry > SB_EXIT)) break;
    SB_TILE(K1, V1, kt - 1);
    if (kt - 2 < 0 || __all(carry > SB_EXIT)) break;
    SB_TILE(K2, V2, kt - 2);
    if (__all(carry > SB_EXIT)) break;
  }
  bf16_t* yp = ycat + (tok0 + r) * 1536 + 512 + hh * 64;
#pragma unroll
  for (int m = 0; m < 2; ++m)
#pragma unroll
    for (int g = 0; g < 4; ++g) { u32x2 w; w.x = pk_bf16(O[m][4 * g], O[m][4 * g + 1]); w.y = pk_bf16(O[m][4 * g + 2], O[m][4 * g + 3]); *(u32x2*)(yp + 32 * m + 8 * g + 4 * hf) = w; }
}
#undef SB_TILE
DI bf16x8 gather_vt_p(const LAS bf16_t* vlp, int key0, int m, int s, int lane) {
  const int i16 = lane & 15, q = i16 >> 2, pp = i16 & 3, g16 = (lane >> 4) & 1, hf = lane >> 5;
  const LAS bf16_t* a0 = vlp + (key0 + 16 * s + 4 * hf + q) * 136 + 32 * m + 16 * g16 + 4 * pp;
  const s16x4 lo = __builtin_amdgcn_ds_read_tr16_b64_v4i16((LAS s16x4*)a0), hi = __builtin_amdgcn_ds_read_tr16_b64_v4i16((LAS s16x4*)(a0 + 8 * 136));
  return __builtin_shufflevector(lo, hi, 0, 1, 2, 3, 4, 5, 6, 7);
}
DI void mem_block(const Ctx& c) {
  const bf16_t* proj = (const bf16_t*)(c.p.ws + WS_PROJ); const bf16_t* mkv = (const bf16_t*)(c.p.ws + WS_MKV); bf16_t* ycat = (bf16_t*)(c.p.ws + WS_YCAT);
  LAS bf16_t* Kl = (LAS bf16_t*)c.lds; LAS bf16_t* Vl = Kl + 256 * 136;
  const int r = c.lane & 31, hf = c.lane >> 5;
  for (int it = c.bid; it < NB * 4 * 4; it += c.G) {
    const int bh = it >> 2, qq = it & 3, b = bh >> 2, hh = bh & 3;
    __syncthreads();
    { const bf16_t* ksrc = mkv + (size_t)b * MEMLEN * 1024 + hh * 128; const bf16_t* vsrc = ksrc + 512;
      u32x4 kr[8], vr[8];
#pragma unroll
      for (int j = 0; j < 8; ++j) { const int i = c.tid + 512 * j, key = i >> 4, pc = (i & 15) * 8; kr[j] = *(const u32x4*)(ksrc + (size_t)key * 1024 + pc); vr[j] = *(const u32x4*)(vsrc + (size_t)key * 1024 + pc); }
#pragma unroll
      for (int j = 0; j < 8; ++j) { const int i = c.tid + 512 * j, key = i >> 4, pc = (i & 15) * 8; *(LAS u32x4*)(Kl + key * 136 + pc) = kr[j]; *(LAS u32x4*)(Vl + key * 136 + pc) = vr[j]; } }
    __syncthreads();
    if (c.p.flags & 256) continue;
    for (int uq = 0; uq < 2; ++uq) {
      const int qt = qq * 16 + c.wave * 2 + uq; const size_t tok0 = (size_t)b * SEQ + 32 * qt;
      bf16x8 Qf[8];
#pragma unroll
      for (int s = 0; s < 8; ++s) Qf[s] = *(const bf16x8*)(proj + (tok0 + r) * NPROJ + C_MQ + hh * 128 + 16 * s + 8 * hf);
      f32x16 z[8];
#pragma unroll
      for (int kt = 0; kt < 8; ++kt) {
#pragma unroll
        for (int i = 0; i < 16; ++i) z[kt][i] = 0.f;
      }
#pragma unroll
      for (int s = 0; s < 8; ++s) {
#pragma unroll
        for (int kt = 0; kt < 8; ++kt) z[kt] = MFMA32(*(const LAS bf16x8*)(Kl + (32 * kt + r) * 136 + 16 * s + 8 * hf), Qf[s], z[kt]);
        asm volatile("" ::: "memory");
      }
      float tm = -INFINITY;
#pragma unroll
      for (int kt = 0; kt < 8; ++kt)
#pragma unroll
        for (int i = 0; i < 16; ++i) tm = fmaxf(tm, z[kt][i]);
      tm = fmaxf(tm, __shfl_xor(tm, 32)) * 0.08838834764831845f;
      float ps = 0.f;
      f32x16 O[4];
#pragma unroll
      for (int m = 0; m < 4; ++m)
#pragma unroll
        for (int i = 0; i < 16; ++i) O[m][i] = 0.f;
#pragma unroll
      for (int kt = 0; kt < 8; ++kt) {
#pragma unroll
        for (int i = 0; i < 16; ++i) { z[kt][i] = __expf(z[kt][i] * 0.08838834764831845f - tm); ps += z[kt][i]; }
        const bf16x8 w0 = pack8(z[kt], 0), w1 = pack8(z[kt], 1);
#pragma unroll
        for (int m = 0; m < 4; ++m) { O[m] = MFMA32(gather_vt_p(Vl, 32 * kt, m, 0, c.lane), w0, O[m]); O[m] = MFMA32(gather_vt_p(Vl, 32 * kt, m, 1, c.lane), w1, O[m]); }
        asm volatile("" ::: "memory");
      }
      ps += __shfl_xor(ps, 32);
      const float il = 1.f / ps;
      bf16_t* yp = ycat + (tok0 + r) * 1536 + 1024 + hh * 128;
#pragma unroll
      for (int m = 0; m < 4; ++m)
#pragma unroll
        for (int g = 0; g < 4; ++g) { u32x2 w; w.x = pk_bf16(O[m][4 * g] * il, O[m][4 * g + 1] * il); w.y = pk_bf16(O[m][4 * g + 2] * il, O[m][4 * g + 3] * il); *(u32x2*)(yp + 32 * m + 8 * g + 4 * hf) = w; }
    }
  }
  __syncthreads();
}
DI void phase_attn_scan(const Ctx& c) {
  __syncthreads();
#if !NAIVE_GDN
  if (c.wave == 0) { if (!(c.p.flags & 1)) scan_unit(c, c.lds); }
#if MOE_I8 && W8_BESIDE_SCAN
  else if (!(c.p.flags & 1)) {
    phase0b_light(c, c.lds + 114688 + (c.wave - 1) * 4608, c.bid * 7 + c.wave - 1, c.G * 7);
    wdn_light(c, (LAS bf16_t*)(c.lds + 114688 + (c.wave - 1) * 4608), c.bid * 7 + c.wave - 1, c.G * 7); }
#endif
  __syncthreads();
#endif
  if (c.p.flags & 2) return;
  if (!(c.p.flags & 64)) mem_block(c);
  LAS bf16_t* vl = (LAS bf16_t*)(c.lds + c.wave * 8704);
  if (!(c.p.flags & 128)) for (int u = c.gw; u < NB * 8 * 64; u += c.ngw) sb_unit(c, u, vl);
}
#endif
#if NAIVE_P5
DI void naive_mixed(const Ctx& c) {
  const bf16_t* ycat = (const bf16_t*)(c.p.ws + WS_YCAT); const bf16_t* wp = (const bf16_t*)(c.p.ws + WS_WP); const bf16_t* proj = (const bf16_t*)(c.p.ws + WS_PROJ); bf16_t* mixed = (bf16_t*)(c.p.ws + WS_MIXED);
  const int r = c.lane & 31, h = c.lane >> 5;
  for (int tile = c.gw; tile < (TT / 32) * 32; tile += c.ngw) {
    const int tm = tile >> 5, tn = tile & 31; float res[16];
#pragma unroll
    for (int i = 0; i < 16; ++i) res[i] = 0.f;
    for (int b = 0; b < 3; ++b) {
      const bf16_t* ap = ycat + (size_t)(tm * 32 + r) * 1536 + b * 512 + 8 * h; const bf16_t* bp = wp + (size_t)(tn * 32 + r) * 1536 + b * 512 + 8 * h;
      f32x16 acc; for (int i = 0; i < 16; ++i) acc[i] = 0.f;
      for (int k0 = 0; k0 < 512; k0 += 16) acc = MFMA32(*(const bf16x8*)(ap + k0), *(const bf16x8*)(bp + k0), acc);
#pragma unroll
      for (int i = 0; i < 16; ++i) res[i] += acc[i] * sigmoidf_(bf2f(proj[(size_t)(tm * 32 + crow(i, h)) * NPROJ + C_GATE + b * 1024 + tn * 32 + r]));
    }
#pragma unroll
    for (int i = 0; i < 16; ++i) mixed[(size_t)(tm * 32 + crow(i, h)) * DM + tn * 32 + r] = f2bf(res[i]);
  }
}
#endif
#if NAIVE_MOE
DI void naive_gateup(const Ctx& c, const LAS int* tab) {
  const bf16_t* x1b = (const bf16_t*)(c.p.ws + WS_X1B); const bf16_t* wgu = (const bf16_t*)(c.p.ws + WS_WGU); bf16_t* act = (bf16_t*)(c.p.ws + WS_ACT); const u32x2* rinfo = (const u32x2*)(c.p.ws + WS_RINFO);
  const float* bgu = c.p.in[I_BGU];
  const int r = c.lane & 31, h = c.lane >> 5, ntile = (tab[64] >> 5) * 32;
  for (int tile = c.gw; tile < ntile; tile += c.ngw) {
    const int tm = tile >> 5, tj = tile & 31, e = tab[96 + (tm >> 3)], local = tm * 32 + r - tab[32 + e];
    const int tok = local < tab[e] ? (int)(rinfo[(size_t)e * ECAP + local].x >> 2) : 0;
    const int j0 = tj * 32, wrow = (j0 >> 7) * 256 + (j0 & 127);
    const bf16_t* ap = x1b + (size_t)tok * DM + 8 * h; const bf16_t* bg = wgu + ((size_t)e * 2048 + wrow + r) * DM + 8 * h; const bf16_t* bl = bg + (size_t)128 * DM;
    f32x16 ag, al; for (int i = 0; i < 16; ++i) { ag[i] = 0.f; al[i] = 0.f; }
    for (int k0 = 0; k0 < DM; k0 += 16) { const bf16x8 a = *(const bf16x8*)(ap + k0); ag = MFMA32(a, *(const bf16x8*)(bg + k0), ag); al = MFMA32(a, *(const bf16x8*)(bl + k0), al); }
    const float bgv = bgu[(size_t)e * 2048 + j0 + r], blv = bgu[(size_t)e * 2048 + 1024 + j0 + r];
#pragma unroll
    for (int i = 0; i < 16; ++i) { const float glu = fminf(ag[i] + bgv, SWIGLU_LIMIT), lin = fminf(fmaxf(al[i] + blv, -SWIGLU_LIMIT), SWIGLU_LIMIT);
      act[(size_t)(tm * 32 + crow(i, h)) * DFF + j0 + r] = f2bf(glu * sigmoidf_(SWIGLU_ALPHA * glu) * (lin + 1.f)); }
  }
}
DI void naive_down(const Ctx& c, const LAS int* tab) {
  const bf16_t* act = (const bf16_t*)(c.p.ws + WS_ACT); const bf16_t* wdn = (const bf16_t*)(c.p.ws + WS_WDN); bf16_t* yp = (bf16_t*)(c.p.ws + WS_YPAIR); const u32x2* rinfo = (const u32x2*)(c.p.ws + WS_RINFO);
  const float* bdn = c.p.in[I_BDN];
  const int r = c.lane & 31, h = c.lane >> 5, ntile = (tab[64] >> 5) * 32;
  for (int tile = c.gw; tile < ntile; tile += c.ngw) {
    const int tm = tile >> 5, tn = tile & 31, e = tab[96 + (tm >> 3)];
    const bf16_t* ap = act + (size_t)(tm * 32 + r) * DFF + 8 * h; const bf16_t* bp = wdn + ((size_t)e * DM + tn * 32 + r) * DFF + 8 * h;
    f32x16 acc; for (int i = 0; i < 16; ++i) acc[i] = 0.f;
    for (int k0 = 0; k0 < DFF; k0 += 16) acc = MFMA32(*(const bf16x8*)(ap + k0), *(const bf16x8*)(bp + k0), acc);
    const float bv = bdn[(size_t)e * DM + tn * 32 + r];
#pragma unroll
    for (int i = 0; i < 16; ++i) { const int local = tm * 32 + crow(i, h) - tab[32 + e];
      if (local < tab[e]) { const u32x2 info = rinfo[(size_t)e * ECAP + local]; yp[(size_t)info.x * DM + tn * 32 + r] = f2bf((acc[i] + bv) * __uint_as_float(info.y)); } }
  }
}
#endif

DI void stagger(const Ctx& c, int ng, int step) {
  const int g = (c.bid >> 3) % ng;
  if (g && c.tid == 0) { const unsigned long long t0 = __builtin_amdgcn_s_memrealtime(), dt = (unsigned long long)(g * step); while (__builtin_amdgcn_s_memrealtime() - t0 < dt) __builtin_amdgcn_s_sleep(32); }
  __syncthreads();
}
__global__ void __launch_bounds__(512, 2) mega(Params p) {
  extern __shared__ __attribute__((aligned(16))) unsigned char lds_raw[];
  cg::grid_group grid = cg::this_grid();
  Ctx c; c.lds = (LAS unsigned char*)lds_raw; c.tid = threadIdx.x; c.lane = c.tid & 63; c.wave = __builtin_amdgcn_readfirstlane(c.tid >> 6);
  c.G = gridDim.x; c.bid = blockIdx.x; c.gw = c.bid * 8 + c.wave; c.ngw = c.G * 8; c.p = p;
  unsigned char* ws = p.ws;
  LAS int* gtab = (LAS int*)(c.lds + 131072);
#define IN(k) (p.ph_lo <= (k) && (k) < p.ph_hi)
  { volatile LAS unsigned* st = (volatile LAS unsigned*)(c.lds + 147440); if (c.tid < 4) st[c.tid] = 0u; }
  __syncthreads();
  const XcdBarrier xbar = xcd_barrier_post((unsigned*)(ws + WS_BAR) + p.pad * XCD_BAR_WORDS, (volatile LAS unsigned*)(c.lds + 147440));
#define SEAM(k) do { if ((k) + 1 < p.ph_hi) { if (USE_CG_ALL || (k) == 0) grid.sync(); else xcd_barrier(xbar); } } while (0)
#define REP(k)

  if (IN(0)) { REP(0) phase0(c); SEAM(0); }
  if (IN(1)) {
    REP(1) {
#if NAIVE_P1
    { bf16_t* proj = (bf16_t*)(ws + WS_PROJ); naive_gemm(c, (const bf16_t*)(ws + WS_XB), DM, (const bf16_t*)(ws + WS_WIN), DM, TT, NPROJ_N, DM, [&](int r, int cc, float v) { proj[(size_t)r * NPROJ + cc] = f2bf(v); }); }
    { bf16_t* mkv = (bf16_t*)(ws + WS_MKV); naive_gemm(c, (const bf16_t*)(ws + WS_MEMB), DM, (const bf16_t*)(ws + WS_WMKV), DM, NB * MEMLEN, DM, DM, [&](int r, int cc, float v) { mkv[(size_t)r * DM + cc] = f2bf(v); }); }
#else
#if MOE_I8 && !W8_BESIDE_SCAN
    phase0b(c); __syncthreads();
#endif
#if GATE_I8
    { pg8::Gemm g{(const bf16_t*)(ws + WS_XB), (const bf16_t*)(ws + WS_WIN), DM}; pg8::StaticOrder S; S.init(TT, C_GATE, c.G, c.bid); pg8::EpiStoreBf16 E{(bf16_t*)(ws + WS_PROJ), NPROJ, p.flags & 32, 1 << 30};
      pg8::gemm_phase<pg8::EpiStoreBf16, pg8::StaticOrder, true>(c.lds, g, S, E); }
    { pg8::Gemm g{(const bf16_t*)(ws + WS_XQ), (const bf16_t*)(ws + WS_WG8), DM}; pg8::StaticOrder S; S.init(TT, 3 * DM, c.G, c.bid);
      pg8::EpiGate8 E{(unsigned char*)(ws + WS_PROJ), NPROJ * 2, C_GATE * 2, (const float*)(ws + WS_TSC), (const float*)(ws + WS_WGS)};
      pg8::gemm_phase<pg8::EpiGate8, pg8::StaticOrder, true, true>(c.lds, g, S, E); }
#else
    { pg8::Gemm g{(const bf16_t*)(ws + WS_XB), (const bf16_t*)(ws + WS_WIN), DM}; pg8::StaticOrder S; S.init(TT, NPROJ_N, c.G, c.bid); pg8::EpiStoreBf16 E{(bf16_t*)(ws + WS_PROJ), NPROJ, p.flags & 32, C_GATE};
      pg8::gemm_phase<pg8::EpiStoreBf16, pg8::StaticOrder, true>(c.lds, g, S, E); }
#endif
    { pg8::Gemm g{(const bf16_t*)(ws + WS_MEMB), (const bf16_t*)(ws + WS_WMKV), DM}; pg8::StaticOrder S; S.init(NB * MEMLEN, DM, c.G, c.bid); pg8::EpiStoreBf16 E{(bf16_t*)(ws + WS_MKV), DM, 0, 1 << 30};
      pg8::gemm_phase<pg8::EpiStoreBf16, pg8::StaticOrder, true>(c.lds, g, S, E); }
#endif
    }
    SEAM(1);
  }
  if (IN(2)) {
#if NAIVE_GDN
    naive_gdn_prep(c);
#else
    phase_gdn_chunk(c);
#endif
    SEAM(2);
  }
  if (IN(3)) {
#if NAIVE_GDN
    naive_gdn_scan(c);
#endif
#if NAIVE_ATTN
    naive_sb(c); naive_mem(c);
#else
    phase_attn_scan(c);
#endif
    SEAM(3);
  }
  if (IN(4)) { phase_gdn_norm(c); SEAM(4); }
  if (IN(5)) {
#if NAIVE_P5
    naive_mixed(c);
#else
    REP(5) {
    pg8::Gemm g{(const bf16_t*)(ws + WS_YCAT), (const bf16_t*)(ws + WS_WP), 1536}; pg8::StaticOrder S; S.init(TT, DM, c.G, c.bid); pg8::EpiMixed E{(const unsigned char*)(ws + WS_PROJ), (bf16_t*)(ws + WS_MIXED)};
    pg8::gemm_phase<pg8::EpiMixed, pg8::StaticOrder, true>(c.lds, g, S, E);
    }
#endif
    SEAM(5);
  }
  if (IN(6)) {
#if NAIVE_P6
    { const float* x = p.in[I_X]; float* hh = (float*)(ws + WS_H);
      naive_gemm(c, (const bf16_t*)(ws + WS_MIXED), DM, (const bf16_t*)(ws + WS_WO), DM, TT, DM, DM, [&](int r, int cc, float v) { hh[(size_t)r * DM + cc] = DN_ALPHA * x[(size_t)r * DM + cc] + v; }); }
#else
    REP(6) {
    pg8::Gemm g{(const bf16_t*)(ws + WS_MIXED), (const bf16_t*)(ws + WS_WO), DM}; pg8::StaticOrder S; S.init(TT, DM, c.G, c.bid); pg8::EpiH E{p.in[I_X], (float*)(ws + WS_H)};
    pg8::gemm_phase<pg8::EpiH, pg8::StaticOrder, true>(c.lds, g, S, E);
    }
#endif
    SEAM(6);
  }
  if (IN(7)) { phase_router(c); SEAM(7); }
  if (IN(8)) {
    build_group_tab(c, gtab);
#if NAIVE_MOE
    naive_gateup(c, gtab);
#else
    REP(8) {
#if MOE_I8
    pg8::Gemm g{(const bf16_t*)(ws + WS_X1Q), (const bf16_t*)(ws + WS_WGU), DM}; pg8::GroupOrder S{gtab, (const u32x2*)(ws + WS_RINFO), 8, c.G, c.bid, 1};
    pg8::EpiGateUpI8 E{p.in[I_BGU], (const float*)(ws + WS_WSC), (const float*)(ws + WS_RSC), gtab, (bf16_t*)(ws + WS_ACT)};
    pg8::gemm_phase<pg8::EpiGateUpI8, pg8::GroupOrder, ALIGN_MOE, true>(c.lds, g, S, E);
#else
    pg8::Gemm g{(const bf16_t*)(ws + WS_X1B), (const bf16_t*)(ws + WS_WGU), DM}; pg8::GroupOrder S{gtab, (const u32x2*)(ws + WS_RINFO), 8, c.G, c.bid, 1}; pg8::EpiGateUp E{p.in[I_BGU], (bf16_t*)(ws + WS_ACT)};
    pg8::gemm_phase<pg8::EpiGateUp, pg8::GroupOrder, ALIGN_MOE>(c.lds, g, S, E);
#endif
    }
#endif
    SEAM(8);
  }
  if (IN(9)) {
    build_group_tab(c, gtab);
#if NAIVE_MOE
    naive_down(c, gtab);
#else
    REP(9) {
    pg8::Gemm g{(const bf16_t*)(ws + WS_ACT), (const bf16_t*)(ws + WS_WDN), DFF}; pg8::GroupOrder S{gtab, (const u32x2*)(ws + WS_RINFO), 4, c.G, c.bid, 0};
    pg8::EpiDown E{p.in[I_BDN], gtab, (const u32x2*)(ws + WS_RINFO), (bf16_t*)(ws + WS_YPAIR)};
    pg8::gemm_phase<pg8::EpiDown, pg8::GroupOrder, ALIGN_MOE>(c.lds, g, S, E);
    }
#endif
    SEAM(9);
  }
  if (IN(10)) { REP(10) phase_final(c); }
#undef IN
#undef SEAM
}

extern "C" void kernel_launch(void* const* d_in, const int* in_sizes, int n_in, void* d_out, int out_size, void* d_ws, size_t ws_size, hipStream_t stream) {
  static int grid_blocks = 0;
  if (grid_blocks == 0) {
    if (n_in != 22 || in_sizes[0] != TT * DM || out_size != TT * DM || ws_size < WS_NEED) {
      fprintf(stderr, "kernel_launch: built for 22 inputs, x/out of %d floats and >= %zu bytes of workspace; got n_in %d in0 %d out %d ws %zu; nothing launched\n", TT * DM, (size_t)WS_NEED, n_in, n_in > 0 ? in_sizes[0] : -1, out_size, ws_size);
      grid_blocks = -1; return; }
    int dev = 0, cus = 0, per_cu = 0;
    if (hipGetDevice(&dev) != hipSuccess || hipDeviceGetAttribute(&cus, hipDeviceAttributeMultiprocessorCount, dev) != hipSuccess) { grid_blocks = -1; return; }
    if (hipFuncSetAttribute((const void*)mega, hipFuncAttributeMaxDynamicSharedMemorySize, LDS_BYTES) != hipSuccess) { fprintf(stderr, "kernel_launch: hipFuncSetAttribute failed\n"); grid_blocks = -1; return; }
    if (hipOccupancyMaxActiveBlocksPerMultiprocessor(&per_cu, (const void*)mega, 512, LDS_BYTES) != hipSuccess || per_cu < 1) { fprintf(stderr, "kernel_launch: occupancy query says %d\n", per_cu); (void)hipGetLastError(); grid_blocks = -1; return; }
    grid_blocks = cus;
    fprintf(stderr, "kernel_launch: grid %d (cus %d, per_cu %d), ws %zu\n", grid_blocks, cus, per_cu, ws_size);
  }
  if (grid_blocks < 0) return;
  if (hipMemsetAsync((char*)d_ws + WS_BAR, 0, WS_ZERO_BYTES, stream) != hipSuccess) { fprintf(stderr, "kernel_launch: memset of the barrier words failed\n"); return; }
  Params p{};
  for (int i = 0; i < 22; ++i) p.in[i] = (const float*)d_in[i];
  p.out = (float*)d_out; p.ws = (unsigned char*)d_ws;
#if MK_SPLIT
  for (int ph = 0; ph < 11; ++ph) { p.ph_lo = ph; p.ph_hi = ph + 1; void* args[] = {&p};
    hipError_t e = hipLaunchCooperativeKernel((const void*)mega, dim3(grid_blocks), dim3(512), args, LDS_BYTES, stream);
    if (e != hipSuccess) { fprintf(stderr, "kernel_launch: launch of phase %d failed: %s\n", ph, hipGetErrorString(e)); break; } }
#elif REPEAT_PH >= 0
  for (int li = 0; li < 2; ++li) { p.ph_lo = li ? REPEAT_PH + SPLIT_ONLY : 0; p.ph_hi = li ? 11 : REPEAT_PH + 1; p.flags = li ? REPEAT_FLAGS : 0; p.pad = li; void* args[] = {&p};
    hipError_t e = hipLaunchCooperativeKernel((const void*)mega, dim3(grid_blocks), dim3(512), args, LDS_BYTES, stream);
    if (e != hipSuccess) { fprintf(stderr, "kernel_launch: launch %d failed: %s\n", li, hipGetErrorString(e)); break; } }
#else
  p.ph_lo = 0; p.ph_hi = 11; void* args[] = {&p};
  hipError_t e = hipLaunchCooperativeKernel((const void*)mega, dim3(grid_blocks), dim3(512), args, LDS_BYTES, stream);
  if (e != hipSuccess) fprintf(stderr, "kernel_launch: cooperative launch failed: %s (grid %d)\n", hipGetErrorString(e), grid_blocks);
#endif
}
```

```cpp
#define NAIVE_P1 0
#define NAIVE_GDN 0
#define NAIVE_ATTN 0
#define NAIVE_P5 0
#define NAIVE_P6 0
#define NAIVE_MOE 0
#define MK_SPLIT 0
#define REPEAT_PH -1
#define SPLIT_ONLY 0
#define REPEAT_FLAGS 0
#define USE_CG_ALL 0
#define ALIGN_MOE true
#define STAG_N 1
#define STAG_STEP 600
#define NT_STORE 1
#define MOE_I8 1
#define ROUTER_LDS 1
#define ATTN_SKIP_W4 1
#define NPROJ_LD 7168
#define W8_BESIDE_SCAN 1
#define GATE_I8 1
#define NAIVE_ANY (NAIVE_P1 || NAIVE_P6)
#include <hip/hip_runtime.h>
#include <hip/hip_cooperative_groups.h>
#include <cstdio>
#include <cstdint>
namespace cg = cooperative_groups;

#define DI __device__ __forceinline__
#define LAS __attribute__((address_space(3)))
typedef unsigned short bf16_t;
typedef short bf16x8 __attribute__((ext_vector_type(8)));
typedef float f32x2 __attribute__((ext_vector_type(2)));
typedef float f32x4 __attribute__((ext_vector_type(4)));
typedef float f32x16 __attribute__((ext_vector_type(16)));
typedef unsigned u32x2 __attribute__((ext_vector_type(2)));
typedef unsigned u32x4 __attribute__((ext_vector_type(4)));
typedef __bf16 bf16x2_t __attribute__((ext_vector_type(2)));

constexpr int NB = 16, SEQ = 2048, DM = 1024, TT = NB * SEQ;
constexpr int MEMLEN = 256, NEXP = 32, TOPK = 4, DFF = 1024;
constexpr int NPROJ_N = 7168;
constexpr int NPROJ = NPROJ_LD;
constexpr int C_GQ = 0, C_GK = 512, C_GV = 1024, C_GZ = 1536, C_SQ = 2048, C_SK = 2560, C_SV = 3072, C_MQ = 3584, C_GATE = 4096;
constexpr float LN_EPS = 1e-5f, NORM_EPS = 1e-6f;
constexpr float DN_ALPHA = 1.189207115002721f;
constexpr float SWIGLU_LIMIT = 7.0f, SWIGLU_ALPHA = 1.702f;
constexpr int ECAP = 32768;

constexpr size_t MiB = 1u << 20;
constexpr size_t WS_MISC = 0;
constexpr size_t WS_WDN = 3 * MiB, WS_WGU = 67 * MiB, WS_WIN = 195 * MiB, WS_WMKV = 209 * MiB, WS_WP = 211 * MiB, WS_WO = 214 * MiB;
constexpr size_t WS_XB = 216 * MiB, WS_MEMB = 280 * MiB, WS_MKV = 1016 * MiB  , WS_PROJ = 288 * MiB, WS_GDN = 744 * MiB, WS_YCAT = 888 * MiB, WS_RINFO = 1016 * MiB;
constexpr size_t WS_MIXED = WS_XB, WS_H = WS_GDN, WS_X1 = WS_YCAT, WS_X1B = WS_PROJ, WS_ACT = 360 * MiB, WS_YPAIR = 67 * MiB;
constexpr size_t WS_NEED = 1024 * MiB;
constexpr size_t GDN_CHUNK_BYTES = 73728;
constexpr int LDS_BYTES = 147456;

struct Params { const float* in[22]; float* out; unsigned char* ws; int ph_lo, ph_hi, flags, pad; };
enum { I_X = 0, I_MEM, I_WIN, I_WCONV, I_ALOG, I_DTB, I_GNW, I_WMKV, I_WPG, I_WPS, I_WPM, I_WO, I_LN1G, I_LN1B, I_WR, I_BR, I_WGU, I_BGU, I_WDN, I_BDN, I_LN2G, I_LN2B };

DI float bf2f(bf16_t v) { return __uint_as_float((unsigned)v << 16); }
DI unsigned pk_bf16(float a, float b) { f32x2 v = {a, b}; bf16x2_t r = __builtin_convertvector(v, bf16x2_t); return __builtin_bit_cast(unsigned, r); }
DI bf16_t f2bf(float a) { return (bf16_t)(pk_bf16(a, 0.f) & 0xffffu); }
DI float bflo(unsigned w) { return __uint_as_float(w << 16); }
DI float bfhi(unsigned w) { return __uint_as_float(w & 0xffff0000u); }
DI float sigmoidf_(float x) { return __frcp_rn(1.0f + __expf(-x)); }
DI float softplusf_(float x) { return x > 20.f ? x : log1pf(__expf(x)); }
DI float softplus_fast(float x) { return fmaxf(x, 0.f) + __logf(1.f + __expf(-fabsf(x))); }
typedef short s16x4 __attribute__((ext_vector_type(4)));
template <int CTRL, int RM> DI float dpp_mov0(float v) { return __builtin_bit_cast(float, __builtin_amdgcn_update_dpp(0, __builtin_bit_cast(int, v), CTRL, RM, 0xF, false)); }
DI float wave_sum(float v) {
  v += dpp_mov0<0xB1, 0xF>(v);
  v += dpp_mov0<0x4E, 0xF>(v);
  v += dpp_mov0<0x141, 0xF>(v);
  v += dpp_mov0<0x140, 0xF>(v);
  v += dpp_mov0<0x142, 0xA>(v);
  v += dpp_mov0<0x143, 0xC>(v);
  return __builtin_bit_cast(float, __builtin_amdgcn_readlane(__builtin_bit_cast(int, v), 63));
}
DI float wave_max(float v) {
  v = fmaxf(v, dpp_mov0<0xB1, 0xF>(v)); v = fmaxf(v, dpp_mov0<0x4E, 0xF>(v)); v = fmaxf(v, dpp_mov0<0x141, 0xF>(v)); v = fmaxf(v, dpp_mov0<0x140, 0xF>(v));
  v = fmaxf(v, dpp_mov0<0x142, 0xA>(v)); v = fmaxf(v, dpp_mov0<0x143, 0xC>(v));
  return __builtin_bit_cast(float, __builtin_amdgcn_readlane(__builtin_bit_cast(int, v), 63));
}
#define LDS_WAIT() asm volatile("s_waitcnt lgkmcnt(0)" ::: "memory")
#define VM_WAIT() asm volatile("s_waitcnt vmcnt(0)" ::: "memory")
#define MFMA32(a, b, c) __builtin_amdgcn_mfma_f32_32x32x16_bf16((a), (b), (c), 0, 0, 0)
DI int crow(int reg, int h) { return (reg & 3) + 8 * (reg >> 2) + 4 * h; }
DI int swap23(int k) { return (k & ~12) | ((k & 4) << 1) | ((k & 8) >> 1); }

#define XB_TMO      128
#define XB_XCNT(j)  (256  + 64 * (j))
#define XB_XSUB(j)  (1280 + 64 * (j))
#define XB_XGEN(j)  (2304 + 64 * (j))
#define XB_TOP      3328
#define XB_TOPGEN   3392
#define XCD_BAR_WORDS 3456
#define XB_SPIN_CAP (1u << 18)
DI unsigned xb_ld(unsigned* p)              { return __hip_atomic_load(p, __ATOMIC_RELAXED, __HIP_MEMORY_SCOPE_AGENT); }
DI unsigned xb_add(unsigned* p, unsigned v) { return __hip_atomic_fetch_add(p, v, __ATOMIC_RELAXED, __HIP_MEMORY_SCOPE_AGENT); }
DI unsigned xb_xcc_id() { return (unsigned)__builtin_amdgcn_s_getreg((3 << 11) | 20) & 0xFu; }
#define XB_SPIN(cond, bar) do { unsigned _sp = 0; while (cond) { __builtin_amdgcn_s_sleep(1); \
    if ((++_sp & 255u) == 0u) { if (xb_ld(&(bar)[XB_TMO])) break; if (_sp > XB_SPIN_CAP) { atomicAdd(&(bar)[XB_TMO], 1u); break; } } } } while (0)
struct XcdBarrier { unsigned* bar; unsigned x; volatile LAS unsigned* st; };
DI XcdBarrier xcd_barrier_post(unsigned* bar, volatile LAS unsigned* st) {
  XcdBarrier b; b.bar = bar; b.x = xb_xcc_id(); b.st = st;
  if (threadIdx.x == 0) (void)xb_add(&bar[XB_XCNT(b.x)], 1u);
  return b;
}
DI void xcd_barrier_complete(unsigned* bar, unsigned x, unsigned& nloc, unsigned& nx) {
  const unsigned G = gridDim.x * gridDim.y * gridDim.z;
  unsigned sum, cnt, mine, sp = 0u;
  for (;;) {
    sum = 0u; cnt = 0u; mine = 0u;
#pragma unroll
    for (unsigned j = 0; j < 16; ++j) { const unsigned c = xb_ld(&bar[XB_XCNT(j)]); sum += c; cnt += (c > 0u) ? 1u : 0u; mine = (j == x) ? c : mine; }
    if (sum == G) break;
    __builtin_amdgcn_s_sleep(1);
    if ((++sp & 255u) == 0u) { if (xb_ld(&bar[XB_TMO])) break; if (sp > XB_SPIN_CAP) { atomicAdd(&bar[XB_TMO], 1u); break; } }
  }
  nloc = mine > 0u ? mine : 1u; nx = cnt > 0u ? cnt : 1u;
}
DI void xcd_barrier(const XcdBarrier& b) {
  asm volatile("s_waitcnt vmcnt(0)" ::: "memory");
  __syncthreads();
  if (threadIdx.x == 0) {
    unsigned* bar = b.bar;
    __builtin_amdgcn_s_waitcnt(0);
    unsigned nloc = b.st[0], nx = b.st[1];
    if (nloc == 0u) { xcd_barrier_complete(bar, b.x, nloc, nx); b.st[0] = nloc; b.st[1] = nx; }
    const unsigned old = xb_add(&bar[XB_XSUB(b.x)], 1u);
    const unsigned gen = old / nloc;
    if (old + 1u == (gen + 1u) * nloc) {
      __builtin_amdgcn_fence(__ATOMIC_RELEASE, "agent");
      asm volatile("s_waitcnt vmcnt(0)" ::: "memory");
      const unsigned og = xb_add(&bar[XB_TOP], 1u);
      const unsigned tg = og / nx;
      if (og + 1u == (tg + 1u) * nx) xb_add(&bar[XB_TOPGEN], 1u);
      else XB_SPIN(xb_ld(&bar[XB_TOPGEN]) == tg, bar);
      __builtin_amdgcn_fence(__ATOMIC_ACQUIRE, "agent");
      xb_add(&bar[XB_XGEN(b.x)], 1u);
      asm volatile("s_waitcnt vmcnt(0)" ::: "memory");
    } else {
      XB_SPIN(xb_ld(&bar[XB_XGEN(b.x)]) == gen, bar);
      __builtin_amdgcn_fence(__ATOMIC_ACQUIRE, "agent");
      asm volatile("s_waitcnt vmcnt(0)" ::: "memory");
    }
  }
  __syncthreads();
}
constexpr size_t WS_WRT = 2 * MiB + 512 * 1024;
constexpr size_t WS_BAR = 2 * MiB;
constexpr size_t WS_CMAX = 2 * MiB + 64 * 1024;
constexpr size_t WS_ZERO_BYTES = 336 * 1024;
constexpr size_t WS_CMAXG = 2 * MiB + 320 * 1024;
constexpr size_t WS_WSC = 1 * MiB + 64 * 1024;
constexpr size_t WS_TSC = 2 * MiB + 768 * 1024;
constexpr size_t WS_RSC = 872 * MiB;
constexpr size_t WS_XQ = 744 * MiB;
constexpr size_t WS_WG8 = 776 * MiB;
constexpr size_t WS_WGS = 1 * MiB + 512 * 1024;
constexpr size_t WS_X1Q = 296 * MiB;
typedef int i32x4 __attribute__((ext_vector_type(4)));

struct Ctx {
  LAS unsigned char* lds;
  int tid, lane, wave, G, bid, gw, ngw;
  Params p;
};
namespace pg8 {
#if NT_STORE
#define NTST(v, p) __builtin_nontemporal_store((v), (p))
#else
#define NTST(v, p) (*(p) = (v))
#endif
constexpr int BM = 256, BK = 64, HALF = 128, HTB = HALF * BK * 2  , STAGE_BYTES = 8 * HTB, NXCD = 8, WGM = 8;
DI int lds_byte(int r, int c) { const int st = (r >> 4) * 2 + (c >> 5), rr = r & 15, cc = c & 31, ob = rr * 64 + cc * 2; return st * 1024 + (ob ^ (((ob >> 9) & 1) << 5)); }
DI void stage_rc(int b, int& R, int& C) { const int st = b / 1024, sb = b % 1024, swz = sb ^ (((sb >> 9) & 1) << 5); R = (st >> 1) * 16 + swz / 64; C = (st & 1) * 32 + (swz % 64) / 2; }
DI int perm32(int rho) { const int n = rho >> 4, i = rho & 15; return 8 * (i >> 2) + 4 * n + (i & 3); }

struct Unit { int pm, pn; };
struct Gemm { const bf16_t* A; const bf16_t* Bt; int K; };

struct StaticOrder {
  static constexpr bool LOADS = true;
  int nM, nN, nwg, G, c;
  DI void init(int M, int N, int G_, int c_) { nM = M / BM; nN = N / BM; nwg = nM * nN; G = G_; c = c_; }
  DI bool next(int i, Unit& u) const {
    const long L = (long)i * G + c; if (L >= nwg) return false;
    int wgid = (int)L; { const int q = nwg / NXCD, r = nwg % NXCD, xcd = wgid % NXCD, off = wgid / NXCD; wgid = (xcd < r ? xcd * (q + 1) : r * (q + 1) + (xcd - r) * q) + off; }
    const int nig = WGM * nN, gid = wgid / nig, fm = gid * WGM, gsz = (nM - fm) < WGM ? (nM - fm) : WGM;
    u.pm = fm + ((wgid % nig) % gsz); u.pn = (wgid % nig) / gsz; return true;
  }
  DI int arow(const Unit& u, int r) const { return u.pm * BM + r; }
};
struct GroupOrder {
  static constexpr bool LOADS = true;
  const LAS int* tab; const u32x2* rinfo; int ntn, G, c, gather;
  DI bool next(int i, Unit& u) const {
    const int L = i * G + c, NT = tab[65]; if (L >= NT * ntn) return false;
    const int tile = L / ntn, pnl = L - tile * ntn; u.pm = tile; u.pn = tab[96 + tile] * ntn + pnl; return true;
  }
  DI int arow(const Unit& u, int r) const {
    if (!gather) return u.pm * BM + r;
    const int e = tab[96 + u.pm], local = u.pm * BM + r - tab[32 + e];
    return local < tab[e] ? (int)(rinfo[(size_t)e * ECAP + local].x >> 2) : 0;
  }
};

template <class Epi, class Sched, bool ALIGN_EPI, bool I8 = false>
DI void gemm_phase(LAS unsigned char* lds, const Gemm g, const Sched& S, const Epi& E) {
  const int tid = threadIdx.x, wid = __builtin_amdgcn_readfirstlane(tid >> 6), lane = tid & 63, wr = wid >> 2, wc = wid & 3, fr = lane & 15, fq = lane >> 4;
  const int K = I8 ? g.K / 2 : g.K, nt = K / BK;
  int RA[2], CA[2]; unsigned voffB[2];
#pragma unroll
  for (int i = 0; i < 2; ++i) { int R, C; stage_rc(tid * 16 + i * 8192, R, C); const int Rb = Epi::PERM ? ((R & ~31) + perm32(R & 31)) : R; RA[i] = R; CA[i] = C; voffB[i] = (unsigned)(Rb * K + C) * 2u; }
  const size_t kstep = (size_t)(BK * 2);
  const size_t hstep = (size_t)HALF * K * 2;
  const size_t tstep = 2 * hstep;
  const unsigned ldsw = (unsigned)wid * 1024u;
  const int aoff = lds_byte(wr * 64 + fr, fq * 8), boff = lds_byte(wc * 32 + fr, fq * 8);
  const char* Ab = (const char*)g.A;
#define PG8_SA(b, h) (((b) * 2 + (h)) * HTB)
#define PG8_SB(b, h) ((4 + (b) * 2 + (h)) * HTB)
#define PG8_STAGE(bufoff, gbase, voff) do { _Pragma("unroll") for (int _i = 0; _i < 2; ++_i) \
    __builtin_amdgcn_global_load_lds((const unsigned*)((const char*)(gbase) + (voff)[_i]), (LAS unsigned*)(lds + (bufoff) + ldsw + _i * 8192), 16, 0, 0); } while (0)
#define PG8_LDA(dst, b, h) do { _Pragma("unroll") for (int m = 0; m < 4; ++m) _Pragma("unroll") for (int k = 0; k < 2; ++k) dst[m][k] = *(const LAS bf16x8*)(lds + PG8_SA(b, h) + aoff + m * 2048 + k * 1024); } while (0)
#define PG8_LDB(dst, b, h) do { _Pragma("unroll") for (int n = 0; n < 2; ++n) _Pragma("unroll") for (int k = 0; k < 2; ++k) dst[n][k] = *(const LAS bf16x8*)(lds + PG8_SB(b, h) + boff + n * 2048 + k * 1024); } while (0)
#define PG8_MMA(ai, bj, At, Bt) do { __builtin_amdgcn_s_setprio(1); _Pragma("unroll") for (int m = 0; m < 4; ++m) _Pragma("unroll") for (int n = 0; n < 2; ++n) _Pragma("unroll") for (int k = 0; k < 2; ++k) { \
    if constexpr (I8) acc[ai][bj][m][n] = __builtin_bit_cast(AccT, __builtin_amdgcn_mfma_i32_16x16x64_i8(__builtin_bit_cast(i32x4, Bt[n][k]), __builtin_bit_cast(i32x4, At[m][k]), __builtin_bit_cast(i32x4, acc[ai][bj][m][n]), 0, 0, 0)); \
    else acc[ai][bj][m][n] = __builtin_bit_cast(AccT, __builtin_amdgcn_mfma_f32_16x16x32_bf16(Bt[n][k], At[m][k], __builtin_bit_cast(f32x4, acc[ai][bj][m][n]), 0, 0, 0)); } __builtin_amdgcn_s_setprio(0); } while (0)
#define PG8_WAIT_V(n) asm volatile("s_waitcnt vmcnt(" #n ")" ::: "memory")
#define PG8_WAIT_L(n) asm volatile("s_waitcnt lgkmcnt(" #n ")" ::: "memory")
#define PG8_BAR __builtin_amdgcn_s_barrier()
#define PG8_SCHED __builtin_amdgcn_sched_barrier(0)
  Unit cur, nxt; int ui = 0;
  if (!S.next(0, cur)) return;
  typedef typename Epi::AccT AccT;
  AccT acc[2][2][4][2];
#pragma unroll
  for (int a = 0; a < 2; ++a)
#pragma unroll
    for (int b = 0; b < 2; ++b)
#pragma unroll
      for (int m = 0; m < 4; ++m)
#pragma unroll
        for (int n = 0; n < 2; ++n) acc[a][b][m][n] = (AccT){0, 0, 0, 0};
  bf16x8 At[4][2], B0[2][2], B1[2][2];
  unsigned cvo0[2], cvo1[2], nvo0[2], nvo1[2];
#pragma unroll
  for (int i = 0; i < 2; ++i) { cvo0[i] = ((unsigned)S.arow(cur, RA[i]) * (unsigned)K + (unsigned)CA[i]) * 2u; cvo1[i] = ((unsigned)S.arow(cur, HALF + RA[i]) * (unsigned)K + (unsigned)CA[i]) * 2u; }
  const char* cB = (const char*)g.Bt + (size_t)cur.pn * tstep;
  PG8_STAGE(PG8_SB(0, 0), cB, voffB); PG8_STAGE(PG8_SB(0, 1), cB + hstep, voffB); PG8_STAGE(PG8_SA(0, 0), Ab, cvo0); PG8_STAGE(PG8_SA(0, 1), Ab, cvo1);
  if (wr == 1) PG8_BAR;
  PG8_WAIT_V(2); PG8_BAR;
  PG8_STAGE(PG8_SB(1, 0), cB + kstep, voffB); PG8_STAGE(PG8_SA(1, 0), Ab + kstep, cvo0); PG8_STAGE(PG8_SB(1, 1), cB + hstep + kstep, voffB);
  PG8_WAIT_V(6); PG8_BAR;
  for (;;) {
    const bool has_next = S.next(ui + 1, nxt);
    if (!has_next) nxt = cur;
#pragma unroll
    for (int i = 0; i < 2; ++i) { nvo0[i] = ((unsigned)S.arow(nxt, RA[i]) * (unsigned)K + (unsigned)CA[i]) * 2u; nvo1[i] = ((unsigned)S.arow(nxt, HALF + RA[i]) * (unsigned)K + (unsigned)CA[i]) * 2u; }
    const char* nB = (const char*)g.Bt + (size_t)nxt.pn * tstep;
    for (int t = 0; t < nt; t += 2) {
      const bool last = (t == nt - 2);
      if constexpr (Epi::MIDHOOK) { if (t == 8 || t == 16) E.mid(acc, cur, (t >> 3) - 1, wr, wc, fr, fq); }
      const char* a1 = Ab + (size_t)(t + 1) * kstep;
      const char* a2 = last ? Ab : Ab + (size_t)(t + 2) * kstep; const char* b2 = last ? nB : cB + (size_t)(t + 2) * kstep;
      const char* a3 = a2 + kstep; const char* b3 = b2 + kstep;
      unsigned vo0[2], vo1[2];
      if constexpr (Sched::LOADS) {
        if (last) {
#pragma unroll
          for (int i = 0; i < 2; ++i) { vo0[i] = nvo0[i]; vo1[i] = nvo1[i]; }
        } else {
#pragma unroll
          for (int i = 0; i < 2; ++i) { vo0[i] = cvo0[i]; vo1[i] = cvo1[i]; }
        }
      } else {
#pragma unroll
        for (int i = 0; i < 2; ++i) { vo0[i] = last ? nvo0[i] : cvo0[i]; vo1[i] = last ? nvo1[i] : cvo1[i]; }
      }
      PG8_LDB(B0, 0, 0); PG8_LDB(B1, 0, 1); PG8_SCHED; PG8_LDA(At, 0, 0); PG8_STAGE(PG8_SA(1, 1), a1, cvo1);
      PG8_WAIT_V(8); PG8_WAIT_L(0); PG8_BAR; PG8_MMA(0, 0, At, B0); PG8_MMA(0, 1, At, B1); PG8_BAR; PG8_SCHED;
      PG8_LDA(At, 0, 1); PG8_STAGE(PG8_SB(0, 0), b2, voffB); PG8_STAGE(PG8_SB(0, 1), b2 + hstep, voffB); PG8_STAGE(PG8_SA(0, 0), a2, vo0);
      PG8_WAIT_V(8); PG8_WAIT_L(0); PG8_BAR; PG8_MMA(1, 0, At, B0); PG8_MMA(1, 1, At, B1); PG8_BAR; PG8_SCHED;
      PG8_LDB(B0, 1, 0); PG8_LDB(B1, 1, 1); PG8_SCHED; PG8_LDA(At, 1, 0); PG8_STAGE(PG8_SA(0, 1), a2, vo1);
      PG8_WAIT_V(8); PG8_WAIT_L(0); PG8_BAR; PG8_MMA(0, 0, At, B0); PG8_MMA(0, 1, At, B1); PG8_BAR; PG8_SCHED;
      PG8_LDA(At, 1, 1); PG8_STAGE(PG8_SB(1, 0), b3, voffB); PG8_STAGE(PG8_SB(1, 1), b3 + hstep, voffB); PG8_STAGE(PG8_SA(1, 0), a3, vo0);
      PG8_WAIT_V(8); PG8_WAIT_L(0); PG8_BAR; PG8_MMA(1, 0, At, B0); PG8_MMA(1, 1, At, B1); PG8_BAR; PG8_SCHED;
    }
    if constexpr (ALIGN_EPI) { if (wr == 0) PG8_BAR; }
    E(acc, cur, wr, wc, fr, fq);
    if (!has_next) break;
#pragma unroll
    for (int a = 0; a < 2; ++a)
#pragma unroll
      for (int b = 0; b < 2; ++b)
#pragma unroll
        for (int m = 0; m < 4; ++m)
#pragma unroll
          for (int n = 0; n < 2; ++n) acc[a][b][m][n] = (AccT){0, 0, 0, 0};
    cur = nxt; cB = nB; ++ui;
#pragma unroll
    for (int i = 0; i < 2; ++i) { cvo0[i] = nvo0[i]; cvo1[i] = nvo1[i]; }
    if constexpr (ALIGN_EPI) { if (wr == 1) PG8_BAR; }
  }
  PG8_WAIT_V(0);
  if constexpr (!ALIGN_EPI) { if (wr == 0) PG8_BAR; }
  PG8_BAR;
#undef PG8_SA
#undef PG8_SB
#undef PG8_STAGE
#undef PG8_LDA
#undef PG8_LDB
#undef PG8_MMA
#undef PG8_WAIT_V
#undef PG8_WAIT_L
#undef PG8_BAR
#undef PG8_SCHED
}

struct EpiStoreBf16 {
  typedef f32x4 AccT;
  static constexpr bool PERM = true, MIDHOOK = false;
  bf16_t* O; int ldc; int skip; int gcol0;
  DI static unsigned q8(float v) { const float g = __frcp_rn(1.f + __expf(-v)); return (unsigned)fminf(fmaxf(rintf(g * 255.f), 1.f), 255.f); }
  DI void operator()(const f32x4 (&acc)[2][2][4][2], const Unit& u, int wr, int wc, int fr, int fq) const {
    if (skip) { asm volatile("" :: "v"(acc[0][0][0][0]), "v"(acc[1][1][3][1])); return; }
    const int row0 = u.pm * BM + wr * 64 + fr, col0 = u.pn * BM + wc * 32 + 8 * fq;
    if (u.pn * BM >= gcol0) {
#pragma unroll
      for (int ai = 0; ai < 2; ++ai)
#pragma unroll
        for (int m = 0; m < 4; ++m) { unsigned char* rowp = (unsigned char*)O + (size_t)(row0 + ai * HALF + m * 16) * ldc * 2 + (size_t)gcol0 * 2 + (col0 - gcol0);
#pragma unroll
          for (int bj = 0; bj < 2; ++bj) { const f32x4 v0 = acc[ai][bj][m][0], v1 = acc[ai][bj][m][1];
            u32x2 w; w.x = q8(v0[0]) | (q8(v0[1]) << 8) | (q8(v0[2]) << 16) | (q8(v0[3]) << 24); w.y = q8(v1[0]) | (q8(v1[1]) << 8) | (q8(v1[2]) << 16) | (q8(v1[3]) << 24);
            NTST(w, (u32x2*)(rowp + bj * HALF)); } }
      return;
    }
#pragma unroll
    for (int ai = 0; ai < 2; ++ai)
#pragma unroll
      for (int m = 0; m < 4; ++m) { bf16_t* rowp = O + (size_t)(row0 + ai * HALF + m * 16) * ldc + col0;
#pragma unroll
        for (int bj = 0; bj < 2; ++bj) { const f32x4 v0 = acc[ai][bj][m][0], v1 = acc[ai][bj][m][1];
          u32x4 w; w.x = pk_bf16(v0[0], v0[1]); w.y = pk_bf16(v0[2], v0[3]); w.z = pk_bf16(v1[0], v1[1]); w.w = pk_bf16(v1[2], v1[3]);
          NTST(w, (u32x4*)(rowp + bj * HALF)); } }
  }
};
struct EpiMixed {
  typedef f32x4 AccT;
  static constexpr bool PERM = true, MIDHOOK = true;
  const unsigned char* gate8; bf16_t* O;
  DI void mid(f32x4 (&acc)[2][2][4][2], const Unit& u, int b, int wr, int wc, int fr, int fq) const {
    int row0 = u.pm * BM + wr * 64 + fr; const int col0 = u.pn * BM + wc * 32 + 8 * fq;
    asm volatile("" : "+v"(row0));
#pragma unroll
    for (int ai = 0; ai < 2; ++ai) {
      u32x2 ga[4][2], gb[4][2];
#pragma unroll
      for (int m = 0; m < 4; ++m) { const unsigned char* gp = gate8 + (size_t)(row0 + ai * HALF + m * 16) * (NPROJ * 2) + C_GATE * 2 + b * DM + col0;
#pragma unroll
        for (int bj = 0; bj < 2; ++bj) { ga[m][bj] = *(const u32x2*)(gp + bj * HALF); gb[m][bj] = *(const u32x2*)(gp + DM + bj * HALF); } }
#pragma unroll
      for (int m = 0; m < 4; ++m)
#pragma unroll
        for (int bj = 0; bj < 2; ++bj)
#pragma unroll
          for (int j = 0; j < 8; ++j) { const float a = (float)((ga[m][bj][j >> 2] >> (8 * (j & 3))) & 0xffu), bb = (float)((gb[m][bj][j >> 2] >> (8 * (j & 3))) & 0xffu);
            acc[ai][bj][m][j >> 2][j & 3] *= a * __frcp_rn(bb); }
      asm volatile("" ::: "memory");
    }
  }
  DI void operator()(const f32x4 (&acc)[2][2][4][2], const Unit& u, int wr, int wc, int fr, int fq) const {
    const int row0 = u.pm * BM + wr * 64 + fr, col0 = u.pn * BM + wc * 32 + 8 * fq;
#pragma unroll
    for (int ai = 0; ai < 2; ++ai) {
      u32x2 ga[4][2];
#pragma unroll
      for (int m = 0; m < 4; ++m) { const unsigned char* gp = gate8 + (size_t)(row0 + ai * HALF + m * 16) * (NPROJ * 2) + C_GATE * 2 + 2 * DM + col0;
#pragma unroll
        for (int bj = 0; bj < 2; ++bj) ga[m][bj] = *(const u32x2*)(gp + bj * HALF); }
#pragma unroll
      for (int m = 0; m < 4; ++m) { const int row = row0 + ai * HALF + m * 16;
#pragma unroll
        for (int bj = 0; bj < 2; ++bj) { float o[8];
#pragma unroll
          for (int j = 0; j < 8; ++j) o[j] = acc[ai][bj][m][j >> 2][j & 3] * ((float)((ga[m][bj][j >> 2] >> (8 * (j & 3))) & 0xffu) * (1.f / 255.f));
          u32x4 w; w.x = pk_bf16(o[0], o[1]); w.y = pk_bf16(o[2], o[3]); w.z = pk_bf16(o[4], o[5]); w.w = pk_bf16(o[6], o[7]);
          *(u32x4*)(O + (size_t)row * DM + col0 + bj * HALF) = w; } }
      asm volatile("" ::: "memory");
    }
  }
};
struct EpiH {
  typedef f32x4 AccT;
  static constexpr bool PERM = false, MIDHOOK = false;
  const float* x; float* h;
  DI void operator()(const f32x4 (&acc)[2][2][4][2], const Unit& u, int wr, int wc, int fr, int fq) const {
    const int row0 = u.pm * BM + wr * 64 + fr, col0 = u.pn * BM + wc * 32 + 4 * fq;
#pragma unroll
    for (int ai = 0; ai < 2; ++ai)
#pragma unroll
      for (int m = 0; m < 4; ++m) { const size_t off = (size_t)(row0 + ai * HALF + m * 16) * DM + col0;
#pragma unroll
        for (int bj = 0; bj < 2; ++bj)
#pragma unroll
          for (int n = 0; n < 2; ++n) { const f32x4 xv = *(const f32x4*)(x + off + bj * HALF + n * 16); *(f32x4*)(h + off + bj * HALF + n * 16) = xv * DN_ALPHA + acc[ai][bj][m][n]; }
        asm volatile("" ::: "memory"); }
  }
};
struct EpiGateUp {
  typedef f32x4 AccT;
  static constexpr bool PERM = true, MIDHOOK = false;
  const float* bgu; bf16_t* act;
  DI void operator()(const f32x4 (&acc)[2][2][4][2], const Unit& u, int wr, int wc, int fr, int fq) const {
    const int e = u.pn >> 3, pnl = u.pn & 7, row0 = u.pm * BM + wr * 64 + fr, j0 = pnl * 128 + wc * 32 + 8 * fq;
    f32x4 bg[2], bl[2];
#pragma unroll
    for (int n = 0; n < 2; ++n) { bg[n] = *(const f32x4*)(bgu + (size_t)e * 2048 + j0 + 4 * n); bl[n] = *(const f32x4*)(bgu + (size_t)e * 2048 + 1024 + j0 + 4 * n); }
#pragma unroll
    for (int ai = 0; ai < 2; ++ai)
#pragma unroll
      for (int m = 0; m < 4; ++m) { float o[8];
#pragma unroll
        for (int n = 0; n < 2; ++n)
#pragma unroll
          for (int j = 0; j < 4; ++j) { const float glu = fminf(acc[ai][0][m][n][j] + bg[n][j], SWIGLU_LIMIT); const float lin = fminf(fmaxf(acc[ai][1][m][n][j] + bl[n][j], -SWIGLU_LIMIT), SWIGLU_LIMIT);
            o[4 * n + j] = glu * __frcp_rn(1.f + __expf(-SWIGLU_ALPHA * glu)) * (lin + 1.f); }
        u32x4 w; w.x = pk_bf16(o[0], o[1]); w.y = pk_bf16(o[2], o[3]); w.z = pk_bf16(o[4], o[5]); w.w = pk_bf16(o[6], o[7]);
        *(u32x4*)(act + (size_t)(row0 + ai * HALF + m * 16) * DFF + j0) = w; }
  }
};
struct EpiGateUpI8 {
  typedef i32x4 AccT;
  static constexpr bool PERM = true, MIDHOOK = false;
  const float* bgu; const float* wsc; const float* rsc; const LAS int* tab; bf16_t* act;
  DI void operator()(const i32x4 (&acc)[2][2][4][2], const Unit& u, int wr, int wc, int fr, int fq) const {
    const int e = u.pn >> 3, pnl = u.pn & 7, row0 = u.pm * BM + wr * 64 + fr, j0 = pnl * 128 + wc * 32 + 8 * fq, r0 = pnl * 256 + wc * 32 + 8 * fq;
    const int local0 = row0 - tab[32 + e], cnt = tab[e];
    f32x4 bg[2], bl[2], sg[2], sl[2];
#pragma unroll
    for (int n = 0; n < 2; ++n) { bg[n] = *(const f32x4*)(bgu + (size_t)e * 2048 + j0 + 4 * n); bl[n] = *(const f32x4*)(bgu + (size_t)e * 2048 + 1024 + j0 + 4 * n);
      sg[n] = *(const f32x4*)(wsc + (size_t)e * 2048 + r0 + 4 * n); sl[n] = *(const f32x4*)(wsc + (size_t)e * 2048 + r0 + 128 + 4 * n); }
#pragma unroll
    for (int ai = 0; ai < 2; ++ai)
#pragma unroll
      for (int m = 0; m < 4; ++m) { const int local = local0 + ai * HALF + m * 16;
        const float sa = local < cnt ? rsc[(size_t)e * ECAP + local] : 0.f; float o[8];
#pragma unroll
        for (int n = 0; n < 2; ++n)
#pragma unroll
          for (int j = 0; j < 4; ++j) { const float glu = fminf((float)acc[ai][0][m][n][j] * (sa * sg[n][j]) + bg[n][j], SWIGLU_LIMIT);
            const float lin = fminf(fmaxf((float)acc[ai][1][m][n][j] * (sa * sl[n][j]) + bl[n][j], -SWIGLU_LIMIT), SWIGLU_LIMIT);
            o[4 * n + j] = glu * __frcp_rn(1.f + __expf(-SWIGLU_ALPHA * glu)) * (lin + 1.f); }
        u32x4 w; w.x = pk_bf16(o[0], o[1]); w.y = pk_bf16(o[2], o[3]); w.z = pk_bf16(o[4], o[5]); w.w = pk_bf16(o[6], o[7]);
        *(u32x4*)(act + (size_t)(row0 + ai * HALF + m * 16) * DFF + j0) = w; }
  }
};
struct EpiGate8 {
  typedef i32x4 AccT;
  static constexpr bool PERM = true, MIDHOOK = false;
  unsigned char* O; int ldcb; int gbyte0; const float* xsc; const float* wgs;
  DI static unsigned q8(float v) { const float g = __frcp_rn(1.f + __expf(-v)); return (unsigned)fminf(fmaxf(rintf(g * 255.f), 1.f), 255.f); }
  DI void operator()(const i32x4 (&acc)[2][2][4][2], const Unit& u, int wr, int wc, int fr, int fq) const {
    const int row0 = u.pm * BM + wr * 64 + fr, col0 = u.pn * BM + wc * 32 + 8 * fq;
    f32x4 sw[2][2];
#pragma unroll
    for (int bj = 0; bj < 2; ++bj)
#pragma unroll
      for (int n = 0; n < 2; ++n) sw[bj][n] = *(const f32x4*)(wgs + col0 + bj * HALF + 4 * n);
#pragma unroll
    for (int ai = 0; ai < 2; ++ai)
#pragma unroll
      for (int m = 0; m < 4; ++m) { const int row = row0 + ai * HALF + m * 16; const float sx = xsc[row]; unsigned char* rowp = O + (size_t)row * ldcb + gbyte0 + col0;
#pragma unroll
        for (int bj = 0; bj < 2; ++bj) { u32x2 w; unsigned q[8];
#pragma unroll
          for (int j = 0; j < 8; ++j) q[j] = q8((float)acc[ai][bj][m][j >> 2][j & 3] * (sx * sw[bj][j >> 2][j & 3]));
          w.x = q[0] | (q[1] << 8) | (q[2] << 16) | (q[3] << 24); w.y = q[4] | (q[5] << 8) | (q[6] << 16) | (q[7] << 24);
          NTST(w, (u32x2*)(rowp + bj * HALF)); } }
  }
};
struct EpiDown {
  typedef f32x4 AccT;
  static constexpr bool PERM = true, MIDHOOK = false;
  const float* bdn; const LAS int* tab; const u32x2* rinfo; bf16_t* ypair;
  DI void operator()(const f32x4 (&acc)[2][2][4][2], const Unit& u, int wr, int wc, int fr, int fq) const {
    const int e = u.pn >> 2, pnl = u.pn & 3, col0 = pnl * BM + wc * 32 + 8 * fq;
    const int local0 = u.pm * BM - tab[32 + e] + wr * 64 + fr, cnt = tab[e];
    f32x4 bv[2][2];
#pragma unroll
    for (int bj = 0; bj < 2; ++bj)
#pragma unroll
      for (int n = 0; n < 2; ++n) bv[bj][n] = *(const f32x4*)(bdn + (size_t)e * DM + col0 + bj * HALF + 4 * n);
#pragma unroll
    for (int ai = 0; ai < 2; ++ai)
#pragma unroll
      for (int m = 0; m < 4; ++m) { const int local = local0 + ai * HALF + m * 16;
        if (local < cnt) { const u32x2 info = rinfo[(size_t)e * ECAP + local]; const float gate = __uint_as_float(info.y); bf16_t* rowp = ypair + (size_t)info.x * DM + col0;
#pragma unroll
          for (int bj = 0; bj < 2; ++bj) { const f32x4 v0 = (acc[ai][bj][m][0] + bv[bj][0]) * gate, v1 = (acc[ai][bj][m][1] + bv[bj][1]) * gate;
            u32x4 w; w.x = pk_bf16(v0[0], v0[1]); w.y = pk_bf16(v0[2], v0[3]); w.z = pk_bf16(v1[0], v1[1]); w.w = pk_bf16(v1[2], v1[3]);
            *(u32x4*)(rowp + bj * HALF) = w; } } }
  }
};
}
#if NAIVE_ANY
template <class F> DI void naive_gemm(const Ctx& c, const bf16_t* A, int lda, const bf16_t* Bt, int ldb, int M, int N, int K, F epi) {
  const int r = c.lane & 31, h = c.lane >> 5, tn_n = N / 32, tiles = (M / 32) * tn_n;
  for (int tile = c.gw; tile < tiles; tile += c.ngw) {
    const int tm = tile / tn_n, tn = tile - tm * tn_n;
    const bf16_t* ap = A + (size_t)(tm * 32 + r) * lda + 8 * h; const bf16_t* bp = Bt + (size_t)(tn * 32 + r) * ldb + 8 * h;
    f32x16 acc; for (int i = 0; i < 16; ++i) acc[i] = 0.f;
    for (int k0 = 0; k0 < K; k0 += 16) { const bf16x8 a = *(const bf16x8*)(ap + k0), b = *(const bf16x8*)(bp + k0); acc = MFMA32(a, b, acc); }
#pragma unroll
    for (int i = 0; i < 16; ++i) epi(tm * 32 + crow(i, h), tn * 32 + r, acc[i]);
  }
}
#endif

#if NAIVE_GDN
DI void naive_gdn_prep(const Ctx& c) {
  const bf16_t* proj = (const bf16_t*)(c.p.ws + WS_PROJ); bf16_t* qkv = (bf16_t*)(c.p.ws + WS_GDN); const float* wc = c.p.in[I_WCONV];
  for (int it = c.gw; it < TT * 4; it += c.ngw) {
    const int t = it >> 2, hh = it & 3, tl = t & (SEQ - 1);
    float val[3][2];
#pragma unroll
    for (int part = 0; part < 3; ++part)
#pragma unroll
      for (int e = 0; e < 2; ++e) { const int ch = part * 512 + hh * 128 + 2 * c.lane + e; float a = 0.f;
#pragma unroll
        for (int j = 0; j < 4; ++j) { const int ts = tl - 3 + j; if (ts >= 0) a += wc[j * 1536 + ch] * bf2f(proj[(size_t)(t - 3 + j) * NPROJ + ch]); }
        val[part][e] = a * sigmoidf_(a); }
    const float sq = wave_sum(val[0][0] * val[0][0] + val[0][1] * val[0][1]), sk = wave_sum(val[1][0] * val[1][0] + val[1][1] * val[1][1]);
    const float rq = rsqrtf(sq + NORM_EPS) * 0.08838834764831845f, rk = rsqrtf(sk + NORM_EPS);
    bf16_t* o = qkv + ((size_t)t * 4 + hh) * 384 + 2 * c.lane;
    *(unsigned*)(o) = pk_bf16(val[0][0] * rq, val[0][1] * rq); *(unsigned*)(o + 128) = pk_bf16(val[1][0] * rk, val[1][1] * rk); *(unsigned*)(o + 256) = pk_bf16(val[2][0], val[2][1]);
  }
}
DI void naive_gdn_scan(const Ctx& c) {
  if (c.bid >= 64) return;
  const int b = c.bid >> 2, hh = c.bid & 3, j = c.tid;
  const bf16_t* qkv = (const bf16_t*)(c.p.ws + WS_GDN); const float* gbeta = (const float*)(c.p.ws + WS_MISC); bf16_t* ycat = (bf16_t*)(c.p.ws + WS_YCAT);
  LAS float* sq = (LAS float*)c.lds; LAS float* sk = sq + 8 * 128;
  float S[128];
#pragma unroll
  for (int d = 0; d < 128; ++d) S[d] = 0.f;
  for (int t0 = 0; t0 < SEQ; t0 += 8) {
    __syncthreads();
    for (int i = c.tid; i < 8 * 256; i += 512) { const int tt = i >> 8, d = i & 255; const size_t t = (size_t)b * SEQ + t0 + tt;
      const float v = bf2f(qkv[(t * 4 + hh) * 384 + d]); if (d < 128) sq[tt * 128 + d] = v; else sk[tt * 128 + d - 128] = v; }
    __syncthreads();
    if (j < 128) {
      for (int tt = 0; tt < 8; ++tt) { const size_t t = (size_t)b * SEQ + t0 + tt;
        const float g = gbeta[t * 8 + hh], beta = gbeta[t * 8 + 4 + hh], dec = __expf(g), vt = bf2f(qkv[(t * 4 + hh) * 384 + 256 + j]);
        float ks = 0.f;
#pragma unroll
        for (int d = 0; d < 128; ++d) ks += sk[tt * 128 + d] * S[d];
        const float vn = beta * (vt - dec * ks); float o = 0.f;
#pragma unroll
        for (int d = 0; d < 128; ++d) { S[d] = dec * S[d] + sk[tt * 128 + d] * vn; o += sq[tt * 128 + d] * S[d]; }
        ycat[t * 1536 + hh * 128 + j] = f2bf(o); }
    }
  }
}
#endif

#if NAIVE_ATTN
DI void naive_sb(const Ctx& c) {
  const bf16_t* proj = (const bf16_t*)(c.p.ws + WS_PROJ); bf16_t* ycat = (bf16_t*)(c.p.ws + WS_YCAT);
  LAS float* wl = (LAS float*)c.lds + c.wave * 64;
  for (int it = c.gw; it < NB * 8 * SEQ; it += c.ngw) {
    const int tq = it & (SEQ - 1), hh = (it >> 11) & 7, b = it >> 14; const size_t trow = (size_t)b * SEQ + tq;
    float q[64];
    { const bf16_t* qp = proj + trow * NPROJ + C_SQ + hh * 64;
#pragma unroll
      for (int d8 = 0; d8 < 8; ++d8) { const u32x4 w = *(const u32x4*)(qp + 8 * d8);
#pragma unroll
        for (int e = 0; e < 4; ++e) { q[8 * d8 + 2 * e] = bflo(w[e]); q[8 * d8 + 2 * e + 1] = bfhi(w[e]); } } }
    float carry = 0.f, o = 0.f;
    for (int kt = (tq - 1) >> 6; kt >= 0 && tq > 0; --kt) {
      const int s = kt * 64 + c.lane; const bool valid = s < tq; const size_t srow = (size_t)b * SEQ + (valid ? s : 0);
      const bf16_t* kp = proj + srow * NPROJ + C_SK + hh * 64; float z = 0.f;
#pragma unroll
      for (int d8 = 0; d8 < 8; ++d8) { const u32x4 w = *(const u32x4*)(kp + 8 * d8);
#pragma unroll
        for (int e = 0; e < 4; ++e) z += q[8 * d8 + 2 * e] * bflo(w[e]) + q[8 * d8 + 2 * e + 1] * bfhi(w[e]); }
      z *= 0.125f;
      const float sp = valid ? softplusf_(z) : 0.f;
      float suf = sp;
#pragma unroll
      for (int off = 1; off < 64; off <<= 1) { const float o2 = __shfl_down(suf, off); if (c.lane + off < 64) suf += o2; }
      const float w = valid ? __expf(z - (carry + suf)) : 0.f;
      carry += __shfl(suf, 0);
      LDS_WAIT(); wl[c.lane] = w; LDS_WAIT();
      const int smax = min(64, tq - kt * 64);
      for (int ss = 0; ss < smax; ++ss) o += wl[ss] * bf2f(proj[((size_t)b * SEQ + kt * 64 + ss) * NPROJ + C_SV + hh * 64 + c.lane]);
      LDS_WAIT();
    }
    ycat[trow * 1536 + 512 + hh * 64 + c.lane] = f2bf(o);
  }
}
DI void naive_mem(const Ctx& c) {
  const bf16_t* proj = (const bf16_t*)(c.p.ws + WS_PROJ); const bf16_t* mkv = (const bf16_t*)(c.p.ws + WS_MKV); bf16_t* ycat = (bf16_t*)(c.p.ws + WS_YCAT);
  LAS float* pl = (LAS float*)(c.lds + 4096) + c.wave * 256;
  for (int it = c.gw; it < NB * 4 * SEQ; it += c.ngw) {
    const int tq = it & (SEQ - 1), hh = (it >> 11) & 3, b = it >> 13; const size_t trow = (size_t)b * SEQ + tq;
    const bf16_t* qp = proj + trow * NPROJ + C_MQ + hh * 128;
    float sc[4];
#pragma unroll
    for (int kt = 0; kt < 4; ++kt) { const bf16_t* kp = mkv + (size_t)(b * MEMLEN + kt * 64 + c.lane) * 1024 + hh * 128; float z = 0.f;
      for (int d8 = 0; d8 < 16; ++d8) { const u32x4 w = *(const u32x4*)(kp + 8 * d8), qw = *(const u32x4*)(qp + 8 * d8);
#pragma unroll
        for (int e = 0; e < 4; ++e) z += bflo(qw[e]) * bflo(w[e]) + bfhi(qw[e]) * bfhi(w[e]); }
      sc[kt] = z * 0.08838834764831845f; }
    const float mx = wave_max(fmaxf(fmaxf(sc[0], sc[1]), fmaxf(sc[2], sc[3])));
    float pe[4], ssum = 0.f;
#pragma unroll
    for (int kt = 0; kt < 4; ++kt) { pe[kt] = __expf(sc[kt] - mx); ssum += pe[kt]; }
    ssum = wave_sum(ssum);
    LDS_WAIT();
#pragma unroll
    for (int kt = 0; kt < 4; ++kt) pl[kt * 64 + c.lane] = pe[kt] / ssum;
    LDS_WAIT();
    float o0 = 0.f, o1 = 0.f;
    for (int s = 0; s < 256; ++s) { const unsigned vv = *(const unsigned*)(mkv + (size_t)(b * MEMLEN + s) * 1024 + 512 + hh * 128 + 2 * c.lane); const float pw = pl[s]; o0 += pw * bflo(vv); o1 += pw * bfhi(vv); }
    LDS_WAIT();
    *(unsigned*)(ycat + trow * 1536 + 1024 + hh * 128 + 2 * c.lane) = pk_bf16(o0, o1);
  }
}
#endif
DI void tr_item(const float* src, int ldw, bf16_t* dst, int ldd, LAS float* scr, int lane) {
#pragma unroll
  for (int i = 0; i < 8; ++i) { const int kk = 8 * i + (lane >> 3); const f32x4 v = *(const f32x4*)(src + (size_t)kk * ldw + 4 * (lane & 7));
    LAS float* s = scr + kk * 33 + 4 * (lane & 7); s[0] = v.x; s[1] = v.y; s[2] = v.z; s[3] = v.w; }
  LDS_WAIT();
  const int cc = lane & 7;
#pragma unroll
  for (int j = 0; j < 4; ++j) { const int n = (lane >> 3) + 8 * j; const LAS float* s = scr + (8 * cc) * 33 + n;
    u32x4 o; o.x = pk_bf16(s[0 * 33], s[1 * 33]); o.y = pk_bf16(s[2 * 33], s[3 * 33]); o.z = pk_bf16(s[4 * 33], s[5 * 33]); o.w = pk_bf16(s[6 * 33], s[7 * 33]);
    *(u32x4*)(dst + (size_t)n * ldd + 8 * cc) = o; }
  LDS_WAIT();
}
DI void phase0(const Ctx& c) {
  unsigned char* ws = c.p.ws;
  if (c.bid == 0 && c.tid < 32) ((int*)(ws + WS_MISC + MiB))[c.tid] = 0;
  {
    LAS float* scr = (LAS float*)(c.lds + c.wave * 8448);
    for (int r = c.gw; r < 16 * (GATE_I8 ? 128 : 224); r += c.ngw) { const int kb = r / (GATE_I8 ? 128 : 224), nb = r % (GATE_I8 ? 128 : 224); const int n0 = 32 * nb + (nb >= 64 ? 8 : 0);
      tr_item(c.p.in[I_WIN] + (size_t)(64 * kb) * 7176 + n0, 7176, (bf16_t*)(ws + WS_WIN) + (size_t)(32 * nb) * 1024 + 64 * kb, 1024, scr, c.lane); }
    for (int r = (c.gw + 512) % c.ngw; r < 16 * 32; r += c.ngw) { const int kb = r / 32, nb = r % 32;
      tr_item(c.p.in[I_WMKV] + (size_t)(64 * kb) * 1024 + 32 * nb, 1024, (bf16_t*)(ws + WS_WMKV) + (size_t)(32 * nb) * 1024 + 64 * kb, 1024, scr, c.lane); }
    for (int r = (c.gw + 1024) % c.ngw; r < 8 * 32; r += c.ngw) { const int kb = r / 32, nb = r % 32;
      tr_item(c.p.in[I_WPG] + (size_t)(64 * kb) * 1024 + 32 * nb, 1024, (bf16_t*)(ws + WS_WP) + (size_t)(32 * nb) * 1536 + 0 * 512 + 64 * kb, 1536, scr, c.lane); }
    for (int r = (c.gw + 1280) % c.ngw; r < 8 * 32; r += c.ngw) { const int kb = r / 32, nb = r % 32;
      tr_item(c.p.in[I_WPS] + (size_t)(64 * kb) * 1024 + 32 * nb, 1024, (bf16_t*)(ws + WS_WP) + (size_t)(32 * nb) * 1536 + 1 * 512 + 64 * kb, 1536, scr, c.lane); }
    for (int r = (c.gw + 1536) % c.ngw; r < 8 * 32; r += c.ngw) { const int kb = r / 32, nb = r % 32;
      tr_item(c.p.in[I_WPM] + (size_t)(64 * kb) * 1024 + 32 * nb, 1024, (bf16_t*)(ws + WS_WP) + (size_t)(32 * nb) * 1536 + 2 * 512 + 64 * kb, 1536, scr, c.lane); }
    for (int r = (c.gw + 1792) % c.ngw; r < 16 * 32; r += c.ngw) { const int kb = r / 32, nb = r % 32;
      tr_item(c.p.in[I_WO] + (size_t)(64 * kb) * 1024 + 32 * nb, 1024, (bf16_t*)(ws + WS_WO) + (size_t)(32 * nb) * 1024 + 64 * kb, 1024, scr, c.lane); }
#if MOE_I8
    { unsigned* cmax = (unsigned*)(ws + WS_CMAX);
      for (int r = c.gw; r < 32 * 16 * 4; r += c.ngw) { const int e = r >> 6, kb = (r >> 2) & 15, nq = r & 3;
        const float* src = c.p.in[I_WGU] + (size_t)e * 1024 * 2048 + (size_t)(64 * kb) * 2048 + 512 * nq + 8 * c.lane;
        f32x4 m0 = {0.f, 0.f, 0.f, 0.f}, m1 = {0.f, 0.f, 0.f, 0.f};
#pragma unroll 8
        for (int kk = 0; kk < 64; ++kk) { const f32x4 a = *(const f32x4*)(src + (size_t)kk * 2048), b = *(const f32x4*)(src + (size_t)kk * 2048 + 4);
          m0.x = fmaxf(m0.x, fabsf(a.x)); m0.y = fmaxf(m0.y, fabsf(a.y)); m0.z = fmaxf(m0.z, fabsf(a.z)); m0.w = fmaxf(m0.w, fabsf(a.w));
          m1.x = fmaxf(m1.x, fabsf(b.x)); m1.y = fmaxf(m1.y, fabsf(b.y)); m1.z = fmaxf(m1.z, fabsf(b.z)); m1.w = fmaxf(m1.w, fabsf(b.w)); }
        unsigned* cm = cmax + e * 2048 + 512 * nq + 8 * c.lane;
        atomicMax(cm + 0, __float_as_uint(m0.x)); atomicMax(cm + 1, __float_as_uint(m0.y)); atomicMax(cm + 2, __float_as_uint(m0.z)); atomicMax(cm + 3, __float_as_uint(m0.w));
        atomicMax(cm + 4, __float_as_uint(m1.x)); atomicMax(cm + 5, __float_as_uint(m1.y)); atomicMax(cm + 6, __float_as_uint(m1.z)); atomicMax(cm + 7, __float_as_uint(m1.w)); } }
#else
    for (int r = c.gw; r < 32 * 16 * 64; r += c.ngw) { const int e = r / 1024, q = r % 1024, kb = q / 64, nb = q % 64; const int r0 = 32 * nb, n0 = ((r0 >> 7) & 1) * 1024 + (r0 >> 8) * 128 + (r0 & 127);
      tr_item(c.p.in[I_WGU] + (size_t)e * 1024 * 2048 + (size_t)(64 * kb) * 2048 + n0, 2048, (bf16_t*)(ws + WS_WGU) + ((size_t)e * 2048 + r0) * 1024 + 64 * kb, 1024, scr, c.lane); }
#endif
#if !(MOE_I8 && W8_BESIDE_SCAN)
    for (int r = c.gw; r < 32 * 16 * 32; r += c.ngw) { const int e = r / 512, q = r % 512, kb = q / 32, nb = q % 32;
      tr_item(c.p.in[I_WDN] + (size_t)e * 1024 * 1024 + (size_t)(64 * kb) * 1024 + 32 * nb, 1024, (bf16_t*)(ws + WS_WDN) + ((size_t)e * 1024 + 32 * nb) * 1024 + 64 * kb, 1024, scr, c.lane); }
#endif
  }
#if GATE_I8
  for (int r = c.gw; r < 16 * 96; r += c.ngw) { const int kb = r / 96, grp = r % 96, n = c.lane & 31, h2 = c.lane >> 5;
    const float* src = c.p.in[I_WIN] + (size_t)(64 * kb + 32 * h2) * 7176 + 4104 + 32 * grp + n; float am = 0.f;
#pragma unroll
    for (int k = 0; k < 32; ++k) am = fmaxf(am, fabsf(src[(size_t)k * 7176]));
    am = fmaxf(am, __shfl_xor(am, 32));
    if (h2 == 0) atomicMax((unsigned*)(ws + WS_CMAXG) + 32 * grp + n, __float_as_uint(am)); }
#endif
  { const float* wr = c.p.in[I_WR]; float* wT = (float*)(ws + WS_WRT); for (int i = c.bid * 512 + c.tid; i < 32 * 1024; i += c.G * 512) wT[i] = wr[(i & 1023) * 32 + (i >> 10)]; }
  { const f32x4* src = (const f32x4*)c.p.in[I_MEM]; u32x2* dst = (u32x2*)(ws + WS_MEMB);
    for (int i = c.bid * 512 + c.tid; i < NB * MEMLEN * DM / 4; i += c.G * 512) { const f32x4 v = src[i]; u32x2 o; o.x = pk_bf16(v.x, v.y); o.y = pk_bf16(v.z, v.w); dst[i] = o; } }
  {
    float wab[4][4][8];
#pragma unroll
    for (int j = 0; j < 4; ++j)
#pragma unroll
      for (int i = 0; i < 4; ++i) { const float* wp = c.p.in[I_WIN] + (size_t)(256 * j + 4 * c.lane + i) * 7176 + 2048; const f32x4 a = *(const f32x4*)wp, b = *(const f32x4*)(wp + 4);
        wab[j][i][0] = a.x; wab[j][i][1] = a.y; wab[j][i][2] = a.z; wab[j][i][3] = a.w; wab[j][i][4] = b.x; wab[j][i][5] = b.y; wab[j][i][6] = b.z; wab[j][i][7] = b.w; }
    const int hh = c.lane & 3; const float nega = -__expf(c.p.in[I_ALOG][hh]), dtb = c.p.in[I_DTB][hh];
    float* gbeta = (float*)(ws + WS_MISC);
    for (int m = c.gw; m < TT; m += c.ngw) {
      const f32x4* xr = (const f32x4*)(c.p.in[I_X] + (size_t)m * DM) + c.lane; u32x2* xo = (u32x2*)(ws + WS_XB + (size_t)m * DM * 2) + c.lane;
      float s[8];
#pragma unroll
      for (int q = 0; q < 8; ++q) s[q] = 0.f;
      f32x4 xv[4];
#pragma unroll
      for (int j = 0; j < 4; ++j) { const f32x4 v = xr[64 * j]; xv[j] = v; u32x2 o; o.x = pk_bf16(v.x, v.y); o.y = pk_bf16(v.z, v.w); xo[64 * j] = o;
#pragma unroll
        for (int q = 0; q < 8; ++q) s[q] += v.x * wab[j][0][q] + v.y * wab[j][1][q] + v.z * wab[j][2][q] + v.w * wab[j][3][q]; }
#pragma unroll
      for (int q = 0; q < 8; ++q) s[q] = wave_sum(s[q]);
#if GATE_I8
      { float am = 0.f;
#pragma unroll
        for (int j = 0; j < 4; ++j) am = fmaxf(fmaxf(am, fmaxf(fabsf(xv[j].x), fabsf(xv[j].y))), fmaxf(fabsf(xv[j].z), fabsf(xv[j].w)));
        am = wave_max(am); const float qs = am > 0.f ? 127.f / am : 0.f;
        if (c.lane == 0) ((float*)(ws + WS_TSC))[m] = am * (1.f / 127.f);
#pragma unroll
        for (int j = 0; j < 4; ++j) ((unsigned*)(ws + WS_XQ + (size_t)m * DM))[64 * j + c.lane] = ((unsigned)(int)rintf(xv[j].x * qs) & 0xffu) | (((unsigned)(int)rintf(xv[j].y * qs) & 0xffu) << 8) | (((unsigned)(int)rintf(xv[j].z * qs) & 0xffu) << 16) | (((unsigned)(int)rintf(xv[j].w * qs) & 0xffu) << 24); }
#endif
      if (c.lane < 8) {
        float pre = s[0];
#pragma unroll
        for (int q = 1; q < 8; ++q) pre = (c.lane == q) ? s[q] : pre;
        const float val = c.lane < 4 ? nega * softplusf_(pre + dtb) : sigmoidf_(pre);
        gbeta[(size_t)m * 8 + c.lane] = val;
      }
    }
  }
}

#if MOE_I8
DI void phase0b(const Ctx& c) {
  unsigned char* ws = c.p.ws; const float* cmaxf = (const float*)(ws + WS_CMAX); float* wsc = (float*)(ws + WS_WSC); signed char* w8 = (signed char*)(ws + WS_WGU);
  LAS float* scr = (LAS float*)(c.lds + c.wave * 8448);
  for (int r = c.gw; r < 32 * 16 * 64; r += c.ngw) { const int e = r / 1024, q = r % 1024, kb = q / 64, nb = q % 64; const int r0 = 32 * nb, n0 = ((r0 >> 7) & 1) * 1024 + (r0 >> 8) * 128 + (r0 & 127);
    const float* src = c.p.in[I_WGU] + (size_t)e * 1024 * 2048 + (size_t)(64 * kb) * 2048 + n0;
#pragma unroll
    for (int i = 0; i < 8; ++i) { const int kk = 8 * i + (c.lane >> 3); const f32x4 v = *(const f32x4*)(src + (size_t)kk * 2048 + 4 * (c.lane & 7));
      LAS float* sp = scr + kk * 33 + 4 * (c.lane & 7); sp[0] = v.x; sp[1] = v.y; sp[2] = v.z; sp[3] = v.w; }
    LDS_WAIT();
    const int n = c.lane >> 1, hk = c.lane & 1; const float cm = cmaxf[e * 2048 + n0 + n], inv = cm > 0.f ? 127.f / cm : 0.f;
    if (kb == 0 && hk == 0) wsc[e * 2048 + r0 + n] = cm * (1.f / 127.f);
    u32x4 o[2];
#pragma unroll
    for (int g = 0; g < 8; ++g) { unsigned w = 0;
#pragma unroll
      for (int b = 0; b < 4; ++b) { const int qv = (int)rintf(scr[(32 * hk + 4 * g + b) * 33 + n] * inv); w |= ((unsigned)qv & 0xffu) << (8 * b); }
      o[g >> 2][g & 3] = w; }
    signed char* dst = w8 + ((size_t)e * 2048 + r0 + n) * 1024 + 64 * kb + 32 * hk;
    *(u32x4*)dst = o[0]; *(u32x4*)(dst + 16) = o[1];
    LDS_WAIT();
  }
}
#endif

#if MOE_I8
DI void phase0b_light(const Ctx& c, LAS unsigned char* scr8, int wi, int nw) {
  unsigned char* ws = c.p.ws; const float* cmaxf = (const float*)(ws + WS_CMAX); float* wsc = (float*)(ws + WS_WSC); signed char* w8 = (signed char*)(ws + WS_WGU);
  for (int r = wi; r < 32 * 16 * 64; r += nw) { const int e = r / 1024, q = r % 1024, kb = q / 64, nb = q % 64; const int r0 = 32 * nb, n0 = ((r0 >> 7) & 1) * 1024 + (r0 >> 8) * 128 + (r0 & 127);
    const float* src = c.p.in[I_WGU] + (size_t)e * 1024 * 2048 + (size_t)(64 * kb) * 2048 + n0;
    const int nq = 4 * (c.lane & 7);
    const f32x4 cm = *(const f32x4*)(cmaxf + e * 2048 + n0 + nq);
    const f32x4 inv = {cm.x > 0.f ? 127.f / cm.x : 0.f, cm.y > 0.f ? 127.f / cm.y : 0.f, cm.z > 0.f ? 127.f / cm.z : 0.f, cm.w > 0.f ? 127.f / cm.w : 0.f};
    if (kb == 0 && c.lane < 8) *(f32x4*)(wsc + e * 2048 + r0 + nq) = cm * (1.f / 127.f);
    f32x4 v[8];
#pragma unroll
    for (int i = 0; i < 8; ++i) v[i] = *(const f32x4*)(src + (size_t)(8 * i + (c.lane >> 3)) * 2048 + nq);
    LDS_WAIT();
#pragma unroll
    for (int i = 0; i < 8; ++i) { const int kk = 8 * i + (c.lane >> 3);
      scr8[(nq + 0) * 80 + kk] = (unsigned char)(int)rintf(v[i].x * inv.x); scr8[(nq + 1) * 80 + kk] = (unsigned char)(int)rintf(v[i].y * inv.y);
      scr8[(nq + 2) * 80 + kk] = (unsigned char)(int)rintf(v[i].z * inv.z); scr8[(nq + 3) * 80 + kk] = (unsigned char)(int)rintf(v[i].w * inv.w); }
    LDS_WAIT();
    const int n = c.lane >> 1, hk = c.lane & 1;
    const u32x4 o0 = *(const LAS u32x4*)(scr8 + n * 80 + 32 * hk), o1 = *(const LAS u32x4*)(scr8 + n * 80 + 32 * hk + 16);
    signed char* dst = w8 + ((size_t)e * 2048 + r0 + n) * 1024 + 64 * kb + 32 * hk;
    *(u32x4*)dst = o0; *(u32x4*)(dst + 16) = o1;
  }
}
#endif

DI void wdn_light(const Ctx& c, LAS bf16_t* scr, int wi, int nw) {
  unsigned char* ws = c.p.ws;
  for (int r = wi; r < 32 * 16 * 32; r += nw) { const int e = r / 512, q = r % 512, kb = q / 32, nb = q % 32;
    const float* src = c.p.in[I_WDN] + (size_t)e * 1024 * 1024 + (size_t)(64 * kb) * 1024 + 32 * nb; bf16_t* dst = (bf16_t*)(ws + WS_WDN) + ((size_t)e * 1024 + 32 * nb) * 1024 + 64 * kb;
    const int nq = 4 * (c.lane & 7); f32x4 v[8];
#pragma unroll
    for (int i = 0; i < 8; ++i) v[i] = *(const f32x4*)(src + (size_t)(8 * i + (c.lane >> 3)) * 1024 + nq);
    LDS_WAIT();
#pragma unroll
    for (int i = 0; i < 8; ++i) { const int kk = 8 * i + (c.lane >> 3); const unsigned a = pk_bf16(v[i].x, v[i].y), b = pk_bf16(v[i].z, v[i].w);
      scr[(nq + 0) * 72 + kk] = (bf16_t)(a & 0xffffu); scr[(nq + 1) * 72 + kk] = (bf16_t)(a >> 16); scr[(nq + 2) * 72 + kk] = (bf16_t)(b & 0xffffu); scr[(nq + 3) * 72 + kk] = (bf16_t)(b >> 16); }
    LDS_WAIT();
    const int n = c.lane >> 1, hk = c.lane & 1;
#pragma unroll
    for (int j = 0; j < 4; ++j) *(u32x4*)(dst + (size_t)n * 1024 + 32 * hk + 8 * j) = *(const LAS u32x4*)(scr + n * 72 + 32 * hk + 8 * j);
  }
}

#if GATE_I8
DI void phase0c(const Ctx& c) {
  unsigned char* ws = c.p.ws; const float* cmaxf = (const float*)(ws + WS_CMAXG); float* wgs = (float*)(ws + WS_WGS); signed char* w8 = (signed char*)(ws + WS_WG8);
  LAS float* scr = (LAS float*)(c.lds + c.wave * 8448);
  for (int r = c.gw; r < 16 * 96; r += c.ngw) { const int kb = r / 96, grp = r % 96;
    const float* src = c.p.in[I_WIN] + (size_t)(64 * kb) * 7176 + 4104 + 32 * grp;
#pragma unroll
    for (int i = 0; i < 8; ++i) { const int kk = 8 * i + (c.lane >> 3); const f32x4 v = *(const f32x4*)(src + (size_t)kk * 7176 + 4 * (c.lane & 7));
      LAS float* sp = scr + kk * 33 + 4 * (c.lane & 7); sp[0] = v.x; sp[1] = v.y; sp[2] = v.z; sp[3] = v.w; }
    LDS_WAIT();
    const int n = c.lane >> 1, hk = c.lane & 1; const float cm = cmaxf[32 * grp + n], inv = cm > 0.f ? 127.f / cm : 0.f;
    if (kb == 0 && hk == 0) wgs[32 * grp + n] = cm * (1.f / 127.f);
    u32x4 o[2];
#pragma unroll
    for (int g = 0; g < 8; ++g) { unsigned w = 0;
#pragma unroll
      for (int b = 0; b < 4; ++b) { const int qv = (int)rintf(scr[(32 * hk + 4 * g + b) * 33 + n] * inv); w |= ((unsigned)qv & 0xffu) << (8 * b); }
      o[g >> 2][g & 3] = w; }
    signed char* dst = w8 + (size_t)(32 * grp + n) * 1024 + 64 * kb + 32 * hk;
    *(u32x4*)dst = o[0]; *(u32x4*)(dst + 16) = o[1];
    LDS_WAIT();
  }
}
#endif

DI void phase_gdn_norm(const Ctx& c) {
  bf16_t* ycat = (bf16_t*)(c.p.ws + WS_YCAT); const bf16_t* proj = (const bf16_t*)(c.p.ws + WS_PROJ); const float* nw = c.p.in[I_GNW];
  const float w0 = nw[2 * c.lane], w1 = nw[2 * c.lane + 1];
  for (int it = c.gw; it < TT * 4; it += c.ngw) {
    const int t = it >> 2, hh = it & 3;
    unsigned* op = (unsigned*)(ycat + (size_t)t * 1536 + hh * 128) + c.lane; const unsigned ov = *op, zv = *((const unsigned*)(proj + (size_t)t * NPROJ + C_GZ + hh * 128) + c.lane);
    const float o0 = bflo(ov), o1 = bfhi(ov), z0 = bflo(zv), z1 = bfhi(zv);
    const float rs = rsqrtf(wave_sum(o0 * o0 + o1 * o1) * (1.f / 128.f) + NORM_EPS);
    *op = pk_bf16(o0 * rs * w0 * (z0 * sigmoidf_(z0)), o1 * rs * w1 * (z1 * sigmoidf_(z1)));
  }
}

#if ROUTER_LDS
DI void phase_router(const Ctx& c) {
  unsigned char* ws = c.p.ws;
  const float* h = (const float*)(ws + WS_H); bf16_t* x1h = (bf16_t*)(ws + WS_X1);
  const float* wT = (const float*)(ws + WS_WRT); int* gcount = (int*)(ws + WS_MISC + MiB); u32x2* rinfo = (u32x2*)(ws + WS_RINFO);
  constexpr int XS = 1028;
  LAS float* xs = (LAS float*)c.lds;
  LAS int* wcnt = (LAS int*)(c.lds + 131584); LAS int* bbase = wcnt + 32; LAS float* tsl = (LAS float*)(bbase + 32);
  LAS int* sel_e = (LAS int*)(tsl + 128); LAS int* sel_pos = sel_e + 512; LAS float* sel_g = (LAS float*)(sel_e + 1024);
  const int e = c.lane & 31, hf = c.lane >> 5;
  f32x4 gam[4], bet[4];
#pragma unroll
  for (int j = 0; j < 4; ++j) { gam[j] = ((const f32x4*)c.p.in[I_LN1G])[64 * j + c.lane]; bet[j] = ((const f32x4*)c.p.in[I_LN1B])[64 * j + c.lane]; }
  for (int gi = c.bid; gi < TT / 128; gi += c.G) {
    const int tokg = gi * 128;
    if (c.tid < 32) wcnt[c.tid] = 0;
    f32x4 vn[4];
    { const f32x4* hr0 = (const f32x4*)(h + ((size_t)tokg + c.wave * 4) * DM) + c.lane;
#pragma unroll
      for (int j = 0; j < 4; ++j) vn[j] = hr0[64 * j]; }
    for (int sg = 0; sg < 4; ++sg) {
      for (int i = 0; i < 4; ++i) {
        const int r = c.wave * 4 + i; const size_t t = (size_t)tokg + sg * 32 + r; f32x4 v[4]; float s = 0.f;
#pragma unroll
        for (int j = 0; j < 4; ++j) { v[j] = vn[j]; s += (v[j].x + v[j].y) + (v[j].z + v[j].w); }
        { const int tn = (i < 3) ? (int)t + 1 : (sg < 3 ? tokg + (sg + 1) * 32 + c.wave * 4 : (int)t);
          const f32x4* hrn = (const f32x4*)(h + (size_t)tn * DM) + c.lane;
#pragma unroll
          for (int j = 0; j < 4; ++j) vn[j] = hrn[64 * j]; }
        const float mean = wave_sum(s) * (1.f / DM); float s2 = 0.f;
#pragma unroll
        for (int j = 0; j < 4; ++j) { v[j] = v[j] - mean; s2 += (v[j].x * v[j].x + v[j].y * v[j].y) + (v[j].z * v[j].z + v[j].w * v[j].w); }
        const float rstd = rsqrtf(wave_sum(s2) * (1.f / DM) + LN_EPS);
        f32x4 y[4]; float am = 0.f;
#pragma unroll
        for (int j = 0; j < 4; ++j) { y[j] = v[j] * rstd * gam[j] + bet[j]; *(LAS f32x4*)(xs + r * XS + 256 * j + 4 * c.lane) = y[j];
          u32x2 o; o.x = pk_bf16(y[j].x, y[j].y); o.y = pk_bf16(y[j].z, y[j].w); ((u32x2*)(x1h + t * DM))[64 * j + c.lane] = o;
          am = fmaxf(fmaxf(am, fmaxf(fabsf(y[j].x), fabsf(y[j].y))), fmaxf(fabsf(y[j].z), fabsf(y[j].w))); }
        am = wave_max(am); const float qs = am > 0.f ? 127.f / am : 0.f;
        if (c.lane == 0) tsl[sg * 32 + r] = am * (1.f / 127.f);
#pragma unroll
        for (int j = 0; j < 4; ++j) { const unsigned w = ((unsigned)(int)rintf(y[j].x * qs) & 0xffu) | (((unsigned)(int)rintf(y[j].y * qs) & 0xffu) << 8) | (((unsigned)(int)rintf(y[j].z * qs) & 0xffu) << 16) | (((unsigned)(int)rintf(y[j].w * qs) & 0xffu) << 24);
          ((unsigned*)(ws + WS_X1Q + t * DM))[64 * j + c.lane] = w; }
      }
      __syncthreads();
      f32x16 acc;
      if (c.wave < 4) {
        const float* ap = wT + (size_t)e * DM + 256 * c.wave + 128 * hf; const LAS float* bp = xs + e * XS + 256 * c.wave + 128 * hf;
#pragma unroll
        for (int i = 0; i < 16; ++i) acc[i] = 0.f;
        f32x4 a4 = *(const f32x4*)ap, a4n = *(const f32x4*)(ap + 4);
        for (int q = 0; q < 32; ++q) {
          const f32x4 a4nn = *(const f32x4*)(ap + 4 * (q + 2 < 32 ? q + 2 : 31)); const f32x4 b4 = *(const LAS f32x4*)(bp + 4 * q);
#pragma unroll
          for (int j = 0; j < 4; ++j) acc = __builtin_amdgcn_mfma_f32_32x32x2f32(a4[j], b4[j], acc, 0, 0, 0);
          a4 = a4n; a4n = a4nn;
        }
      }
      __syncthreads();
      if (c.wave < 4) {
#pragma unroll
        for (int rg = 0; rg < 16; ++rg) xs[(c.wave * 32 + crow(rg, hf)) * 32 + e] = acc[rg];
      }
      __syncthreads();
      if (c.wave == 4) {
        float L[32];
#pragma unroll
        for (int q = 0; q < 32; ++q) L[q] = ((xs[q * 32 + e] + xs[(32 + q) * 32 + e]) + (xs[(64 + q) * 32 + e] + xs[(96 + q) * 32 + e])) + c.p.in[I_BR][q];
        float tv[4]; int ti[4];
#pragma unroll
        for (int k = 0; k < 4; ++k) {
          float bv = L[0]; int bi = 0;
#pragma unroll
          for (int q = 1; q < 32; ++q) { const bool g = L[q] > bv; bv = g ? L[q] : bv; bi = g ? q : bi; }
          tv[k] = bv; ti[k] = bi;
#pragma unroll
          for (int q = 0; q < 32; ++q) L[q] = (q == bi) ? -INFINITY : L[q];
        }
        const float e1 = __expf(tv[1] - tv[0]), e2 = __expf(tv[2] - tv[0]), e3 = __expf(tv[3] - tv[0]), inv = 1.f / (1.f + e1 + e2 + e3);
        if (hf == 0) {
          const float gk[4] = {inv, e1 * inv, e2 * inv, e3 * inv};
#pragma unroll
          for (int k = 0; k < 4; ++k) { const int si = (sg * 32 + e) * 4 + k; sel_e[si] = ti[k]; sel_g[si] = gk[k]; sel_pos[si] = (int)__hip_atomic_fetch_add((LAS unsigned*)(wcnt + ti[k]), 1u, __ATOMIC_RELAXED, __HIP_MEMORY_SCOPE_WORKGROUP); }
        }
      }
      __syncthreads();
    }
    if (c.tid < 32) { const int tot = wcnt[c.tid]; bbase[c.tid] = (tot && !(c.p.flags & 16)) ? atomicAdd(gcount + c.tid, tot) : 0; }
    __syncthreads();
    if (!(c.p.flags & 16)) {
      const int ek = sel_e[c.tid];
      u32x2 info; info.x = (unsigned)(tokg * 4 + c.tid); info.y = __float_as_uint(sel_g[c.tid]);
      rinfo[(size_t)ek * ECAP + bbase[ek] + sel_pos[c.tid]] = info;
      ((float*)(ws + WS_RSC))[(size_t)ek * ECAP + bbase[ek] + sel_pos[c.tid]] = tsl[c.tid >> 2];
    }
    __syncthreads();
  }
}
#else
DI void phase_router(const Ctx& c) {
  unsigned char* ws = c.p.ws;
  const float* h = (const float*)(ws + WS_H); float* x1 = (float*)(ws + WS_X1); bf16_t* x1b = (bf16_t*)(ws + WS_X1B);
  const float* wT = (const float*)(ws + WS_WRT); int* gcount = (int*)(ws + WS_MISC + MiB); u32x2* rinfo = (u32x2*)(ws + WS_RINFO);
  LAS int* wcnt = (LAS int*)(c.lds);
  LAS int* bbase = wcnt + 256;
  LAS float* tsl = (LAS float*)(c.lds + 16384);
  LAS int* sel_e = bbase + 32; LAS int* sel_pos = sel_e + 512; LAS float* sel_g = (LAS float*)(sel_e + 1024);
  const int e = c.lane & 31, hf = c.lane >> 5;
  f32x4 gam[4], bet[4];
#pragma unroll
  for (int j = 0; j < 4; ++j) { gam[j] = ((const f32x4*)c.p.in[I_LN1G])[64 * j + c.lane]; bet[j] = ((const f32x4*)c.p.in[I_LN1B])[64 * j + c.lane]; }
  float brl[32];
#pragma unroll
  for (int q = 0; q < 32; ++q) brl[q] = c.p.in[I_BR][q];
  for (int gi = c.bid; gi < TT / 128; gi += c.G) {
    const int tokg = gi * 128;
    if (c.tid < 32) wcnt[c.tid] = 0;
    {
      const f32x4* hr0 = (const f32x4*)(h + ((size_t)tokg + c.wave * 16) * DM) + c.lane; f32x4 vn[4];
#pragma unroll
      for (int j = 0; j < 4; ++j) vn[j] = hr0[64 * j];
      for (int tt = 0; tt < 16; ++tt) {
        const size_t t = (size_t)tokg + c.wave * 16 + tt; f32x4 v[4]; float s = 0.f;
#pragma unroll
        for (int j = 0; j < 4; ++j) { v[j] = vn[j]; s += (v[j].x + v[j].y) + (v[j].z + v[j].w); }
        { const f32x4* hrn = (const f32x4*)(h + (t + (tt < 15 ? 1 : 0)) * DM) + c.lane;
#pragma unroll
          for (int j = 0; j < 4; ++j) vn[j] = hrn[64 * j]; }
        const float mean = wave_sum(s) * (1.f / DM); float s2 = 0.f;
#pragma unroll
        for (int j = 0; j < 4; ++j) { v[j] = v[j] - mean; s2 += (v[j].x * v[j].x + v[j].y * v[j].y) + (v[j].z * v[j].z + v[j].w * v[j].w); }
        const float rstd = rsqrtf(wave_sum(s2) * (1.f / DM) + LN_EPS);
#if MOE_I8
        f32x4 y[4]; float am = 0.f;
#pragma unroll
        for (int j = 0; j < 4; ++j) { y[j] = v[j] * rstd * gam[j] + bet[j]; ((f32x4*)(x1 + t * DM))[64 * j + c.lane] = y[j];
          am = fmaxf(fmaxf(am, fmaxf(fabsf(y[j].x), fabsf(y[j].y))), fmaxf(fabsf(y[j].z), fabsf(y[j].w))); }
        am = wave_max(am); const float qs = am > 0.f ? 127.f / am : 0.f;
        if (c.lane == 0) tsl[c.wave * 16 + tt] = am * (1.f / 127.f);
#pragma unroll
        for (int j = 0; j < 4; ++j) { const unsigned w = ((unsigned)(int)rintf(y[j].x * qs) & 0xffu) | (((unsigned)(int)rintf(y[j].y * qs) & 0xffu) << 8) | (((unsigned)(int)rintf(y[j].z * qs) & 0xffu) << 16) | (((unsigned)(int)rintf(y[j].w * qs) & 0xffu) << 24);
          ((unsigned*)(ws + WS_X1Q + t * DM))[64 * j + c.lane] = w; }
#else
#pragma unroll
        for (int j = 0; j < 4; ++j) { const f32x4 y = v[j] * rstd * gam[j] + bet[j];
          ((f32x4*)(x1 + t * DM))[64 * j + c.lane] = y; u32x2 o; o.x = pk_bf16(y.x, y.y); o.y = pk_bf16(y.z, y.w); ((u32x2*)(x1b + t * DM))[64 * j + c.lane] = o; }
#endif
      }
    }
    asm volatile("s_waitcnt vmcnt(0)" ::: "memory");
    __syncthreads();
    if (c.wave < 4) {
      const float* ap = wT + (size_t)e * DM + 512 * hf; const float* bp = x1 + ((size_t)tokg + c.wave * 32 + e) * DM + 512 * hf;
      f32x16 acc;
#pragma unroll
      for (int i = 0; i < 16; ++i) acc[i] = 0.f;
      f32x4 a4 = *(const f32x4*)ap, b4 = *(const f32x4*)bp, a4n = *(const f32x4*)(ap + 4), b4n = *(const f32x4*)(bp + 4);
      for (int q = 0; q < 128; ++q) {
        const int qn = q + 2 < 128 ? q + 2 : 127;
        const f32x4 a4nn = *(const f32x4*)(ap + 4 * qn), b4nn = *(const f32x4*)(bp + 4 * qn);
#pragma unroll
        for (int j = 0; j < 4; ++j) acc = __builtin_amdgcn_mfma_f32_32x32x2f32(a4[j], b4[j], acc, 0, 0, 0);
        a4 = a4n; b4 = b4n; a4n = a4nn; b4n = b4nn;
      }
      float L[32];
#pragma unroll
      for (int rg = 0; rg < 16; ++rg) { const float own = acc[rg], oth = __shfl_xor(own, 32); L[crow(rg, 0)] = (hf ? oth : own) + brl[crow(rg, 0)]; L[crow(rg, 1)] = (hf ? own : oth) + brl[crow(rg, 1)]; }
      float tv[4]; int ti[4];
#pragma unroll
      for (int k = 0; k < 4; ++k) {
        float bv = L[0]; int bi = 0;
#pragma unroll
        for (int q = 1; q < 32; ++q) { const bool g = L[q] > bv; bv = g ? L[q] : bv; bi = g ? q : bi; }
        tv[k] = bv; ti[k] = bi;
#pragma unroll
        for (int q = 0; q < 32; ++q) L[q] = (q == bi) ? -INFINITY : L[q];
      }
      const float e1 = __expf(tv[1] - tv[0]), e2 = __expf(tv[2] - tv[0]), e3 = __expf(tv[3] - tv[0]), inv = 1.f / (1.f + e1 + e2 + e3);
      if (hf == 0) {
        const float gk[4] = {inv, e1 * inv, e2 * inv, e3 * inv};
#pragma unroll
        for (int k = 0; k < 4; ++k) { const int si = (c.wave * 32 + e) * 4 + k; sel_e[si] = ti[k]; sel_g[si] = gk[k]; sel_pos[si] = (int)__hip_atomic_fetch_add((LAS unsigned*)(wcnt + ti[k]), 1u, __ATOMIC_RELAXED, __HIP_MEMORY_SCOPE_WORKGROUP); }
      }
    }
    __syncthreads();
    if (c.tid < 32) { const int tot = wcnt[c.tid]; bbase[c.tid] = (tot && !(c.p.flags & 16)) ? atomicAdd(gcount + c.tid, tot) : 0; }
    __syncthreads();
    if (!(c.p.flags & 16)) {
      const int ek = sel_e[c.tid];
      u32x2 info; info.x = (unsigned)(tokg * 4 + c.tid); info.y = __float_as_uint(sel_g[c.tid]);
      rinfo[(size_t)ek * ECAP + bbase[ek] + sel_pos[c.tid]] = info;
#if MOE_I8
      ((float*)(ws + WS_RSC))[(size_t)ek * ECAP + bbase[ek] + sel_pos[c.tid]] = tsl[c.tid >> 2];
#endif
    }
    __syncthreads();
  }
}

#endif

DI void build_group_tab(const Ctx& c, LAS int* tab) {
  const int* gcount = (const int*)(c.p.ws + WS_MISC + MiB);
  __syncthreads();
  if (c.tid == 0) { int ps = 0;
    for (int e = 0; e < 32; ++e) { const int cnt = gcount[e]; tab[e] = cnt; tab[32 + e] = ps; const int nt_ = (cnt + 255) >> 8; for (int q = 0; q < nt_; ++q) tab[96 + (ps >> 8) + q] = e; ps += nt_ << 8; }
    tab[64] = ps; tab[65] = ps >> 8; }
  __syncthreads();
}

DI void phase_final(const Ctx& c) {
  const float* x1 = (const float*)(c.p.ws + WS_X1); const bf16_t* yp = (const bf16_t*)(c.p.ws + WS_YPAIR);
  f32x4 gam[4], bet[4];
#pragma unroll
  for (int j = 0; j < 4; ++j) { gam[j] = ((const f32x4*)c.p.in[I_LN2G])[64 * j + c.lane]; bet[j] = ((const f32x4*)c.p.in[I_LN2B])[64 * j + c.lane]; }
  for (int t = c.gw; t < TT; t += c.ngw) {
    f32x4 v[4]; float s = 0.f;
#pragma unroll
    for (int j = 0; j < 4; ++j) {
#if ROUTER_LDS
      { const u32x2 xw = ((const u32x2*)((const bf16_t*)x1 + (size_t)t * DM))[64 * j + c.lane]; v[j] = (f32x4){bflo(xw.x), bfhi(xw.x), bflo(xw.y), bfhi(xw.y)} * DN_ALPHA; }
#else
      v[j] = ((const f32x4*)(x1 + (size_t)t * DM))[64 * j + c.lane] * DN_ALPHA;
#endif
#pragma unroll
      for (int k = 0; k < 4; ++k) { const u32x2 w = ((const u32x2*)(yp + ((size_t)t * 4 + k) * DM))[64 * j + c.lane]; v[j].x += bflo(w.x); v[j].y += bfhi(w.x); v[j].z += bflo(w.y); v[j].w += bfhi(w.y); }
      s += (v[j].x + v[j].y) + (v[j].z + v[j].w); }
    const float mean = wave_sum(s) * (1.f / DM); float s2 = 0.f;
#pragma unroll
    for (int j = 0; j < 4; ++j) { v[j] = v[j] - mean; s2 += (v[j].x * v[j].x + v[j].y * v[j].y) + (v[j].z * v[j].z + v[j].w * v[j].w); }
    const float rstd = rsqrtf(wave_sum(s2) * (1.f / DM) + LN_EPS);
#pragma unroll
    for (int j = 0; j < 4; ++j) ((f32x4*)(c.p.out + (size_t)t * DM))[64 * j + c.lane] = v[j] * rstd * gam[j] + bet[j];
  }
}
DI bf16x8 pack8(const f32x16& x, int s) {
  u32x4 p; p.x = pk_bf16(x[8 * s + 0], x[8 * s + 1]); p.y = pk_bf16(x[8 * s + 2], x[8 * s + 3]); p.z = pk_bf16(x[8 * s + 4], x[8 * s + 5]); p.w = pk_bf16(x[8 * s + 6], x[8 * s + 7]);
  return __builtin_bit_cast(bf16x8, p);
}
DI void store8(bf16_t* dst, const f32x16& x, int s, float sc) {
  u32x4 p; p.x = pk_bf16(x[8 * s + 0] * sc, x[8 * s + 1] * sc); p.y = pk_bf16(x[8 * s + 2] * sc, x[8 * s + 3] * sc); p.z = pk_bf16(x[8 * s + 4] * sc, x[8 * s + 5] * sc); p.w = pk_bf16(x[8 * s + 6] * sc, x[8 * s + 7] * sc);
  *(u32x4*)dst = p;
}

#if !NAIVE_GDN
DI void phase_gdn_chunk(const Ctx& c) {
  unsigned char* ws = c.p.ws;
  const bf16_t* proj = (const bf16_t*)(ws + WS_PROJ); const float* gbeta = (const float*)(ws + WS_MISC); const float* wcv = c.p.in[I_WCONV];
  float* egl = (float*)(ws + WS_MISC + MiB + 4096);
  const int team = c.wave >> 2, tw = c.wave & 3, ttid = c.tid & 255, r = c.lane & 31, hf = c.lane >> 5;
  LAS unsigned char* tl = c.lds + team * 71680;
  LAS bf16_t* ks = (LAS bf16_t*)tl; LAS bf16_t* qs = (LAS bf16_t*)(tl + 17408); LAS bf16_t* kT = (LAS bf16_t*)(tl + 34816); LAS bf16_t* vT = (LAS bf16_t*)(tl + 53248);
  LAS float* Am = (LAS float*)(tl + 17408); LAS bf16_t* T1 = (LAS bf16_t*)tl; LAS bf16_t* T2 = (LAS bf16_t*)(tl + 9216);
  LAS float* sc = (LAS float*)(c.lds + 143360 + team * 1024);
  float wc[3][2][4];
  const int nchunk = NB * 4 * 32, niter = (nchunk + 2 * c.G - 1) / (2 * c.G);
  for (int itr = 0; itr < niter; ++itr) {
    const int ci_raw = (itr * c.G + c.bid) * 2 + team; const int ci = ci_raw < nchunk ? ci_raw : 0;
    const int n = ci & 31, hh = (ci >> 5) & 3, b = ci >> 7; const int tok0 = b * SEQ + n * 64;
    unsigned char* cb = ws + WS_GDN + (size_t)ci * GDN_CHUNK_BYTES;
#pragma unroll
    for (int part = 0; part < 3; ++part)
#pragma unroll
      for (int e = 0; e < 2; ++e)
#pragma unroll
        for (int j = 0; j < 4; ++j) wc[part][e][j] = wcv[j * 1536 + part * 512 + hh * 128 + 2 * c.lane + e];
    const float gl = gbeta[(size_t)(tok0 + c.lane) * 8 + hh], bt = gbeta[(size_t)(tok0 + c.lane) * 8 + 4 + hh];
    float gc = gl;
#pragma unroll
    for (int off = 1; off < 64; off <<= 1) { const float o2 = __shfl_up(gc, off); if (c.lane >= off) gc += o2; }
    const float glast = __shfl(gc, 63);
    if (tw == 0) { sc[c.lane] = gc; sc[64 + c.lane] = bt; sc[128 + c.lane] = __expf(glast - gc); if (c.lane == 0) egl[ci] = __expf(glast); }
    unsigned pvn[3][7];
#pragma unroll
    for (int part = 0; part < 3; ++part)
#pragma unroll
      for (int rr = 0; rr < 7; ++rr) { const int tl2 = n * 64 + tw * 16 - 3 + rr; pvn[part][rr] = tl2 >= 0 ? *(const unsigned*)(proj + (size_t)(tok0 + tw * 16 - 3 + rr) * NPROJ + part * 512 + hh * 128 + 2 * c.lane) : 0u; }
    for (int i4 = 0; i4 < 16; i4 += 4) {
    unsigned pv[3][7];
#pragma unroll
    for (int part = 0; part < 3; ++part)
#pragma unroll
      for (int rr = 0; rr < 7; ++rr) pv[part][rr] = pvn[part][rr];
    if (i4 < 12) {
#pragma unroll
      for (int part = 0; part < 3; ++part)
#pragma unroll
        for (int rr = 0; rr < 7; ++rr) pvn[part][rr] = *(const unsigned*)(proj + (size_t)(tok0 + tw * 16 + i4 + 4 - 3 + rr) * NPROJ + part * 512 + hh * 128 + 2 * c.lane);
    }
    unsigned kprev = 0u, vprev = 0u;
#pragma unroll
    for (int ii = 0; ii < 4; ++ii) {
      const int cc = tw * 16 + i4 + ii; float val[3][2];
#pragma unroll
      for (int part = 0; part < 3; ++part) { float a0 = 0.f, a1 = 0.f;
#pragma unroll
        for (int j = 0; j < 4; ++j) { a0 += wc[part][0][j] * bflo(pv[part][ii + j]); a1 += wc[part][1][j] * bfhi(pv[part][ii + j]); }
        val[part][0] = a0 * sigmoidf_(a0); val[part][1] = a1 * sigmoidf_(a1); }
      const float sq = wave_sum(val[0][0] * val[0][0] + val[0][1] * val[0][1]), sk = wave_sum(val[1][0] * val[1][0] + val[1][1] * val[1][1]);
      const float rq = rsqrtf(sq + NORM_EPS) * 0.08838834764831845f, rk = rsqrtf(sk + NORM_EPS);
      const float q0 = val[0][0] * rq, q1 = val[0][1] * rq, k0 = val[1][0] * rk, k1 = val[1][1] * rk;
      const unsigned kp = pk_bf16(k0, k1), vp = pk_bf16(val[2][0], val[2][1]);
      *(LAS unsigned*)(qs + cc * 136 + 2 * c.lane) = pk_bf16(q0, q1); *(LAS unsigned*)(ks + cc * 136 + 2 * c.lane) = kp;
      if (ii & 1) {
        *(LAS unsigned*)(kT + (2 * c.lane) * 72 + cc - 1) = (kprev & 0xffffu) | (kp << 16); *(LAS unsigned*)(kT + (2 * c.lane + 1) * 72 + cc - 1) = (kprev >> 16) | (kp & 0xffff0000u);
        *(LAS unsigned*)(vT + (2 * c.lane) * 72 + cc - 1) = (vprev & 0xffffu) | (vp << 16); *(LAS unsigned*)(vT + (2 * c.lane + 1) * 72 + cc - 1) = (vprev >> 16) | (vp & 0xffff0000u);
      }
      kprev = kp; vprev = vp;
      const float eg = __expf(__shfl(gc, cc));
      { const int pos = swap23(2 * c.lane); *(unsigned*)(cb + 16384 + (size_t)cc * 256 + 16 * ((pos >> 3) ^ (cc & 15)) + 2 * (pos & 7)) = pk_bf16(q0 * eg, q1 * eg); }
    }
    }
    __syncthreads();
    if (c.p.flags & 4) continue;
    const int mi = tw >> 1, ni = tw & 1;
    f32x16 akk, aat;
#pragma unroll
    for (int i = 0; i < 16; ++i) { akk[i] = 0.f; aat[i] = 0.f; }
#pragma unroll
    for (int s = 0; s < 8; ++s) { const bf16x8 ka = *(const LAS bf16x8*)(ks + (32 * mi + r) * 136 + 16 * s + 8 * hf);
      akk = MFMA32(ka, *(const LAS bf16x8*)(ks + (32 * ni + r) * 136 + 16 * s + 8 * hf), akk);
      aat = MFMA32(ka, *(const LAS bf16x8*)(qs + (32 * ni + r) * 136 + 16 * s + 8 * hf), aat); }
    {
      const int cout = 32 * ni + r; const float gco = sc[cout];
#pragma unroll
      for (int i = 0; i < 16; ++i) { const int cr = 32 * mi + crow(i, hf); aat[i] = cout >= cr ? aat[i] * __expf(gco - sc[cr]) : 0.f; }
      { unsigned char* rp = cb + 49152 + (size_t)cout * 128; const int sw = (cout >> 1) & 7; store8((bf16_t*)(rp + 16 * ((4 * mi + hf) ^ sw)), aat, 0, 1.f); store8((bf16_t*)(rp + 16 * ((4 * mi + 2 + hf) ^ sw)), aat, 1, 1.f); }
    }
    __syncthreads();
    { const int j = 32 * ni + r; const float gcj = sc[j];
#pragma unroll
      for (int i = 0; i < 16; ++i) { const int cr = 32 * mi + crow(i, hf); Am[cr * 64 + j] = cr > j ? akk[i] * __expf(sc[cr] - gcj) * sc[64 + cr] : 0.f; } }
    __syncthreads();
    if (c.p.flags & 8) continue;
    {
      LAS float* Pt = (LAS float*)tl;
      if (c.lane < 16) {
        const int pb = tw, j = c.lane; float t[16];
#pragma unroll
        for (int i = 0; i < 16; ++i) {
          float a0 = 0.f, a1 = 0.f;
#pragma unroll
          for (int m4 = 0; m4 < i; m4 += 4) { const f32x4 av = *(const LAS f32x4*)(Am + (16 * pb + i) * 64 + 16 * pb + m4);
            a0 += av.x * t[m4]; if (m4 + 1 < i) a1 += av.y * t[m4 + 1]; if (m4 + 2 < i) a0 += av.z * t[m4 + 2]; if (m4 + 3 < i) a1 += av.w * t[m4 + 3]; }
          t[i] = (j == i ? 1.f : 0.f) - (a0 + a1);
        }
        LDS_WAIT();
#pragma unroll
        for (int i = 0; i < 16; ++i) Am[(16 * pb + i) * 64 + 16 * pb + j] = t[i];
      }
      for (int it = ttid; it < 1024; it += 256) { const int dk = it >> 3, s = (it >> 1) & 3, h2 = it & 1;
        const u32x2 lo = *(const LAS u32x2*)(kT + dk * 72 + 16 * s + 4 * h2), hi = *(const LAS u32x2*)(kT + dk * 72 + 16 * s + 8 + 4 * h2);
        const LAS float* e0 = sc + 128 + 16 * s + 4 * h2; const LAS float* e1 = e0 + 8;
        u32x4 o; o.x = pk_bf16(bflo(lo.x) * e0[0], bfhi(lo.x) * e0[1]); o.y = pk_bf16(bflo(lo.y) * e0[2], bfhi(lo.y) * e0[3]);
        o.z = pk_bf16(bflo(hi.x) * e1[0], bfhi(hi.x) * e1[1]); o.w = pk_bf16(bflo(hi.y) * e1[2], bfhi(hi.y) * e1[3]);
        *(u32x4*)(cb + 32768 + (size_t)dk * 128 + 16 * ((2 * s + h2) ^ ((dk >> 1) & 7))) = o; }
      __syncthreads();
      const int ii = ttid >> 4, jj = ttid & 15;
#pragma unroll
      for (int pb = 1; pb < 4; ++pb) {
#pragma unroll
        for (int q = 0; q < pb; ++q) {
          float acc = 0.f;
#pragma unroll
          for (int r2 = q; r2 < pb; ++r2)
#pragma unroll
            for (int m4 = 0; m4 < 16; m4 += 4) { const f32x4 av = *(const LAS f32x4*)(Am + (16 * pb + ii) * 64 + 16 * r2 + m4); const LAS float* tp = Am + (16 * r2 + m4) * 64 + 16 * q + jj;
              acc += av.x * tp[0] + av.y * tp[64] + av.z * tp[128] + av.w * tp[192]; }
          Pt[q * 256 + ii * 16 + jj] = acc;
        }
        __syncthreads();
#pragma unroll
        for (int q = 0; q < pb; ++q) {
          float acc = 0.f;
#pragma unroll
          for (int m4 = 0; m4 < 16; m4 += 4) { const f32x4 tv = *(const LAS f32x4*)(Am + (16 * pb + ii) * 64 + 16 * pb + m4); const LAS float* pp = Pt + q * 256 + m4 * 16 + jj;
            acc += tv.x * pp[0] + tv.y * pp[16] + tv.z * pp[32] + tv.w * pp[48]; }
          Am[(16 * pb + ii) * 64 + 16 * q + jj] = -acc;
        }
        __syncthreads();
      }
      float tv2[16];
#pragma unroll
      for (int k = 0; k < 16; ++k) tv2[k] = Am[(ttid >> 6) * 64 + k * 256 + (ttid & 63)];
      const float bj = sc[64 + (ttid & 63)], bej = bj * __expf(sc[ttid & 63]);
      __syncthreads();
#pragma unroll
      for (int k = 0; k < 16; ++k) { const int row = 4 * k + (ttid >> 6); T1[row * 72 + (ttid & 63)] = f2bf(tv2[k] * bj); T2[row * 72 + (ttid & 63)] = f2bf(tv2[k] * bej); }
    }
    __syncthreads();
#pragma unroll
    for (int q = 0; q < 2; ++q) {
      const int job = tw * 2 + q;
      const int mu = job & 1, nu = job >> 1, mw = job >> 1, nw = job & 1;
      f32x16 au, aw;
#pragma unroll
      for (int i = 0; i < 16; ++i) { au[i] = 0.f; aw[i] = 0.f; }
#pragma unroll
      for (int s = 0; s < 4; ++s) {
        au = MFMA32(*(const LAS bf16x8*)(T1 + (32 * mu + r) * 72 + 16 * s + 8 * hf), *(const LAS bf16x8*)(vT + (32 * nu + r) * 72 + 16 * s + 8 * hf), au);
        aw = MFMA32(*(const LAS bf16x8*)(kT + (32 * mw + r) * 72 + 16 * s + 8 * hf), *(const LAS bf16x8*)(T2 + (32 * nw + r) * 72 + 16 * s + 8 * hf), aw); }
      {
        bf16_t* up = (bf16_t*)(cb + 57344 + (size_t)(32 * nu + r) * 128) + 32 * mu + 8 * hf; store8(up, au, 0, 1.f); store8(up + 16, au, 1, 1.f);
        unsigned char* wp = cb + (size_t)(32 * nw + r) * 256; const int sw = (32 * nw + r) & 15; store8((bf16_t*)(wp + 16 * ((4 * mw + hf) ^ sw)), aw, 0, 1.f); store8((bf16_t*)(wp + 16 * ((4 * mw + 2 + hf) ^ sw)), aw, 1, 1.f); }
    }
    __syncthreads();
  }
}

DI void scan_unit(const Ctx& c, LAS unsigned char* sl) {
  const int bh = c.bid & 63, dv0 = (c.bid >> 6) * 32, b = bh >> 2, hh = bh & 3, r = c.lane & 31, hf = c.lane >> 5;
  const unsigned char* ws = c.p.ws; const float* egl = (const float*)(ws + WS_MISC + MiB + 4096); bf16_t* ycat = (bf16_t*)(c.p.ws + WS_YCAT);
  const unsigned char* cb0 = ws + WS_GDN + (size_t)(bh * 32) * GDN_CHUNK_BYTES;
  f32x16 S[4];
#pragma unroll
  for (int m = 0; m < 4; ++m)
#pragma unroll
    for (int i = 0; i < 16; ++i) S[m][i] = 0.f;
  const int sw16 = r & 15, sw8 = (r >> 1) & 7;
#define SCAN_DMA(buf, chunk) do { const unsigned char* _g = cb0 + (size_t)(chunk) * GDN_CHUNK_BYTES + c.lane * 16; LAS unsigned char* _l = sl + (buf) * 57344; \
    _Pragma("unroll") for (int _i = 0; _i < 56; ++_i) __builtin_amdgcn_global_load_lds((const unsigned*)(_g + _i * 1024), (LAS unsigned*)(_l + _i * 1024), 16, 0, 0); } while (0)
  SCAN_DMA(0, 0);
  u32x4 un[4];
#pragma unroll
  for (int q = 0; q < 4; ++q) un[q] = *(const u32x4*)(cb0 + 57344 + (size_t)(dv0 + r) * 128 + 32 * q + 16 * hf);
  for (int n = 0; n < 32; ++n) {
    asm volatile("s_waitcnt vmcnt(0)" ::: "memory");
    u32x4 uc[4];
#pragma unroll
    for (int q = 0; q < 4; ++q) uc[q] = un[q];
    const int nn = n < 31 ? n + 1 : 31;
    SCAN_DMA((n + 1) & 1, nn);
#pragma unroll
    for (int q = 0; q < 4; ++q) un[q] = *(const u32x4*)(cb0 + (size_t)nn * GDN_CHUNK_BYTES + 57344 + (size_t)(dv0 + r) * 128 + 32 * q + 16 * hf);
    const float eg = egl[bh * 32 + n];
    const LAS unsigned char* L = sl + (n & 1) * 57344;
    const LAS unsigned char* wL = L + r * 256; const LAS unsigned char* qL = L + 16384 + r * 256; const LAS unsigned char* kL = L + 32768 + r * 128; const LAS unsigned char* aL = L + 49152 + r * 128;
    bf16x8 Sb[8];
#pragma unroll
    for (int s = 0; s < 8; ++s) Sb[s] = pack8(S[s >> 1], s & 1);
    f32x16 vn[2], o[2];
#pragma unroll
    for (int m = 0; m < 2; ++m) {
#pragma unroll
      for (int i = 0; i < 16; ++i) { vn[m][i] = 0.f; o[m][i] = 0.f; }
#pragma unroll
      for (int s = 0; s < 8; ++s) { vn[m] = MFMA32(*(const LAS bf16x8*)(wL + m * 8192 + 16 * ((2 * s + hf) ^ sw16)), Sb[s], vn[m]); o[m] = MFMA32(*(const LAS bf16x8*)(qL + m * 8192 + 16 * ((2 * s + hf) ^ sw16)), Sb[s], o[m]); }
    }
#pragma unroll
    for (int m = 0; m < 2; ++m)
#pragma unroll
      for (int s2 = 0; s2 < 2; ++s2) { const u32x4 uv = uc[2 * m + s2];
#pragma unroll
        for (int q = 0; q < 4; ++q) { vn[m][8 * s2 + 2 * q] = bflo(uv[q]) - vn[m][8 * s2 + 2 * q]; vn[m][8 * s2 + 2 * q + 1] = bfhi(uv[q]) - vn[m][8 * s2 + 2 * q + 1]; } }
    bf16x8 vb[4];
#pragma unroll
    for (int s = 0; s < 4; ++s) vb[s] = pack8(vn[s >> 1], s & 1);
#pragma unroll
    for (int m = 0; m < 2; ++m)
#pragma unroll
      for (int s = 0; s < 4; ++s) o[m] = MFMA32(*(const LAS bf16x8*)(aL + m * 4096 + 16 * ((2 * s + hf) ^ sw8)), vb[s], o[m]);
#pragma unroll
    for (int m = 0; m < 4; ++m) {
#pragma unroll
      for (int i = 0; i < 16; ++i) S[m][i] *= eg;
#pragma unroll
      for (int s = 0; s < 4; ++s) S[m] = MFMA32(*(const LAS bf16x8*)(kL + m * 4096 + 16 * ((2 * s + hf) ^ sw8)), vb[s], S[m]);
    }
    bf16_t* yp = ycat + (size_t)(b * SEQ + n * 64) * 1536 + hh * 128 + dv0 + r;
#pragma unroll
    for (int m = 0; m < 2; ++m)
#pragma unroll
      for (int i = 0; i < 16; ++i) yp[(size_t)(32 * m + crow(i, hf)) * 1536] = f2bf(o[m][i]);
  }
  asm volatile("s_waitcnt vmcnt(0)" ::: "memory");
#undef SCAN_DMA
}
#endif

#if !NAIVE_ATTN
DI void load_v64(u32x4 (&vr)[4], const bf16_t* vsrc, size_t ld, int lane) {
#pragma unroll
  for (int i = 0; i < 4; ++i) { const int q = lane + 64 * i; vr[i] = *(const u32x4*)(vsrc + (size_t)(q >> 3) * ld + (q & 7) * 8); }
}
DI void put_v64(LAS bf16_t* vl, const u32x4 (&vr)[4], int lane) {
#pragma unroll
  for (int i = 0; i < 4; ++i) { const int q = lane + 64 * i; *(LAS u32x4*)(vl + (q >> 3) * 64 + (q & 7) * 8) = vr[i]; }
}
DI bf16x8 gather_vt(const LAS bf16_t* vl, int m, int s, int lane) {
  const int i16 = lane & 15, q = i16 >> 2, pp = i16 & 3, g16 = (lane >> 4) & 1, hf = lane >> 5;
  const LAS bf16_t* a0 = vl + (16 * s + 4 * hf + q) * 64 + 32 * m + 16 * g16 + 4 * pp;
  const s16x4 lo = __builtin_amdgcn_ds_read_tr16_b64_v4i16((LAS s16x4*)a0), hi = __builtin_amdgcn_ds_read_tr16_b64_v4i16((LAS s16x4*)(a0 + 8 * 64));
  return __builtin_shufflevector(lo, hi, 0, 1, 2, 3, 4, 5, 6, 7);
}
constexpr float SB_EXIT = 40.f;
#define SB_TILE(Kc, Vc, KT) do { \
    LDS_WAIT(); \
    put_v64(vl, Vc, c.lane); \
    _Pragma("unroll") for (int i = 0; i < 4; ++i) { const int q = c.lane + 64 * i; *(LAS u32x4*)(kl + (q >> 3) * 72 + (q & 7) * 8) = Kc[i]; } \
    { const int kp = (KT) - 3 > 0 ? (KT) - 3 : 0;          \
      load_v64(Kc, kbase + (size_t)(32 * kp) * NPROJ, NPROJ, c.lane); load_v64(Vc, vbase + (size_t)(32 * kp) * NPROJ, NPROJ, c.lane); } \
    LDS_WAIT(); \
    f32x16 z; \
    _Pragma("unroll") for (int i = 0; i < 16; ++i) z[i] = 0.f; \
    _Pragma("unroll") for (int s = 0; s < 4; ++s) z = MFMA32(*(const LAS bf16x8*)(kl + r * 72 + 16 * s + 8 * hf), Qf[s], z); \
    float sp[16]; \
    _Pragma("unroll") for (int i = 0; i < 16; ++i) { z[i] *= 0.125f; const bool valid = ((KT) < qt) || (crow(i, hf) < r); sp[i] = valid ? softplus_fast(z[i]) : 0.f; } \
    float mine[4], oth[4], both[4]; \
    _Pragma("unroll") for (int g = 0; g < 4; ++g) { mine[g] = (sp[4 * g] + sp[4 * g + 1]) + (sp[4 * g + 2] + sp[4 * g + 3]); oth[g] = __shfl_xor(mine[g], 32); both[g] = mine[g] + oth[g]; } \
    float tail[4]; tail[3] = 0.f; tail[2] = both[3]; tail[1] = both[3] + both[2]; tail[0] = tail[1] + both[1]; \
    _Pragma("unroll") for (int g = 0; g < 4; ++g) { \
      float run = carry + tail[g] + (hf == 0 ? oth[g] : 0.f); \
      _Pragma("unroll") for (int q = 3; q >= 0; --q) { const int i = 4 * g + q; run += sp[i]; const bool valid = ((KT) < qt) || (crow(i, hf) < r); z[i] = valid ? __expf(z[i] - run) : 0.f; } \
    } \
    carry += tail[0] + both[0]; \
    const bf16x8 w0 = pack8(z, 0), w1 = pack8(z, 1); \
    LDS_WAIT(); \
    _Pragma("unroll") for (int m = 0; m < 2; ++m) { O[m] = MFMA32(gather_vt(vl, m, 0, c.lane), w0, O[m]); O[m] = MFMA32(gather_vt(vl, m, 1, c.lane), w1, O[m]); } \
  } while (0)
DI void sb_unit(const Ctx& c, int u, LAS bf16_t* vl) {
  const bf16_t* proj = (const bf16_t*)(c.p.ws + WS_PROJ); bf16_t* ycat = (bf16_t*)(c.p.ws + WS_YCAT);
  const int qt = 63 - (u & 63), hh = (u >> 6) & 7, b = u >> 9, r = c.lane & 31, hf = c.lane >> 5;
  const size_t tok0 = (size_t)b * SEQ + 32 * qt;
  LAS bf16_t* kl = vl + 2048;
  const bf16_t* kbase = proj + (size_t)b * SEQ * NPROJ + C_SK + hh * 64; const bf16_t* vbase = proj + (size_t)b * SEQ * NPROJ + C_SV + hh * 64;
  bf16x8 Qf[4]; u32x4 K0[4], V0[4], K1[4], V1[4], K2[4], V2[4];
  { const int k1 = qt > 0 ? qt - 1 : 0, k2 = qt > 1 ? qt - 2 : 0;
    load_v64(K0, kbase + (size_t)(32 * qt) * NPROJ, NPROJ, c.lane); load_v64(V0, vbase + (size_t)(32 * qt) * NPROJ, NPROJ, c.lane);
#pragma unroll
    for (int s = 0; s < 4; ++s) Qf[s] = *(const bf16x8*)(proj + (tok0 + r) * NPROJ + C_SQ + hh * 64 + 16 * s + 8 * hf);
    load_v64(K1, kbase + (size_t)(32 * k1) * NPROJ, NPROJ, c.lane); load_v64(V1, vbase + (size_t)(32 * k1) * NPROJ, NPROJ, c.lane);
    load_v64(K2, kbase + (size_t)(32 * k2) * NPROJ, NPROJ, c.lane); load_v64(V2, vbase + (size_t)(32 * k2) * NPROJ, NPROJ, c.lane); }
  f32x16 O[2];
#pragma unroll
  for (int m = 0; m < 2; ++m)
#pragma unroll
    for (int i = 0; i < 16; ++i) O[m][i] = 0.f;
  float carry = 0.f;
  for (int kt = qt; kt >= 0; kt -= 3) {
    SB_TILE(K0, V0, kt);
    if (kt - 1 < 0 || __all(carry > SB_EXIT)) break;
    SB_TILE(K1, V1, kt - 1);
    if (kt - 2 < 0 || __all(carry > SB_EXIT)) break;
    SB_TILE(K2, V2, kt - 2);
    if (__all(carry > SB_EXIT)) break;
  }
  bf16_t* yp = ycat + (tok0 + r) * 1536 + 512 + hh * 64;
#pragma unroll
  for (int m = 0; m < 2; ++m)
#pragma unroll
    for (int g = 0; g < 4; ++g) { u32x2 w; w.x = pk_bf16(O[m][4 * g], O[m][4 * g + 1]); w.y = pk_bf16(O[m][4 * g + 2], O[m][4 * g + 3]); *(u32x2*)(yp + 32 * m + 8 * g + 4 * hf) = w; }
}
#undef SB_TILE
DI bf16x8 gather_vt_p(const LAS bf16_t* vlp, int key0, int m, int s, int lane) {
  const int i16 = lane & 15, q = i16 >> 2, pp = i16 & 3, g16 = (lane >> 4) & 1, hf = lane >> 5;
  const LAS bf16_t* a0 = vlp + (key0 + 16 * s + 4 * hf + q) * 136 + 32 * m + 16 * g16 + 4 * pp;
  const s16x4 lo = __builtin_amdgcn_ds_read_tr16_b64_v4i16((LAS s16x4*)a0), hi = __builtin_amdgcn_ds_read_tr16_b64_v4i16((LAS s16x4*)(a0 + 8 * 136));
  return __builtin_shufflevector(lo, hi, 0, 1, 2, 3, 4, 5, 6, 7);
}
DI void mem_block(const Ctx& c) {
  const bf16_t* proj = (const bf16_t*)(c.p.ws + WS_PROJ); const bf16_t* mkv = (const bf16_t*)(c.p.ws + WS_MKV); bf16_t* ycat = (bf16_t*)(c.p.ws + WS_YCAT);
  LAS bf16_t* Kl = (LAS bf16_t*)c.lds; LAS bf16_t* Vl = Kl + 256 * 136;
  const int r = c.lane & 31, hf = c.lane >> 5;
  for (int it = c.bid; it < NB * 4 * 4; it += c.G) {
    const int bh = it >> 2, qq = it & 3, b = bh >> 2, hh = bh & 3;
    __syncthreads();
    { const bf16_t* ksrc = mkv + (size_t)b * MEMLEN * 1024 + hh * 128; const bf16_t* vsrc = ksrc + 512;
      u32x4 kr[8], vr[8];
#pragma unroll
      for (int j = 0; j < 8; ++j) { const int i = c.tid + 512 * j, key = i >> 4, pc = (i & 15) * 8; kr[j] = *(const u32x4*)(ksrc + (size_t)key * 1024 + pc); vr[j] = *(const u32x4*)(vsrc + (size_t)key * 1024 + pc); }
#pragma unroll
      for (int j = 0; j < 8; ++j) { const int i = c.tid + 512 * j, key = i >> 4, pc = (i & 15) * 8; *(LAS u32x4*)(Kl + key * 136 + pc) = kr[j]; *(LAS u32x4*)(Vl + key * 136 + pc) = vr[j]; } }
    __syncthreads();
    if (c.p.flags & 256) continue;
    for (int uq = 0; uq < 2; ++uq) {
      const int qt = qq * 16 + c.wave * 2 + uq; const size_t tok0 = (size_t)b * SEQ + 32 * qt;
      bf16x8 Qf[8];
#pragma unroll
      for (int s = 0; s < 8; ++s) Qf[s] = *(const bf16x8*)(proj + (tok0 + r) * NPROJ + C_MQ + hh * 128 + 16 * s + 8 * hf);
      f32x16 z[8];
#pragma unroll
      for (int kt = 0; kt < 8; ++kt) {
#pragma unroll
        for (int i = 0; i < 16; ++i) z[kt][i] = 0.f;
      }
#pragma unroll
      for (int s = 0; s < 8; ++s) {
#pragma unroll
        for (int kt = 0; kt < 8; ++kt) z[kt] = MFMA32(*(const LAS bf16x8*)(Kl + (32 * kt + r) * 136 + 16 * s + 8 * hf), Qf[s], z[kt]);
        asm volatile("" ::: "memory");
      }
      float tm = -INFINITY;
#pragma unroll
      for (int kt = 0; kt < 8; ++kt)
#pragma unroll
        for (int i = 0; i < 16; ++i) tm = fmaxf(tm, z[kt][i]);
      tm = fmaxf(tm, __shfl_xor(tm, 32)) * 0.08838834764831845f;
      float ps = 0.f;
      f32x16 O[4];
#pragma unroll
      for (int m = 0; m < 4; ++m)
#pragma unroll
        for (int i = 0; i < 16; ++i) O[m][i] = 0.f;
#pragma unroll
      for (int kt = 0; kt < 8; ++kt) {
#pragma unroll
        for (int i = 0; i < 16; ++i) { z[kt][i] = __expf(z[kt][i] * 0.08838834764831845f - tm); ps += z[kt][i]; }
        const bf16x8 w0 = pack8(z[kt], 0), w1 = pack8(z[kt], 1);
#pragma unroll
        for (int m = 0; m < 4; ++m) { O[m] = MFMA32(gather_vt_p(Vl, 32 * kt, m, 0, c.lane), w0, O[m]); O[m] = MFMA32(gather_vt_p(Vl, 32 * kt, m, 1, c.lane), w1, O[m]); }
        asm volatile("" ::: "memory");
      }
      ps += __shfl_xor(ps, 32);
      const float il = 1.f / ps;
      bf16_t* yp = ycat + (tok0 + r) * 1536 + 1024 + hh * 128;
#pragma unroll
      for (int m = 0; m < 4; ++m)
#pragma unroll
        for (int g = 0; g < 4; ++g) { u32x2 w; w.x = pk_bf16(O[m][4 * g] * il, O[m][4 * g + 1] * il); w.y = pk_bf16(O[m][4 * g + 2] * il, O[m][4 * g + 3] * il); *(u32x2*)(yp + 32 * m + 8 * g + 4 * hf) = w; }
    }
  }
  __syncthreads();
}
DI void phase_attn_scan(const Ctx& c) {
  __syncthreads();
#if !NAIVE_GDN
  if (c.wave == 0) { if (!(c.p.flags & 1)) scan_unit(c, c.lds); }
#if MOE_I8 && W8_BESIDE_SCAN
  else if (!(c.p.flags & 1)) {
    phase0b_light(c, c.lds + 114688 + (c.wave - 1) * 4608, c.bid * 7 + c.wave - 1, c.G * 7);
    wdn_light(c, (LAS bf16_t*)(c.lds + 114688 + (c.wave - 1) * 4608), c.bid * 7 + c.wave - 1, c.G * 7); }
#endif
  __syncthreads();
#endif
  if (c.p.flags & 2) return;
  if (!(c.p.flags & 64)) mem_block(c);
  LAS bf16_t* vl = (LAS bf16_t*)(c.lds + c.wave * 8704);
  if (!(c.p.flags & 128)) for (int u = c.gw; u < NB * 8 * 64; u += c.ngw) sb_unit(c, u, vl);
}
#endif
#if NAIVE_P5
DI void naive_mixed(const Ctx& c) {
  const bf16_t* ycat = (const bf16_t*)(c.p.ws + WS_YCAT); const bf16_t* wp = (const bf16_t*)(c.p.ws + WS_WP); const bf16_t* proj = (const bf16_t*)(c.p.ws + WS_PROJ); bf16_t* mixed = (bf16_t*)(c.p.ws + WS_MIXED);
  const int r = c.lane & 31, h = c.lane >> 5;
  for (int tile = c.gw; tile < (TT / 32) * 32; tile += c.ngw) {
    const int tm = tile >> 5, tn = tile & 31; float res[16];
#pragma unroll
    for (int i = 0; i < 16; ++i) res[i] = 0.f;
    for (int b = 0; b < 3; ++b) {
      const bf16_t* ap = ycat + (size_t)(tm * 32 + r) * 1536 + b * 512 + 8 * h; const bf16_t* bp = wp + (size_t)(tn * 32 + r) * 1536 + b * 512 + 8 * h;
      f32x16 acc; for (int i = 0; i < 16; ++i) acc[i] = 0.f;
      for (int k0 = 0; k0 < 512; k0 += 16) acc = MFMA32(*(const bf16x8*)(ap + k0), *(const bf16x8*)(bp + k0), acc);
#pragma unroll
      for (int i = 0; i < 16; ++i) res[i] += acc[i] * sigmoidf_(bf2f(proj[(size_t)(tm * 32 + crow(i, h)) * NPROJ + C_GATE + b * 1024 + tn * 32 + r]));
    }
#pragma unroll
    for (int i = 0; i < 16; ++i) mixed[(size_t)(tm * 32 + crow(i, h)) * DM + tn * 32 + r] = f2bf(res[i]);
  }
}
#endif
#if NAIVE_MOE
DI void naive_gateup(const Ctx& c, const LAS int* tab) {
  const bf16_t* x1b = (const bf16_t*)(c.p.ws + WS_X1B); const bf16_t* wgu = (const bf16_t*)(c.p.ws + WS_WGU); bf16_t* act = (bf16_t*)(c.p.ws + WS_ACT); const u32x2* rinfo = (const u32x2*)(c.p.ws + WS_RINFO);
  const float* bgu = c.p.in[I_BGU];
  const int r = c.lane & 31, h = c.lane >> 5, ntile = (tab[64] >> 5) * 32;
  for (int tile = c.gw; tile < ntile; tile += c.ngw) {
    const int tm = tile >> 5, tj = tile & 31, e = tab[96 + (tm >> 3)], local = tm * 32 + r - tab[32 + e];
    const int tok = local < tab[e] ? (int)(rinfo[(size_t)e * ECAP + local].x >> 2) : 0;
    const int j0 = tj * 32, wrow = (j0 >> 7) * 256 + (j0 & 127);
    const bf16_t* ap = x1b + (size_t)tok * DM + 8 * h; const bf16_t* bg = wgu + ((size_t)e * 2048 + wrow + r) * DM + 8 * h; const bf16_t* bl = bg + (size_t)128 * DM;
    f32x16 ag, al; for (int i = 0; i < 16; ++i) { ag[i] = 0.f; al[i] = 0.f; }
    for (int k0 = 0; k0 < DM; k0 += 16) { const bf16x8 a = *(const bf16x8*)(ap + k0); ag = MFMA32(a, *(const bf16x8*)(bg + k0), ag); al = MFMA32(a, *(const bf16x8*)(bl + k0), al); }
    const float bgv = bgu[(size_t)e * 2048 + j0 + r], blv = bgu[(size_t)e * 2048 + 1024 + j0 + r];
#pragma unroll
    for (int i = 0; i < 16; ++i) { const float glu = fminf(ag[i] + bgv, SWIGLU_LIMIT), lin = fminf(fmaxf(al[i] + blv, -SWIGLU_LIMIT), SWIGLU_LIMIT);
      act[(size_t)(tm * 32 + crow(i, h)) * DFF + j0 + r] = f2bf(glu * sigmoidf_(SWIGLU_ALPHA * glu) * (lin + 1.f)); }
  }
}
DI void naive_down(const Ctx& c, const LAS int* tab) {
  const bf16_t* act = (const bf16_t*)(c.p.ws + WS_ACT); const bf16_t* wdn = (const bf16_t*)(c.p.ws + WS_WDN); bf16_t* yp = (bf16_t*)(c.p.ws + WS_YPAIR); const u32x2* rinfo = (const u32x2*)(c.p.ws + WS_RINFO);
  const float* bdn = c.p.in[I_BDN];
  const int r = c.lane & 31, h = c.lane >> 5, ntile = (tab[64] >> 5) * 32;
  for (int tile = c.gw; tile < ntile; tile += c.ngw) {
    const int tm = tile >> 5, tn = tile & 31, e = tab[96 + (tm >> 3)];
    const bf16_t* ap = act + (size_t)(tm * 32 + r) * DFF + 8 * h; const bf16_t* bp = wdn + ((size_t)e * DM + tn * 32 + r) * DFF + 8 * h;
    f32x16 acc; for (int i = 0; i < 16; ++i) acc[i] = 0.f;
    for (int k0 = 0; k0 < DFF; k0 += 16) acc = MFMA32(*(const bf16x8*)(ap + k0), *(const bf16x8*)(bp + k0), acc);
    const float bv = bdn[(size_t)e * DM + tn * 32 + r];
#pragma unroll
    for (int i = 0; i < 16; ++i) { const int local = tm * 32 + crow(i, h) - tab[32 + e];
      if (local < tab[e]) { const u32x2 info = rinfo[(size_t)e * ECAP + local]; yp[(size_t)info.x * DM + tn * 32 + r] = f2bf((acc[i] + bv) * __uint_as_float(info.y)); } }
  }
}
#endif

DI void stagger(const Ctx& c, int ng, int step) {
  const int g = (c.bid >> 3) % ng;
  if (g && c.tid == 0) { const unsigned long long t0 = __builtin_amdgcn_s_memrealtime(), dt = (unsigned long long)(g * step); while (__builtin_amdgcn_s_memrealtime() - t0 < dt) __builtin_amdgcn_s_sleep(32); }
  __syncthreads();
}
__global__ void __launch_bounds__(512, 2) mega(Params p) {
  extern __shared__ __attribute__((aligned(16))) unsigned char lds_raw[];
  cg::grid_group grid = cg::this_grid();
  Ctx c; c.lds = (LAS unsigned char*)lds_raw; c.tid = threadIdx.x; c.lane = c.tid & 63; c.wave = __builtin_amdgcn_readfirstlane(c.tid >> 6);
  c.G = gridDim.x; c.bid = blockIdx.x; c.gw = c.bid * 8 + c.wave; c.ngw = c.G * 8; c.p = p;
  unsigned char* ws = p.ws;
  LAS int* gtab = (LAS int*)(c.lds + 131072);
#define IN(k) (p.ph_lo <= (k) && (k) < p.ph_hi)
  { volatile LAS unsigned* st = (volatile LAS unsigned*)(c.lds + 147440); if (c.tid < 4) st[c.tid] = 0u; }
  __syncthreads();
  const XcdBarrier xbar = xcd_barrier_post((unsigned*)(ws + WS_BAR) + p.pad * XCD_BAR_WORDS, (volatile LAS unsigned*)(c.lds + 147440));
#define SEAM(k) do { if ((k) + 1 < p.ph_hi) { if (USE_CG_ALL || (k) == 0) grid.sync(); else xcd_barrier(xbar); } } while (0)
#define REP(k)

  if (IN(0)) { REP(0) phase0(c);
#if GATE_I8
    xcd_barrier(xbar); phase0c(c);
#endif
    SEAM(0); }
  if (IN(1)) {
    REP(1) {
#if NAIVE_P1
    { bf16_t* proj = (bf16_t*)(ws + WS_PROJ); naive_gemm(c, (const bf16_t*)(ws + WS_XB), DM, (const bf16_t*)(ws + WS_WIN), DM, TT, NPROJ_N, DM, [&](int r, int cc, float v) { proj[(size_t)r * NPROJ + cc] = f2bf(v); }); }
    { bf16_t* mkv = (bf16_t*)(ws + WS_MKV); naive_gemm(c, (const bf16_t*)(ws + WS_MEMB), DM, (const bf16_t*)(ws + WS_WMKV), DM, NB * MEMLEN, DM, DM, [&](int r, int cc, float v) { mkv[(size_t)r * DM + cc] = f2bf(v); }); }
#else
#if MOE_I8 && !W8_BESIDE_SCAN
    phase0b(c); __syncthreads();
#endif
#if GATE_I8
    { pg8::Gemm g{(const bf16_t*)(ws + WS_XB), (const bf16_t*)(ws + WS_WIN), DM}; pg8::StaticOrder S; S.init(TT, C_GATE, c.G, c.bid); pg8::EpiStoreBf16 E{(bf16_t*)(ws + WS_PROJ), NPROJ, p.flags & 32, 1 << 30};
      pg8::gemm_phase<pg8::EpiStoreBf16, pg8::StaticOrder, true>(c.lds, g, S, E); }
    { pg8::Gemm g{(const bf16_t*)(ws + WS_XQ), (const bf16_t*)(ws + WS_WG8), DM}; pg8::StaticOrder S; S.init(TT, 3 * DM, c.G, c.bid);
      pg8::EpiGate8 E{(unsigned char*)(ws + WS_PROJ), NPROJ * 2, C_GATE * 2, (const float*)(ws + WS_TSC), (const float*)(ws + WS_WGS)};
      pg8::gemm_phase<pg8::EpiGate8, pg8::StaticOrder, true, true>(c.lds, g, S, E); }
#else
    { pg8::Gemm g{(const bf16_t*)(ws + WS_XB), (const bf16_t*)(ws + WS_WIN), DM}; pg8::StaticOrder S; S.init(TT, NPROJ_N, c.G, c.bid); pg8::EpiStoreBf16 E{(bf16_t*)(ws + WS_PROJ), NPROJ, p.flags & 32, C_GATE};
      pg8::gemm_phase<pg8::EpiStoreBf16, pg8::StaticOrder, true>(c.lds, g, S, E); }
#endif
    { pg8::Gemm g{(const bf16_t*)(ws + WS_MEMB), (const bf16_t*)(ws + WS_WMKV), DM}; pg8::StaticOrder S; S.init(NB * MEMLEN, DM, c.G, c.bid); pg8::EpiStoreBf16 E{(bf16_t*)(ws + WS_MKV), DM, 0, 1 << 30};
      pg8::gemm_phase<pg8::EpiStoreBf16, pg8::StaticOrder, true>(c.lds, g, S, E); }
#endif
    }
    SEAM(1);
  }
  if (IN(2)) {
#if NAIVE_GDN
    naive_gdn_prep(c);
#else
    phase_gdn_chunk(c);
#endif
    SEAM(2);
  }
  if (IN(3)) {
#if NAIVE_GDN
    naive_gdn_scan(c);
#endif
#if NAIVE_ATTN
    naive_sb(c); naive_mem(c);
#else
    phase_attn_scan(c);
#endif
    SEAM(3);
  }
  if (IN(4)) { phase_gdn_norm(c); SEAM(4); }
  if (IN(5)) {
#if NAIVE_P5
    naive_mixed(c);
#else
    REP(5) {
    pg8::Gemm g{(const bf16_t*)(ws + WS_YCAT), (const bf16_t*)(ws + WS_WP), 1536}; pg8::StaticOrder S; S.init(TT, DM, c.G, c.bid); pg8::EpiMixed E{(const unsigned char*)(ws + WS_PROJ), (bf16_t*)(ws + WS_MIXED)};
    pg8::gemm_phase<pg8::EpiMixed, pg8::StaticOrder, true>(c.lds, g, S, E);
    }
#endif
    SEAM(5);
  }
  if (IN(6)) {
#if NAIVE_P6
    { const float* x = p.in[I_X]; float* hh = (float*)(ws + WS_H);
      naive_gemm(c, (const bf16_t*)(ws + WS_MIXED), DM, (const bf16_t*)(ws + WS_WO), DM, TT, DM, DM, [&](int r, int cc, float v) { hh[(size_t)r * DM + cc] = DN_ALPHA * x[(size_t)r * DM + cc] + v; }); }
#else
    REP(6) {
    pg8::Gemm g{(const bf16_t*)(ws + WS_MIXED), (const bf16_t*)(ws + WS_WO), DM}; pg8::StaticOrder S; S.init(TT, DM, c.G, c.bid); pg8::EpiH E{p.in[I_X], (float*)(ws + WS_H)};
    pg8::gemm_phase<pg8::EpiH, pg8::StaticOrder, true>(c.lds, g, S, E);
    }
#endif
    SEAM(6);
  }
  if (IN(7)) { phase_router(c); SEAM(7); }
  if (IN(8)) {
    build_group_tab(c, gtab);
#if NAIVE_MOE
    naive_gateup(c, gtab);
#else
    REP(8) {
#if MOE_I8
    pg8::Gemm g{(const bf16_t*)(ws + WS_X1Q), (const bf16_t*)(ws + WS_WGU), DM}; pg8::GroupOrder S{gtab, (const u32x2*)(ws + WS_RINFO), 8, c.G, c.bid, 1};
    pg8::EpiGateUpI8 E{p.in[I_BGU], (const float*)(ws + WS_WSC), (const float*)(ws + WS_RSC), gtab, (bf16_t*)(ws + WS_ACT)};
    pg8::gemm_phase<pg8::EpiGateUpI8, pg8::GroupOrder, ALIGN_MOE, true>(c.lds, g, S, E);
#else
    pg8::Gemm g{(const bf16_t*)(ws + WS_X1B), (const bf16_t*)(ws + WS_WGU), DM}; pg8::GroupOrder S{gtab, (const u32x2*)(ws + WS_RINFO), 8, c.G, c.bid, 1}; pg8::EpiGateUp E{p.in[I_BGU], (bf16_t*)(ws + WS_ACT)};
    pg8::gemm_phase<pg8::EpiGateUp, pg8::GroupOrder, ALIGN_MOE>(c.lds, g, S, E);
#endif
    }
#endif
    SEAM(8);
  }
  if (IN(9)) {
    build_group_tab(c, gtab);
#if NAIVE_MOE
    naive_down(c, gtab);
#else
    REP(9) {
    pg8::Gemm g{(const bf16_t*)(ws + WS_ACT), (const bf16_t*)(ws + WS_WDN), DFF}; pg8::GroupOrder S{gtab, (const u32x2*)(ws + WS_RINFO), 4, c.G, c.bid, 0};
    pg8::EpiDown E{p.in[I_BDN], gtab, (const u32x2*)(ws + WS_RINFO), (bf16_t*)(ws + WS_YPAIR)};
    pg8::gemm_phase<pg8::EpiDown, pg8::GroupOrder, ALIGN_MOE>(c.lds, g, S, E);
    }
#endif
    SEAM(9);
  }
  if (IN(10)) { REP(10) phase_final(c); }
#undef IN
#undef SEAM
}

extern "C" void kernel_launch(void* const* d_in, const int* in_sizes, int n_in, void* d_out, int out_size, void* d_ws, size_t ws_size, hipStream_t stream) {
  static int grid_blocks = 0;
  if (grid_blocks == 0) {
    if (n_in != 22 || in_sizes[0] != TT * DM || out_size != TT * DM || ws_size < WS_NEED) {
      fprintf(stderr, "kernel_launch: built for 22 inputs, x/out of %d floats and >= %zu bytes of workspace; got n_in %d in0 %d out %d ws %zu; nothing launched\n", TT * DM, (size_t)WS_NEED, n_in, n_in > 0 ? in_sizes[0] : -1, out_size, ws_size);
      grid_blocks = -1; return; }
    int dev = 0, cus = 0, per_cu = 0;
    if (hipGetDevice(&dev) != hipSuccess || hipDeviceGetAttribute(&cus, hipDeviceAttributeMultiprocessorCount, dev) != hipSuccess) { grid_blocks = -1; return; }
    if (hipFuncSetAttribute((const void*)mega, hipFuncAttributeMaxDynamicSharedMemorySize, LDS_BYTES) != hipSuccess) { fprintf(stderr, "kernel_launch: hipFuncSetAttribute failed\n"); grid_blocks = -1; return; }
    if (hipOccupancyMaxActiveBlocksPerMultiprocessor(&per_cu, (const void*)mega, 512, LDS_BYTES) != hipSuccess || per_cu < 1) { fprintf(stderr, "kernel_launch: occupancy query says %d\n", per_cu); (void)hipGetLastError(); grid_blocks = -1; return; }
    grid_blocks = cus;
    fprintf(stderr, "kernel_launch: grid %d (cus %d, per_cu %d), ws %zu\n", grid_blocks, cus, per_cu, ws_size);
  }
  if (grid_blocks < 0) return;
  if (hipMemsetAsync((char*)d_ws + WS_BAR, 0, WS_ZERO_BYTES, stream) != hipSuccess) { fprintf(stderr, "kernel_launch: memset of the barrier words failed\n"); return; }
  Params p{};
  for (int i = 0; i < 22; ++i) p.in[i] = (const float*)d_in[i];
  p.out = (float*)d_out; p.ws = (unsigned char*)d_ws;
#if MK_SPLIT
  for (int ph = 0; ph < 11; ++ph) { p.ph_lo = ph; p.ph_hi = ph + 1; void* args[] = {&p};
    hipError_t e = hipLaunchCooperativeKernel((const void*)mega, dim3(grid_blocks), dim3(512), args, LDS_BYTES, stream);
    if (e != hipSuccess) { fprintf(stderr, "kernel_launch: launch of phase %d failed: %s\n", ph, hipGetErrorString(e)); break; } }
#elif REPEAT_PH >= 0
  for (int li = 0; li < 2; ++li) { p.ph_lo = li ? REPEAT_PH + SPLIT_ONLY : 0; p.ph_hi = li ? 11 : REPEAT_PH + 1; p.flags = li ? REPEAT_FLAGS : 0; p.pad = li; void* args[] = {&p};
    hipError_t e = hipLaunchCooperativeKernel((const void*)mega, dim3(grid_blocks), dim3(512), args, LDS_BYTES, stream);
    if (e != hipSuccess) { fprintf(stderr, "kernel_launch: launch %d failed: %s\n", li, hipGetErrorString(e)); break; } }
#else
  p.ph_lo = 0; p.ph_hi = 11; void* args[] = {&p};
  hipError_t e = hipLaunchCooperativeKernel((const void*)mega, dim3(grid_blocks), dim3(512), args, LDS_BYTES, stream);
  if (e != hipSuccess) fprintf(stderr, "kernel_launch: cooperative launch failed: %s (grid %d)\n", hipGetErrorString(e), grid_blocks);
#endif
}
```

```cpp
#define NAIVE_P1 0
#define NAIVE_GDN 0
#define NAIVE_ATTN 0
#define NAIVE_P5 0
#define NAIVE_P6 0
#define NAIVE_MOE 0
#define MK_SPLIT 0
#define REPEAT_PH -1
#define SPLIT_ONLY 0
#define REPEAT_FLAGS 0
#define USE_CG_ALL 0
#define ALIGN_MOE true
#define STAG_N 1
#define STAG_STEP 600
#define NT_STORE 1
#define MOE_I8 1
#define ROUTER_LDS 1
#define ATTN_SKIP_W4 1
#define NPROJ_LD 7168
#define W8_BESIDE_SCAN 1
#define GATE_I8 1
#define NAIVE_ANY (NAIVE_P1 || NAIVE_P6)
#include <hip/hip_runtime.h>
#include <hip/hip_cooperative_groups.h>
#include <cstdio>
#include <cstdint>
namespace cg = cooperative_groups;

#define DI __device__ __forceinline__
#define LAS __attribute__((address_space(3)))
typedef unsigned short bf16_t;
typedef short bf16x8 __attribute__((ext_vector_type(8)));
typedef float f32x2 __attribute__((ext_vector_type(2)));
typedef float f32x4 __attribute__((ext_vector_type(4)));
typedef float f32x16 __attribute__((ext_vector_type(16)));
typedef unsigned u32x2 __attribute__((ext_vector_type(2)));
typedef unsigned u32x4 __attribute__((ext_vector_type(4)));
typedef __bf16 bf16x2_t __attribute__((ext_vector_type(2)));

constexpr int NB = 16, SEQ = 2048, DM = 1024, TT = NB * SEQ;
constexpr int MEMLEN = 256, NEXP = 32, TOPK = 4, DFF = 1024;
constexpr int NPROJ_N = 7168;
constexpr int NPROJ = NPROJ_LD;
constexpr int C_GQ = 0, C_GK = 512, C_GV = 1024, C_GZ = 1536, C_SQ = 2048, C_SK = 2560, C_SV = 3072, C_MQ = 3584, C_GATE = 4096;
constexpr float LN_EPS = 1e-5f, NORM_EPS = 1e-6f;
constexpr float DN_ALPHA = 1.189207115002721f;
constexpr float SWIGLU_LIMIT = 7.0f, SWIGLU_ALPHA = 1.702f;
constexpr int ECAP = 32768;

constexpr size_t MiB = 1u << 20;
constexpr size_t WS_MISC = 0;
constexpr size_t WS_WDN = 3 * MiB, WS_WGU = 67 * MiB, WS_WIN = 195 * MiB, WS_WMKV = 209 * MiB, WS_WP = 211 * MiB, WS_WO = 214 * MiB;
constexpr size_t WS_XB = 216 * MiB, WS_MEMB = 280 * MiB, WS_MKV = 1016 * MiB  , WS_PROJ = 288 * MiB, WS_GDN = 744 * MiB, WS_YCAT = 888 * MiB, WS_RINFO = 1016 * MiB;
constexpr size_t WS_MIXED = WS_XB, WS_H = WS_GDN, WS_X1 = WS_YCAT, WS_X1B = WS_PROJ, WS_ACT = 360 * MiB, WS_YPAIR = 67 * MiB;
constexpr size_t WS_NEED = 1024 * MiB;
constexpr size_t GDN_CHUNK_BYTES = 73728;
constexpr int LDS_BYTES = 147456;

struct Params { const float* in[22]; float* out; unsigned char* ws; int ph_lo, ph_hi, flags, pad; };
enum { I_X = 0, I_MEM, I_WIN, I_WCONV, I_ALOG, I_DTB, I_GNW, I_WMKV, I_WPG, I_WPS, I_WPM, I_WO, I_LN1G, I_LN1B, I_WR, I_BR, I_WGU, I_BGU, I_WDN, I_BDN, I_LN2G, I_LN2B };

DI float bf2f(bf16_t v) { return __uint_as_float((unsigned)v << 16); }
DI unsigned pk_bf16(float a, float b) { f32x2 v = {a, b}; bf16x2_t r = __builtin_convertvector(v, bf16x2_t); return __builtin_bit_cast(unsigned, r); }
DI bf16_t f2bf(float a) { return (bf16_t)(pk_bf16(a, 0.f) & 0xffffu); }
DI float bflo(unsigned w) { return __uint_as_float(w << 16); }
DI float bfhi(unsigned w) { return __uint_as_float(w & 0xffff0000u); }
DI float sigmoidf_(float x) { return __frcp_rn(1.0f + __expf(-x)); }
DI float softplusf_(float x) { return x > 20.f ? x : log1pf(__expf(x)); }
DI float softplus_fast(float x) { return fmaxf(x, 0.f) + __logf(1.f + __expf(-fabsf(x))); }
typedef short s16x4 __attribute__((ext_vector_type(4)));
template <int CTRL, int RM> DI float dpp_mov0(float v) { return __builtin_bit_cast(float, __builtin_amdgcn_update_dpp(0, __builtin_bit_cast(int, v), CTRL, RM, 0xF, false)); }
DI float wave_sum(float v) {
  v += dpp_mov0<0xB1, 0xF>(v);
  v += dpp_mov0<0x4E, 0xF>(v);
  v += dpp_mov0<0x141, 0xF>(v);
  v += dpp_mov0<0x140, 0xF>(v);
  v += dpp_mov0<0x142, 0xA>(v);
  v += dpp_mov0<0x143, 0xC>(v);
  return __builtin_bit_cast(float, __builtin_amdgcn_readlane(__builtin_bit_cast(int, v), 63));
}
DI float wave_max(float v) {
  v = fmaxf(v, dpp_mov0<0xB1, 0xF>(v)); v = fmaxf(v, dpp_mov0<0x4E, 0xF>(v)); v = fmaxf(v, dpp_mov0<0x141, 0xF>(v)); v = fmaxf(v, dpp_mov0<0x140, 0xF>(v));
  v = fmaxf(v, dpp_mov0<0x142, 0xA>(v)); v = fmaxf(v, dpp_mov0<0x143, 0xC>(v));
  return __builtin_bit_cast(float, __builtin_amdgcn_readlane(__builtin_bit_cast(int, v), 63));
}
#define LDS_WAIT() asm volatile("s_waitcnt lgkmcnt(0)" ::: "memory")
#define VM_WAIT() asm volatile("s_waitcnt vmcnt(0)" ::: "memory")
#define MFMA32(a, b, c) __builtin_amdgcn_mfma_f32_32x32x16_bf16((a), (b), (c), 0, 0, 0)
DI int crow(int reg, int h) { return (reg & 3) + 8 * (reg >> 2) + 4 * h; }
DI int swap23(int k) { return (k & ~12) | ((k & 4) << 1) | ((k & 8) >> 1); }

#define XB_TMO      128
#define XB_XCNT(j)  (256  + 64 * (j))
#define XB_XSUB(j)  (1280 + 64 * (j))
#define XB_XGEN(j)  (2304 + 64 * (j))
#define XB_TOP      3328
#define XB_TOPGEN   3392
#define XCD_BAR_WORDS 3456
#define XB_SPIN_CAP (1u << 18)
DI unsigned xb_ld(unsigned* p)              { return __hip_atomic_load(p, __ATOMIC_RELAXED, __HIP_MEMORY_SCOPE_AGENT); }
DI unsigned xb_add(unsigned* p, unsigned v) { return __hip_atomic_fetch_add(p, v, __ATOMIC_RELAXED, __HIP_MEMORY_SCOPE_AGENT); }
DI unsigned xb_xcc_id() { return (unsigned)__builtin_amdgcn_s_getreg((3 << 11) | 20) & 0xFu; }
#define XB_SPIN(cond, bar) do { unsigned _sp = 0; while (cond) { __builtin_amdgcn_s_sleep(1); \
    if ((++_sp & 255u) == 0u) { if (xb_ld(&(bar)[XB_TMO])) break; if (_sp > XB_SPIN_CAP) { atomicAdd(&(bar)[XB_TMO], 1u); break; } } } } while (0)
struct XcdBarrier { unsigned* bar; unsigned x; volatile LAS unsigned* st; };
DI XcdBarrier xcd_barrier_post(unsigned* bar, volatile LAS unsigned* st) {
  XcdBarrier b; b.bar = bar; b.x = xb_xcc_id(); b.st = st;
  if (threadIdx.x == 0) (void)xb_add(&bar[XB_XCNT(b.x)], 1u);
  return b;
}
DI void xcd_barrier_complete(unsigned* bar, unsigned x, unsigned& nloc, unsigned& nx) {
  const unsigned G = gridDim.x * gridDim.y * gridDim.z;
  unsigned sum, cnt, mine, sp = 0u;
  for (;;) {
    sum = 0u; cnt = 0u; mine = 0u;
#pragma unroll
    for (unsigned j = 0; j < 16; ++j) { const unsigned c = xb_ld(&bar[XB_XCNT(j)]); sum += c; cnt += (c > 0u) ? 1u : 0u; mine = (j == x) ? c : mine; }
    if (sum == G) break;
    __builtin_amdgcn_s_sleep(1);
    if ((++sp & 255u) == 0u) { if (xb_ld(&bar[XB_TMO])) break; if (sp > XB_SPIN_CAP) { atomicAdd(&bar[XB_TMO], 1u); break; } }
  }
  nloc = mine > 0u ? mine : 1u; nx = cnt > 0u ? cnt : 1u;
}
DI void xcd_barrier(const XcdBarrier& b) {
  asm volatile("s_waitcnt vmcnt(0)" ::: "memory");
  __syncthreads();
  if (threadIdx.x == 0) {
    unsigned* bar = b.bar;
    __builtin_amdgcn_s_waitcnt(0);
    unsigned nloc = b.st[0], nx = b.st[1];
    if (nloc == 0u) { xcd_barrier_complete(bar, b.x, nloc, nx); b.st[0] = nloc; b.st[1] = nx; }
    const unsigned old = xb_add(&bar[XB_XSUB(b.x)], 1u);
    const unsigned gen = old / nloc;
    if (old + 1u == (gen + 1u) * nloc) {
      __builtin_amdgcn_fence(__ATOMIC_RELEASE, "agent");
      asm volatile("s_waitcnt vmcnt(0)" ::: "memory");
      const unsigned og = xb_add(&bar[XB_TOP], 1u);
      const unsigned tg = og / nx;
      if (og + 1u == (tg + 1u) * nx) xb_add(&bar[XB_TOPGEN], 1u);
      else XB_SPIN(xb_ld(&bar[XB_TOPGEN]) == tg, bar);
      __builtin_amdgcn_fence(__ATOMIC_ACQUIRE, "agent");
      xb_add(&bar[XB_XGEN(b.x)], 1u);
      asm volatile("s_waitcnt vmcnt(0)" ::: "memory");
    } else {
      XB_SPIN(xb_ld(&bar[XB_XGEN(b.x)]) == gen, bar);
      __builtin_amdgcn_fence(__ATOMIC_ACQUIRE, "agent");
      asm volatile("s_waitcnt vmcnt(0)" ::: "memory");
    }
  }
  __syncthreads();
}
constexpr size_t WS_WRT = 2 * MiB + 512 * 1024;
constexpr size_t WS_BAR = 2 * MiB;
constexpr size_t WS_CMAX = 2 * MiB + 64 * 1024;
constexpr size_t WS_ZERO_BYTES = 336 * 1024;
constexpr size_t WS_CMAXG = 2 * MiB + 320 * 1024;
constexpr size_t WS_WSC = 1 * MiB + 64 * 1024;
constexpr size_t WS_TSC = 2 * MiB + 768 * 1024;
constexpr size_t WS_RSC = 872 * MiB;
constexpr size_t WS_XQ = 744 * MiB;
constexpr size_t WS_WG8 = 776 * MiB;
constexpr size_t WS_WGS = 1 * MiB + 512 * 1024;
constexpr size_t WS_X1Q = 296 * MiB;
typedef int i32x4 __attribute__((ext_vector_type(4)));

struct Ctx {
  LAS unsigned char* lds;
  int tid, lane, wave, G, bid, gw, ngw;
  Params p;
};
namespace pg8 {
#if NT_STORE
#define NTST(v, p) __builtin_nontemporal_store((v), (p))
#else
#define NTST(v, p) (*(p) = (v))
#endif
constexpr int BM = 256, BK = 64, HALF = 128, HTB = HALF * BK * 2  , STAGE_BYTES = 8 * HTB, NXCD = 8, WGM = 8;
DI int lds_byte(int r, int c) { const int st = (r >> 4) * 2 + (c >> 5), rr = r & 15, cc = c & 31, ob = rr * 64 + cc * 2; return st * 1024 + (ob ^ (((ob >> 9) & 1) << 5)); }
DI void stage_rc(int b, int& R, int& C) { const int st = b / 1024, sb = b % 1024, swz = sb ^ (((sb >> 9) & 1) << 5); R = (st >> 1) * 16 + swz / 64; C = (st & 1) * 32 + (swz % 64) / 2; }
DI int perm32(int rho) { const int n = rho >> 4, i = rho & 15; return 8 * (i >> 2) + 4 * n + (i & 3); }

struct Unit { int pm, pn; };
struct Gemm { const bf16_t* A; const bf16_t* Bt; int K; };

struct StaticOrder {
  static constexpr bool LOADS = true;
  int nM, nN, nwg, G, c;
  DI void init(int M, int N, int G_, int c_) { nM = M / BM; nN = N / BM; nwg = nM * nN; G = G_; c = c_; }
  DI bool next(int i, Unit& u) const {
    const long L = (long)i * G + c; if (L >= nwg) return false;
    int wgid = (int)L; { const int q = nwg / NXCD, r = nwg % NXCD, xcd = wgid % NXCD, off = wgid / NXCD; wgid = (xcd < r ? xcd * (q + 1) : r * (q + 1) + (xcd - r) * q) + off; }
    const int nig = WGM * nN, gid = wgid / nig, fm = gid * WGM, gsz = (nM - fm) < WGM ? (nM - fm) : WGM;
    u.pm = fm + ((wgid % nig) % gsz); u.pn = (wgid % nig) / gsz; return true;
  }
  DI int arow(const Unit& u, int r) const { return u.pm * BM + r; }
};
struct GroupOrder {
  static constexpr bool LOADS = true;
  const LAS int* tab; const u32x2* rinfo; int ntn, G, c, gather;
  DI bool next(int i, Unit& u) const {
    const int L = i * G + c, NT = tab[65]; if (L >= NT * ntn) return false;
    const int tile = L / ntn, pnl = L - tile * ntn; u.pm = tile; u.pn = tab[96 + tile] * ntn + pnl; return true;
  }
  DI int arow(const Unit& u, int r) const {
    if (!gather) return u.pm * BM + r;
    const int e = tab[96 + u.pm], local = u.pm * BM + r - tab[32 + e];
    return local < tab[e] ? (int)(rinfo[(size_t)e * ECAP + local].x >> 2) : 0;
  }
};

template <class Epi, class Sched, bool ALIGN_EPI, bool I8 = false>
DI void gemm_phase(LAS unsigned char* lds, const Gemm g, const Sched& S, const Epi& E) {
  const int tid = threadIdx.x, wid = __builtin_amdgcn_readfirstlane(tid >> 6), lane = tid & 63, wr = wid >> 2, wc = wid & 3, fr = lane & 15, fq = lane >> 4;
  const int K = I8 ? g.K / 2 : g.K, nt = K / BK;
  int RA[2], CA[2]; unsigned voffB[2];
#pragma unroll
  for (int i = 0; i < 2; ++i) { int R, C; stage_rc(tid * 16 + i * 8192, R, C); const int Rb = Epi::PERM ? ((R & ~31) + perm32(R & 31)) : R; RA[i] = R; CA[i] = C; voffB[i] = (unsigned)(Rb * K + C) * 2u; }
  const size_t kstep = (size_t)(BK * 2);
  const size_t hstep = (size_t)HALF * K * 2;
  const size_t tstep = 2 * hstep;
  const unsigned ldsw = (unsigned)wid * 1024u;
  const int aoff = lds_byte(wr * 64 + fr, fq * 8), boff = lds_byte(wc * 32 + fr, fq * 8);
  const char* Ab = (const char*)g.A;
#define PG8_SA(b, h) (((b) * 2 + (h)) * HTB)
#define PG8_SB(b, h) ((4 + (b) * 2 + (h)) * HTB)
#define PG8_STAGE(bufoff, gbase, voff) do { _Pragma("unroll") for (int _i = 0; _i < 2; ++_i) \
    __builtin_amdgcn_global_load_lds((const unsigned*)((const char*)(gbase) + (voff)[_i]), (LAS unsigned*)(lds + (bufoff) + ldsw + _i * 8192), 16, 0, 0); } while (0)
#define PG8_LDA(dst, b, h) do { _Pragma("unroll") for (int m = 0; m < 4; ++m) _Pragma("unroll") for (int k = 0; k < 2; ++k) dst[m][k] = *(const LAS bf16x8*)(lds + PG8_SA(b, h) + aoff + m * 2048 + k * 1024); } while (0)
#define PG8_LDB(dst, b, h) do { _Pragma("unroll") for (int n = 0; n < 2; ++n) _Pragma("unroll") for (int k = 0; k < 2; ++k) dst[n][k] = *(const LAS bf16x8*)(lds + PG8_SB(b, h) + boff + n * 2048 + k * 1024); } while (0)
#define PG8_MMA(ai, bj, At, Bt) do { __builtin_amdgcn_s_setprio(1); _Pragma("unroll") for (int m = 0; m < 4; ++m) _Pragma("unroll") for (int n = 0; n < 2; ++n) _Pragma("unroll") for (int k = 0; k < 2; ++k) { \
    if constexpr (I8) acc[ai][bj][m][n] = __builtin_bit_cast(AccT, __builtin_amdgcn_mfma_i32_16x16x64_i8(__builtin_bit_cast(i32x4, Bt[n][k]), __builtin_bit_cast(i32x4, At[m][k]), __builtin_bit_cast(i32x4, acc[ai][bj][m][n]), 0, 0, 0)); \
    else acc[ai][bj][m][n] = __builtin_bit_cast(AccT, __builtin_amdgcn_mfma_f32_16x16x32_bf16(Bt[n][k], At[m][k], __builtin_bit_cast(f32x4, acc[ai][bj][m][n]), 0, 0, 0)); } __builtin_amdgcn_s_setprio(0); } while (0)
#define PG8_WAIT_V(n) asm volatile("s_waitcnt vmcnt(" #n ")" ::: "memory")
#define PG8_WAIT_L(n) asm volatile("s_waitcnt lgkmcnt(" #n ")" ::: "memory")
#define PG8_BAR __builtin_amdgcn_s_barrier()
#define PG8_SCHED __builtin_amdgcn_sched_barrier(0)
  Unit cur, nxt; int ui = 0;
  if (!S.next(0, cur)) return;
  typedef typename Epi::AccT AccT;
  AccT acc[2][2][4][2];
#pragma unroll
  for (int a = 0; a < 2; ++a)
#pragma unroll
    for (int b = 0; b < 2; ++b)
#pragma unroll
      for (int m = 0; m < 4; ++m)
#pragma unroll
        for (int n = 0; n < 2; ++n) acc[a][b][m][n] = (AccT){0, 0, 0, 0};
  bf16x8 At[4][2], B0[2][2], B1[2][2];
  unsigned cvo0[2], cvo1[2], nvo0[2], nvo1[2];
#pragma unroll
  for (int i = 0; i < 2; ++i) { cvo0[i] = ((unsigned)S.arow(cur, RA[i]) * (unsigned)K + (unsigned)CA[i]) * 2u; cvo1[i] = ((unsigned)S.arow(cur, HALF + RA[i]) * (unsigned)K + (unsigned)CA[i]) * 2u; }
  const char* cB = (const char*)g.Bt + (size_t)cur.pn * tstep;
  PG8_STAGE(PG8_SB(0, 0), cB, voffB); PG8_STAGE(PG8_SB(0, 1), cB + hstep, voffB); PG8_STAGE(PG8_SA(0, 0), Ab, cvo0); PG8_STAGE(PG8_SA(0, 1), Ab, cvo1);
  if (wr == 1) PG8_BAR;
  PG8_WAIT_V(2); PG8_BAR;
  PG8_STAGE(PG8_SB(1, 0), cB + kstep, voffB); PG8_STAGE(PG8_SA(1, 0), Ab + kstep, cvo0); PG8_STAGE(PG8_SB(1, 1), cB + hstep + kstep, voffB);
  PG8_WAIT_V(6); PG8_BAR;
  for (;;) {
    const bool has_next = S.next(ui + 1, nxt);
    if (!has_next) nxt = cur;
#pragma unroll
    for (int i = 0; i < 2; ++i) { nvo0[i] = ((unsigned)S.arow(nxt, RA[i]) * (unsigned)K + (unsigned)CA[i]) * 2u; nvo1[i] = ((unsigned)S.arow(nxt, HALF + RA[i]) * (unsigned)K + (unsigned)CA[i]) * 2u; }
    const char* nB = (const char*)g.Bt + (size_t)nxt.pn * tstep;
    for (int t = 0; t < nt; t += 2) {
      const bool last = (t == nt - 2);
      if constexpr (Epi::MIDHOOK) { if (t == 8 || t == 16) E.mid(acc, cur, (t >> 3) - 1, wr, wc, fr, fq); }
      const char* a1 = Ab + (size_t)(t + 1) * kstep;
      const char* a2 = last ? Ab : Ab + (size_t)(t + 2) * kstep; const char* b2 = last ? nB : cB + (size_t)(t + 2) * kstep;
      const char* a3 = a2 + kstep; const char* b3 = b2 + kstep;
      unsigned vo0[2], vo1[2];
      if constexpr (Sched::LOADS) {
        if (last) {
#pragma unroll
          for (int i = 0; i < 2; ++i) { vo0[i] = nvo0[i]; vo1[i] = nvo1[i]; }
        } else {
#pragma unroll
          for (int i = 0; i < 2; ++i) { vo0[i] = cvo0[i]; vo1[i] = cvo1[i]; }
        }
      } else {
#pragma unroll
        for (int i = 0; i < 2; ++i) { vo0[i] = last ? nvo0[i] : cvo0[i]; vo1[i] = last ? nvo1[i] : cvo1[i]; }
      }
      PG8_LDB(B0, 0, 0); PG8_LDB(B1, 0, 1); PG8_SCHED; PG8_LDA(At, 0, 0); PG8_STAGE(PG8_SA(1, 1), a1, cvo1);
      PG8_WAIT_V(8); PG8_WAIT_L(0); PG8_BAR; PG8_MMA(0, 0, At, B0); PG8_MMA(0, 1, At, B1); PG8_BAR; PG8_SCHED;
      PG8_LDA(At, 0, 1); PG8_STAGE(PG8_SB(0, 0), b2, voffB); PG8_STAGE(PG8_SB(0, 1), b2 + hstep, voffB); PG8_STAGE(PG8_SA(0, 0), a2, vo0);
      PG8_WAIT_V(8); PG8_WAIT_L(0); PG8_BAR; PG8_MMA(1, 0, At, B0); PG8_MMA(1, 1, At, B1); PG8_BAR; PG8_SCHED;
      PG8_LDB(B0, 1, 0); PG8_LDB(B1, 1, 1); PG8_SCHED; PG8_LDA(At, 1, 0); PG8_STAGE(PG8_SA(0, 1), a2, vo1);
      PG8_WAIT_V(8); PG8_WAIT_L(0); PG8_BAR; PG8_MMA(0, 0, At, B0); PG8_MMA(0, 1, At, B1); PG8_BAR; PG8_SCHED;
      PG8_LDA(At, 1, 1); PG8_STAGE(PG8_SB(1, 0), b3, voffB); PG8_STAGE(PG8_SB(1, 1), b3 + hstep, voffB); PG8_STAGE(PG8_SA(1, 0), a3, vo0);
      PG8_WAIT_V(8); PG8_WAIT_L(0); PG8_BAR; PG8_MMA(1, 0, At, B0); PG8_MMA(1, 1, At, B1); PG8_BAR; PG8_SCHED;
    }
    if constexpr (ALIGN_EPI) { if (wr == 0) PG8_BAR; }
    E(acc, cur, wr, wc, fr, fq);
    if (!has_next) break;
#pragma unroll
    for (int a = 0; a < 2; ++a)
#pragma unroll
      for (int b = 0; b < 2; ++b)
#pragma unroll
        for (int m = 0; m < 4; ++m)
#pragma unroll
          for (int n = 0; n < 2; ++n) acc[a][b][m][n] = (AccT){0, 0, 0, 0};
    cur = nxt; cB = nB; ++ui;
#pragma unroll
    for (int i = 0; i < 2; ++i) { cvo0[i] = nvo0[i]; cvo1[i] = nvo1[i]; }
    if constexpr (ALIGN_EPI) { if (wr == 1) PG8_BAR; }
  }
  PG8_WAIT_V(0);
  if constexpr (!ALIGN_EPI) { if (wr == 0) PG8_BAR; }
  PG8_BAR;
#undef PG8_SA
#undef PG8_SB
#undef PG8_STAGE
#undef PG8_LDA
#undef PG8_LDB
#undef PG8_MMA
#undef PG8_WAIT_V
#undef PG8_WAIT_L
#undef PG8_BAR
#undef PG8_SCHED
}

struct EpiStoreBf16 {
  typedef f32x4 AccT;
  static constexpr bool PERM = true, MIDHOOK = false;
  bf16_t* O; int ldc; int skip; int gcol0;
  DI static unsigned q8(float v) { const float g = __frcp_rn(1.f + __expf(-v)); return (unsigned)fminf(fmaxf(rintf(g * 255.f), 1.f), 255.f); }
  DI void operator()(const f32x4 (&acc)[2][2][4][2], const Unit& u, int wr, int wc, int fr, int fq) const {
    if (skip) { asm volatile("" :: "v"(acc[0][0][0][0]), "v"(acc[1][1][3][1])); return; }
    const int row0 = u.pm * BM + wr * 64 + fr, col0 = u.pn * BM + wc * 32 + 8 * fq;
    if (u.pn * BM >= gcol0) {
#pragma unroll
      for (int ai = 0; ai < 2; ++ai)
#pragma unroll
        for (int m = 0; m < 4; ++m) { unsigned char* rowp = (unsigned char*)O + (size_t)(row0 + ai * HALF + m * 16) * ldc * 2 + (size_t)gcol0 * 2 + (col0 - gcol0);
#pragma unroll
          for (int bj = 0; bj < 2; ++bj) { const f32x4 v0 = acc[ai][bj][m][0], v1 = acc[ai][bj][m][1];
            u32x2 w; w.x = q8(v0[0]) | (q8(v0[1]) << 8) | (q8(v0[2]) << 16) | (q8(v0[3]) << 24); w.y = q8(v1[0]) | (q8(v1[1]) << 8) | (q8(v1[2]) << 16) | (q8(v1[3]) << 24);
            NTST(w, (u32x2*)(rowp + bj * HALF)); } }
      return;
    }
#pragma unroll
    for (int ai = 0; ai < 2; ++ai)
#pragma unroll
      for (int m = 0; m < 4; ++m) { bf16_t* rowp = O + (size_t)(row0 + ai * HALF + m * 16) * ldc + col0;
#pragma unroll
        for (int bj = 0; bj < 2; ++bj) { const f32x4 v0 = acc[ai][bj][m][0], v1 = acc[ai][bj][m][1];
          u32x4 w; w.x = pk_bf16(v0[0], v0[1]); w.y = pk_bf16(v0[2], v0[3]); w.z = pk_bf16(v1[0], v1[1]); w.w = pk_bf16(v1[2], v1[3]);
          NTST(w, (u32x4*)(rowp + bj * HALF)); } }
  }
};
struct EpiMixed {
  typedef f32x4 AccT;
  static constexpr bool PERM = true, MIDHOOK = true;
  const unsigned char* gate8; bf16_t* O;
  DI void mid(f32x4 (&acc)[2][2][4][2], const Unit& u, int b, int wr, int wc, int fr, int fq) const {
    int row0 = u.pm * BM + wr * 64 + fr; const int col0 = u.pn * BM + wc * 32 + 8 * fq;
    asm volatile("" : "+v"(row0));
#pragma unroll
    for (int ai = 0; ai < 2; ++ai) {
      u32x2 ga[4][2], gb[4][2];
#pragma unroll
      for (int m = 0; m < 4; ++m) { const unsigned char* gp = gate8 + (size_t)(row0 + ai * HALF + m * 16) * (NPROJ * 2) + C_GATE * 2 + b * DM + col0;
#pragma unroll
        for (int bj = 0; bj < 2; ++bj) { ga[m][bj] = *(const u32x2*)(gp + bj * HALF); gb[m][bj] = *(const u32x2*)(gp + DM + bj * HALF); } }
#pragma unroll
      for (int m = 0; m < 4; ++m)
#pragma unroll
        for (int bj = 0; bj < 2; ++bj)
#pragma unroll
          for (int j = 0; j < 8; ++j) { const float a = (float)((ga[m][bj][j >> 2] >> (8 * (j & 3))) & 0xffu), bb = (float)((gb[m][bj][j >> 2] >> (8 * (j & 3))) & 0xffu);
            acc[ai][bj][m][j >> 2][j & 3] *= a * __frcp_rn(bb); }
      asm volatile("" ::: "memory");
    }
  }
  DI void operator()(const f32x4 (&acc)[2][2][4][2], const Unit& u, int wr, int wc, int fr, int fq) const {
    const int row0 = u.pm * BM + wr * 64 + fr, col0 = u.pn * BM + wc * 32 + 8 * fq;
#pragma unroll
    for (int ai = 0; ai < 2; ++ai) {
      u32x2 ga[4][2];
#pragma unroll
      for (int m = 0; m < 4; ++m) { const unsigned char* gp = gate8 + (size_t)(row0 + ai * HALF + m * 16) * (NPROJ * 2) + C_GATE * 2 + 2 * DM + col0;
#pragma unroll
        for (int bj = 0; bj < 2; ++bj) ga[m][bj] = *(const u32x2*)(gp + bj * HALF); }
#pragma unroll
      for (int m = 0; m < 4; ++m) { const int row = row0 + ai * HALF + m * 16;
#pragma unroll
        for (int bj = 0; bj < 2; ++bj) { float o[8];
#pragma unroll
          for (int j = 0; j < 8; ++j) o[j] = acc[ai][bj][m][j >> 2][j & 3] * ((float)((ga[m][bj][j >> 2] >> (8 * (j & 3))) & 0xffu) * (1.f / 255.f));
          u32x4 w; w.x = pk_bf16(o[0], o[1]); w.y = pk_bf16(o[2], o[3]); w.z = pk_bf16(o[4], o[5]); w.w = pk_bf16(o[6], o[7]);
          *(u32x4*)(O + (size_t)row * DM + col0 + bj * HALF) = w; } }
      asm volatile("" ::: "memory");
    }
  }
};
struct EpiH {
  typedef f32x4 AccT;
  static constexpr bool PERM = false, MIDHOOK = false;
  const float* x; float* h;
  DI void operator()(const f32x4 (&acc)[2][2][4][2], const Unit& u, int wr, int wc, int fr, int fq) const {
    const int row0 = u.pm * BM + wr * 64 + fr, col0 = u.pn * BM + wc * 32 + 4 * fq;
#pragma unroll
    for (int ai = 0; ai < 2; ++ai)
#pragma unroll
      for (int m = 0; m < 4; ++m) { const size_t off = (size_t)(row0 + ai * HALF + m * 16) * DM + col0;
#pragma unroll
        for (int bj = 0; bj < 2; ++bj)
#pragma unroll
          for (int n = 0; n < 2; ++n) { const f32x4 xv = *(const f32x4*)(x + off + bj * HALF + n * 16); *(f32x4*)(h + off + bj * HALF + n * 16) = xv * DN_ALPHA + acc[ai][bj][m][n]; }
        asm volatile("" ::: "memory"); }
  }
};
struct EpiGateUp {
  typedef f32x4 AccT;
  static constexpr bool PERM = true, MIDHOOK = false;
  const float* bgu; bf16_t* act;
  DI void operator()(const f32x4 (&acc)[2][2][4][2], const Unit& u, int wr, int wc, int fr, int fq) const {
    const int e = u.pn >> 3, pnl = u.pn & 7, row0 = u.pm * BM + wr * 64 + fr, j0 = pnl * 128 + wc * 32 + 8 * fq;
    f32x4 bg[2], bl[2];
#pragma unroll
    for (int n = 0; n < 2; ++n) { bg[n] = *(const f32x4*)(bgu + (size_t)e * 2048 + j0 + 4 * n); bl[n] = *(const f32x4*)(bgu + (size_t)e * 2048 + 1024 + j0 + 4 * n); }
#pragma unroll
    for (int ai = 0; ai < 2; ++ai)
#pragma unroll
      for (int m = 0; m < 4; ++m) { float o[8];
#pragma unroll
        for (int n = 0; n < 2; ++n)
#pragma unroll
          for (int j = 0; j < 4; ++j) { const float glu = fminf(acc[ai][0][m][n][j] + bg[n][j], SWIGLU_LIMIT); const float lin = fminf(fmaxf(acc[ai][1][m][n][j] + bl[n][j], -SWIGLU_LIMIT), SWIGLU_LIMIT);
            o[4 * n + j] = glu * __frcp_rn(1.f + __expf(-SWIGLU_ALPHA * glu)) * (lin + 1.f); }
        u32x4 w; w.x = pk_bf16(o[0], o[1]); w.y = pk_bf16(o[2], o[3]); w.z = pk_bf16(o[4], o[5]); w.w = pk_bf16(o[6], o[7]);
        *(u32x4*)(act + (size_t)(row0 + ai * HALF + m * 16) * DFF + j0) = w; }
  }
};
struct EpiGateUpI8 {
  typedef i32x4 AccT;
  static constexpr bool PERM = true, MIDHOOK = false;
  const float* bgu; const float* wsc; const float* rsc; const LAS int* tab; bf16_t* act;
  DI void operator()(const i32x4 (&acc)[2][2][4][2], const Unit& u, int wr, int wc, int fr, int fq) const {
    const int e = u.pn >> 3, pnl = u.pn & 7, row0 = u.pm * BM + wr * 64 + fr, j0 = pnl * 128 + wc * 32 + 8 * fq, r0 = pnl * 256 + wc * 32 + 8 * fq;
    const int local0 = row0 - tab[32 + e], cnt = tab[e];
    f32x4 bg[2], bl[2], sg[2], sl[2];
#pragma unroll
    for (int n = 0; n < 2; ++n) { bg[n] = *(const f32x4*)(bgu + (size_t)e * 2048 + j0 + 4 * n); bl[n] = *(const f32x4*)(bgu + (size_t)e * 2048 + 1024 + j0 + 4 * n);
      sg[n] = *(const f32x4*)(wsc + (size_t)e * 2048 + r0 + 4 * n); sl[n] = *(const f32x4*)(wsc + (size_t)e * 2048 + r0 + 128 + 4 * n); }
#pragma unroll
    for (int ai = 0; ai < 2; ++ai)
#pragma unroll
      for (int m = 0; m < 4; ++m) { const int local = local0 + ai * HALF + m * 16;
        const float sa = local < cnt ? rsc[(size_t)e * ECAP + local] : 0.f; float o[8];
#pragma unroll
        for (int n = 0; n < 2; ++n)
#pragma unroll
          for (int j = 0; j < 4; ++j) { const float glu = fminf((float)acc[ai][0][m][n][j] * (sa * sg[n][j]) + bg[n][j], SWIGLU_LIMIT);
            const float lin = fminf(fmaxf((float)acc[ai][1][m][n][j] * (sa * sl[n][j]) + bl[n][j], -SWIGLU_LIMIT), SWIGLU_LIMIT);
            o[4 * n + j] = glu * __frcp_rn(1.f + __expf(-SWIGLU_ALPHA * glu)) * (lin + 1.f); }
        u32x4 w; w.x = pk_bf16(o[0], o[1]); w.y = pk_bf16(o[2], o[3]); w.z = pk_bf16(o[4], o[5]); w.w = pk_bf16(o[6], o[7]);
        *(u32x4*)(act + (size_t)(row0 + ai * HALF + m * 16) * DFF + j0) = w; }
  }
};
struct EpiGate8 {
  typedef i32x4 AccT;
  static constexpr bool PERM = true, MIDHOOK = false;
  unsigned char* O; int ldcb; int gbyte0; const float* xsc; const float* wgs;
  DI static unsigned q8(float v) { const float g = __frcp_rn(1.f + __expf(-v)); return (unsigned)fminf(fmaxf(rintf(g * 255.f), 1.f), 255.f); }
  DI void operator()(const i32x4 (&acc)[2][2][4][2], const Unit& u, int wr, int wc, int fr, int fq) const {
    const int row0 = u.pm * BM + wr * 64 + fr, col0 = u.pn * BM + wc * 32 + 8 * fq;
    f32x4 sw[2][2];
#pragma unroll
    for (int bj = 0; bj < 2; ++bj)
#pragma unroll
      for (int n = 0; n < 2; ++n) sw[bj][n] = *(const f32x4*)(wgs + col0 + bj * HALF + 4 * n);
#pragma unroll
    for (int ai = 0; ai < 2; ++ai)
#pragma unroll
      for (int m = 0; m < 4; ++m) { const int row = row0 + ai * HALF + m * 16; const float sx = xsc[row]; unsigned char* rowp = O + (size_t)row * ldcb + gbyte0 + col0;
#pragma unroll
        for (int bj = 0; bj < 2; ++bj) { u32x2 w; unsigned q[8];
#pragma unroll
          for (int j = 0; j < 8; ++j) q[j] = q8((float)acc[ai][bj][m][j >> 2][j & 3] * (sx * sw[bj][j >> 2][j & 3]));
          w.x = q[0] | (q[1] << 8) | (q[2] << 16) | (q[3] << 24); w.y = q[4] | (q[5] << 8) | (q[6] << 16) | (q[7] << 24);
          NTST(w, (u32x2*)(rowp + bj * HALF)); } }
  }
};
struct EpiDown {
  typedef f32x4 AccT;
  static constexpr bool PERM = true, MIDHOOK = false;
  const float* bdn; const LAS int* tab; const u32x2* rinfo; bf16_t* ypair;
  DI void operator()(const f32x4 (&acc)[2][2][4][2], const Unit& u, int wr, int wc, int fr, int fq) const {
    const int e = u.pn >> 2, pnl = u.pn & 3, col0 = pnl * BM + wc * 32 + 8 * fq;
    const int local0 = u.pm * BM - tab[32 + e] + wr * 64 + fr, cnt = tab[e];
    f32x4 bv[2][2];
#pragma unroll
    for (int bj = 0; bj < 2; ++bj)
#pragma unroll
      for (int n = 0; n < 2; ++n) bv[bj][n] = *(const f32x4*)(bdn + (size_t)e * DM + col0 + bj * HALF + 4 * n);
#pragma unroll
    for (int ai = 0; ai < 2; ++ai)
#pragma unroll
      for (int m = 0; m < 4; ++m) { const int local = local0 + ai * HALF + m * 16;
        if (local < cnt) { const u32x2 info = rinfo[(size_t)e * ECAP + local]; const float gate = __uint_as_float(info.y); bf16_t* rowp = ypair + (size_t)info.x * DM + col0;
#pragma unroll
          for (int bj = 0; bj < 2; ++bj) { const f32x4 v0 = (acc[ai][bj][m][0] + bv[bj][0]) * gate, v1 = (acc[ai][bj][m][1] + bv[bj][1]) * gate;
            u32x4 w; w.x = pk_bf16(v0[0], v0[1]); w.y = pk_bf16(v0[2], v0[3]); w.z = pk_bf16(v1[0], v1[1]); w.w = pk_bf16(v1[2], v1[3]);
            *(u32x4*)(rowp + bj * HALF) = w; } } }
  }
};
}
#if NAIVE_ANY
template <class F> DI void naive_gemm(const Ctx& c, const bf16_t* A, int lda, const bf16_t* Bt, int ldb, int M, int N, int K, F epi) {
  const int r = c.lane & 31, h = c.lane >> 5, tn_n = N / 32, tiles = (M / 32) * tn_n;
  for (int tile = c.gw; tile < tiles; tile += c.ngw) {
    const int tm = tile / tn_n, tn = tile - tm * tn_n;
    const bf16_t* ap = A + (size_t)(tm * 32 + r) * lda + 8 * h; const bf16_t* bp = Bt + (size_t)(tn * 32 + r) * ldb + 8 * h;
    f32x16 acc; for (int i = 0; i < 16; ++i) acc[i] = 0.f;
    for (int k0 = 0; k0 < K; k0 += 16) { const bf16x8 a = *(const bf16x8*)(ap + k0), b = *(const bf16x8*)(bp + k0); acc = MFMA32(a, b, acc); }
#pragma unroll
    for (int i = 0; i < 16; ++i) epi(tm * 32 + crow(i, h), tn * 32 + r, acc[i]);
  }
}
#endif

#if NAIVE_GDN
DI void naive_gdn_prep(const Ctx& c) {
  const bf16_t* proj = (const bf16_t*)(c.p.ws + WS_PROJ); bf16_t* qkv = (bf16_t*)(c.p.ws + WS_GDN); const float* wc = c.p.in[I_WCONV];
  for (int it = c.gw; it < TT * 4; it += c.ngw) {
    const int t = it >> 2, hh = it & 3, tl = t & (SEQ - 1);
    float val[3][2];
#pragma unroll
    for (int part = 0; part < 3; ++part)
#pragma unroll
      for (int e = 0; e < 2; ++e) { const int ch = part * 512 + hh * 128 + 2 * c.lane + e; float a = 0.f;
#pragma unroll
        for (int j = 0; j < 4; ++j) { const int ts = tl - 3 + j; if (ts >= 0) a += wc[j * 1536 + ch] * bf2f(proj[(size_t)(t - 3 + j) * NPROJ + ch]); }
        val[part][e] = a * sigmoidf_(a); }
    const float sq = wave_sum(val[0][0] * val[0][0] + val[0][1] * val[0][1]), sk = wave_sum(val[1][0] * val[1][0] + val[1][1] * val[1][1]);
    const float rq = rsqrtf(sq + NORM_EPS) * 0.08838834764831845f, rk = rsqrtf(sk + NORM_EPS);
    bf16_t* o = qkv + ((size_t)t * 4 + hh) * 384 + 2 * c.lane;
    *(unsigned*)(o) = pk_bf16(val[0][0] * rq, val[0][1] * rq); *(unsigned*)(o + 128) = pk_bf16(val[1][0] * rk, val[1][1] * rk); *(unsigned*)(o + 256) = pk_bf16(val[2][0], val[2][1]);
  }
}
DI void naive_gdn_scan(const Ctx& c) {
  if (c.bid >= 64) return;
  const int b = c.bid >> 2, hh = c.bid & 3, j = c.tid;
  const bf16_t* qkv = (const bf16_t*)(c.p.ws + WS_GDN); const float* gbeta = (const float*)(c.p.ws + WS_MISC); bf16_t* ycat = (bf16_t*)(c.p.ws + WS_YCAT);
  LAS float* sq = (LAS float*)c.lds; LAS float* sk = sq + 8 * 128;
  float S[128];
#pragma unroll
  for (int d = 0; d < 128; ++d) S[d] = 0.f;
  for (int t0 = 0; t0 < SEQ; t0 += 8) {
    __syncthreads();
    for (int i = c.tid; i < 8 * 256; i += 512) { const int tt = i >> 8, d = i & 255; const size_t t = (size_t)b * SEQ + t0 + tt;
      const float v = bf2f(qkv[(t * 4 + hh) * 384 + d]); if (d < 128) sq[tt * 128 + d] = v; else sk[tt * 128 + d - 128] = v; }
    __syncthreads();
    if (j < 128) {
      for (int tt = 0; tt < 8; ++tt) { const size_t t = (size_t)b * SEQ + t0 + tt;
        const float g = gbeta[t * 8 + hh], beta = gbeta[t * 8 + 4 + hh], dec = __expf(g), vt = bf2f(qkv[(t * 4 + hh) * 384 + 256 + j]);
        float ks = 0.f;
#pragma unroll
        for (int d = 0; d < 128; ++d) ks += sk[tt * 128 + d] * S[d];
        const float vn = beta * (vt - dec * ks); float o = 0.f;
#pragma unroll
        for (int d = 0; d < 128; ++d) { S[d] = dec * S[d] + sk[tt * 128 + d] * vn; o += sq[tt * 128 + d] * S[d]; }
        ycat[t * 1536 + hh * 128 + j] = f2bf(o); }
    }
  }
}
#endif

#if NAIVE_ATTN
DI void naive_sb(const Ctx& c) {
  const bf16_t* proj = (const bf16_t*)(c.p.ws + WS_PROJ); bf16_t* ycat = (bf16_t*)(c.p.ws + WS_YCAT);
  LAS float* wl = (LAS float*)c.lds + c.wave * 64;
  for (int it = c.gw; it < NB * 8 * SEQ; it += c.ngw) {
    const int tq = it & (SEQ - 1), hh = (it >> 11) & 7, b = it >> 14; const size_t trow = (size_t)b * SEQ + tq;
    float q[64];
    { const bf16_t* qp = proj + trow * NPROJ + C_SQ + hh * 64;
#pragma unroll
      for (int d8 = 0; d8 < 8; ++d8) { const u32x4 w = *(const u32x4*)(qp + 8 * d8);
#pragma unroll
        for (int e = 0; e < 4; ++e) { q[8 * d8 + 2 * e] = bflo(w[e]); q[8 * d8 + 2 * e + 1] = bfhi(w[e]); } } }
    float carry = 0.f, o = 0.f;
    for (int kt = (tq - 1) >> 6; kt >= 0 && tq > 0; --kt) {
      const int s = kt * 64 + c.lane; const bool valid = s < tq; const size_t srow = (size_t)b * SEQ + (valid ? s : 0);
      const bf16_t* kp = proj + srow * NPROJ + C_SK + hh * 64; float z = 0.f;
#pragma unroll
      for (int d8 = 0; d8 < 8; ++d8) { const u32x4 w = *(const u32x4*)(kp + 8 * d8);
#pragma unroll
        for (int e = 0; e < 4; ++e) z += q[8 * d8 + 2 * e] * bflo(w[e]) + q[8 * d8 + 2 * e + 1] * bfhi(w[e]); }
      z *= 0.125f;
      const float sp = valid ? softplusf_(z) : 0.f;
      float suf = sp;
#pragma unroll
      for (int off = 1; off < 64; off <<= 1) { const float o2 = __shfl_down(suf, off); if (c.lane + off < 64) suf += o2; }
      const float w = valid ? __expf(z - (carry + suf)) : 0.f;
      carry += __shfl(suf, 0);
      LDS_WAIT(); wl[c.lane] = w; LDS_WAIT();
      const int smax = min(64, tq - kt * 64);
      for (int ss = 0; ss < smax; ++ss) o += wl[ss] * bf2f(proj[((size_t)b * SEQ + kt * 64 + ss) * NPROJ + C_SV + hh * 64 + c.lane]);
      LDS_WAIT();
    }
    ycat[trow * 1536 + 512 + hh * 64 + c.lane] = f2bf(o);
  }
}
DI void naive_mem(const Ctx& c) {
  const bf16_t* proj = (const bf16_t*)(c.p.ws + WS_PROJ); const bf16_t* mkv = (const bf16_t*)(c.p.ws + WS_MKV); bf16_t* ycat = (bf16_t*)(c.p.ws + WS_YCAT);
  LAS float* pl = (LAS float*)(c.lds + 4096) + c.wave * 256;
  for (int it = c.gw; it < NB * 4 * SEQ; it += c.ngw) {
    const int tq = it & (SEQ - 1), hh = (it >> 11) & 3, b = it >> 13; const size_t trow = (size_t)b * SEQ + tq;
    const bf16_t* qp = proj + trow * NPROJ + C_MQ + hh * 128;
    float sc[4];
#pragma unroll
    for (int kt = 0; kt < 4; ++kt) { const bf16_t* kp = mkv + (size_t)(b * MEMLEN + kt * 64 + c.lane) * 1024 + hh * 128; float z = 0.f;
      for (int d8 = 0; d8 < 16; ++d8) { const u32x4 w = *(const u32x4*)(kp + 8 * d8), qw = *(const u32x4*)(qp + 8 * d8);
#pragma unroll
        for (int e = 0; e < 4; ++e) z += bflo(qw[e]) * bflo(w[e]) + bfhi(qw[e]) * bfhi(w[e]); }
      sc[kt] = z * 0.08838834764831845f; }
    const float mx = wave_max(fmaxf(fmaxf(sc[0], sc[1]), fmaxf(sc[2], sc[3])));
    float pe[4], ssum = 0.f;
#pragma unroll
    for (int kt = 0; kt < 4; ++kt) { pe[kt] = __expf(sc[kt] - mx); ssum += pe[kt]; }
    ssum = wave_sum(ssum);
    LDS_WAIT();
#pragma unroll
    for (int kt = 0; kt < 4; ++kt) pl[kt * 64 + c.lane] = pe[kt] / ssum;
    LDS_WAIT();
    float o0 = 0.f, o1 = 0.f;
    for (int s = 0; s < 256; ++s) { const unsigned vv = *(const unsigned*)(mkv + (size_t)(b * MEMLEN + s) * 1024 + 512 + hh * 128 + 2 * c.lane); const float pw = pl[s]; o0 += pw * bflo(vv); o1 += pw * bfhi(vv); }
    LDS_WAIT();
    *(unsigned*)(ycat + trow * 1536 + 1024 + hh * 128 + 2 * c.lane) = pk_bf16(o0, o1);
  }
}
#endif
DI void tr_item(const float* src, int ldw, bf16_t* dst, int ldd, LAS float* scr, int lane) {
#pragma unroll
  for (int i = 0; i < 8; ++i) { const int kk = 8 * i + (lane >> 3); const f32x4 v = *(const f32x4*)(src + (size_t)kk * ldw + 4 * (lane & 7));
    LAS float* s = scr + kk * 33 + 4 * (lane & 7); s[0] = v.x; s[1] = v.y; s[2] = v.z; s[3] = v.w; }
  LDS_WAIT();
  const int cc = lane & 7;
#pragma unroll
  for (int j = 0; j < 4; ++j) { const int n = (lane >> 3) + 8 * j; const LAS float* s = scr + (8 * cc) * 33 + n;
    u32x4 o; o.x = pk_bf16(s[0 * 33], s[1 * 33]); o.y = pk_bf16(s[2 * 33], s[3 * 33]); o.z = pk_bf16(s[4 * 33], s[5 * 33]); o.w = pk_bf16(s[6 * 33], s[7 * 33]);
    *(u32x4*)(dst + (size_t)n * ldd + 8 * cc) = o; }
  LDS_WAIT();
}
DI void phase0(const Ctx& c) {
  unsigned char* ws = c.p.ws;
  if (c.bid == 0 && c.tid < 32) ((int*)(ws + WS_MISC + MiB))[c.tid] = 0;
  {
    LAS float* scr = (LAS float*)(c.lds + c.wave * 8448);
    for (int r = c.gw; r < 16 * (GATE_I8 ? 128 : 224); r += c.ngw) { const int kb = r / (GATE_I8 ? 128 : 224), nb = r % (GATE_I8 ? 128 : 224); const int n0 = 32 * nb + (nb >= 64 ? 8 : 0);
      tr_item(c.p.in[I_WIN] + (size_t)(64 * kb) * 7176 + n0, 7176, (bf16_t*)(ws + WS_WIN) + (size_t)(32 * nb) * 1024 + 64 * kb, 1024, scr, c.lane); }
    for (int r = (c.gw + 512) % c.ngw; r < 16 * 32; r += c.ngw) { const int kb = r / 32, nb = r % 32;
      tr_item(c.p.in[I_WMKV] + (size_t)(64 * kb) * 1024 + 32 * nb, 1024, (bf16_t*)(ws + WS_WMKV) + (size_t)(32 * nb) * 1024 + 64 * kb, 1024, scr, c.lane); }
    for (int r = (c.gw + 1024) % c.ngw; r < 8 * 32; r += c.ngw) { const int kb = r / 32, nb = r % 32;
      tr_item(c.p.in[I_WPG] + (size_t)(64 * kb) * 1024 + 32 * nb, 1024, (bf16_t*)(ws + WS_WP) + (size_t)(32 * nb) * 1536 + 0 * 512 + 64 * kb, 1536, scr, c.lane); }
    for (int r = (c.gw + 1280) % c.ngw; r < 8 * 32; r += c.ngw) { const int kb = r / 32, nb = r % 32;
      tr_item(c.p.in[I_WPS] + (size_t)(64 * kb) * 1024 + 32 * nb, 1024, (bf16_t*)(ws + WS_WP) + (size_t)(32 * nb) * 1536 + 1 * 512 + 64 * kb, 1536, scr, c.lane); }
    for (int r = (c.gw + 1536) % c.ngw; r < 8 * 32; r += c.ngw) { const int kb = r / 32, nb = r % 32;
      tr_item(c.p.in[I_WPM] + (size_t)(64 * kb) * 1024 + 32 * nb, 1024, (bf16_t*)(ws + WS_WP) + (size_t)(32 * nb) * 1536 + 2 * 512 + 64 * kb, 1536, scr, c.lane); }
    for (int r = (c.gw + 1792) % c.ngw; r < 16 * 32; r += c.ngw) { const int kb = r / 32, nb = r % 32;
      tr_item(c.p.in[I_WO] + (size_t)(64 * kb) * 1024 + 32 * nb, 1024, (bf16_t*)(ws + WS_WO) + (size_t)(32 * nb) * 1024 + 64 * kb, 1024, scr, c.lane); }
#if MOE_I8
    { unsigned* cmax = (unsigned*)(ws + WS_CMAX);
      for (int r = c.gw; r < 32 * 16 * 4; r += c.ngw) { const int e = r >> 6, kb = (r >> 2) & 15, nq = r & 3;
        const float* src = c.p.in[I_WGU] + (size_t)e * 1024 * 2048 + (size_t)(64 * kb) * 2048 + 512 * nq + 8 * c.lane;
        f32x4 m0 = {0.f, 0.f, 0.f, 0.f}, m1 = {0.f, 0.f, 0.f, 0.f};
#pragma unroll 8
        for (int kk = 0; kk < 64; ++kk) { const f32x4 a = *(const f32x4*)(src + (size_t)kk * 2048), b = *(const f32x4*)(src + (size_t)kk * 2048 + 4);
          m0.x = fmaxf(m0.x, fabsf(a.x)); m0.y = fmaxf(m0.y, fabsf(a.y)); m0.z = fmaxf(m0.z, fabsf(a.z)); m0.w = fmaxf(m0.w, fabsf(a.w));
          m1.x = fmaxf(m1.x, fabsf(b.x)); m1.y = fmaxf(m1.y, fabsf(b.y)); m1.z = fmaxf(m1.z, fabsf(b.z)); m1.w = fmaxf(m1.w, fabsf(b.w)); }
        unsigned* cm = cmax + e * 2048 + 512 * nq + 8 * c.lane;
        atomicMax(cm + 0, __float_as_uint(m0.x)); atomicMax(cm + 1, __float_as_uint(m0.y)); atomicMax(cm + 2, __float_as_uint(m0.z)); atomicMax(cm + 3, __float_as_uint(m0.w));
        atomicMax(cm + 4, __float_as_uint(m1.x)); atomicMax(cm + 5, __float_as_uint(m1.y)); atomicMax(cm + 6, __float_as_uint(m1.z)); atomicMax(cm + 7, __float_as_uint(m1.w)); } }
#else
    for (int r = c.gw; r < 32 * 16 * 64; r += c.ngw) { const int e = r / 1024, q = r % 1024, kb = q / 64, nb = q % 64; const int r0 = 32 * nb, n0 = ((r0 >> 7) & 1) * 1024 + (r0 >> 8) * 128 + (r0 & 127);
      tr_item(c.p.in[I_WGU] + (size_t)e * 1024 * 2048 + (size_t)(64 * kb) * 2048 + n0, 2048, (bf16_t*)(ws + WS_WGU) + ((size_t)e * 2048 + r0) * 1024 + 64 * kb, 1024, scr, c.lane); }
#endif
#if !(MOE_I8 && W8_BESIDE_SCAN)
    for (int r = c.gw; r < 32 * 16 * 32; r += c.ngw) { const int e = r / 512, q = r % 512, kb = q / 32, nb = q % 32;
      tr_item(c.p.in[I_WDN] + (size_t)e * 1024 * 1024 + (size_t)(64 * kb) * 1024 + 32 * nb, 1024, (bf16_t*)(ws + WS_WDN) + ((size_t)e * 1024 + 32 * nb) * 1024 + 64 * kb, 1024, scr, c.lane); }
#endif
  }
#if GATE_I8
  for (int r = c.gw; r < 16 * 96; r += c.ngw) { const int kb = r / 96, grp = r % 96, n = c.lane & 31, h2 = c.lane >> 5;
    const float* src = c.p.in[I_WIN] + (size_t)(64 * kb + 32 * h2) * 7176 + 4104 + 32 * grp + n; float am = 0.f;
#pragma unroll
    for (int k = 0; k < 32; ++k) am = fmaxf(am, fabsf(src[(size_t)k * 7176]));
    am = fmaxf(am, __shfl_xor(am, 32));
    if (h2 == 0) atomicMax((unsigned*)(ws + WS_CMAXG) + 32 * grp + n, __float_as_uint(am)); }
#endif
  { const float* wr = c.p.in[I_WR]; float* wT = (float*)(ws + WS_WRT); for (int i = c.bid * 512 + c.tid; i < 32 * 1024; i += c.G * 512) wT[i] = wr[(i & 1023) * 32 + (i >> 10)]; }
  { const f32x4* src = (const f32x4*)c.p.in[I_MEM]; u32x2* dst = (u32x2*)(ws + WS_MEMB);
    for (int i = c.bid * 512 + c.tid; i < NB * MEMLEN * DM / 4; i += c.G * 512) { const f32x4 v = src[i]; u32x2 o; o.x = pk_bf16(v.x, v.y); o.y = pk_bf16(v.z, v.w); dst[i] = o; } }
  {
    float wab[4][4][8];
#pragma unroll
    for (int j = 0; j < 4; ++j)
#pragma unroll
      for (int i = 0; i < 4; ++i) { const float* wp = c.p.in[I_WIN] + (size_t)(256 * j + 4 * c.lane + i) * 7176 + 2048; const f32x4 a = *(const f32x4*)wp, b = *(const f32x4*)(wp + 4);
        wab[j][i][0] = a.x; wab[j][i][1] = a.y; wab[j][i][2] = a.z; wab[j][i][3] = a.w; wab[j][i][4] = b.x; wab[j][i][5] = b.y; wab[j][i][6] = b.z; wab[j][i][7] = b.w; }
    const int hh = c.lane & 3; const float nega = -__expf(c.p.in[I_ALOG][hh]), dtb = c.p.in[I_DTB][hh];
    float* gbeta = (float*)(ws + WS_MISC);
    for (int m = c.gw; m < TT; m += c.ngw) {
      const f32x4* xr = (const f32x4*)(c.p.in[I_X] + (size_t)m * DM) + c.lane; u32x2* xo = (u32x2*)(ws + WS_XB + (size_t)m * DM * 2) + c.lane;
      float s[8];
#pragma unroll
      for (int q = 0; q < 8; ++q) s[q] = 0.f;
      f32x4 xv[4];
#pragma unroll
      for (int j = 0; j < 4; ++j) { const f32x4 v = xr[64 * j]; xv[j] = v; u32x2 o; o.x = pk_bf16(v.x, v.y); o.y = pk_bf16(v.z, v.w); xo[64 * j] = o;
#pragma unroll
        for (int q = 0; q < 8; ++q) s[q] += v.x * wab[j][0][q] + v.y * wab[j][1][q] + v.z * wab[j][2][q] + v.w * wab[j][3][q]; }
#pragma unroll
      for (int q = 0; q < 8; ++q) s[q] = wave_sum(s[q]);
#if GATE_I8
      { float am = 0.f;
#pragma unroll
        for (int j = 0; j < 4; ++j) am = fmaxf(fmaxf(am, fmaxf(fabsf(xv[j].x), fabsf(xv[j].y))), fmaxf(fabsf(xv[j].z), fabsf(xv[j].w)));
        am = wave_max(am); const float qs = am > 0.f ? 127.f / am : 0.f;
        if (c.lane == 0) ((float*)(ws + WS_TSC))[m] = am * (1.f / 127.f);
#pragma unroll
        for (int j = 0; j < 4; ++j) ((unsigned*)(ws + WS_XQ + (size_t)m * DM))[64 * j + c.lane] = ((unsigned)(int)rintf(xv[j].x * qs) & 0xffu) | (((unsigned)(int)rintf(xv[j].y * qs) & 0xffu) << 8) | (((unsigned)(int)rintf(xv[j].z * qs) & 0xffu) << 16) | (((unsigned)(int)rintf(xv[j].w * qs) & 0xffu) << 24); }
#endif
      if (c.lane < 8) {
        float pre = s[0];
#pragma unroll
        for (int q = 1; q < 8; ++q) pre = (c.lane == q) ? s[q] : pre;
        const float val = c.lane < 4 ? nega * softplusf_(pre + dtb) : sigmoidf_(pre);
        gbeta[(size_t)m * 8 + c.lane] = val;
      }
    }
  }
}

#if MOE_I8
DI void phase0b(const Ctx& c) {
  unsigned char* ws = c.p.ws; const float* cmaxf = (const float*)(ws + WS_CMAX); float* wsc = (float*)(ws + WS_WSC); signed char* w8 = (signed char*)(ws + WS_WGU);
  LAS float* scr = (LAS float*)(c.lds + c.wave * 8448);
  for (int r = c.gw; r < 32 * 16 * 64; r += c.ngw) { const int e = r / 1024, q = r % 1024, kb = q / 64, nb = q % 64; const int r0 = 32 * nb, n0 = ((r0 >> 7) & 1) * 1024 + (r0 >> 8) * 128 + (r0 & 127);
    const float* src = c.p.in[I_WGU] + (size_t)e * 1024 * 2048 + (size_t)(64 * kb) * 2048 + n0;
#pragma unroll
    for (int i = 0; i < 8; ++i) { const int kk = 8 * i + (c.lane >> 3); const f32x4 v = *(const f32x4*)(src + (size_t)kk * 2048 + 4 * (c.lane & 7));
      LAS float* sp = scr + kk * 33 + 4 * (c.lane & 7); sp[0] = v.x; sp[1] = v.y; sp[2] = v.z; sp[3] = v.w; }
    LDS_WAIT();
    const int n = c.lane >> 1, hk = c.lane & 1; const float cm = cmaxf[e * 2048 + n0 + n], inv = cm > 0.f ? 127.f / cm : 0.f;
    if (kb == 0 && hk == 0) wsc[e * 2048 + r0 + n] = cm * (1.f / 127.f);
    u32x4 o[2];
#pragma unroll
    for (int g = 0; g < 8; ++g) { unsigned w = 0;
#pragma unroll
      for (int b = 0; b < 4; ++b) { const int qv = (int)rintf(scr[(32 * hk + 4 * g + b) * 33 + n] * inv); w |= ((unsigned)qv & 0xffu) << (8 * b); }
      o[g >> 2][g & 3] = w; }
    signed char* dst = w8 + ((size_t)e * 2048 + r0 + n) * 1024 + 64 * kb + 32 * hk;
    *(u32x4*)dst = o[0]; *(u32x4*)(dst + 16) = o[1];
    LDS_WAIT();
  }
}
#endif

#if MOE_I8
DI void phase0b_light(const Ctx& c, LAS unsigned char* scr8, int wi, int nw) {
  unsigned char* ws = c.p.ws; const float* cmaxf = (const float*)(ws + WS_CMAX); float* wsc = (float*)(ws + WS_WSC); signed char* w8 = (signed char*)(ws + WS_WGU);
  for (int r = wi; r < 32 * 16 * 64; r += nw) { const int e = r / 1024, q = r % 1024, kb = q / 64, nb = q % 64; const int r0 = 32 * nb, n0 = ((r0 >> 7) & 1) * 1024 + (r0 >> 8) * 128 + (r0 & 127);
    const float* src = c.p.in[I_WGU] + (size_t)e * 1024 * 2048 + (size_t)(64 * kb) * 2048 + n0;
    const int nq = 4 * (c.lane & 7);
    const f32x4 cm = *(const f32x4*)(cmaxf + e * 2048 + n0 + nq);
    const f32x4 inv = {cm.x > 0.f ? 127.f / cm.x : 0.f, cm.y > 0.f ? 127.f / cm.y : 0.f, cm.z > 0.f ? 127.f / cm.z : 0.f, cm.w > 0.f ? 127.f / cm.w : 0.f};
    if (kb == 0 && c.lane < 8) *(f32x4*)(wsc + e * 2048 + r0 + nq) = cm * (1.f / 127.f);
    f32x4 v[8];
#pragma unroll
    for (int i = 0; i < 8; ++i) v[i] = *(const f32x4*)(src + (size_t)(8 * i + (c.lane >> 3)) * 2048 + nq);
    LDS_WAIT();
#pragma unroll
    for (int i = 0; i < 8; ++i) { const int kk = 8 * i + (c.lane >> 3);
      scr8[(nq + 0) * 80 + kk] = (unsigned char)(int)rintf(v[i].x * inv.x); scr8[(nq + 1) * 80 + kk] = (unsigned char)(int)rintf(v[i].y * inv.y);
      scr8[(nq + 2) * 80 + kk] = (unsigned char)(int)rintf(v[i].z * inv.z); scr8[(nq + 3) * 80 + kk] = (unsigned char)(int)rintf(v[i].w * inv.w); }
    LDS_WAIT();
    const int n = c.lane >> 1, hk = c.lane & 1;
    const u32x4 o0 = *(const LAS u32x4*)(scr8 + n * 80 + 32 * hk), o1 = *(const LAS u32x4*)(scr8 + n * 80 + 32 * hk + 16);
    signed char* dst = w8 + ((size_t)e * 2048 + r0 + n) * 1024 + 64 * kb + 32 * hk;
    *(u32x4*)dst = o0; *(u32x4*)(dst + 16) = o1;
  }
}
#endif

DI void wdn_light(const Ctx& c, LAS bf16_t* scr, int wi, int nw) {
  unsigned char* ws = c.p.ws;
  for (int r = wi; r < 32 * 16 * 32; r += nw) { const int e = r / 512, q = r % 512, kb = q / 32, nb = q % 32;
    const float* src = c.p.in[I_WDN] + (size_t)e * 1024 * 1024 + (size_t)(64 * kb) * 1024 + 32 * nb; bf16_t* dst = (bf16_t*)(ws + WS_WDN) + ((size_t)e * 1024 + 32 * nb) * 1024 + 64 * kb;
    const int nq = 4 * (c.lane & 7); f32x4 v[8];
#pragma unroll
    for (int i = 0; i < 8; ++i) v[i] = *(const f32x4*)(src + (size_t)(8 * i + (c.lane >> 3)) * 1024 + nq);
    LDS_WAIT();
#pragma unroll
    for (int i = 0; i < 8; ++i) { const int kk = 8 * i + (c.lane >> 3); const unsigned a = pk_bf16(v[i].x, v[i].y), b = pk_bf16(v[i].z, v[i].w);
      scr[(nq + 0) * 72 + kk] = (bf16_t)(a & 0xffffu); scr[(nq + 1) * 72 + kk] = (bf16_t)(a >> 16); scr[(nq + 2) * 72 + kk] = (bf16_t)(b & 0xffffu); scr[(nq + 3) * 72 + kk] = (bf16_t)(b >> 16); }
    LDS_WAIT();
    const int n = c.lane >> 1, hk = c.lane & 1;
#pragma unroll
    for (int j = 0; j < 4; ++j) *(u32x4*)(dst + (size_t)n * 1024 + 32 * hk + 8 * j) = *(const LAS u32x4*)(scr + n * 72 + 32 * hk + 8 * j);
  }
}

#if GATE_I8
DI void phase0c(const Ctx& c) {
  unsigned char* ws = c.p.ws; const float* cmaxf = (const float*)(ws + WS_CMAXG); float* wgs = (float*)(ws + WS_WGS); signed char* w8 = (signed char*)(ws + WS_WG8);
  LAS float* scr = (LAS float*)(c.lds + c.wave * 8448);
  for (int r = c.gw; r < 16 * 96; r += c.ngw) { const int kb = r / 96, grp = r % 96;
    const float* src = c.p.in[I_WIN] + (size_t)(64 * kb) * 7176 + 4104 + 32 * grp;
#pragma unroll
    for (int i = 0; i < 8; ++i) { const int kk = 8 * i + (c.lane >> 3); const f32x4 v = *(const f32x4*)(src + (size_t)kk * 7176 + 4 * (c.lane & 7));
      LAS float* sp = scr + kk * 33 + 4 * (c.lane & 7); sp[0] = v.x; sp[1] = v.y; sp[2] = v.z; sp[3] = v.w; }
    LDS_WAIT();
    const int n = c.lane >> 1, hk = c.lane & 1; const float cm = cmaxf[32 * grp + n], inv = cm > 0.f ? 127.f / cm : 0.f;
    if (kb == 0 && hk == 0) wgs[32 * grp + n] = cm * (1.f / 127.f);
    u32x4 o[2];
#pragma unroll
    for (int g = 0; g < 8; ++g) { unsigned w = 0;
#pragma unroll
      for (int b = 0; b < 4; ++b) { const int qv = (int)rintf(scr[(32 * hk + 4 * g + b) * 33 + n] * inv); w |= ((unsigned)qv & 0xffu) << (8 * b); }
      o[g >> 2][g & 3] = w; }
    signed char* dst = w8 + (size_t)(32 * grp + n) * 1024 + 64 * kb + 32 * hk;
    *(u32x4*)dst = o[0]; *(u32x4*)(dst + 16) = o[1];
    LDS_WAIT();
  }
}
#endif

DI void phase_gdn_norm(const Ctx& c) {
  bf16_t* ycat = (bf16_t*)(c.p.ws + WS_YCAT); const bf16_t* proj = (const bf16_t*)(c.p.ws + WS_PROJ); const float* nw = c.p.in[I_GNW];
  const float w0 = nw[2 * c.lane], w1 = nw[2 * c.lane + 1];
  for (int it = c.gw; it < TT * 4; it += c.ngw) {
    const int t = it >> 2, hh = it & 3;
    unsigned* op = (unsigned*)(ycat + (size_t)t * 1536 + hh * 128) + c.lane; const unsigned ov = *op, zv = *((const unsigned*)(proj + (size_t)t * NPROJ + C_GZ + hh * 128) + c.lane);
    const float o0 = bflo(ov), o1 = bfhi(ov), z0 = bflo(zv), z1 = bfhi(zv);
    const float rs = rsqrtf(wave_sum(o0 * o0 + o1 * o1) * (1.f / 128.f) + NORM_EPS);
    *op = pk_bf16(o0 * rs * w0 * (z0 * sigmoidf_(z0)), o1 * rs * w1 * (z1 * sigmoidf_(z1)));
  }
}

#if ROUTER_LDS
DI void phase_router(const Ctx& c) {
  unsigned char* ws = c.p.ws;
  const float* h = (const float*)(ws + WS_H); bf16_t* x1h = (bf16_t*)(ws + WS_X1);
  const float* wT = (const float*)(ws + WS_WRT); int* gcount = (int*)(ws + WS_MISC + MiB); u32x2* rinfo = (u32x2*)(ws + WS_RINFO);
  constexpr int XS = 1028;
  LAS float* xs = (LAS float*)c.lds;
  LAS int* wcnt = (LAS int*)(c.lds + 131584); LAS int* bbase = wcnt + 32; LAS float* tsl = (LAS float*)(bbase + 32);
  LAS int* sel_e = (LAS int*)(tsl + 128); LAS int* sel_pos = sel_e + 512; LAS float* sel_g = (LAS float*)(sel_e + 1024);
  const int e = c.lane & 31, hf = c.lane >> 5;
  f32x4 gam[4], bet[4];
#pragma unroll
  for (int j = 0; j < 4; ++j) { gam[j] = ((const f32x4*)c.p.in[I_LN1G])[64 * j + c.lane]; bet[j] = ((const f32x4*)c.p.in[I_LN1B])[64 * j + c.lane]; }
  for (int gi = c.bid; gi < TT / 128; gi += c.G) {
    const int tokg = gi * 128;
    if (c.tid < 32) wcnt[c.tid] = 0;
    f32x4 vn[4];
    { const f32x4* hr0 = (const f32x4*)(h + ((size_t)tokg + c.wave * 4) * DM) + c.lane;
#pragma unroll
      for (int j = 0; j < 4; ++j) vn[j] = hr0[64 * j]; }
    for (int sg = 0; sg < 4; ++sg) {
      for (int i = 0; i < 4; ++i) {
        const int r = c.wave * 4 + i; const size_t t = (size_t)tokg + sg * 32 + r; f32x4 v[4]; float s = 0.f;
#pragma unroll
        for (int j = 0; j < 4; ++j) { v[j] = vn[j]; s += (v[j].x + v[j].y) + (v[j].z + v[j].w); }
        { const int tn = (i < 3) ? (int)t + 1 : (sg < 3 ? tokg + (sg + 1) * 32 + c.wave * 4 : (int)t);
          const f32x4* hrn = (const f32x4*)(h + (size_t)tn * DM) + c.lane;
#pragma unroll
          for (int j = 0; j < 4; ++j) vn[j] = hrn[64 * j]; }
        const float mean = wave_sum(s) * (1.f / DM); float s2 = 0.f;
#pragma unroll
        for (int j = 0; j < 4; ++j) { v[j] = v[j] - mean; s2 += (v[j].x * v[j].x + v[j].y * v[j].y) + (v[j].z * v[j].z + v[j].w * v[j].w); }
        const float rstd = rsqrtf(wave_sum(s2) * (1.f / DM) + LN_EPS);
        f32x4 y[4]; float am = 0.f;
#pragma unroll
        for (int j = 0; j < 4; ++j) { y[j] = v[j] * rstd * gam[j] + bet[j]; *(LAS f32x4*)(xs + r * XS + 256 * j + 4 * c.lane) = y[j];
          u32x2 o; o.x = pk_bf16(y[j].x, y[j].y); o.y = pk_bf16(y[j].z, y[j].w); ((u32x2*)(x1h + t * DM))[64 * j + c.lane] = o;
          am = fmaxf(fmaxf(am, fmaxf(fabsf(y[j].x), fabsf(y[j].y))), fmaxf(fabsf(y[j].z), fabsf(y[j].w))); }
        am = wave_max(am); const float qs = am > 0.f ? 127.f / am : 0.f;
        if (c.lane == 0) tsl[sg * 32 + r] = am * (1.f / 127.f);
#pragma unroll
        for (int j = 0; j < 4; ++j) { const unsigned w = ((unsigned)(int)rintf(y[j].x * qs) & 0xffu) | (((unsigned)(int)rintf(y[j].y * qs) & 0xffu) << 8) | (((unsigned)(int)rintf(y[j].z * qs) & 0xffu) << 16) | (((unsigned)(int)rintf(y[j].w * qs) & 0xffu) << 24);
          ((unsigned*)(ws + WS_X1Q + t * DM))[64 * j + c.lane] = w; }
      }
      __syncthreads();
      f32x16 acc;
      if (c.wave < 4) {
        const float* ap = wT + (size_t)e * DM + 256 * c.wave + 128 * hf; const LAS float* bp = xs + e * XS + 256 * c.wave + 128 * hf;
#pragma unroll
        for (int i = 0; i < 16; ++i) acc[i] = 0.f;
        f32x4 a4 = *(const f32x4*)ap, a4n = *(const f32x4*)(ap + 4);
        for (int q = 0; q < 32; ++q) {
          const f32x4 a4nn = *(const f32x4*)(ap + 4 * (q + 2 < 32 ? q + 2 : 31)); const f32x4 b4 = *(const LAS f32x4*)(bp + 4 * q);
#pragma unroll
          for (int j = 0; j < 4; ++j) acc = __builtin_amdgcn_mfma_f32_32x32x2f32(a4[j], b4[j], acc, 0, 0, 0);
          a4 = a4n; a4n = a4nn;
        }
      }
      __syncthreads();
      if (c.wave < 4) {
#pragma unroll
        for (int rg = 0; rg < 16; ++rg) xs[(c.wave * 32 + crow(rg, hf)) * 32 + e] = acc[rg];
      }
      __syncthreads();
      if (c.wave == 4) {
        float L[32];
#pragma unroll
        for (int q = 0; q < 32; ++q) L[q] = ((xs[q * 32 + e] + xs[(32 + q) * 32 + e]) + (xs[(64 + q) * 32 + e] + xs[(96 + q) * 32 + e])) + c.p.in[I_BR][q];
        float tv[4]; int ti[4];
#pragma unroll
        for (int k = 0; k < 4; ++k) {
          float bv = L[0]; int bi = 0;
#pragma unroll
          for (int q = 1; q < 32; ++q) { const bool g = L[q] > bv; bv = g ? L[q] : bv; bi = g ? q : bi; }
          tv[k] = bv; ti[k] = bi;
#pragma unroll
          for (int q = 0; q < 32; ++q) L[q] = (q == bi) ? -INFINITY : L[q];
        }
        const float e1 = __expf(tv[1] - tv[0]), e2 = __expf(tv[2] - tv[0]), e3 = __expf(tv[3] - tv[0]), inv = 1.f / (1.f + e1 + e2 + e3);
        if (hf == 0) {
          const float gk[4] = {inv, e1 * inv, e2 * inv, e3 * inv};
#pragma unroll
          for (int k = 0; k < 4; ++k) { const int si = (sg * 32 + e) * 4 + k; sel_e[si] = ti[k]; sel_g[si] = gk[k]; sel_pos[si] = (int)__hip_atomic_fetch_add((LAS unsigned*)(wcnt + ti[k]), 1u, __ATOMIC_RELAXED, __HIP_MEMORY_SCOPE_WORKGROUP); }
        }
      }
      __syncthreads();
    }
    if (c.tid < 32) { const int tot = wcnt[c.tid]; bbase[c.tid] = (tot && !(c.p.flags & 16)) ? atomicAdd(gcount + c.tid, tot) : 0; }
    __syncthreads();
    if (!(c.p.flags & 16)) {
      const int ek = sel_e[c.tid];
      u32x2 info; info.x = (unsigned)(tokg * 4 + c.tid); info.y = __float_as_uint(sel_g[c.tid]);
      rinfo[(size_t)ek * ECAP + bbase[ek] + sel_pos[c.tid]] = info;
      ((float*)(ws + WS_RSC))[(size_t)ek * ECAP + bbase[ek] + sel_pos[c.tid]] = tsl[c.tid >> 2];
    }
    __syncthreads();
  }
}
#else
DI void phase_router(const Ctx& c) {
  unsigned char* ws = c.p.ws;
  const float* h = (const float*)(ws + WS_H); float* x1 = (float*)(ws + WS_X1); bf16_t* x1b = (bf16_t*)(ws + WS_X1B);
  const float* wT = (const float*)(ws + WS_WRT); int* gcount = (int*)(ws + WS_MISC + MiB); u32x2* rinfo = (u32x2*)(ws + WS_RINFO);
  LAS int* wcnt = (LAS int*)(c.lds);
  LAS int* bbase = wcnt + 256;
  LAS float* tsl = (LAS float*)(c.lds + 16384);
  LAS int* sel_e = bbase + 32; LAS int* sel_pos = sel_e + 512; LAS float* sel_g = (LAS float*)(sel_e + 1024);
  const int e = c.lane & 31, hf = c.lane >> 5;
  f32x4 gam[4], bet[4];
#pragma unroll
  for (int j = 0; j < 4; ++j) { gam[j] = ((const f32x4*)c.p.in[I_LN1G])[64 * j + c.lane]; bet[j] = ((const f32x4*)c.p.in[I_LN1B])[64 * j + c.lane]; }
  float brl[32];
#pragma unroll
  for (int q = 0; q < 32; ++q) brl[q] = c.p.in[I_BR][q];
  for (int gi = c.bid; gi < TT / 128; gi += c.G) {
    const int tokg = gi * 128;
    if (c.tid < 32) wcnt[c.tid] = 0;
    {
      const f32x4* hr0 = (const f32x4*)(h + ((size_t)tokg + c.wave * 16) * DM) + c.lane; f32x4 vn[4];
#pragma unroll
      for (int j = 0; j < 4; ++j) vn[j] = hr0[64 * j];
      for (int tt = 0; tt < 16; ++tt) {
        const size_t t = (size_t)tokg + c.wave * 16 + tt; f32x4 v[4]; float s = 0.f;
#pragma unroll
        for (int j = 0; j < 4; ++j) { v[j] = vn[j]; s += (v[j].x + v[j].y) + (v[j].z + v[j].w); }
        { const f32x4* hrn = (const f32x4*)(h + (t + (tt < 15 ? 1 : 0)) * DM) + c.lane;
#pragma unroll
          for (int j = 0; j < 4; ++j) vn[j] = hrn[64 * j]; }
        const float mean = wave_sum(s) * (1.f / DM); float s2 = 0.f;
#pragma unroll
        for (int j = 0; j < 4; ++j) { v[j] = v[j] - mean; s2 += (v[j].x * v[j].x + v[j].y * v[j].y) + (v[j].z * v[j].z + v[j].w * v[j].w); }
        const float rstd = rsqrtf(wave_sum(s2) * (1.f / DM) + LN_EPS);
#if MOE_I8
        f32x4 y[4]; float am = 0.f;
#pragma unroll
        for (int j = 0; j < 4; ++j) { y[j] = v[j] * rstd * gam[j] + bet[j]; ((f32x4*)(x1 + t * DM))[64 * j + c.lane] = y[j];
          am = fmaxf(fmaxf(am, fmaxf(fabsf(y[j].x), fabsf(y[j].y))), fmaxf(fabsf(y[j].z), fabsf(y[j].w))); }
        am = wave_max(am); const float qs = am > 0.f ? 127.f / am : 0.f;
        if (c.lane == 0) tsl[c.wave * 16 + tt] = am * (1.f / 127.f);
#pragma unroll
        for (int j = 0; j < 4; ++j) { const unsigned w = ((unsigned)(int)rintf(y[j].x * qs) & 0xffu) | (((unsigned)(int)rintf(y[j].y * qs) & 0xffu) << 8) | (((unsigned)(int)rintf(y[j].z * qs) & 0xffu) << 16) | (((unsigned)(int)rintf(y[j].w * qs) & 0xffu) << 24);
          ((unsigned*)(ws + WS_X1Q + t * DM))[64 * j + c.lane] = w; }
#else
#pragma unroll
        for (int j = 0; j < 4; ++j) { const f32x4 y = v[j] * rstd * gam[j] + bet[j];
          ((f32x4*)(x1 + t * DM))[64 * j + c.lane] = y; u32x2 o; o.x = pk_bf16(y.x, y.y); o.y = pk_bf16(y.z, y.w); ((u32x2*)(x1b + t * DM))[64 * j + c.lane] = o; }
#endif
      }
    }
    asm volatile("s_waitcnt vmcnt(0)" ::: "memory");
    __syncthreads();
    if (c.wave < 4) {
      const float* ap = wT + (size_t)e * DM + 512 * hf; const float* bp = x1 + ((size_t)tokg + c.wave * 32 + e) * DM + 512 * hf;
      f32x16 acc;
#pragma unroll
      for (int i = 0; i < 16; ++i) acc[i] = 0.f;
      f32x4 a4 = *(const f32x4*)ap, b4 = *(const f32x4*)bp, a4n = *(const f32x4*)(ap + 4), b4n = *(const f32x4*)(bp + 4);
      for (int q = 0; q < 128; ++q) {
        const int qn = q + 2 < 128 ? q + 2 : 127;
        const f32x4 a4nn = *(const f32x4*)(ap + 4 * qn), b4nn = *(const f32x4*)(bp + 4 * qn);
#pragma unroll
        for (int j = 0; j < 4; ++j) acc = __builtin_amdgcn_mfma_f32_32x32x2f32(a4[j], b4[j], acc, 0, 0, 0);
        a4 = a4n; b4 = b4n; a4n = a4nn; b4n = b4nn;
      }
      float L[32];
#pragma unroll
      for (int rg = 0; rg < 16; ++rg) { const float own = acc[rg], oth = __shfl_xor(own, 32); L[crow(rg, 0)] = (hf ? oth : own) + brl[crow(rg, 0)]; L[crow(rg, 1)] = (hf ? own : oth) + brl[crow(rg, 1)]; }
      float tv[4]; int ti[4];
#pragma unroll
      for (int k = 0; k < 4; ++k) {
        float bv = L[0]; int bi = 0;
#pragma unroll
        for (int q = 1; q < 32; ++q) { const bool g = L[q] > bv; bv = g ? L[q] : bv; bi = g ? q : bi; }
        tv[k] = bv; ti[k] = bi;
#pragma unroll
        for (int q = 0; q < 32; ++q) L[q] = (q == bi) ? -INFINITY : L[q];
      }
      const float e1 = __expf(tv[1] - tv[0]), e2 = __expf(tv[2] - tv[0]), e3 = __expf(tv[3] - tv[0]), inv = 1.f / (1.f + e1 + e2 + e3);
      if (hf == 0) {
        const float gk[4] = {inv, e1 * inv, e2 * inv, e3 * inv};
#pragma unroll
        for (int k = 0; k < 4; ++k) { const int si = (c.wave * 32 + e) * 4 + k; sel_e[si] = ti[k]; sel_g[si] = gk[k]; sel_pos[si] = (int)__hip_atomic_fetch_add((LAS unsigned*)(wcnt + ti[k]), 1u, __ATOMIC_RELAXED, __HIP_MEMORY_SCOPE_WORKGROUP); }
      }
    }
    __syncthreads();
    if (c.tid < 32) { const int tot = wcnt[c.tid]; bbase[c.tid] = (tot && !(c.p.flags & 16)) ? atomicAdd(gcount + c.tid, tot) : 0; }
    __syncthreads();
    if (!(c.p.flags & 16)) {
      const int ek = sel_e[c.tid];
      u32x2 info; info.x = (unsigned)(tokg * 4 + c.tid); info.y = __float_as_uint(sel_g[c.tid]);
      rinfo[(size_t)ek * ECAP + bbase[ek] + sel_pos[c.tid]] = info;
#if MOE_I8
      ((float*)(ws + WS_RSC))[(size_t)ek * ECAP + bbase[ek] + sel_pos[c.tid]] = tsl[c.tid >> 2];
#endif
    }
    __syncthreads();
  }
}

#endif

DI void build_group_tab(const Ctx& c, LAS int* tab) {
  const int* gcount = (const int*)(c.p.ws + WS_MISC + MiB);
  __syncthreads();
  if (c.tid == 0) { int ps = 0;
    for (int e = 0; e < 32; ++e) { const int cnt = gcount[e]; tab[e] = cnt; tab[32 + e] = ps; const int nt_ = (cnt + 255) >> 8; for (int q = 0; q < nt_; ++q) tab[96 + (ps >> 8) + q] = e; ps += nt_ << 8; }
    tab[64] = ps; tab[65] = ps >> 8; }
  __syncthreads();
}

DI void phase_final(const Ctx& c) {
  const float* x1 = (const float*)(c.p.ws + WS_X1); const bf16_t* yp = (const bf16_t*)(c.p.ws + WS_YPAIR);
  f32x4 gam[4], bet[4];
#pragma unroll
  for (int j = 0; j < 4; ++j) { gam[j] = ((const f32x4*)c.p.in[I_LN2G])[64 * j + c.lane]; bet[j] = ((const f32x4*)c.p.in[I_LN2B])[64 * j + c.lane]; }
  for (int t = c.gw; t < TT; t += c.ngw) {
    f32x4 v[4]; float s = 0.f;
#pragma unroll
    for (int j = 0; j < 4; ++j) {
#if ROUTER_LDS
      { const u32x2 xw = ((const u32x2*)((const bf16_t*)x1 + (size_t)t * DM))[64 * j + c.lane]; v[j] = (f32x4){bflo(xw.x), bfhi(xw.x), bflo(xw.y), bfhi(xw.y)} * DN_ALPHA; }
#else
      v[j] = ((const f32x4*)(x1 + (size_t)t * DM))[64 * j + c.lane] * DN_ALPHA;
#endif
#pragma unroll
      for (int k = 0; k < 4; ++k) { const u32x2 w = ((const u32x2*)(yp + ((size_t)t * 4 + k) * DM))[64 * j + c.lane]; v[j].x += bflo(w.x); v[j].y += bfhi(w.x); v[j].z += bflo(w.y); v[j].w += bfhi(w.y); }
      s += (v[j].x + v[j].y) + (v[j].z + v[j].w); }
    const float mean = wave_sum(s) * (1.f / DM); float s2 = 0.f;
#pragma unroll
    for (int j = 0; j < 4; ++j) { v[j] = v[j] - mean; s2 += (v[j].x * v[j].x + v[j].y * v[j].y) + (v[j].z * v[j].z + v[j].w * v[j].w); }
    const float rstd = rsqrtf(wave_sum(s2) * (1.f / DM) + LN_EPS);
#pragma unroll
    for (int j = 0; j < 4; ++j) ((f32x4*)(c.p.out + (size_t)t * DM))[64 * j + c.lane] = v[j] * rstd * gam[j] + bet[j];
  }
}
DI bf16x8 pack8(const f32x16& x, int s) {
  u32x4 p; p.x = pk_bf16(x[8 * s + 0], x[8 * s + 1]); p.y = pk_bf16(x[8 * s + 2], x[8 * s + 3]); p.z = pk_bf16(x[8 * s + 4], x[8 * s + 5]); p.w = pk_bf16(x[8 * s + 6], x[8 * s + 7]);
  return __builtin_bit_cast(bf16x8, p);
}
DI void store8(bf16_t* dst, const f32x16& x, int s, float sc) {
  u32x4 p; p.x = pk_bf16(x[8 * s + 0] * sc, x[8 * s + 1] * sc); p.y = pk_bf16(x[8 * s + 2] * sc, x[8 * s + 3] * sc); p.z = pk_bf16(x[8 * s + 4] * sc, x[8 * s + 5] * sc); p.w = pk_bf16(x[8 * s + 6] * sc, x[8 * s + 7] * sc);
  *(u32x4*)dst = p;
}

#if !NAIVE_GDN
DI void phase_gdn_chunk(const Ctx& c) {
  unsigned char* ws = c.p.ws;
  const bf16_t* proj = (const bf16_t*)(ws + WS_PROJ); const float* gbeta = (const float*)(ws + WS_MISC); const float* wcv = c.p.in[I_WCONV];
  float* egl = (float*)(ws + WS_MISC + MiB + 4096);
  const int team = c.wave >> 2, tw = c.wave & 3, ttid = c.tid & 255, r = c.lane & 31, hf = c.lane >> 5;
  LAS unsigned char* tl = c.lds + team * 71680;
  LAS bf16_t* ks = (LAS bf16_t*)tl; LAS bf16_t* qs = (LAS bf16_t*)(tl + 17408); LAS bf16_t* kT = (LAS bf16_t*)(tl + 34816); LAS bf16_t* vT = (LAS bf16_t*)(tl + 53248);
  LAS float* Am = (LAS float*)(tl + 17408); LAS bf16_t* T1 = (LAS bf16_t*)tl; LAS bf16_t* T2 = (LAS bf16_t*)(tl + 9216);
  LAS float* sc = (LAS float*)(c.lds + 143360 + team * 1024);
  float wc[3][2][4];
  const int nchunk = NB * 4 * 32, niter = (nchunk + 2 * c.G - 1) / (2 * c.G);
  for (int itr = 0; itr < niter; ++itr) {
    const int ci_raw = (itr * c.G + c.bid) * 2 + team; const int ci = ci_raw < nchunk ? ci_raw : 0;
    const int n = ci & 31, hh = (ci >> 5) & 3, b = ci >> 7; const int tok0 = b * SEQ + n * 64;
    unsigned char* cb = ws + WS_GDN + (size_t)ci * GDN_CHUNK_BYTES;
#pragma unroll
    for (int part = 0; part < 3; ++part)
#pragma unroll
      for (int e = 0; e < 2; ++e)
#pragma unroll
        for (int j = 0; j < 4; ++j) wc[part][e][j] = wcv[j * 1536 + part * 512 + hh * 128 + 2 * c.lane + e];
    const float gl = gbeta[(size_t)(tok0 + c.lane) * 8 + hh], bt = gbeta[(size_t)(tok0 + c.lane) * 8 + 4 + hh];
    float gc = gl;
#pragma unroll
    for (int off = 1; off < 64; off <<= 1) { const float o2 = __shfl_up(gc, off); if (c.lane >= off) gc += o2; }
    const float glast = __shfl(gc, 63);
    if (tw == 0) { sc[c.lane] = gc; sc[64 + c.lane] = bt; sc[128 + c.lane] = __expf(glast - gc); if (c.lane == 0) egl[ci] = __expf(glast); }
    unsigned pvn[3][7];
#pragma unroll
    for (int part = 0; part < 3; ++part)
#pragma unroll
      for (int rr = 0; rr < 7; ++rr) { const int tl2 = n * 64 + tw * 16 - 3 + rr; pvn[part][rr] = tl2 >= 0 ? *(const unsigned*)(proj + (size_t)(tok0 + tw * 16 - 3 + rr) * NPROJ + part * 512 + hh * 128 + 2 * c.lane) : 0u; }
    for (int i4 = 0; i4 < 16; i4 += 4) {
    unsigned pv[3][7];
#pragma unroll
    for (int part = 0; part < 3; ++part)
#pragma unroll
      for (int rr = 0; rr < 7; ++rr) pv[part][rr] = pvn[part][rr];
    if (i4 < 12) {
#pragma unroll
      for (int part = 0; part < 3; ++part)
#pragma unroll
        for (int rr = 0; rr < 7; ++rr) pvn[part][rr] = *(const unsigned*)(proj + (size_t)(tok0 + tw * 16 + i4 + 4 - 3 + rr) * NPROJ + part * 512 + hh * 128 + 2 * c.lane);
    }
    unsigned kprev = 0u, vprev = 0u;
#pragma unroll
    for (int ii = 0; ii < 4; ++ii) {
      const int cc = tw * 16 + i4 + ii; float val[3][2];
#pragma unroll
      for (int part = 0; part < 3; ++part) { float a0 = 0.f, a1 = 0.f;
#pragma unroll
        for (int j = 0; j < 4; ++j) { a0 += wc[part][0][j] * bflo(pv[part][ii + j]); a1 += wc[part][1][j] * bfhi(pv[part][ii + j]); }
        val[part][0] = a0 * sigmoidf_(a0); val[part][1] = a1 * sigmoidf_(a1); }
      const float sq = wave_sum(val[0][0] * val[0][0] + val[0][1] * val[0][1]), sk = wave_sum(val[1][0] * val[1][0] + val[1][1] * val[1][1]);
      const float rq = rsqrtf(sq + NORM_EPS) * 0.08838834764831845f, rk = rsqrtf(sk + NORM_EPS);
      const float q0 = val[0][0] * rq, q1 = val[0][1] * rq, k0 = val[1][0] * rk, k1 = val[1][1] * rk;
      const unsigned kp = pk_bf16(k0, k1), vp = pk_bf16(val[2][0], val[2][1]);
      *(LAS unsigned*)(qs + cc * 136 + 2 * c.lane) = pk_bf16(q0, q1); *(LAS unsigned*)(ks + cc * 136 + 2 * c.lane) = kp;
      if (ii & 1) {
        *(LAS unsigned*)(kT + (2 * c.lane) * 72 + cc - 1) = (kprev & 0xffffu) | (kp << 16); *(LAS unsigned*)(kT + (2 * c.lane + 1) * 72 + cc - 1) = (kprev >> 16) | (kp & 0xffff0000u);
        *(LAS unsigned*)(vT + (2 * c.lane) * 72 + cc - 1) = (vprev & 0xffffu) | (vp << 16); *(LAS unsigned*)(vT + (2 * c.lane + 1) * 72 + cc - 1) = (vprev >> 16) | (vp & 0xffff0000u);
      }
      kprev = kp; vprev = vp;
      const float eg = __expf(__shfl(gc, cc));
      { const int pos = swap23(2 * c.lane); *(unsigned*)(cb + 16384 + (size_t)cc * 256 + 16 * ((pos >> 3) ^ (cc & 15)) + 2 * (pos & 7)) = pk_bf16(q0 * eg, q1 * eg); }
    }
    }
    __syncthreads();
    if (c.p.flags & 4) continue;
    const int mi = tw >> 1, ni = tw & 1;
    f32x16 akk, aat;
#pragma unroll
    for (int i = 0; i < 16; ++i) { akk[i] = 0.f; aat[i] = 0.f; }
#pragma unroll
    for (int s = 0; s < 8; ++s) { const bf16x8 ka = *(const LAS bf16x8*)(ks + (32 * mi + r) * 136 + 16 * s + 8 * hf);
      akk = MFMA32(ka, *(const LAS bf16x8*)(ks + (32 * ni + r) * 136 + 16 * s + 8 * hf), akk);
      aat = MFMA32(ka, *(const LAS bf16x8*)(qs + (32 * ni + r) * 136 + 16 * s + 8 * hf), aat); }
    {
      const int cout = 32 * ni + r; const float gco = sc[cout];
#pragma unroll
      for (int i = 0; i < 16; ++i) { const int cr = 32 * mi + crow(i, hf); aat[i] = cout >= cr ? aat[i] * __expf(gco - sc[cr]) : 0.f; }
      { unsigned char* rp = cb + 49152 + (size_t)cout * 128; const int sw = (cout >> 1) & 7; store8((bf16_t*)(rp + 16 * ((4 * mi + hf) ^ sw)), aat, 0, 1.f); store8((bf16_t*)(rp + 16 * ((4 * mi + 2 + hf) ^ sw)), aat, 1, 1.f); }
    }
    __syncthreads();
    { const int j = 32 * ni + r; const float gcj = sc[j];
#pragma unroll
      for (int i = 0; i < 16; ++i) { const int cr = 32 * mi + crow(i, hf); Am[cr * 64 + j] = cr > j ? akk[i] * __expf(sc[cr] - gcj) * sc[64 + cr] : 0.f; } }
    __syncthreads();
    if (c.p.flags & 8) continue;
    {
      LAS float* Pt = (LAS float*)tl;
      if (c.lane < 16) {
        const int pb = tw, j = c.lane; float t[16];
#pragma unroll
        for (int i = 0; i < 16; ++i) {
          float a0 = 0.f, a1 = 0.f;
#pragma unroll
          for (int m4 = 0; m4 < i; m4 += 4) { const f32x4 av = *(const LAS f32x4*)(Am + (16 * pb + i) * 64 + 16 * pb + m4);
            a0 += av.x * t[m4]; if (m4 + 1 < i) a1 += av.y * t[m4 + 1]; if (m4 + 2 < i) a0 += av.z * t[m4 + 2]; if (m4 + 3 < i) a1 += av.w * t[m4 + 3]; }
          t[i] = (j == i ? 1.f : 0.f) - (a0 + a1);
        }
        LDS_WAIT();
#pragma unroll
        for (int i = 0; i < 16; ++i) Am[(16 * pb + i) * 64 + 16 * pb + j] = t[i];
      }
      for (int it = ttid; it < 1024; it += 256) { const int dk = it >> 3, s = (it >> 1) & 3, h2 = it & 1;
        const u32x2 lo = *(const LAS u32x2*)(kT + dk * 72 + 16 * s + 4 * h2), hi = *(const LAS u32x2*)(kT + dk * 72 + 16 * s + 8 + 4 * h2);
        const LAS float* e0 = sc + 128 + 16 * s + 4 * h2; const LAS float* e1 = e0 + 8;
        u32x4 o; o.x = pk_bf16(bflo(lo.x) * e0[0], bfhi(lo.x) * e0[1]); o.y = pk_bf16(bflo(lo.y) * e0[2], bfhi(lo.y) * e0[3]);
        o.z = pk_bf16(bflo(hi.x) * e1[0], bfhi(hi.x) * e1[1]); o.w = pk_bf16(bflo(hi.y) * e1[2], bfhi(hi.y) * e1[3]);
        *(u32x4*)(cb + 32768 + (size_t)dk * 128 + 16 * ((2 * s + h2) ^ ((dk >> 1) & 7))) = o; }
      __syncthreads();
      const int ii = ttid >> 4, jj = ttid & 15;
#pragma unroll
      for (int pb = 1; pb < 4; ++pb) {
#pragma unroll
        for (int q = 0; q < pb; ++q) {
          float acc = 0.f;
#pragma unroll
          for (int r2 = q; r2 < pb; ++r2)
#pragma unroll
            for (int m4 = 0; m4 < 16; m4 += 4) { const f32x4 av = *(const LAS f32x4*)(Am + (16 * pb + ii) * 64 + 16 * r2 + m4); const LAS float* tp = Am + (16 * r2 + m4) * 64 + 16 * q + jj;
              acc += av.x * tp[0] + av.y * tp[64] + av.z * tp[128] + av.w * tp[192]; }
          Pt[q * 256 + ii * 16 + jj] = acc;
        }
        __syncthreads();
#pragma unroll
        for (int q = 0; q < pb; ++q) {
          float acc = 0.f;
#pragma unroll
          for (int m4 = 0; m4 < 16; m4 += 4) { const f32x4 tv = *(const LAS f32x4*)(Am + (16 * pb + ii) * 64 + 16 * pb + m4); const LAS float* pp = Pt + q * 256 + m4 * 16 + jj;
            acc += tv.x * pp[0] + tv.y * pp[16] + tv.z * pp[32] + tv.w * pp[48]; }
          Am[(16 * pb + ii) * 64 + 16 * q + jj] = -acc;
        }
        __syncthreads();
      }
      float tv2[16];
#pragma unroll
      for (int k = 0; k < 16; ++k) tv2[k] = Am[(ttid >> 6) * 64 + k * 256 + (ttid & 63)];
      const float bj = sc[64 + (ttid & 63)], bej = bj * __expf(sc[ttid & 63]);
      __syncthreads();
#pragma unroll
      for (int k = 0; k < 16; ++k) { const int row = 4 * k + (ttid >> 6); T1[row * 72 + (ttid & 63)] = f2bf(tv2[k] * bj); T2[row * 72 + (ttid & 63)] = f2bf(tv2[k] * bej); }
    }
    __syncthreads();
#pragma unroll
    for (int q = 0; q < 2; ++q) {
      const int job = tw * 2 + q;
      const int mu = job & 1, nu = job >> 1, mw = job >> 1, nw = job & 1;
      f32x16 au, aw;
#pragma unroll
      for (int i = 0; i < 16; ++i) { au[i] = 0.f; aw[i] = 0.f; }
#pragma unroll
      for (int s = 0; s < 4; ++s) {
        au = MFMA32(*(const LAS bf16x8*)(T1 + (32 * mu + r) * 72 + 16 * s + 8 * hf), *(const LAS bf16x8*)(vT + (32 * nu + r) * 72 + 16 * s + 8 * hf), au);
        aw = MFMA32(*(const LAS bf16x8*)(kT + (32 * mw + r) * 72 + 16 * s + 8 * hf), *(const LAS bf16x8*)(T2 + (32 * nw + r) * 72 + 16 * s + 8 * hf), aw); }
      {
        bf16_t* up = (bf16_t*)(cb + 57344 + (size_t)(32 * nu + r) * 128) + 32 * mu + 8 * hf; store8(up, au, 0, 1.f); store8(up + 16, au, 1, 1.f);
        unsigned char* wp = cb + (size_t)(32 * nw + r) * 256; const int sw = (32 * nw + r) & 15; store8((bf16_t*)(wp + 16 * ((4 * mw + hf) ^ sw)), aw, 0, 1.f); store8((bf16_t*)(wp + 16 * ((4 * mw + 2 + hf) ^ sw)), aw, 1, 1.f); }
    }
    __syncthreads();
  }
}

DI void scan_unit(const Ctx& c, LAS unsigned char* sl) {
  const int bh = c.bid & 63, dv0 = (c.bid >> 6) * 32, b = bh >> 2, hh = bh & 3, r = c.lane & 31, hf = c.lane >> 5;
  const unsigned char* ws = c.p.ws; const float* egl = (const float*)(ws + WS_MISC + MiB + 4096); bf16_t* ycat = (bf16_t*)(c.p.ws + WS_YCAT);
  const unsigned char* cb0 = ws + WS_GDN + (size_t)(bh * 32) * GDN_CHUNK_BYTES;
  f32x16 S[4];
#pragma unroll
  for (int m = 0; m < 4; ++m)
#pragma unroll
    for (int i = 0; i < 16; ++i) S[m][i] = 0.f;
  const int sw16 = r & 15, sw8 = (r >> 1) & 7;
#define SCAN_DMA(buf, chunk) do { const unsigned char* _g = cb0 + (size_t)(chunk) * GDN_CHUNK_BYTES + c.lane * 16; LAS unsigned char* _l = sl + (buf) * 57344; \
    _Pragma("unroll") for (int _i = 0; _i < 56; ++_i) __builtin_amdgcn_global_load_lds((const unsigned*)(_g + _i * 1024), (LAS unsigned*)(_l + _i * 1024), 16, 0, 0); } while (0)
  SCAN_DMA(0, 0);
  u32x4 un[4];
#pragma unroll
  for (int q = 0; q < 4; ++q) un[q] = *(const u32x4*)(cb0 + 57344 + (size_t)(dv0 + r) * 128 + 32 * q + 16 * hf);
  for (int n = 0; n < 32; ++n) {
    asm volatile("s_waitcnt vmcnt(0)" ::: "memory");
    u32x4 uc[4];
#pragma unroll
    for (int q = 0; q < 4; ++q) uc[q] = un[q];
    const int nn = n < 31 ? n + 1 : 31;
    SCAN_DMA((n + 1) & 1, nn);
#pragma unroll
    for (int q = 0; q < 4; ++q) un[q] = *(const u32x4*)(cb0 + (size_t)nn * GDN_CHUNK_BYTES + 57344 + (size_t)(dv0 + r) * 128 + 32 * q + 16 * hf);
    const float eg = egl[bh * 32 + n];
    const LAS unsigned char* L = sl + (n & 1) * 57344;
    const LAS unsigned char* wL = L + r * 256; const LAS unsigned char* qL = L + 16384 + r * 256; const LAS unsigned char* kL = L + 32768 + r * 128; const LAS unsigned char* aL = L + 49152 + r * 128;
    bf16x8 Sb[8];
#pragma unroll
    for (int s = 0; s < 8; ++s) Sb[s] = pack8(S[s >> 1], s & 1);
    f32x16 vn[2], o[2];
#pragma unroll
    for (int m = 0; m < 2; ++m) {
#pragma unroll
      for (int i = 0; i < 16; ++i) { vn[m][i] = 0.f; o[m][i] = 0.f; }
#pragma unroll
      for (int s = 0; s < 8; ++s) { vn[m] = MFMA32(*(const LAS bf16x8*)(wL + m * 8192 + 16 * ((2 * s + hf) ^ sw16)), Sb[s], vn[m]); o[m] = MFMA32(*(const LAS bf16x8*)(qL + m * 8192 + 16 * ((2 * s + hf) ^ sw16)), Sb[s], o[m]); }
    }
#pragma unroll
    for (int m = 0; m < 2; ++m)
#pragma unroll
      for (int s2 = 0; s2 < 2; ++s2) { const u32x4 uv = uc[2 * m + s2];
#pragma unroll
        for (int q = 0; q < 4; ++q) { vn[m][8 * s2 + 2 * q] = bflo(uv[q]) - vn[m][8 * s2 + 2 * q]; vn[m][8 * s2 + 2 * q + 1] = bfhi(uv[q]) - vn[m][8 * s2 + 2 * q + 1]; } }
    bf16x8 vb[4];
#pragma unroll
    for (int s = 0; s < 4; ++s) vb[s] = pack8(vn[s >> 1], s & 1);
#pragma unroll
    for (int m = 0; m < 2; ++m)
#pragma unroll
      for (int s = 0; s < 4; ++s) o[m] = MFMA32(*(const LAS bf16x8*)(aL + m * 4096 + 16 * ((2 * s + hf) ^ sw8)), vb[s], o[m]);
#pragma unroll
    for (int m = 0; m < 4; ++m) {
#pragma unroll
      for (int i = 0; i < 16; ++i) S[m][i] *= eg;
#pragma unroll
      for (int s = 0; s < 4; ++s) S[m] = MFMA32(*(const LAS bf16x8*)(kL + m * 4096 + 16 * ((2 * s + hf) ^ sw8)), vb[s], S[m]);
    }
    bf16_t* yp = ycat + (size_t)(b * SEQ + n * 64) * 1536 + hh * 128 + dv0 + r;
#pragma unroll
    for (int m = 0; m < 2; ++m)
#pragma unroll
      for (int i = 0; i < 16; ++i) yp[(size_t)(32 * m + crow(i, hf)) * 1536] = f2bf(o[m][i]);
  }
  asm volatile("s_waitcnt vmcnt(0)" ::: "memory");
#undef SCAN_DMA
}
#endif

#if !NAIVE_ATTN
DI void load_v64(u32x4 (&vr)[4], const bf16_t* vsrc, size_t ld, int lane) {
#pragma unroll
  for (int i = 0; i < 4; ++i) { const int q = lane + 64 * i; vr[i] = *(const u32x4*)(vsrc + (size_t)(q >> 3) * ld + (q & 7) * 8); }
}
DI void put_v64(LAS bf16_t* vl, const u32x4 (&vr)[4], int lane) {
#pragma unroll
  for (int i = 0; i < 4; ++i) { const int q = lane + 64 * i; *(LAS u32x4*)(vl + (q >> 3) * 64 + (q & 7) * 8) = vr[i]; }
}
DI bf16x8 gather_vt(const LAS bf16_t* vl, int m, int s, int lane) {
  const int i16 = lane & 15, q = i16 >> 2, pp = i16 & 3, g16 = (lane >> 4) & 1, hf = lane >> 5;
  const LAS bf16_t* a0 = vl + (16 * s + 4 * hf + q) * 64 + 32 * m + 16 * g16 + 4 * pp;
  const s16x4 lo = __builtin_amdgcn_ds_read_tr16_b64_v4i16((LAS s16x4*)a0), hi = __builtin_amdgcn_ds_read_tr16_b64_v4i16((LAS s16x4*)(a0 + 8 * 64));
  return __builtin_shufflevector(lo, hi, 0, 1, 2, 3, 4, 5, 6, 7);
}
constexpr float SB_EXIT = 40.f;
#define SB_TILE(Kc, Vc, KT) do { \
    LDS_WAIT(); \
    put_v64(vl, Vc, c.lane); \
    _Pragma("unroll") for (int i = 0; i < 4; ++i) { const int q = c.lane + 64 * i; *(LAS u32x4*)(kl + (q >> 3) * 72 + (q & 7) * 8) = Kc[i]; } \
    { const int kp = (KT) - 3 > 0 ? (KT) - 3 : 0;          \
      load_v64(Kc, kbase + (size_t)(32 * kp) * NPROJ, NPROJ, c.lane); load_v64(Vc, vbase + (size_t)(32 * kp) * NPROJ, NPROJ, c.lane); } \
    LDS_WAIT(); \
    f32x16 z; \
    _Pragma("unroll") for (int i = 0; i < 16; ++i) z[i] = 0.f; \
    _Pragma("unroll") for (int s = 0; s < 4; ++s) z = MFMA32(*(const LAS bf16x8*)(kl + r * 72 + 16 * s + 8 * hf), Qf[s], z); \
    float sp[16]; \
    _Pragma("unroll") for (int i = 0; i < 16; ++i) { z[i] *= 0.125f; const bool valid = ((KT) < qt) || (crow(i, hf) < r); sp[i] = valid ? softplus_fast(z[i]) : 0.f; } \
    float mine[4], oth[4], both[4]; \
    _Pragma("unroll") for (int g = 0; g < 4; ++g) { mine[g] = (sp[4 * g] + sp[4 * g + 1]) + (sp[4 * g + 2] + sp[4 * g + 3]); oth[g] = __shfl_xor(mine[g], 32); both[g] = mine[g] + oth[g]; } \
    float tail[4]; tail[3] = 0.f; tail[2] = both[3]; tail[1] = both[3] + both[2]; tail[0] = tail[1] + both[1]; \
    _Pragma("unroll") for (int g = 0; g < 4; ++g) { \
      float run = carry + tail[g] + (hf == 0 ? oth[g] : 0.f); \
      _Pragma("unroll") for (int q = 3; q >= 0; --q) { const int i = 4 * g + q; run += sp[i]; const bool valid = ((KT) < qt) || (crow(i, hf) < r); z[i] = valid ? __expf(z[i] - run) : 0.f; } \
    } \
    carry += tail[0] + both[0]; \
    const bf16x8 w0 = pack8(z, 0), w1 = pack8(z, 1); \
    LDS_WAIT(); \
    _Pragma("unroll") for (int m = 0; m < 2; ++m) { O[m] = MFMA32(gather_vt(vl, m, 0, c.lane), w0, O[m]); O[m] = MFMA32(gather_vt(vl, m, 1, c.lane), w1, O[m]); } \
  } while (0)
DI void sb_unit(const Ctx& c, int u, LAS bf16_t* vl) {
  const bf16_t* proj = (const bf16_t*)(c.p.ws + WS_PROJ); bf16_t* ycat = (bf16_t*)(c.p.ws + WS_YCAT);
  const int qt = 63 - (u & 63), hh = (u >> 6) & 7, b = u >> 9, r = c.lane & 31, hf = c.lane >> 5;
  const size_t tok0 = (size_t)b * SEQ + 32 * qt;
  LAS bf16_t* kl = vl + 2048;
  const bf16_t* kbase = proj + (size_t)b * SEQ * NPROJ + C_SK + hh * 64; const bf16_t* vbase = proj + (size_t)b * SEQ * NPROJ + C_SV + hh * 64;
  bf16x8 Qf[4]; u32x4 K0[4], V0[4], K1[4], V1[4], K2[4], V2[4];
  { const int k1 = qt > 0 ? qt - 1 : 0, k2 = qt > 1 ? qt - 2 : 0;
    load_v64(K0, kbase + (size_t)(32 * qt) * NPROJ, NPROJ, c.lane); load_v64(V0, vbase + (size_t)(32 * qt) * NPROJ, NPROJ, c.lane);
#pragma unroll
    for (int s = 0; s < 4; ++s) Qf[s] = *(const bf16x8*)(proj + (tok0 + r) * NPROJ + C_SQ + hh * 64 + 16 * s + 8 * hf);
    load_v64(K1, kbase + (size_t)(32 * k1) * NPROJ, NPROJ, c.lane); load_v64(V1, vbase + (size_t)(32 * k1) * NPROJ, NPROJ, c.lane);
    load_v64(K2, kbase + (size_t)(32 * k2) * NPROJ, NPROJ, c.lane); load_v64(V2, vbase + (size_t)(32 * k2) * NPROJ, NPROJ, c.lane); }
  f32x16 O[2];
#pragma unroll
  for (int m = 0; m < 2; ++m)
#pragma unroll
    for (int i = 0; i < 16; ++i) O[m][i] = 0.f;
  float carry = 0.f;
  for (int kt = qt; kt >= 0; kt -= 3) {
    SB_TILE(K0, V0, kt);
    if (kt - 1 < 0 || __all(carry > SB_EXIT)) break;
    SB_TILE(K1, V1, kt - 1);
    if (kt - 2 < 0 || __all(carry > SB_EXIT)) break;
    SB_TILE(K2, V2, kt - 2);
    if (__all(carry > SB_EXIT)) break;
  }
  bf16_t* yp = ycat + (tok0 + r) * 1536 + 512 + hh * 64;
#pragma unroll
  for (int m = 0; m < 2; ++m)
#pragma unroll
    for (int g = 0; g < 4; ++g) { u32x2 w; w.x = pk_bf16(O[m][4 * g], O[m][4 * g + 1]); w.y = pk_bf16(O[m][4 * g + 2], O[m][4 * g + 3]); *(u32x2*)(yp + 32 * m + 8 * g + 4 * hf) = w; }
}
#undef SB_TILE
DI bf16x8 gather_vt_p(const LAS bf16_t* vlp, int key0, int m, int s, int lane) {
  const int i16 = lane & 15, q = i16 >> 2, pp = i16 & 3, g16 = (lane >> 4) & 1, hf = lane >> 5;
  const LAS bf16_t* a0 = vlp + (key0 + 16 * s + 4 * hf + q) * 136 + 32 * m + 16 * g16 + 4 * pp;
  const s16x4 lo = __builtin_amdgcn_ds_read_tr16_b64_v4i16((LAS s16x4*)a0), hi = __builtin_amdgcn_ds_read_tr16_b64_v4i16((LAS s16x4*)(a0 + 8 * 136));
  return __builtin_shufflevector(lo, hi, 0, 1, 2, 3, 4, 5, 6, 7);
}
DI void mem_block(const Ctx& c) {
  const bf16_t* proj = (const bf16_t*)(c.p.ws + WS_PROJ); const bf16_t* mkv = (const bf16_t*)(c.p.ws + WS_MKV); bf16_t* ycat = (bf16_t*)(c.p.ws + WS_YCAT);
  LAS bf16_t* Kl = (LAS bf16_t*)c.lds; LAS bf16_t* Vl = Kl + 256 * 136;
  const int r = c.lane & 31, hf = c.lane >> 5;
  for (int it = c.bid; it < NB * 4 * 4; it += c.G) {
    const int bh = it >> 2, qq = it & 3, b = bh >> 2, hh = bh & 3;
    __syncthreads();
    { const bf16_t* ksrc = mkv + (size_t)b * MEMLEN * 1024 + hh * 128; const bf16_t* vsrc = ksrc + 512;
      u32x4 kr[8], vr[8];
#pragma unroll
      for (int j = 0; j < 8; ++j) { const int i = c.tid + 512 * j, key = i >> 4, pc = (i & 15) * 8; kr[j] = *(const u32x4*)(ksrc + (size_t)key * 1024 + pc); vr[j] = *(const u32x4*)(vsrc + (size_t)key * 1024 + pc); }
#pragma unroll
      for (int j = 0; j < 8; ++j) { const int i = c.tid + 512 * j, key = i >> 4, pc = (i & 15) * 8; *(LAS u32x4*)(Kl + key * 136 + pc) = kr[j]; *(LAS u32x4*)(Vl + key * 136 + pc) = vr[j]; } }
    __syncthreads();
    if (c.p.flags & 256) continue;
    for (int uq = 0; uq < 2; ++uq) {
      const int qt = qq * 16 + c.wave * 2 + uq; const size_t tok0 = (size_t)b * SEQ + 32 * qt;
      bf16x8 Qf[8];
#pragma unroll
      for (int s = 0; s < 8; ++s) Qf[s] = *(const bf16x8*)(proj + (tok0 + r) * NPROJ + C_MQ + hh * 128 + 16 * s + 8 * hf);
      f32x16 z[8];
#pragma unroll
      for (int kt = 0; kt < 8; ++kt) {
#pragma unroll
        for (int i = 0; i < 16; ++i) z[kt][i] = 0.f;
      }
#pragma unroll
      for (int s = 0; s < 8; ++s) {
#pragma unroll
        for (int kt = 0; kt < 8; ++kt) z[kt] = MFMA32(*(const LAS bf16x8*)(Kl + (32 * kt + r) * 136 + 16 * s + 8 * hf), Qf[s], z[kt]);
        asm volatile("" ::: "memory");
      }
      float tm = -INFINITY;
#pragma unroll
      for (int kt = 0; kt < 8; ++kt)
#pragma unroll
        for (int i = 0; i < 16; ++i) tm = fmaxf(tm, z[kt][i]);
      tm = fmaxf(tm, __shfl_xor(tm, 32)) * 0.08838834764831845f;
      float ps = 0.f;
      f32x16 O[4];
#pragma unroll
      for (int m = 0; m < 4; ++m)
#pragma unroll
        for (int i = 0; i < 16; ++i) O[m][i] = 0.f;
#pragma unroll
      for (int kt = 0; kt < 8; ++kt) {
#pragma unroll
        for (int i = 0; i < 16; ++i) { z[kt][i] = __expf(z[kt][i] * 0.08838834764831845f - tm); ps += z[kt][i]; }
        const bf16x8 w0 = pack8(z[kt], 0), w1 = pack8(z[kt], 1);
#pragma unroll
        for (int m = 0; m < 4; ++m) { O[m] = MFMA32(gather_vt_p(Vl, 32 * kt, m, 0, c.lane), w0, O[m]); O[m] = MFMA32(gather_vt_p(Vl, 32 * kt, m, 1, c.lane), w1, O[m]); }
        asm volatile("" ::: "memory");
      }
      ps += __shfl_xor(ps, 32);
      const float il = 1.f / ps;
      bf16_t* yp = ycat + (tok0 + r) * 1536 + 1024 + hh * 128;
#pragma unroll
      for (int m = 0; m < 4; ++m)
#pragma unroll
        for (int g = 0; g < 4; ++g) { u32x2 w; w.x = pk_bf16(O[m][4 * g] * il, O[m][4 * g + 1] * il); w.y = pk_bf16(O[m][4 * g + 2] * il, O[m][4 * g + 3] * il); *(u32x2*)(yp + 32 * m + 8 * g + 4 * hf) = w; }
    }
  }
  __syncthreads();
}
DI void phase_attn_scan(const Ctx& c) {
  __syncthreads();
#if !NAIVE_GDN
  if (c.wave == 0) { if (!(c.p.flags & 1)) scan_unit(c, c.lds); }
#if MOE_I8 && W8_BESIDE_SCAN
  else if (!(c.p.flags & 1)) {
    phase0b_light(c, c.lds + 114688 + (c.wave - 1) * 4608, c.bid * 7 + c.wave - 1, c.G * 7);
    wdn_light(c, (LAS bf16_t*)(c.lds + 114688 + (c.wave - 1) * 4608), c.bid * 7 + c.wave - 1, c.G * 7); }
#endif
  __syncthreads();
#endif
  if (c.p.flags & 2) return;
  if (!(c.p.flags & 64)) mem_block(c);
  LAS bf16_t* vl = (LAS bf16_t*)(c.lds + c.wave * 8704);
  if (!(c.p.flags & 128)) for (int u = c.gw; u < NB * 8 * 64; u += c.ngw) sb_unit(c, u, vl);
}
#endif
#if NAIVE_P5
DI void naive_mixed(const Ctx& c) {
  const bf16_t* ycat = (const bf16_t*)(c.p.ws + WS_YCAT); const bf16_t* wp = (const bf16_t*)(c.p.ws + WS_WP); const bf16_t* proj = (const bf16_t*)(c.p.ws + WS_PROJ); bf16_t* mixed = (bf16_t*)(c.p.ws + WS_MIXED);
  const int r = c.lane & 31, h = c.lane >> 5;
  for (int tile = c.gw; tile < (TT / 32) * 32; tile += c.ngw) {
    const int tm = tile >> 5, tn = tile & 31; float res[16];
#pragma unroll
    for (int i = 0; i < 16; ++i) res[i] = 0.f;
    for (int b = 0; b < 3; ++b) {
      const bf16_t* ap = ycat + (size_t)(tm * 32 + r) * 1536 + b * 512 + 8 * h; const bf16_t* bp = wp + (size_t)(tn * 32 + r) * 1536 + b * 512 + 8 * h;
      f32x16 acc; for (int i = 0; i < 16; ++i) acc[i] = 0.f;
      for (int k0 = 0; k0 < 512; k0 += 16) acc = MFMA32(*(const bf16x8*)(ap + k0), *(const bf16x8*)(bp + k0), acc);
#pragma unroll
      for (int i = 0; i < 16; ++i) res[i] += acc[i] * sigmoidf_(bf2f(proj[(size_t)(tm * 32 + crow(i, h)) * NPROJ + C_GATE + b * 1024 + tn * 32 + r]));
    }
#pragma unroll
    for (int i = 0; i < 16; ++i) mixed[(size_t)(tm * 32 + crow(i, h)) * DM + tn * 32 + r] = f2bf(res[i]);
  }
}
#endif
#if NAIVE_MOE
DI void naive_gateup(const Ctx& c, const LAS int* tab) {
  const bf16_t* x1b = (const bf16_t*)(c.p.ws + WS_X1B); const bf16_t* wgu = (const bf16_t*)(c.p.ws + WS_WGU); bf16_t* act = (bf16_t*)(c.p.ws + WS_ACT); const u32x2* rinfo = (const u32x2*)(c.p.ws + WS_RINFO);
  const float* bgu = c.p.in[I_BGU];
  const int r = c.lane & 31, h = c.lane >> 5, ntile = (tab[64] >> 5) * 32;
  for (int tile = c.gw; tile < ntile; tile += c.ngw) {
    const int tm = tile >> 5, tj = tile & 31, e = tab[96 + (tm >> 3)], local = tm * 32 + r - tab[32 + e];
    const int tok = local < tab[e] ? (int)(rinfo[(size_t)e * ECAP + local].x >> 2) : 0;
    const int j0 = tj * 32, wrow = (j0 >> 7) * 256 + (j0 & 127);
    const bf16_t* ap = x1b + (size_t)tok * DM + 8 * h; const bf16_t* bg = wgu + ((size_t)e * 2048 + wrow + r) * DM + 8 * h; const bf16_t* bl = bg + (size_t)128 * DM;
    f32x16 ag, al; for (int i = 0; i < 16; ++i) { ag[i] = 0.f; al[i] = 0.f; }
    for (int k0 = 0; k0 < DM; k0 += 16) { const bf16x8 a = *(const bf16x8*)(ap + k0); ag = MFMA32(a, *(const bf16x8*)(bg + k0), ag); al = MFMA32(a, *(const bf16x8*)(bl + k0), al); }
    const float bgv = bgu[(size_t)e * 2048 + j0 + r], blv = bgu[(size_t)e * 2048 + 1024 + j0 + r];
#pragma unroll
    for (int i = 0; i < 16; ++i) { const float glu = fminf(ag[i] + bgv, SWIGLU_LIMIT), lin = fminf(fmaxf(al[i] + blv, -SWIGLU_LIMIT), SWIGLU_LIMIT);
      act[(size_t)(tm * 32 + crow(i, h)) * DFF + j0 + r] = f2bf(glu * sigmoidf_(SWIGLU_ALPHA * glu) * (lin + 1.f)); }
  }
}
DI void naive_down(const Ctx& c, const LAS int* tab) {
  const bf16_t* act = (const bf16_t*)(c.p.ws + WS_ACT); const bf16_t* wdn = (const bf16_t*)(c.p.ws + WS_WDN); bf16_t* yp = (bf16_t*)(c.p.ws + WS_YPAIR); const u32x2* rinfo = (const u32x2*)(c.p.ws + WS_RINFO);
  const float* bdn = c.p.in[I_BDN];
  const int r = c.lane & 31, h = c.lane >> 5, ntile = (tab[64] >> 5) * 32;
  for (int tile = c.gw; tile < ntile; tile += c.ngw) {
    const int tm = tile >> 5, tn = tile & 31, e = tab[96 + (tm >> 3)];
    const bf16_t* ap = act + (size_t)(tm * 32 + r) * DFF + 8 * h; const bf16_t* bp = wdn + ((size_t)e * DM + tn * 32 + r) * DFF + 8 * h;
    f32x16 acc; for (int i = 0; i < 16; ++i) acc[i] = 0.f;
    for (int k0 = 0; k0 < DFF; k0 += 16) acc = MFMA32(*(const bf16x8*)(ap + k0), *(const bf16x8*)(bp + k0), acc);
    const float bv = bdn[(size_t)e * DM + tn * 32 + r];
#pragma unroll
    for (int i = 0; i < 16; ++i) { const int local = tm * 32 + crow(i, h) - tab[32 + e];
      if (local < tab[e]) { const u32x2 info = rinfo[(size_t)e * ECAP + local]; yp[(size_t)info.x * DM + tn * 32 + r] = f2bf((acc[i] + bv) * __uint_as_float(info.y)); } }
  }
}
#endif

DI void stagger(const Ctx& c, int ng, int step) {
  const int g = (c.bid >> 3) % ng;
  if (g && c.tid == 0) { const unsigned long long t0 = __builtin_amdgcn_s_memrealtime(), dt = (unsigned long long)(g * step); while (__builtin_amdgcn_s_memrealtime() - t0 < dt) __builtin_amdgcn_s_sleep(32); }
  __syncthreads();
}
__global__ void __launch_bounds__(512, 2) mega(Params p) {
  extern __shared__ __attribute__((aligned(16))) unsigned char lds_raw[];
  cg::grid_group grid = cg::this_grid();
  Ctx c; c.lds = (LAS unsigned char*)lds_raw; c.tid = threadIdx.x; c.lane = c.tid & 63; c.wave = __builtin_amdgcn_readfirstlane(c.tid >> 6);
  c.G = gridDim.x; c.bid = blockIdx.x; c.gw = c.bid * 8 + c.wave; c.ngw = c.G * 8; c.p = p;
  unsigned char* ws = p.ws;
  LAS int* gtab = (LAS int*)(c.lds + 131072);
#define IN(k) (p.ph_lo <= (k) && (k) < p.ph_hi)
  { volatile LAS unsigned* st = (volatile LAS unsigned*)(c.lds + 147440); if (c.tid < 4) st[c.tid] = 0u; }
  __syncthreads();
  const XcdBarrier xbar = xcd_barrier_post((unsigned*)(ws + WS_BAR) + p.pad * XCD_BAR_WORDS, (volatile LAS unsigned*)(c.lds + 147440));
#define SEAM(k) do { if ((k) + 1 < p.ph_hi) { if (USE_CG_ALL || (k) == 0) grid.sync(); else xcd_barrier(xbar); } } while (0)
#define REP(k)

  if (IN(0)) { REP(0) phase0(c);
#if GATE_I8
    xcd_barrier(xbar); phase0c(c);
#endif
    SEAM(0); }
  if (IN(1)) {
    REP(1) {
#if NAIVE_P1
    { bf16_t* proj = (bf16_t*)(ws + WS_PROJ); naive_gemm(c, (const bf16_t*)(ws + WS_XB), DM, (const bf16_t*)(ws + WS_WIN), DM, TT, NPROJ_N, DM, [&](int r, int cc, float v) { proj[(size_t)r * NPROJ + cc] = f2bf(v); }); }
    { bf16_t* mkv = (bf16_t*)(ws + WS_MKV); naive_gemm(c, (const bf16_t*)(ws + WS_MEMB), DM, (const bf16_t*)(ws + WS_WMKV), DM, NB * MEMLEN, DM, DM, [&](int r, int cc, float v) { mkv[(size_t)r * DM + cc] = f2bf(v); }); }
#else
#if MOE_I8 && !W8_BESIDE_SCAN
    phase0b(c); __syncthreads();
#endif
#if GATE_I8
    { pg8::Gemm g{(const bf16_t*)(ws + WS_XB), (const bf16_t*)(ws + WS_WIN), DM}; pg8::StaticOrder S; S.init(TT, C_GATE, c.G, c.bid); pg8::EpiStoreBf16 E{(bf16_t*)(ws + WS_PROJ), NPROJ, p.flags & 32, 1 << 30};
      pg8::gemm_phase<pg8::EpiStoreBf16, pg8::StaticOrder, true>(c.lds, g, S, E); }
    { pg8::Gemm g{(const bf16_t*)(ws + WS_XQ), (const bf16_t*)(ws + WS_WG8), DM}; pg8::StaticOrder S; S.init(TT, 3 * DM, c.G, c.bid);
      pg8::EpiGate8 E{(unsigned char*)(ws + WS_PROJ), NPROJ * 2, C_GATE * 2, (const float*)(ws + WS_TSC), (const float*)(ws + WS_WGS)};
      pg8::gemm_phase<pg8::EpiGate8, pg8::StaticOrder, true, true>(c.lds, g, S, E); }
#else
    { pg8::Gemm g{(const bf16_t*)(ws + WS_XB), (const bf16_t*)(ws + WS_WIN), DM}; pg8::StaticOrder S; S.init(TT, NPROJ_N, c.G, c.bid); pg8::EpiStoreBf16 E{(bf16_t*)(ws + WS_PROJ), NPROJ, p.flags & 32, C_GATE};
      pg8::gemm_phase<pg8::EpiStoreBf16, pg8::StaticOrder, true>(c.lds, g, S, E); }
#endif
    { pg8::Gemm g{(const bf16_t*)(ws + WS_MEMB), (const bf16_t*)(ws + WS_WMKV), DM}; pg8::StaticOrder S; S.init(NB * MEMLEN, DM, c.G, c.bid); pg8::EpiStoreBf16 E{(bf16_t*)(ws + WS_MKV), DM, 0, 1 << 30};
      pg8::gemm_phase<pg8::EpiStoreBf16, pg8::StaticOrder, true>(c.lds, g, S, E); }
#endif
    }
    SEAM(1);
  }
  if (IN(2)) {
#if NAIVE_GDN
    naive_gdn_prep(c);
#else
    phase_gdn_chunk(c);
#endif
    SEAM(2);
  }
  if (IN(3)) {
#if NAIVE_GDN
    naive_gdn_scan(c);
#endif
#if NAIVE_ATTN
    naive_sb(c); naive_mem(c);
#else
    phase_attn_scan(c);
#endif
    SEAM(3);
  }
  if (IN(4)) { phase_gdn_norm(c); SEAM(4); }
  if (IN(5)) {
#if NAIVE_P5
    naive_mixed(c);
#else
    REP(5) {
    pg8::Gemm g{(const bf16_t*)(ws + WS_YCAT), (const bf16_t*)(ws + WS_WP), 1536}; pg8::StaticOrder S; S.init(TT, DM, c.G, c.bid); pg8::EpiMixed E{(const unsigned char*)(ws + WS_PROJ), (bf16_t*)(ws + WS_MIXED)};
    pg8::gemm_phase<pg8::EpiMixed, pg8::StaticOrder, true>(c.lds, g, S, E);
    }
#endif
    SEAM(5);
  }
  if (IN(6)) {
#if NAIVE_P6
    { const float* x = p.in[I_X]; float* hh = (float*)(ws + WS_H);
      naive_gemm(c, (const bf16_t*)(ws + WS_MIXED), DM, (const bf16_t*)(ws + WS_WO), DM, TT, DM, DM, [&](int r, int cc, float v) { hh[(size_t)r * DM + cc] = DN_ALPHA * x[(size_t)r * DM + cc] + v; }); }
#else
    REP(6) {
    pg8::Gemm g{(const bf16_t*)(ws + WS_MIXED), (const bf16_t*)(ws + WS_WO), DM}; pg8::StaticOrder S; S.init(TT, DM, c.G, c.bid); pg8::EpiH E{p.in[I_X], (float*)(ws + WS_H)};
    pg8::gemm_phase<pg8::EpiH, pg8::StaticOrder, true>(c.lds, g, S, E);
    }
#endif
    SEAM(6);
  }
  if (IN(7)) { phase_router(c); SEAM(7); }
  if (IN(8)) {
    build_group_tab(c, gtab);
#if NAIVE_MOE
    naive_gateup(c, gtab);
#else
    REP(8) {
#if MOE_I8
    pg8::Gemm g{(const bf16_t*)(ws + WS_X1Q), (const bf16_t*)(ws + WS_WGU), DM}; pg8::GroupOrder S{gtab, (const u32x2*)(ws + WS_RINFO), 8, c.G, c.bid, 1};
    pg8::EpiGateUpI8 E{p.in[I_BGU], (const float*)(ws + WS_WSC), (const float*)(ws + WS_RSC), gtab, (bf16_t*)(ws + WS_ACT)};
    pg8::gemm_phase<pg8::EpiGateUpI8, pg8::GroupOrder, ALIGN_MOE, true>(c.lds, g, S, E);
#else
    pg8::Gemm g{(const bf16_t*)(ws + WS_X1B), (const bf16_t*)(ws + WS_WGU), DM}; pg8::GroupOrder S{gtab, (const u32x2*)(ws + WS_RINFO), 8, c.G, c.bid, 1}; pg8::EpiGateUp E{p.in[I_BGU], (bf16_t*)(ws + WS_ACT)};
    pg8::gemm_phase<pg8::EpiGateUp, pg8::GroupOrder, ALIGN_MOE>(c.lds, g, S, E);
#endif
    }
#endif
    SEAM(8);
  }
  if (IN(9)) {
    build_group_tab(c, gtab);
#if NAIVE_MOE
    naive_down(c, gtab);
#else
    REP(9) {
    pg8::Gemm g{(const bf16_t*)(ws + WS_ACT), (const bf16_t*)(ws + WS_WDN), DFF}; pg8::GroupOrder S{gtab, (const u32x2*)(ws + WS_RINFO), 4, c.G, c.bid, 0};
    pg8::EpiDown E{p.in[I_BDN], gtab, (const u32x2*)(ws + WS_RINFO), (bf16_t*)(ws + WS_YPAIR)};
    pg8::gemm_phase<pg8::EpiDown, pg8::GroupOrder, ALIGN_MOE>(c.lds, g, S, E);
    }
#endif
    SEAM(9);
  }
  if (IN(10)) { REP(10) phase_final(c); }
#undef IN
#undef SEAM
}

extern "C" void kernel_launch(void* const* d_in, const int* in_sizes, int n_in, void* d_out, int out_size, void* d_ws, size_t ws_size, hipStream_t stream) {
  static int grid_blocks = 0;
  if (grid_blocks == 0) {
    if (n_in != 22 || in_sizes[0] != TT * DM || out_size != TT * DM || ws_size < WS_NEED) {
      fprintf(stderr, "kernel_launch: built for 22 inputs, x/out of %d floats and >= %zu bytes of workspace; got n_in %d in0 %d out %d ws %zu; nothing launched\n", TT * DM, (size_t)WS_NEED, n_in, n_in > 0 ? in_sizes[0] : -1, out_size, ws_size);
      grid_blocks = -1; return; }
    int dev = 0, cus = 0, per_cu = 0;
    if (hipGetDevice(&dev) != hipSuccess || hipDeviceGetAttribute(&cus, hipDeviceAttributeMultiprocessorCount, dev) != hipSuccess) { grid_blocks = -1; return; }
    if (hipFuncSetAttribute((const void*)mega, hipFuncAttributeMaxDynamicSharedMemorySize, LDS_BYTES) != hipSuccess) { fprintf(stderr, "kernel_launch: hipFuncSetAttribute failed\n"); grid_blocks = -1; return; }
    if (hipOccupancyMaxActiveBlocksPerMultiprocessor(&per_cu, (const void*)mega, 512, LDS_BYTES) != hipSuccess || per_cu < 1) { fprintf(stderr, "kernel_launch: occupancy query says %d\n", per_cu); (void)hipGetLastError(); grid_blocks = -1; return; }
    if (cus != 256) { fprintf(stderr, "kernel_launch: the phase program is laid out for 256 CUs (one workgroup each), found %d; nothing launched\n", cus); grid_blocks = -1; return; }
    grid_blocks = cus;
    fprintf(stderr, "kernel_launch: grid %d (cus %d, per_cu %d), ws %zu\n", grid_blocks, cus, per_cu, ws_size);
  }
  if (grid_blocks < 0) return;
  if (hipMemsetAsync((char*)d_ws + WS_BAR, 0, WS_ZERO_BYTES, stream) != hipSuccess) { fprintf(stderr, "kernel_launch: memset of the barrier words failed\n"); return; }
  Params p{};
  for (int i = 0; i < 22; ++i) p.in[i] = (const float*)d_in[i];
  p.out = (float*)d_out; p.ws = (unsigned char*)d_ws;
#if MK_SPLIT
  for (int ph = 0; ph < 11; ++ph) { p.ph_lo = ph; p.ph_hi = ph + 1; void* args[] = {&p};
    hipError_t e = hipLaunchCooperativeKernel((const void*)mega, dim3(grid_blocks), dim3(512), args, LDS_BYTES, stream);
    if (e != hipSuccess) { fprintf(stderr, "kernel_launch: launch of phase %d failed: %s\n", ph, hipGetErrorString(e)); break; } }
#elif REPEAT_PH >= 0
  for (int li = 0; li < 2; ++li) { p.ph_lo = li ? REPEAT_PH + SPLIT_ONLY : 0; p.ph_hi = li ? 11 : REPEAT_PH + 1; p.flags = li ? REPEAT_FLAGS : 0; p.pad = li; void* args[] = {&p};
    hipError_t e = hipLaunchCooperativeKernel((const void*)mega, dim3(grid_blocks), dim3(512), args, LDS_BYTES, stream);
    if (e != hipSuccess) { fprintf(stderr, "kernel_launch: launch %d failed: %s\n", li, hipGetErrorString(e)); break; } }
#else
  p.ph_lo = 0; p.ph_hi = 11; void* args[] = {&p};
  hipError_t e = hipLaunchCooperativeKernel((const void*)mega, dim3(grid_blocks), dim3(512), args, LDS_BYTES, stream);
  if (e != hipSuccess) fprintf(stderr, "kernel_launch: cooperative launch failed: %s (grid %d)\n", hipGetErrorString(e), grid_blocks);
#endif
}
```

```cpp
#define NAIVE_P1 0
#define NAIVE_GDN 0
#define NAIVE_ATTN 0
#define NAIVE_P5 0
#define NAIVE_P6 0
#define NAIVE_MOE 0
#define MK_SPLIT 0
#define REPEAT_PH -1
#define SPLIT_ONLY 0
#define REPEAT_FLAGS 0
#define USE_CG_ALL 0
#define ALIGN_MOE true
#define STAG_N 1
#define STAG_STEP 600
#define NT_STORE 1
#define MOE_I8 1
#define ROUTER_LDS 1
#define ATTN_SKIP_W4 1
#define NPROJ_LD 7168
#define W8_BESIDE_SCAN 1
#define GATE_I8 1
#define DIAG_P8 0
#define NAIVE_ANY (NAIVE_P1 || NAIVE_P6)
#include <hip/hip_runtime.h>
#include <hip/hip_cooperative_groups.h>
#include <cstdio>
#include <cstdint>
namespace cg = cooperative_groups;

#define DI __device__ __forceinline__
#define LAS __attribute__((address_space(3)))
typedef unsigned short bf16_t;
typedef short bf16x8 __attribute__((ext_vector_type(8)));
typedef float f32x2 __attribute__((ext_vector_type(2)));
typedef float f32x4 __attribute__((ext_vector_type(4)));
typedef float f32x16 __attribute__((ext_vector_type(16)));
typedef unsigned u32x2 __attribute__((ext_vector_type(2)));
typedef unsigned u32x4 __attribute__((ext_vector_type(4)));
typedef __bf16 bf16x2_t __attribute__((ext_vector_type(2)));

constexpr int NB = 16, SEQ = 2048, DM = 1024, TT = NB * SEQ;
constexpr int MEMLEN = 256, NEXP = 32, TOPK = 4, DFF = 1024;
constexpr int NPROJ_N = 7168;
constexpr int NPROJ = NPROJ_LD;
constexpr int C_GQ = 0, C_GK = 512, C_GV = 1024, C_GZ = 1536, C_SQ = 2048, C_SK = 2560, C_SV = 3072, C_MQ = 3584, C_GATE = 4096;
constexpr float LN_EPS = 1e-5f, NORM_EPS = 1e-6f;
constexpr float DN_ALPHA = 1.189207115002721f;
constexpr float SWIGLU_LIMIT = 7.0f, SWIGLU_ALPHA = 1.702f;
constexpr int ECAP = 32768;

constexpr size_t MiB = 1u << 20;
constexpr size_t WS_MISC = 0;
constexpr size_t WS_WDN = 3 * MiB, WS_WGU = 67 * MiB, WS_WIN = 195 * MiB, WS_WMKV = 209 * MiB, WS_WP = 211 * MiB, WS_WO = 214 * MiB;
constexpr size_t WS_XB = 216 * MiB, WS_MEMB = 280 * MiB, WS_MKV = 1016 * MiB  , WS_PROJ = 288 * MiB, WS_GDN = 744 * MiB, WS_YCAT = 888 * MiB, WS_RINFO = 1016 * MiB;
constexpr size_t WS_MIXED = WS_XB, WS_H = WS_GDN, WS_X1 = WS_YCAT, WS_X1B = WS_PROJ, WS_ACT = 360 * MiB, WS_YPAIR = 67 * MiB;
constexpr size_t WS_NEED = 1024 * MiB;
constexpr size_t GDN_CHUNK_BYTES = 73728;
constexpr int LDS_BYTES = 147456;

struct Params { const float* in[22]; float* out; unsigned char* ws; int ph_lo, ph_hi, flags, pad; };
enum { I_X = 0, I_MEM, I_WIN, I_WCONV, I_ALOG, I_DTB, I_GNW, I_WMKV, I_WPG, I_WPS, I_WPM, I_WO, I_LN1G, I_LN1B, I_WR, I_BR, I_WGU, I_BGU, I_WDN, I_BDN, I_LN2G, I_LN2B };

DI float bf2f(bf16_t v) { return __uint_as_float((unsigned)v << 16); }
DI unsigned pk_bf16(float a, float b) { f32x2 v = {a, b}; bf16x2_t r = __builtin_convertvector(v, bf16x2_t); return __builtin_bit_cast(unsigned, r); }
DI bf16_t f2bf(float a) { return (bf16_t)(pk_bf16(a, 0.f) & 0xffffu); }
DI float bflo(unsigned w) { return __uint_as_float(w << 16); }
DI float bfhi(unsigned w) { return __uint_as_float(w & 0xffff0000u); }
DI float fexp(float x) { return __builtin_amdgcn_exp2f(x * 1.44269504f); }
DI float sigmoidf_(float x) { return __builtin_amdgcn_rcpf(1.0f + fexp(-x)); }
DI float softplusf_(float x) { return x > 20.f ? x : log1pf(__expf(x)); }
DI float softplus_fast(float x) { return fmaxf(x, 0.f) + 0.69314718f * __builtin_amdgcn_logf(1.f + fexp(-fabsf(x))); }
typedef short s16x4 __attribute__((ext_vector_type(4)));
template <int CTRL, int RM> DI float dpp_mov0(float v) { return __builtin_bit_cast(float, __builtin_amdgcn_update_dpp(0, __builtin_bit_cast(int, v), CTRL, RM, 0xF, false)); }
DI float wave_sum(float v) {
  v += dpp_mov0<0xB1, 0xF>(v);
  v += dpp_mov0<0x4E, 0xF>(v);
  v += dpp_mov0<0x141, 0xF>(v);
  v += dpp_mov0<0x140, 0xF>(v);
  v += dpp_mov0<0x142, 0xA>(v);
  v += dpp_mov0<0x143, 0xC>(v);
  return __builtin_bit_cast(float, __builtin_amdgcn_readlane(__builtin_bit_cast(int, v), 63));
}
DI void wave_sum8(float a0, float a1, float a2, float a3, float b0, float b1, float b2, float b3, float (&ra)[4], float (&rb)[4]) {
  float v[8] = {a0, a1, a2, a3, b0, b1, b2, b3};
#pragma unroll
  for (int i = 0; i < 8; ++i) v[i] += dpp_mov0<0xB1, 0xF>(v[i]);
#pragma unroll
  for (int i = 0; i < 8; ++i) v[i] += dpp_mov0<0x4E, 0xF>(v[i]);
#pragma unroll
  for (int i = 0; i < 8; ++i) v[i] += dpp_mov0<0x141, 0xF>(v[i]);
#pragma unroll
  for (int i = 0; i < 8; ++i) v[i] += dpp_mov0<0x140, 0xF>(v[i]);
#pragma unroll
  for (int i = 0; i < 8; ++i) v[i] += dpp_mov0<0x142, 0xA>(v[i]);
#pragma unroll
  for (int i = 0; i < 8; ++i) v[i] += dpp_mov0<0x143, 0xC>(v[i]);
#pragma unroll
  for (int i = 0; i < 4; ++i) { ra[i] = __builtin_bit_cast(float, __builtin_amdgcn_readlane(__builtin_bit_cast(int, v[i]), 63)); rb[i] = __builtin_bit_cast(float, __builtin_amdgcn_readlane(__builtin_bit_cast(int, v[4 + i]), 63)); }
}
DI float wave_max(float v) {
  v = fmaxf(v, dpp_mov0<0xB1, 0xF>(v)); v = fmaxf(v, dpp_mov0<0x4E, 0xF>(v)); v = fmaxf(v, dpp_mov0<0x141, 0xF>(v)); v = fmaxf(v, dpp_mov0<0x140, 0xF>(v));
  v = fmaxf(v, dpp_mov0<0x142, 0xA>(v)); v = fmaxf(v, dpp_mov0<0x143, 0xC>(v));
  return __builtin_bit_cast(float, __builtin_amdgcn_readlane(__builtin_bit_cast(int, v), 63));
}
#define LDS_WAIT() asm volatile("s_waitcnt lgkmcnt(0)" ::: "memory")
#define VM_WAIT() asm volatile("s_waitcnt vmcnt(0)" ::: "memory")
#define MFMA32(a, b, c) __builtin_amdgcn_mfma_f32_32x32x16_bf16((a), (b), (c), 0, 0, 0)
DI int crow(int reg, int h) { return (reg & 3) + 8 * (reg >> 2) + 4 * h; }
DI int swap23(int k) { return (k & ~12) | ((k & 4) << 1) | ((k & 8) >> 1); }

#define XB_TMO      128
#define XB_XCNT(j)  (256  + 64 * (j))
#define XB_XSUB(j)  (1280 + 64 * (j))
#define XB_XGEN(j)  (2304 + 64 * (j))
#define XB_TOP      3328
#define XB_TOPGEN   3392
#define XCD_BAR_WORDS 3456
#define XB_SPIN_CAP (1u << 18)
DI unsigned xb_ld(unsigned* p)              { return __hip_atomic_load(p, __ATOMIC_RELAXED, __HIP_MEMORY_SCOPE_AGENT); }
DI unsigned xb_add(unsigned* p, unsigned v) { return __hip_atomic_fetch_add(p, v, __ATOMIC_RELAXED, __HIP_MEMORY_SCOPE_AGENT); }
DI unsigned xb_xcc_id() { return (unsigned)__builtin_amdgcn_s_getreg((3 << 11) | 20) & 0xFu; }
#define XB_SPIN(cond, bar) do { unsigned _sp = 0; while (cond) { __builtin_amdgcn_s_sleep(1); \
    if ((++_sp & 255u) == 0u) { if (xb_ld(&(bar)[XB_TMO])) break; if (_sp > XB_SPIN_CAP) { atomicAdd(&(bar)[XB_TMO], 1u); break; } } } } while (0)
struct XcdBarrier { unsigned* bar; unsigned x; volatile LAS unsigned* st; };
DI XcdBarrier xcd_barrier_post(unsigned* bar, volatile LAS unsigned* st) {
  XcdBarrier b; b.bar = bar; b.x = xb_xcc_id(); b.st = st;
  if (threadIdx.x == 0) (void)xb_add(&bar[XB_XCNT(b.x)], 1u);
  return b;
}
DI void xcd_barrier_complete(unsigned* bar, unsigned x, unsigned& nloc, unsigned& nx) {
  const unsigned G = gridDim.x * gridDim.y * gridDim.z;
  unsigned sum, cnt, mine, sp = 0u;
  for (;;) {
    sum = 0u; cnt = 0u; mine = 0u;
#pragma unroll
    for (unsigned j = 0; j < 16; ++j) { const unsigned c = xb_ld(&bar[XB_XCNT(j)]); sum += c; cnt += (c > 0u) ? 1u : 0u; mine = (j == x) ? c : mine; }
    if (sum == G) break;
    __builtin_amdgcn_s_sleep(1);
    if ((++sp & 255u) == 0u) { if (xb_ld(&bar[XB_TMO])) break; if (sp > XB_SPIN_CAP) { atomicAdd(&bar[XB_TMO], 1u); break; } }
  }
  nloc = mine > 0u ? mine : 1u; nx = cnt > 0u ? cnt : 1u;
}
DI void xcd_barrier(const XcdBarrier& b) {
  asm volatile("s_waitcnt vmcnt(0)" ::: "memory");
  __syncthreads();
  if (threadIdx.x == 0) {
    unsigned* bar = b.bar;
    __builtin_amdgcn_s_waitcnt(0);
    unsigned nloc = b.st[0], nx = b.st[1];
    if (nloc == 0u) { xcd_barrier_complete(bar, b.x, nloc, nx); b.st[0] = nloc; b.st[1] = nx; }
    const unsigned old = xb_add(&bar[XB_XSUB(b.x)], 1u);
    const unsigned gen = old / nloc;
    if (old + 1u == (gen + 1u) * nloc) {
      __builtin_amdgcn_fence(__ATOMIC_RELEASE, "agent");
      asm volatile("s_waitcnt vmcnt(0)" ::: "memory");
      const unsigned og = xb_add(&bar[XB_TOP], 1u);
      const unsigned tg = og / nx;
      if (og + 1u == (tg + 1u) * nx) xb_add(&bar[XB_TOPGEN], 1u);
      else XB_SPIN(xb_ld(&bar[XB_TOPGEN]) == tg, bar);
      __builtin_amdgcn_fence(__ATOMIC_ACQUIRE, "agent");
      xb_add(&bar[XB_XGEN(b.x)], 1u);
      asm volatile("s_waitcnt vmcnt(0)" ::: "memory");
    } else {
      XB_SPIN(xb_ld(&bar[XB_XGEN(b.x)]) == gen, bar);
      __builtin_amdgcn_fence(__ATOMIC_ACQUIRE, "agent");
      asm volatile("s_waitcnt vmcnt(0)" ::: "memory");
    }
  }
  __syncthreads();
}
constexpr size_t WS_WRT = 2 * MiB + 512 * 1024;
constexpr size_t WS_BAR = 2 * MiB;
constexpr size_t WS_CMAX = 2 * MiB + 64 * 1024;
constexpr size_t WS_ZERO_BYTES = 336 * 1024;
constexpr size_t WS_CMAXG = 2 * MiB + 320 * 1024;
constexpr size_t WS_WSC = 1 * MiB + 64 * 1024;
constexpr size_t WS_TSC = 2 * MiB + 768 * 1024;
constexpr size_t WS_RSC = 872 * MiB;
constexpr size_t WS_XQ = 744 * MiB;
constexpr size_t WS_WG8 = 776 * MiB;
constexpr size_t WS_WGS = 1 * MiB + 512 * 1024;
constexpr size_t WS_X1Q = 296 * MiB;
typedef int i32x4 __attribute__((ext_vector_type(4)));

struct Ctx {
  LAS unsigned char* lds;
  int tid, lane, wave, G, bid, gw, ngw;
  Params p;
};
namespace pg8 {
#if NT_STORE
#define NTST(v, p) __builtin_nontemporal_store((v), (p))
#else
#define NTST(v, p) (*(p) = (v))
#endif
constexpr int BM = 256, BK = 64, HALF = 128, HTB = HALF * BK * 2  , STAGE_BYTES = 8 * HTB, NXCD = 8, WGM = 8;
DI int lds_byte(int r, int c) { const int st = (r >> 4) * 2 + (c >> 5), rr = r & 15, cc = c & 31, ob = rr * 64 + cc * 2; return st * 1024 + (ob ^ (((ob >> 9) & 1) << 5)); }
DI void stage_rc(int b, int& R, int& C) { const int st = b / 1024, sb = b % 1024, swz = sb ^ (((sb >> 9) & 1) << 5); R = (st >> 1) * 16 + swz / 64; C = (st & 1) * 32 + (swz % 64) / 2; }
DI int perm32(int rho) { const int n = rho >> 4, i = rho & 15; return 8 * (i >> 2) + 4 * n + (i & 3); }

struct Unit { int pm, pn; };
struct Gemm { const bf16_t* A; const bf16_t* Bt; int K; };

struct StaticOrder {
  static constexpr bool LOADS = true;
  int nM, nN, nwg, G, c;
  DI void init(int M, int N, int G_, int c_) { nM = M / BM; nN = N / BM; nwg = nM * nN; G = G_; c = c_; }
  DI bool next(int i, Unit& u) const {
    const long L = (long)i * G + c; if (L >= nwg) return false;
    int wgid = (int)L; { const int q = nwg / NXCD, r = nwg % NXCD, xcd = wgid % NXCD, off = wgid / NXCD; wgid = (xcd < r ? xcd * (q + 1) : r * (q + 1) + (xcd - r) * q) + off; }
    const int nig = WGM * nN, gid = wgid / nig, fm = gid * WGM, gsz = (nM - fm) < WGM ? (nM - fm) : WGM;
    u.pm = fm + ((wgid % nig) % gsz); u.pn = (wgid % nig) / gsz; return true;
  }
  DI int arow(const Unit& u, int r) const { return u.pm * BM + r; }
};
struct GroupOrder {
  static constexpr bool LOADS = true;
  const LAS int* tab; const u32x2* rinfo; int ntn, G, c, gather;
  DI bool next(int i, Unit& u) const {
    const int L = i * G + c, NT = tab[65]; if (L >= NT * ntn) return false;
    const int tile = L / ntn, pnl = L - tile * ntn; u.pm = tile; u.pn = tab[96 + tile] * ntn + pnl; return true;
  }
  DI int arow(const Unit& u, int r) const {
    if (!gather) return u.pm * BM + r;
    const int e = tab[96 + u.pm], local = u.pm * BM + r - tab[32 + e];
    return local < tab[e] ? (int)(rinfo[(size_t)e * ECAP + local].x >> 2) : 0;
  }
};

template <class Epi, class Sched, bool ALIGN_EPI, bool I8 = false, int DIAG_MMA = 0>
DI void gemm_phase(LAS unsigned char* lds, const Gemm g, const Sched& S, const Epi& E) {
  const int tid = threadIdx.x, wid = __builtin_amdgcn_readfirstlane(tid >> 6), lane = tid & 63, wr = wid >> 2, wc = wid & 3, fr = lane & 15, fq = lane >> 4;
  const int K = I8 ? g.K / 2 : g.K, nt = K / BK;
  int RA[2], CA[2]; unsigned voffB[2];
#pragma unroll
  for (int i = 0; i < 2; ++i) { int R, C; stage_rc(tid * 16 + i * 8192, R, C); const int Rb = Epi::PERM ? ((R & ~31) + perm32(R & 31)) : R; RA[i] = R; CA[i] = C; voffB[i] = (unsigned)(Rb * K + C) * 2u; }
  const size_t kstep = (size_t)(BK * 2);
  const size_t hstep = (size_t)HALF * K * 2;
  const size_t tstep = 2 * hstep;
  const unsigned ldsw = (unsigned)wid * 1024u;
  const int aoff = lds_byte(wr * 64 + fr, fq * 8), boff = lds_byte(wc * 32 + fr, fq * 8);
  const char* Ab = (const char*)g.A;
#define PG8_SA(b, h) (((b) * 2 + (h)) * HTB)
#define PG8_SB(b, h) ((4 + (b) * 2 + (h)) * HTB)
#define PG8_STAGE(bufoff, gbase, voff) do { _Pragma("unroll") for (int _i = 0; _i < 2; ++_i) \
    __builtin_amdgcn_global_load_lds((const unsigned*)((const char*)(gbase) + (voff)[_i]), (LAS unsigned*)(lds + (bufoff) + ldsw + _i * 8192), 16, 0, 0); } while (0)
#define PG8_LDA(dst, b, h) do { _Pragma("unroll") for (int m = 0; m < 4; ++m) _Pragma("unroll") for (int k = 0; k < 2; ++k) dst[m][k] = *(const LAS bf16x8*)(lds + PG8_SA(b, h) + aoff + m * 2048 + k * 1024); } while (0)
#define PG8_LDB(dst, b, h) do { _Pragma("unroll") for (int n = 0; n < 2; ++n) _Pragma("unroll") for (int k = 0; k < 2; ++k) dst[n][k] = *(const LAS bf16x8*)(lds + PG8_SB(b, h) + boff + n * 2048 + k * 1024); } while (0)
#define PG8_MMA(ai, bj, At, Bt) do { __builtin_amdgcn_s_setprio(1); _Pragma("unroll") for (int m = 0; m < 4; ++m) _Pragma("unroll") for (int n = 0; n < 2; ++n) _Pragma("unroll") for (int k = 0; k < 2; ++k) { \
    if constexpr (DIAG_MMA == 2) { asm volatile("" :: "v"(Bt[n][k]), "v"(At[m][k])); } else if constexpr (DIAG_MMA == 1) { if (k == 0) { if constexpr (I8) acc[ai][bj][m][n] = __builtin_bit_cast(AccT, __builtin_amdgcn_mfma_i32_16x16x64_i8(__builtin_bit_cast(i32x4, Bt[n][k]), __builtin_bit_cast(i32x4, At[m][k]), __builtin_bit_cast(i32x4, acc[ai][bj][m][n]), 0, 0, 0)); else acc[ai][bj][m][n] = __builtin_bit_cast(AccT, __builtin_amdgcn_mfma_f32_16x16x32_bf16(Bt[n][k], At[m][k], __builtin_bit_cast(f32x4, acc[ai][bj][m][n]), 0, 0, 0)); } else asm volatile("" :: "v"(Bt[n][k]), "v"(At[m][k])); } else \
    if constexpr (I8) acc[ai][bj][m][n] = __builtin_bit_cast(AccT, __builtin_amdgcn_mfma_i32_16x16x64_i8(__builtin_bit_cast(i32x4, Bt[n][k]), __builtin_bit_cast(i32x4, At[m][k]), __builtin_bit_cast(i32x4, acc[ai][bj][m][n]), 0, 0, 0)); \
    else acc[ai][bj][m][n] = __builtin_bit_cast(AccT, __builtin_amdgcn_mfma_f32_16x16x32_bf16(Bt[n][k], At[m][k], __builtin_bit_cast(f32x4, acc[ai][bj][m][n]), 0, 0, 0)); } __builtin_amdgcn_s_setprio(0); } while (0)
#define PG8_WAIT_V(n) asm volatile("s_waitcnt vmcnt(" #n ")" ::: "memory")
#define PG8_WAIT_L(n) asm volatile("s_waitcnt lgkmcnt(" #n ")" ::: "memory")
#define PG8_BAR __builtin_amdgcn_s_barrier()
#define PG8_SCHED __builtin_amdgcn_sched_barrier(0)
  Unit cur, nxt; int ui = 0;
  if (!S.next(0, cur)) return;
  typedef typename Epi::AccT AccT;
  AccT acc[2][2][4][2];
#pragma unroll
  for (int a = 0; a < 2; ++a)
#pragma unroll
    for (int b = 0; b < 2; ++b)
#pragma unroll
      for (int m = 0; m < 4; ++m)
#pragma unroll
        for (int n = 0; n < 2; ++n) acc[a][b][m][n] = (AccT){0, 0, 0, 0};
  bf16x8 At[4][2], B0[2][2], B1[2][2];
  unsigned cvo0[2], cvo1[2], nvo0[2], nvo1[2];
#pragma unroll
  for (int i = 0; i < 2; ++i) { cvo0[i] = ((unsigned)S.arow(cur, RA[i]) * (unsigned)K + (unsigned)CA[i]) * 2u; cvo1[i] = ((unsigned)S.arow(cur, HALF + RA[i]) * (unsigned)K + (unsigned)CA[i]) * 2u; }
  const char* cB = (const char*)g.Bt + (size_t)cur.pn * tstep;
  PG8_STAGE(PG8_SB(0, 0), cB, voffB); PG8_STAGE(PG8_SB(0, 1), cB + hstep, voffB); PG8_STAGE(PG8_SA(0, 0), Ab, cvo0); PG8_STAGE(PG8_SA(0, 1), Ab, cvo1);
  if (wr == 1) PG8_BAR;
  PG8_WAIT_V(2); PG8_BAR;
  PG8_STAGE(PG8_SB(1, 0), cB + kstep, voffB); PG8_STAGE(PG8_SA(1, 0), Ab + kstep, cvo0); PG8_STAGE(PG8_SB(1, 1), cB + hstep + kstep, voffB);
  PG8_WAIT_V(6); PG8_BAR;
  for (;;) {
    const bool has_next = S.next(ui + 1, nxt);
    if (!has_next) nxt = cur;
#pragma unroll
    for (int i = 0; i < 2; ++i) { nvo0[i] = ((unsigned)S.arow(nxt, RA[i]) * (unsigned)K + (unsigned)CA[i]) * 2u; nvo1[i] = ((unsigned)S.arow(nxt, HALF + RA[i]) * (unsigned)K + (unsigned)CA[i]) * 2u; }
    const char* nB = (const char*)g.Bt + (size_t)nxt.pn * tstep;
    for (int t = 0; t < nt; t += 2) {
      const bool last = (t == nt - 2);
      if constexpr (Epi::MIDHOOK) { if (t == 8 || t == 16) E.mid(acc, cur, (t >> 3) - 1, wr, wc, fr, fq); }
      const char* a1 = Ab + (size_t)(t + 1) * kstep;
      const char* a2 = last ? Ab : Ab + (size_t)(t + 2) * kstep; const char* b2 = last ? nB : cB + (size_t)(t + 2) * kstep;
      const char* a3 = a2 + kstep; const char* b3 = b2 + kstep;
      unsigned vo0[2], vo1[2];
      if constexpr (Sched::LOADS) {
        if (last) {
#pragma unroll
          for (int i = 0; i < 2; ++i) { vo0[i] = nvo0[i]; vo1[i] = nvo1[i]; }
        } else {
#pragma unroll
          for (int i = 0; i < 2; ++i) { vo0[i] = cvo0[i]; vo1[i] = cvo1[i]; }
        }
      } else {
#pragma unroll
        for (int i = 0; i < 2; ++i) { vo0[i] = last ? nvo0[i] : cvo0[i]; vo1[i] = last ? nvo1[i] : cvo1[i]; }
      }
      PG8_LDB(B0, 0, 0); PG8_LDB(B1, 0, 1); PG8_SCHED; PG8_LDA(At, 0, 0); PG8_STAGE(PG8_SA(1, 1), a1, cvo1);
      PG8_WAIT_V(8); PG8_WAIT_L(0); PG8_BAR; PG8_MMA(0, 0, At, B0); PG8_MMA(0, 1, At, B1); PG8_BAR; PG8_SCHED;
      PG8_LDA(At, 0, 1); PG8_STAGE(PG8_SB(0, 0), b2, voffB); PG8_STAGE(PG8_SB(0, 1), b2 + hstep, voffB); PG8_STAGE(PG8_SA(0, 0), a2, vo0);
      PG8_WAIT_V(8); PG8_WAIT_L(0); PG8_BAR; PG8_MMA(1, 0, At, B0); PG8_MMA(1, 1, At, B1); PG8_BAR; PG8_SCHED;
      PG8_LDB(B0, 1, 0); PG8_LDB(B1, 1, 1); PG8_SCHED; PG8_LDA(At, 1, 0); PG8_STAGE(PG8_SA(0, 1), a2, vo1);
      PG8_WAIT_V(8); PG8_WAIT_L(0); PG8_BAR; PG8_MMA(0, 0, At, B0); PG8_MMA(0, 1, At, B1); PG8_BAR; PG8_SCHED;
      PG8_LDA(At, 1, 1); PG8_STAGE(PG8_SB(1, 0), b3, voffB); PG8_STAGE(PG8_SB(1, 1), b3 + hstep, voffB); PG8_STAGE(PG8_SA(1, 0), a3, vo0);
      PG8_WAIT_V(8); PG8_WAIT_L(0); PG8_BAR; PG8_MMA(1, 0, At, B0); PG8_MMA(1, 1, At, B1); PG8_BAR; PG8_SCHED;
    }
    if constexpr (ALIGN_EPI) { if (wr == 0) PG8_BAR; }
    E(acc, cur, wr, wc, fr, fq);
    if (!has_next) break;
#pragma unroll
    for (int a = 0; a < 2; ++a)
#pragma unroll
      for (int b = 0; b < 2; ++b)
#pragma unroll
        for (int m = 0; m < 4; ++m)
#pragma unroll
          for (int n = 0; n < 2; ++n) acc[a][b][m][n] = (AccT){0, 0, 0, 0};
    cur = nxt; cB = nB; ++ui;
#pragma unroll
    for (int i = 0; i < 2; ++i) { cvo0[i] = nvo0[i]; cvo1[i] = nvo1[i]; }
    if constexpr (ALIGN_EPI) { if (wr == 1) PG8_BAR; }
  }
  PG8_WAIT_V(0);
  if constexpr (!ALIGN_EPI) { if (wr == 0) PG8_BAR; }
  PG8_BAR;
#undef PG8_SA
#undef PG8_SB
#undef PG8_STAGE
#undef PG8_LDA
#undef PG8_LDB
#undef PG8_MMA
#undef PG8_WAIT_V
#undef PG8_WAIT_L
#undef PG8_BAR
#undef PG8_SCHED
}

struct EpiStoreBf16 {
  typedef f32x4 AccT;
  static constexpr bool PERM = true, MIDHOOK = false;
  bf16_t* O; int ldc; int skip; int gcol0;
  DI static unsigned q8(float v) { const float g = __builtin_amdgcn_rcpf(1.f + fexp(-v)); return (unsigned)fminf(fmaxf(rintf(g * 255.f), 1.f), 255.f); }
  DI void operator()(const f32x4 (&acc)[2][2][4][2], const Unit& u, int wr, int wc, int fr, int fq) const {
    if (skip) { asm volatile("" :: "v"(acc[0][0][0][0]), "v"(acc[1][1][3][1])); return; }
    const int row0 = u.pm * BM + wr * 64 + fr, col0 = u.pn * BM + wc * 32 + 8 * fq;
    if (u.pn * BM >= gcol0) {
#pragma unroll
      for (int ai = 0; ai < 2; ++ai)
#pragma unroll
        for (int m = 0; m < 4; ++m) { unsigned char* rowp = (unsigned char*)O + (size_t)(row0 + ai * HALF + m * 16) * ldc * 2 + (size_t)gcol0 * 2 + (col0 - gcol0);
#pragma unroll
          for (int bj = 0; bj < 2; ++bj) { const f32x4 v0 = acc[ai][bj][m][0], v1 = acc[ai][bj][m][1];
            u32x2 w; w.x = q8(v0[0]) | (q8(v0[1]) << 8) | (q8(v0[2]) << 16) | (q8(v0[3]) << 24); w.y = q8(v1[0]) | (q8(v1[1]) << 8) | (q8(v1[2]) << 16) | (q8(v1[3]) << 24);
            NTST(w, (u32x2*)(rowp + bj * HALF)); } }
      return;
    }
#pragma unroll
    for (int ai = 0; ai < 2; ++ai)
#pragma unroll
      for (int m = 0; m < 4; ++m) { bf16_t* rowp = O + (size_t)(row0 + ai * HALF + m * 16) * ldc + col0;
#pragma unroll
        for (int bj = 0; bj < 2; ++bj) { const f32x4 v0 = acc[ai][bj][m][0], v1 = acc[ai][bj][m][1];
          u32x4 w; w.x = pk_bf16(v0[0], v0[1]); w.y = pk_bf16(v0[2], v0[3]); w.z = pk_bf16(v1[0], v1[1]); w.w = pk_bf16(v1[2], v1[3]);
          NTST(w, (u32x4*)(rowp + bj * HALF)); } }
  }
};
struct EpiMixed {
  typedef f32x4 AccT;
  static constexpr bool PERM = true, MIDHOOK = true;
  const unsigned char* gate8; bf16_t* O;
  DI void mid(f32x4 (&acc)[2][2][4][2], const Unit& u, int b, int wr, int wc, int fr, int fq) const {
    int row0 = u.pm * BM + wr * 64 + fr; const int col0 = u.pn * BM + wc * 32 + 8 * fq;
    asm volatile("" : "+v"(row0));
#pragma unroll
    for (int ai = 0; ai < 2; ++ai) {
      u32x2 ga[4][2], gb[4][2];
#pragma unroll
      for (int m = 0; m < 4; ++m) { const unsigned char* gp = gate8 + (size_t)(row0 + ai * HALF + m * 16) * (NPROJ * 2) + C_GATE * 2 + b * DM + col0;
#pragma unroll
        for (int bj = 0; bj < 2; ++bj) { ga[m][bj] = *(const u32x2*)(gp + bj * HALF); gb[m][bj] = *(const u32x2*)(gp + DM + bj * HALF); } }
#pragma unroll
      for (int m = 0; m < 4; ++m)
#pragma unroll
        for (int bj = 0; bj < 2; ++bj)
#pragma unroll
          for (int j = 0; j < 8; ++j) { const float a = (float)((ga[m][bj][j >> 2] >> (8 * (j & 3))) & 0xffu), bb = (float)((gb[m][bj][j >> 2] >> (8 * (j & 3))) & 0xffu);
            acc[ai][bj][m][j >> 2][j & 3] *= a * __builtin_amdgcn_rcpf(bb); }
      asm volatile("" ::: "memory");
    }
  }
  DI void operator()(const f32x4 (&acc)[2][2][4][2], const Unit& u, int wr, int wc, int fr, int fq) const {
    const int row0 = u.pm * BM + wr * 64 + fr, col0 = u.pn * BM + wc * 32 + 8 * fq;
#pragma unroll
    for (int ai = 0; ai < 2; ++ai) {
      u32x2 ga[4][2];
#pragma unroll
      for (int m = 0; m < 4; ++m) { const unsigned char* gp = gate8 + (size_t)(row0 + ai * HALF + m * 16) * (NPROJ * 2) + C_GATE * 2 + 2 * DM + col0;
#pragma unroll
        for (int bj = 0; bj < 2; ++bj) ga[m][bj] = *(const u32x2*)(gp + bj * HALF); }
#pragma unroll
      for (int m = 0; m < 4; ++m) { const int row = row0 + ai * HALF + m * 16;
#pragma unroll
        for (int bj = 0; bj < 2; ++bj) { float o[8];
#pragma unroll
          for (int j = 0; j < 8; ++j) o[j] = acc[ai][bj][m][j >> 2][j & 3] * ((float)((ga[m][bj][j >> 2] >> (8 * (j & 3))) & 0xffu) * (1.f / 255.f));
          u32x4 w; w.x = pk_bf16(o[0], o[1]); w.y = pk_bf16(o[2], o[3]); w.z = pk_bf16(o[4], o[5]); w.w = pk_bf16(o[6], o[7]);
          *(u32x4*)(O + (size_t)row * DM + col0 + bj * HALF) = w; } }
      asm volatile("" ::: "memory");
    }
  }
};
struct EpiH {
  typedef f32x4 AccT;
  static constexpr bool PERM = false, MIDHOOK = false;
  const float* x; float* h;
  DI void operator()(const f32x4 (&acc)[2][2][4][2], const Unit& u, int wr, int wc, int fr, int fq) const {
    const int row0 = u.pm * BM + wr * 64 + fr, col0 = u.pn * BM + wc * 32 + 4 * fq;
#pragma unroll
    for (int ai = 0; ai < 2; ++ai)
#pragma unroll
      for (int m = 0; m < 4; ++m) { const size_t off = (size_t)(row0 + ai * HALF + m * 16) * DM + col0;
#pragma unroll
        for (int bj = 0; bj < 2; ++bj)
#pragma unroll
          for (int n = 0; n < 2; ++n) { const f32x4 xv = *(const f32x4*)(x + off + bj * HALF + n * 16); *(f32x4*)(h + off + bj * HALF + n * 16) = xv * DN_ALPHA + acc[ai][bj][m][n]; }
        asm volatile("" ::: "memory"); }
  }
};
struct EpiGateUp {
  typedef f32x4 AccT;
  static constexpr bool PERM = true, MIDHOOK = false;
  const float* bgu; bf16_t* act;
  DI void operator()(const f32x4 (&acc)[2][2][4][2], const Unit& u, int wr, int wc, int fr, int fq) const {
    const int e = u.pn >> 3, pnl = u.pn & 7, row0 = u.pm * BM + wr * 64 + fr, j0 = pnl * 128 + wc * 32 + 8 * fq;
    f32x4 bg[2], bl[2];
#pragma unroll
    for (int n = 0; n < 2; ++n) { bg[n] = *(const f32x4*)(bgu + (size_t)e * 2048 + j0 + 4 * n); bl[n] = *(const f32x4*)(bgu + (size_t)e * 2048 + 1024 + j0 + 4 * n); }
#pragma unroll
    for (int ai = 0; ai < 2; ++ai)
#pragma unroll
      for (int m = 0; m < 4; ++m) { float o[8];
#pragma unroll
        for (int n = 0; n < 2; ++n)
#pragma unroll
          for (int j = 0; j < 4; ++j) { const float glu = fminf(acc[ai][0][m][n][j] + bg[n][j], SWIGLU_LIMIT); const float lin = fminf(fmaxf(acc[ai][1][m][n][j] + bl[n][j], -SWIGLU_LIMIT), SWIGLU_LIMIT);
            o[4 * n + j] = glu * __builtin_amdgcn_rcpf(1.f + fexp(-SWIGLU_ALPHA * glu)) * (lin + 1.f); }
        u32x4 w; w.x = pk_bf16(o[0], o[1]); w.y = pk_bf16(o[2], o[3]); w.z = pk_bf16(o[4], o[5]); w.w = pk_bf16(o[6], o[7]);
        *(u32x4*)(act + (size_t)(row0 + ai * HALF + m * 16) * DFF + j0) = w; }
  }
};
struct EpiGateUpI8 {
  typedef i32x4 AccT;
  static constexpr bool PERM = true, MIDHOOK = false;
  const float* bgu; const float* wsc; const float* rsc; const LAS int* tab; bf16_t* act; int skip;
  DI void operator()(const i32x4 (&acc)[2][2][4][2], const Unit& u, int wr, int wc, int fr, int fq) const {
    if (skip == 1) { asm volatile("" :: "v"(acc[0][0][0][0]), "v"(acc[1][1][3][1])); return; }
    const int e = u.pn >> 3, pnl = u.pn & 7, row0 = u.pm * BM + wr * 64 + fr, j0 = pnl * 128 + wc * 32 + 8 * fq, r0 = pnl * 256 + wc * 32 + 8 * fq;
    const int local0 = row0 - tab[32 + e], cnt = tab[e];
    f32x4 bg[2], bl[2], sg[2], sl[2];
#pragma unroll
    for (int n = 0; n < 2; ++n) { bg[n] = *(const f32x4*)(bgu + (size_t)e * 2048 + j0 + 4 * n); bl[n] = *(const f32x4*)(bgu + (size_t)e * 2048 + 1024 + j0 + 4 * n);
      sg[n] = *(const f32x4*)(wsc + (size_t)e * 2048 + r0 + 4 * n); sl[n] = *(const f32x4*)(wsc + (size_t)e * 2048 + r0 + 128 + 4 * n); }
#pragma unroll
    for (int ai = 0; ai < 2; ++ai)
#pragma unroll
      for (int m = 0; m < 4; ++m) { const int local = local0 + ai * HALF + m * 16;
        const float sa = rsc[(size_t)e * ECAP + (local < cnt ? local : 0)]; float o[8];
#pragma unroll
        for (int n = 0; n < 2; ++n)
#pragma unroll
          for (int j = 0; j < 4; ++j) { const float glu = fminf((float)acc[ai][0][m][n][j] * (sa * sg[n][j]) + bg[n][j], SWIGLU_LIMIT);
            const float lin = fminf(fmaxf((float)acc[ai][1][m][n][j] * (sa * sl[n][j]) + bl[n][j], -SWIGLU_LIMIT), SWIGLU_LIMIT);
            o[4 * n + j] = glu * __builtin_amdgcn_rcpf(1.f + fexp(-SWIGLU_ALPHA * glu)) * (lin + 1.f); }
        u32x4 w; w.x = pk_bf16(o[0], o[1]); w.y = pk_bf16(o[2], o[3]); w.z = pk_bf16(o[4], o[5]); w.w = pk_bf16(o[6], o[7]);
        if (skip == 2) asm volatile("" :: "v"(w)); else *(u32x4*)(act + (size_t)(row0 + ai * HALF + m * 16) * DFF + j0) = w; }
  }
};
struct EpiGate8 {
  typedef i32x4 AccT;
  static constexpr bool PERM = true, MIDHOOK = false;
  unsigned char* O; int ldcb; int gbyte0; const float* xsc; const float* wgs;
  DI static unsigned q8(float v) { const float g = __builtin_amdgcn_rcpf(1.f + fexp(-v)); return (unsigned)fminf(fmaxf(rintf(g * 255.f), 1.f), 255.f); }
  DI void operator()(const i32x4 (&acc)[2][2][4][2], const Unit& u, int wr, int wc, int fr, int fq) const {
    const int row0 = u.pm * BM + wr * 64 + fr, col0 = u.pn * BM + wc * 32 + 8 * fq;
    f32x4 sw[2][2];
#pragma unroll
    for (int bj = 0; bj < 2; ++bj)
#pragma unroll
      for (int n = 0; n < 2; ++n) sw[bj][n] = *(const f32x4*)(wgs + col0 + bj * HALF + 4 * n);
#pragma unroll
    for (int ai = 0; ai < 2; ++ai)
#pragma unroll
      for (int m = 0; m < 4; ++m) { const int row = row0 + ai * HALF + m * 16; const float sx = xsc[row]; unsigned char* rowp = O + (size_t)row * ldcb + gbyte0 + col0;
#pragma unroll
        for (int bj = 0; bj < 2; ++bj) { u32x2 w; unsigned q[8];
#pragma unroll
          for (int j = 0; j < 8; ++j) q[j] = q8((float)acc[ai][bj][m][j >> 2][j & 3] * (sx * sw[bj][j >> 2][j & 3]));
          w.x = q[0] | (q[1] << 8) | (q[2] << 16) | (q[3] << 24); w.y = q[4] | (q[5] << 8) | (q[6] << 16) | (q[7] << 24);
          NTST(w, (u32x2*)(rowp + bj * HALF)); } }
  }
};
struct EpiDown {
  typedef f32x4 AccT;
  static constexpr bool PERM = true, MIDHOOK = false;
  const float* bdn; const LAS int* tab; const u32x2* rinfo; bf16_t* ypair;
  DI void operator()(const f32x4 (&acc)[2][2][4][2], const Unit& u, int wr, int wc, int fr, int fq) const {
    const int e = u.pn >> 2, pnl = u.pn & 3, col0 = pnl * BM + wc * 32 + 8 * fq;
    const int local0 = u.pm * BM - tab[32 + e] + wr * 64 + fr, cnt = tab[e];
    f32x4 bv[2][2];
#pragma unroll
    for (int bj = 0; bj < 2; ++bj)
#pragma unroll
      for (int n = 0; n < 2; ++n) bv[bj][n] = *(const f32x4*)(bdn + (size_t)e * DM + col0 + bj * HALF + 4 * n);
#pragma unroll
    for (int ai = 0; ai < 2; ++ai)
#pragma unroll
      for (int m = 0; m < 4; ++m) { const int local = local0 + ai * HALF + m * 16;
        if (local < cnt) { const u32x2 info = rinfo[(size_t)e * ECAP + local]; const float gate = __uint_as_float(info.y); bf16_t* rowp = ypair + (size_t)info.x * DM + col0;
#pragma unroll
          for (int bj = 0; bj < 2; ++bj) { const f32x4 v0 = (acc[ai][bj][m][0] + bv[bj][0]) * gate, v1 = (acc[ai][bj][m][1] + bv[bj][1]) * gate;
            u32x4 w; w.x = pk_bf16(v0[0], v0[1]); w.y = pk_bf16(v0[2], v0[3]); w.z = pk_bf16(v1[0], v1[1]); w.w = pk_bf16(v1[2], v1[3]);
            *(u32x4*)(rowp + bj * HALF) = w; } } }
  }
};
}
#if NAIVE_ANY
template <class F> DI void naive_gemm(const Ctx& c, const bf16_t* A, int lda, const bf16_t* Bt, int ldb, int M, int N, int K, F epi) {
  const int r = c.lane & 31, h = c.lane >> 5, tn_n = N / 32, tiles = (M / 32) * tn_n;
  for (int tile = c.gw; tile < tiles; tile += c.ngw) {
    const int tm = tile / tn_n, tn = tile - tm * tn_n;
    const bf16_t* ap = A + (size_t)(tm * 32 + r) * lda + 8 * h; const bf16_t* bp = Bt + (size_t)(tn * 32 + r) * ldb + 8 * h;
    f32x16 acc; for (int i = 0; i < 16; ++i) acc[i] = 0.f;
    for (int k0 = 0; k0 < K; k0 += 16) { const bf16x8 a = *(const bf16x8*)(ap + k0), b = *(const bf16x8*)(bp + k0); acc = MFMA32(a, b, acc); }
#pragma unroll
    for (int i = 0; i < 16; ++i) epi(tm * 32 + crow(i, h), tn * 32 + r, acc[i]);
  }
}
#endif

#if NAIVE_GDN
DI void naive_gdn_prep(const Ctx& c) {
  const bf16_t* proj = (const bf16_t*)(c.p.ws + WS_PROJ); bf16_t* qkv = (bf16_t*)(c.p.ws + WS_GDN); const float* wc = c.p.in[I_WCONV];
  for (int it = c.gw; it < TT * 4; it += c.ngw) {
    const int t = it >> 2, hh = it & 3, tl = t & (SEQ - 1);
    float val[3][2];
#pragma unroll
    for (int part = 0; part < 3; ++part)
#pragma unroll
      for (int e = 0; e < 2; ++e) { const int ch = part * 512 + hh * 128 + 2 * c.lane + e; float a = 0.f;
#pragma unroll
        for (int j = 0; j < 4; ++j) { const int ts = tl - 3 + j; if (ts >= 0) a += wc[j * 1536 + ch] * bf2f(proj[(size_t)(t - 3 + j) * NPROJ + ch]); }
        val[part][e] = a * sigmoidf_(a); }
    const float sq = wave_sum(val[0][0] * val[0][0] + val[0][1] * val[0][1]), sk = wave_sum(val[1][0] * val[1][0] + val[1][1] * val[1][1]);
    const float rq = rsqrtf(sq + NORM_EPS) * 0.08838834764831845f, rk = rsqrtf(sk + NORM_EPS);
    bf16_t* o = qkv + ((size_t)t * 4 + hh) * 384 + 2 * c.lane;
    *(unsigned*)(o) = pk_bf16(val[0][0] * rq, val[0][1] * rq); *(unsigned*)(o + 128) = pk_bf16(val[1][0] * rk, val[1][1] * rk); *(unsigned*)(o + 256) = pk_bf16(val[2][0], val[2][1]);
  }
}
DI void naive_gdn_scan(const Ctx& c) {
  if (c.bid >= 64) return;
  const int b = c.bid >> 2, hh = c.bid & 3, j = c.tid;
  const bf16_t* qkv = (const bf16_t*)(c.p.ws + WS_GDN); const float* gbeta = (const float*)(c.p.ws + WS_MISC); bf16_t* ycat = (bf16_t*)(c.p.ws + WS_YCAT);
  LAS float* sq = (LAS float*)c.lds; LAS float* sk = sq + 8 * 128;
  float S[128];
#pragma unroll
  for (int d = 0; d < 128; ++d) S[d] = 0.f;
  for (int t0 = 0; t0 < SEQ; t0 += 8) {
    __syncthreads();
    for (int i = c.tid; i < 8 * 256; i += 512) { const int tt = i >> 8, d = i & 255; const size_t t = (size_t)b * SEQ + t0 + tt;
      const float v = bf2f(qkv[(t * 4 + hh) * 384 + d]); if (d < 128) sq[tt * 128 + d] = v; else sk[tt * 128 + d - 128] = v; }
    __syncthreads();
    if (j < 128) {
      for (int tt = 0; tt < 8; ++tt) { const size_t t = (size_t)b * SEQ + t0 + tt;
        const float g = gbeta[t * 8 + hh], beta = gbeta[t * 8 + 4 + hh], dec = __expf(g), vt = bf2f(qkv[(t * 4 + hh) * 384 + 256 + j]);
        float ks = 0.f;
#pragma unroll
        for (int d = 0; d < 128; ++d) ks += sk[tt * 128 + d] * S[d];
        const float vn = beta * (vt - dec * ks); float o = 0.f;
#pragma unroll
        for (int d = 0; d < 128; ++d) { S[d] = dec * S[d] + sk[tt * 128 + d] * vn; o += sq[tt * 128 + d] * S[d]; }
        ycat[t * 1536 + hh * 128 + j] = f2bf(o); }
    }
  }
}
#endif

#if NAIVE_ATTN
DI void naive_sb(const Ctx& c) {
  const bf16_t* proj = (const bf16_t*)(c.p.ws + WS_PROJ); bf16_t* ycat = (bf16_t*)(c.p.ws + WS_YCAT);
  LAS float* wl = (LAS float*)c.lds + c.wave * 64;
  for (int it = c.gw; it < NB * 8 * SEQ; it += c.ngw) {
    const int tq = it & (SEQ - 1), hh = (it >> 11) & 7, b = it >> 14; const size_t trow = (size_t)b * SEQ + tq;
    float q[64];
    { const bf16_t* qp = proj + trow * NPROJ + C_SQ + hh * 64;
#pragma unroll
      for (int d8 = 0; d8 < 8; ++d8) { const u32x4 w = *(const u32x4*)(qp + 8 * d8);
#pragma unroll
        for (int e = 0; e < 4; ++e) { q[8 * d8 + 2 * e] = bflo(w[e]); q[8 * d8 + 2 * e + 1] = bfhi(w[e]); } } }
    float carry = 0.f, o = 0.f;
    for (int kt = (tq - 1) >> 6; kt >= 0 && tq > 0; --kt) {
      const int s = kt * 64 + c.lane; const bool valid = s < tq; const size_t srow = (size_t)b * SEQ + (valid ? s : 0);
      const bf16_t* kp = proj + srow * NPROJ + C_SK + hh * 64; float z = 0.f;
#pragma unroll
      for (int d8 = 0; d8 < 8; ++d8) { const u32x4 w = *(const u32x4*)(kp + 8 * d8);
#pragma unroll
        for (int e = 0; e < 4; ++e) z += q[8 * d8 + 2 * e] * bflo(w[e]) + q[8 * d8 + 2 * e + 1] * bfhi(w[e]); }
      z *= 0.125f;
      const float sp = valid ? softplusf_(z) : 0.f;
      float suf = sp;
#pragma unroll
      for (int off = 1; off < 64; off <<= 1) { const float o2 = __shfl_down(suf, off); if (c.lane + off < 64) suf += o2; }
      const float w = valid ? __expf(z - (carry + suf)) : 0.f;
      carry += __shfl(suf, 0);
      LDS_WAIT(); wl[c.lane] = w; LDS_WAIT();
      const int smax = min(64, tq - kt * 64);
      for (int ss = 0; ss < smax; ++ss) o += wl[ss] * bf2f(proj[((size_t)b * SEQ + kt * 64 + ss) * NPROJ + C_SV + hh * 64 + c.lane]);
      LDS_WAIT();
    }
    ycat[trow * 1536 + 512 + hh * 64 + c.lane] = f2bf(o);
  }
}
DI void naive_mem(const Ctx& c) {
  const bf16_t* proj = (const bf16_t*)(c.p.ws + WS_PROJ); const bf16_t* mkv = (const bf16_t*)(c.p.ws + WS_MKV); bf16_t* ycat = (bf16_t*)(c.p.ws + WS_YCAT);
  LAS float* pl = (LAS float*)(c.lds + 4096) + c.wave * 256;
  for (int it = c.gw; it < NB * 4 * SEQ; it += c.ngw) {
    const int tq = it & (SEQ - 1), hh = (it >> 11) & 3, b = it >> 13; const size_t trow = (size_t)b * SEQ + tq;
    const bf16_t* qp = proj + trow * NPROJ + C_MQ + hh * 128;
    float sc[4];
#pragma unroll
    for (int kt = 0; kt < 4; ++kt) { const bf16_t* kp = mkv + (size_t)(b * MEMLEN + kt * 64 + c.lane) * 1024 + hh * 128; float z = 0.f;
      for (int d8 = 0; d8 < 16; ++d8) { const u32x4 w = *(const u32x4*)(kp + 8 * d8), qw = *(const u32x4*)(qp + 8 * d8);
#pragma unroll
        for (int e = 0; e < 4; ++e) z += bflo(qw[e]) * bflo(w[e]) + bfhi(qw[e]) * bfhi(w[e]); }
      sc[kt] = z * 0.08838834764831845f; }
    const float mx = wave_max(fmaxf(fmaxf(sc[0], sc[1]), fmaxf(sc[2], sc[3])));
    float pe[4], ssum = 0.f;
#pragma unroll
    for (int kt = 0; kt < 4; ++kt) { pe[kt] = __expf(sc[kt] - mx); ssum += pe[kt]; }
    ssum = wave_sum(ssum);
    LDS_WAIT();
#pragma unroll
    for (int kt = 0; kt < 4; ++kt) pl[kt * 64 + c.lane] = pe[kt] / ssum;
    LDS_WAIT();
    float o0 = 0.f, o1 = 0.f;
    for (int s = 0; s < 256; ++s) { const unsigned vv = *(const unsigned*)(mkv + (size_t)(b * MEMLEN + s) * 1024 + 512 + hh * 128 + 2 * c.lane); const float pw = pl[s]; o0 += pw * bflo(vv); o1 += pw * bfhi(vv); }
    LDS_WAIT();
    *(unsigned*)(ycat + trow * 1536 + 1024 + hh * 128 + 2 * c.lane) = pk_bf16(o0, o1);
  }
}
#endif
DI void tr_item(const float* src, int ldw, bf16_t* dst, int ldd, LAS float* scr, int lane) {
#pragma unroll
  for (int i = 0; i < 8; ++i) { const int kk = 8 * i + (lane >> 3); const f32x4 v = *(const f32x4*)(src + (size_t)kk * ldw + 4 * (lane & 7));
    LAS float* s = scr + kk * 33 + 4 * (lane & 7); s[0] = v.x; s[1] = v.y; s[2] = v.z; s[3] = v.w; }
  LDS_WAIT();
  const int cc = lane & 7;
#pragma unroll
  for (int j = 0; j < 4; ++j) { const int n = (lane >> 3) + 8 * j; const LAS float* s = scr + (8 * cc) * 33 + n;
    u32x4 o; o.x = pk_bf16(s[0 * 33], s[1 * 33]); o.y = pk_bf16(s[2 * 33], s[3 * 33]); o.z = pk_bf16(s[4 * 33], s[5 * 33]); o.w = pk_bf16(s[6 * 33], s[7 * 33]);
    *(u32x4*)(dst + (size_t)n * ldd + 8 * cc) = o; }
  LDS_WAIT();
}
DI void phase0(const Ctx& c) {
  unsigned char* ws = c.p.ws;
  if (c.bid == 0 && c.tid < 32) ((int*)(ws + WS_MISC + MiB))[c.tid] = 0;
  {
    LAS float* scr = (LAS float*)(c.lds + c.wave * 8448);
    for (int r = c.gw; r < 16 * (GATE_I8 ? 128 : 224); r += c.ngw) { const int kb = r / (GATE_I8 ? 128 : 224), nb = r % (GATE_I8 ? 128 : 224); const int n0 = 32 * nb + (nb >= 64 ? 8 : 0);
      tr_item(c.p.in[I_WIN] + (size_t)(64 * kb) * 7176 + n0, 7176, (bf16_t*)(ws + WS_WIN) + (size_t)(32 * nb) * 1024 + 64 * kb, 1024, scr, c.lane); }
    for (int r = (c.gw + 512) % c.ngw; r < 16 * 32; r += c.ngw) { const int kb = r / 32, nb = r % 32;
      tr_item(c.p.in[I_WMKV] + (size_t)(64 * kb) * 1024 + 32 * nb, 1024, (bf16_t*)(ws + WS_WMKV) + (size_t)(32 * nb) * 1024 + 64 * kb, 1024, scr, c.lane); }
    for (int r = (c.gw + 1024) % c.ngw; r < 8 * 32; r += c.ngw) { const int kb = r / 32, nb = r % 32;
      tr_item(c.p.in[I_WPG] + (size_t)(64 * kb) * 1024 + 32 * nb, 1024, (bf16_t*)(ws + WS_WP) + (size_t)(32 * nb) * 1536 + 0 * 512 + 64 * kb, 1536, scr, c.lane); }
    for (int r = (c.gw + 1280) % c.ngw; r < 8 * 32; r += c.ngw) { const int kb = r / 32, nb = r % 32;
      tr_item(c.p.in[I_WPS] + (size_t)(64 * kb) * 1024 + 32 * nb, 1024, (bf16_t*)(ws + WS_WP) + (size_t)(32 * nb) * 1536 + 1 * 512 + 64 * kb, 1536, scr, c.lane); }
    for (int r = (c.gw + 1536) % c.ngw; r < 8 * 32; r += c.ngw) { const int kb = r / 32, nb = r % 32;
      tr_item(c.p.in[I_WPM] + (size_t)(64 * kb) * 1024 + 32 * nb, 1024, (bf16_t*)(ws + WS_WP) + (size_t)(32 * nb) * 1536 + 2 * 512 + 64 * kb, 1536, scr, c.lane); }
    for (int r = (c.gw + 1792) % c.ngw; r < 16 * 32; r += c.ngw) { const int kb = r / 32, nb = r % 32;
      tr_item(c.p.in[I_WO] + (size_t)(64 * kb) * 1024 + 32 * nb, 1024, (bf16_t*)(ws + WS_WO) + (size_t)(32 * nb) * 1024 + 64 * kb, 1024, scr, c.lane); }
#if MOE_I8
    { unsigned* cmax = (unsigned*)(ws + WS_CMAX);
      for (int r = c.gw; r < 32 * 16 * 4; r += c.ngw) { const int e = r >> 6, kb = (r >> 2) & 15, nq = r & 3;
        const float* src = c.p.in[I_WGU] + (size_t)e * 1024 * 2048 + (size_t)(64 * kb) * 2048 + 512 * nq + 8 * c.lane;
        f32x4 m0 = {0.f, 0.f, 0.f, 0.f}, m1 = {0.f, 0.f, 0.f, 0.f};
#pragma unroll 8
        for (int kk = 0; kk < 64; ++kk) { const f32x4 a = *(const f32x4*)(src + (size_t)kk * 2048), b = *(const f32x4*)(src + (size_t)kk * 2048 + 4);
          m0.x = fmaxf(m0.x, fabsf(a.x)); m0.y = fmaxf(m0.y, fabsf(a.y)); m0.z = fmaxf(m0.z, fabsf(a.z)); m0.w = fmaxf(m0.w, fabsf(a.w));
          m1.x = fmaxf(m1.x, fabsf(b.x)); m1.y = fmaxf(m1.y, fabsf(b.y)); m1.z = fmaxf(m1.z, fabsf(b.z)); m1.w = fmaxf(m1.w, fabsf(b.w)); }
        unsigned* cm = cmax + e * 2048 + 512 * nq + 8 * c.lane;
        atomicMax(cm + 0, __float_as_uint(m0.x)); atomicMax(cm + 1, __float_as_uint(m0.y)); atomicMax(cm + 2, __float_as_uint(m0.z)); atomicMax(cm + 3, __float_as_uint(m0.w));
        atomicMax(cm + 4, __float_as_uint(m1.x)); atomicMax(cm + 5, __float_as_uint(m1.y)); atomicMax(cm + 6, __float_as_uint(m1.z)); atomicMax(cm + 7, __float_as_uint(m1.w)); } }
#else
    for (int r = c.gw; r < 32 * 16 * 64; r += c.ngw) { const int e = r / 1024, q = r % 1024, kb = q / 64, nb = q % 64; const int r0 = 32 * nb, n0 = ((r0 >> 7) & 1) * 1024 + (r0 >> 8) * 128 + (r0 & 127);
      tr_item(c.p.in[I_WGU] + (size_t)e * 1024 * 2048 + (size_t)(64 * kb) * 2048 + n0, 2048, (bf16_t*)(ws + WS_WGU) + ((size_t)e * 2048 + r0) * 1024 + 64 * kb, 1024, scr, c.lane); }
#endif
#if !(MOE_I8 && W8_BESIDE_SCAN)
    for (int r = c.gw; r < 32 * 16 * 32; r += c.ngw) { const int e = r / 512, q = r % 512, kb = q / 32, nb = q % 32;
      tr_item(c.p.in[I_WDN] + (size_t)e * 1024 * 1024 + (size_t)(64 * kb) * 1024 + 32 * nb, 1024, (bf16_t*)(ws + WS_WDN) + ((size_t)e * 1024 + 32 * nb) * 1024 + 64 * kb, 1024, scr, c.lane); }
#endif
  }
#if GATE_I8
  for (int r = c.gw; r < 16 * 96; r += c.ngw) { const int kb = r / 96, grp = r % 96, n = c.lane & 31, h2 = c.lane >> 5;
    const float* src = c.p.in[I_WIN] + (size_t)(64 * kb + 32 * h2) * 7176 + 4104 + 32 * grp + n; float am = 0.f;
#pragma unroll
    for (int k = 0; k < 32; ++k) am = fmaxf(am, fabsf(src[(size_t)k * 7176]));
    am = fmaxf(am, __shfl_xor(am, 32));
    if (h2 == 0) atomicMax((unsigned*)(ws + WS_CMAXG) + 32 * grp + n, __float_as_uint(am)); }
#endif
  { const float* wr = c.p.in[I_WR]; float* wT = (float*)(ws + WS_WRT); for (int i = c.bid * 512 + c.tid; i < 32 * 1024; i += c.G * 512) wT[i] = wr[(i & 1023) * 32 + (i >> 10)]; }
  { const f32x4* src = (const f32x4*)c.p.in[I_MEM]; u32x2* dst = (u32x2*)(ws + WS_MEMB);
    for (int i = c.bid * 512 + c.tid; i < NB * MEMLEN * DM / 4; i += c.G * 512) { const f32x4 v = src[i]; u32x2 o; o.x = pk_bf16(v.x, v.y); o.y = pk_bf16(v.z, v.w); dst[i] = o; } }
  {
    float wab[4][4][8];
#pragma unroll
    for (int j = 0; j < 4; ++j)
#pragma unroll
      for (int i = 0; i < 4; ++i) { const float* wp = c.p.in[I_WIN] + (size_t)(256 * j + 4 * c.lane + i) * 7176 + 2048; const f32x4 a = *(const f32x4*)wp, b = *(const f32x4*)(wp + 4);
        wab[j][i][0] = a.x; wab[j][i][1] = a.y; wab[j][i][2] = a.z; wab[j][i][3] = a.w; wab[j][i][4] = b.x; wab[j][i][5] = b.y; wab[j][i][6] = b.z; wab[j][i][7] = b.w; }
    const int hh = c.lane & 3; const float nega = -__expf(c.p.in[I_ALOG][hh]), dtb = c.p.in[I_DTB][hh];
    float* gbeta = (float*)(ws + WS_MISC);
    for (int m = c.gw; m < TT; m += c.ngw) {
      const f32x4* xr = (const f32x4*)(c.p.in[I_X] + (size_t)m * DM) + c.lane; u32x2* xo = (u32x2*)(ws + WS_XB + (size_t)m * DM * 2) + c.lane;
      float s[8];
#pragma unroll
      for (int q = 0; q < 8; ++q) s[q] = 0.f;
      f32x4 xv[4];
#pragma unroll
      for (int j = 0; j < 4; ++j) { const f32x4 v = xr[64 * j]; xv[j] = v; u32x2 o; o.x = pk_bf16(v.x, v.y); o.y = pk_bf16(v.z, v.w); xo[64 * j] = o;
#pragma unroll
        for (int q = 0; q < 8; ++q) s[q] += v.x * wab[j][0][q] + v.y * wab[j][1][q] + v.z * wab[j][2][q] + v.w * wab[j][3][q]; }
#pragma unroll
      for (int q = 0; q < 8; ++q) s[q] = wave_sum(s[q]);
#if GATE_I8
      { float am = 0.f;
#pragma unroll
        for (int j = 0; j < 4; ++j) am = fmaxf(fmaxf(am, fmaxf(fabsf(xv[j].x), fabsf(xv[j].y))), fmaxf(fabsf(xv[j].z), fabsf(xv[j].w)));
        am = wave_max(am); const float qs = am > 0.f ? 127.f / am : 0.f;
        if (c.lane == 0) ((float*)(ws + WS_TSC))[m] = am * (1.f / 127.f);
#pragma unroll
        for (int j = 0; j < 4; ++j) ((unsigned*)(ws + WS_XQ + (size_t)m * DM))[64 * j + c.lane] = ((unsigned)(int)rintf(xv[j].x * qs) & 0xffu) | (((unsigned)(int)rintf(xv[j].y * qs) & 0xffu) << 8) | (((unsigned)(int)rintf(xv[j].z * qs) & 0xffu) << 16) | (((unsigned)(int)rintf(xv[j].w * qs) & 0xffu) << 24); }
#endif
      if (c.lane < 8) {
        float pre = s[0];
#pragma unroll
        for (int q = 1; q < 8; ++q) pre = (c.lane == q) ? s[q] : pre;
        const float val = c.lane < 4 ? nega * softplusf_(pre + dtb) : sigmoidf_(pre);
        gbeta[(size_t)m * 8 + c.lane] = val;
      }
    }
  }
}

#if MOE_I8
DI void phase0b(const Ctx& c) {
  unsigned char* ws = c.p.ws; const float* cmaxf = (const float*)(ws + WS_CMAX); float* wsc = (float*)(ws + WS_WSC); signed char* w8 = (signed char*)(ws + WS_WGU);
  LAS float* scr = (LAS float*)(c.lds + c.wave * 8448);
  for (int r = c.gw; r < 32 * 16 * 64; r += c.ngw) { const int e = r / 1024, q = r % 1024, kb = q / 64, nb = q % 64; const int r0 = 32 * nb, n0 = ((r0 >> 7) & 1) * 1024 + (r0 >> 8) * 128 + (r0 & 127);
    const float* src = c.p.in[I_WGU] + (size_t)e * 1024 * 2048 + (size_t)(64 * kb) * 2048 + n0;
#pragma unroll
    for (int i = 0; i < 8; ++i) { const int kk = 8 * i + (c.lane >> 3); const f32x4 v = *(const f32x4*)(src + (size_t)kk * 2048 + 4 * (c.lane & 7));
      LAS float* sp = scr + kk * 33 + 4 * (c.lane & 7); sp[0] = v.x; sp[1] = v.y; sp[2] = v.z; sp[3] = v.w; }
    LDS_WAIT();
    const int n = c.lane >> 1, hk = c.lane & 1; const float cm = cmaxf[e * 2048 + n0 + n], inv = cm > 0.f ? 127.f / cm : 0.f;
    if (kb == 0 && hk == 0) wsc[e * 2048 + r0 + n] = cm * (1.f / 127.f);
    u32x4 o[2];
#pragma unroll
    for (int g = 0; g < 8; ++g) { unsigned w = 0;
#pragma unroll
      for (int b = 0; b < 4; ++b) { const int qv = (int)rintf(scr[(32 * hk + 4 * g + b) * 33 + n] * inv); w |= ((unsigned)qv & 0xffu) << (8 * b); }
      o[g >> 2][g & 3] = w; }
    signed char* dst = w8 + ((size_t)e * 2048 + r0 + n) * 1024 + 64 * kb + 32 * hk;
    *(u32x4*)dst = o[0]; *(u32x4*)(dst + 16) = o[1];
    LDS_WAIT();
  }
}
#endif

#if MOE_I8
DI void phase0b_light(const Ctx& c, LAS unsigned char* scr8, int wi, int nw) {
  unsigned char* ws = c.p.ws; const float* cmaxf = (const float*)(ws + WS_CMAX); float* wsc = (float*)(ws + WS_WSC); signed char* w8 = (signed char*)(ws + WS_WGU);
  for (int r = wi; r < 32 * 16 * 64; r += nw) { const int e = r / 1024, q = r % 1024, kb = q / 64, nb = q % 64; const int r0 = 32 * nb, n0 = ((r0 >> 7) & 1) * 1024 + (r0 >> 8) * 128 + (r0 & 127);
    const float* src = c.p.in[I_WGU] + (size_t)e * 1024 * 2048 + (size_t)(64 * kb) * 2048 + n0;
    const int nq = 4 * (c.lane & 7);
    const f32x4 cm = *(const f32x4*)(cmaxf + e * 2048 + n0 + nq);
    const f32x4 inv = {cm.x > 0.f ? 127.f / cm.x : 0.f, cm.y > 0.f ? 127.f / cm.y : 0.f, cm.z > 0.f ? 127.f / cm.z : 0.f, cm.w > 0.f ? 127.f / cm.w : 0.f};
    if (kb == 0 && c.lane < 8) *(f32x4*)(wsc + e * 2048 + r0 + nq) = cm * (1.f / 127.f);
    f32x4 v[8];
#pragma unroll
    for (int i = 0; i < 8; ++i) v[i] = *(const f32x4*)(src + (size_t)(8 * i + (c.lane >> 3)) * 2048 + nq);
    LDS_WAIT();
#pragma unroll
    for (int i = 0; i < 8; ++i) { const int kk = 8 * i + (c.lane >> 3);
      scr8[(nq + 0) * 80 + kk] = (unsigned char)(int)rintf(v[i].x * inv.x); scr8[(nq + 1) * 80 + kk] = (unsigned char)(int)rintf(v[i].y * inv.y);
      scr8[(nq + 2) * 80 + kk] = (unsigned char)(int)rintf(v[i].z * inv.z); scr8[(nq + 3) * 80 + kk] = (unsigned char)(int)rintf(v[i].w * inv.w); }
    LDS_WAIT();
    const int n = c.lane >> 1, hk = c.lane & 1;
    const u32x4 o0 = *(const LAS u32x4*)(scr8 + n * 80 + 32 * hk), o1 = *(const LAS u32x4*)(scr8 + n * 80 + 32 * hk + 16);
    signed char* dst = w8 + ((size_t)e * 2048 + r0 + n) * 1024 + 64 * kb + 32 * hk;
    *(u32x4*)dst = o0; *(u32x4*)(dst + 16) = o1;
  }
}
#endif

DI void wdn_light(const Ctx& c, LAS bf16_t* scr, int wi, int nw) {
  unsigned char* ws = c.p.ws;
  for (int r = wi; r < 32 * 16 * 32; r += nw) { const int e = r / 512, q = r % 512, kb = q / 32, nb = q % 32;
    const float* src = c.p.in[I_WDN] + (size_t)e * 1024 * 1024 + (size_t)(64 * kb) * 1024 + 32 * nb; bf16_t* dst = (bf16_t*)(ws + WS_WDN) + ((size_t)e * 1024 + 32 * nb) * 1024 + 64 * kb;
    const int nq = 4 * (c.lane & 7); f32x4 v[8];
#pragma unroll
    for (int i = 0; i < 8; ++i) v[i] = *(const f32x4*)(src + (size_t)(8 * i + (c.lane >> 3)) * 1024 + nq);
    LDS_WAIT();
#pragma unroll
    for (int i = 0; i < 8; ++i) { const int kk = 8 * i + (c.lane >> 3); const unsigned a = pk_bf16(v[i].x, v[i].y), b = pk_bf16(v[i].z, v[i].w);
      scr[(nq + 0) * 72 + kk] = (bf16_t)(a & 0xffffu); scr[(nq + 1) * 72 + kk] = (bf16_t)(a >> 16); scr[(nq + 2) * 72 + kk] = (bf16_t)(b & 0xffffu); scr[(nq + 3) * 72 + kk] = (bf16_t)(b >> 16); }
    LDS_WAIT();
    const int n = c.lane >> 1, hk = c.lane & 1;
#pragma unroll
    for (int j = 0; j < 4; ++j) *(u32x4*)(dst + (size_t)n * 1024 + 32 * hk + 8 * j) = *(const LAS u32x4*)(scr + n * 72 + 32 * hk + 8 * j);
  }
}

#if GATE_I8
DI void phase0c(const Ctx& c) {
  unsigned char* ws = c.p.ws; const float* cmaxf = (const float*)(ws + WS_CMAXG); float* wgs = (float*)(ws + WS_WGS); signed char* w8 = (signed char*)(ws + WS_WG8);
  LAS float* scr = (LAS float*)(c.lds + c.wave * 8448);
  for (int r = c.gw; r < 16 * 96; r += c.ngw) { const int kb = r / 96, grp = r % 96;
    const float* src = c.p.in[I_WIN] + (size_t)(64 * kb) * 7176 + 4104 + 32 * grp;
#pragma unroll
    for (int i = 0; i < 8; ++i) { const int kk = 8 * i + (c.lane >> 3); const f32x4 v = *(const f32x4*)(src + (size_t)kk * 7176 + 4 * (c.lane & 7));
      LAS float* sp = scr + kk * 33 + 4 * (c.lane & 7); sp[0] = v.x; sp[1] = v.y; sp[2] = v.z; sp[3] = v.w; }
    LDS_WAIT();
    const int n = c.lane >> 1, hk = c.lane & 1; const float cm = cmaxf[32 * grp + n], inv = cm > 0.f ? 127.f / cm : 0.f;
    if (kb == 0 && hk == 0) wgs[32 * grp + n] = cm * (1.f / 127.f);
    u32x4 o[2];
#pragma unroll
    for (int g = 0; g < 8; ++g) { unsigned w = 0;
#pragma unroll
      for (int b = 0; b < 4; ++b) { const int qv = (int)rintf(scr[(32 * hk + 4 * g + b) * 33 + n] * inv); w |= ((unsigned)qv & 0xffu) << (8 * b); }
      o[g >> 2][g & 3] = w; }
    signed char* dst = w8 + (size_t)(32 * grp + n) * 1024 + 64 * kb + 32 * hk;
    *(u32x4*)dst = o[0]; *(u32x4*)(dst + 16) = o[1];
    LDS_WAIT();
  }
}
#endif

DI void phase_gdn_norm(const Ctx& c) {
  bf16_t* ycat = (bf16_t*)(c.p.ws + WS_YCAT); const bf16_t* proj = (const bf16_t*)(c.p.ws + WS_PROJ); const float* nw = c.p.in[I_GNW];
  const float w0 = nw[2 * c.lane], w1 = nw[2 * c.lane + 1];
  for (int it = c.gw; it < TT * 4; it += c.ngw) {
    const int t = it >> 2, hh = it & 3;
    unsigned* op = (unsigned*)(ycat + (size_t)t * 1536 + hh * 128) + c.lane; const unsigned ov = *op, zv = *((const unsigned*)(proj + (size_t)t * NPROJ + C_GZ + hh * 128) + c.lane);
    const float o0 = bflo(ov), o1 = bfhi(ov), z0 = bflo(zv), z1 = bfhi(zv);
    const float rs = rsqrtf(wave_sum(o0 * o0 + o1 * o1) * (1.f / 128.f) + NORM_EPS);
    *op = pk_bf16(o0 * rs * w0 * (z0 * sigmoidf_(z0)), o1 * rs * w1 * (z1 * sigmoidf_(z1)));
  }
}

#if ROUTER_LDS
DI void phase_router(const Ctx& c) {
  unsigned char* ws = c.p.ws;
  const float* h = (const float*)(ws + WS_H); bf16_t* x1h = (bf16_t*)(ws + WS_X1);
  const float* wT = (const float*)(ws + WS_WRT); int* gcount = (int*)(ws + WS_MISC + MiB); u32x2* rinfo = (u32x2*)(ws + WS_RINFO);
  constexpr int XS = 1028;
  LAS float* xs = (LAS float*)c.lds;
  LAS int* wcnt = (LAS int*)(c.lds + 131584); LAS int* bbase = wcnt + 32; LAS float* tsl = (LAS float*)(bbase + 32);
  LAS int* sel_e = (LAS int*)(tsl + 128); LAS int* sel_pos = sel_e + 512; LAS float* sel_g = (LAS float*)(sel_e + 1024);
  const int e = c.lane & 31, hf = c.lane >> 5;
  f32x4 gam[4], bet[4];
#pragma unroll
  for (int j = 0; j < 4; ++j) { gam[j] = ((const f32x4*)c.p.in[I_LN1G])[64 * j + c.lane]; bet[j] = ((const f32x4*)c.p.in[I_LN1B])[64 * j + c.lane]; }
  for (int gi = c.bid; gi < TT / 128; gi += c.G) {
    const int tokg = gi * 128;
    if (c.tid < 32) wcnt[c.tid] = 0;
    f32x4 vn[4];
    { const f32x4* hr0 = (const f32x4*)(h + ((size_t)tokg + c.wave * 4) * DM) + c.lane;
#pragma unroll
      for (int j = 0; j < 4; ++j) vn[j] = hr0[64 * j]; }
    for (int sg = 0; sg < 4; ++sg) {
      for (int i = 0; i < 4; ++i) {
        const int r = c.wave * 4 + i; const size_t t = (size_t)tokg + sg * 32 + r; f32x4 v[4]; float s = 0.f;
#pragma unroll
        for (int j = 0; j < 4; ++j) { v[j] = vn[j]; s += (v[j].x + v[j].y) + (v[j].z + v[j].w); }
        { const int tn = (i < 3) ? (int)t + 1 : (sg < 3 ? tokg + (sg + 1) * 32 + c.wave * 4 : (int)t);
          const f32x4* hrn = (const f32x4*)(h + (size_t)tn * DM) + c.lane;
#pragma unroll
          for (int j = 0; j < 4; ++j) vn[j] = hrn[64 * j]; }
        const float mean = wave_sum(s) * (1.f / DM); float s2 = 0.f;
#pragma unroll
        for (int j = 0; j < 4; ++j) { v[j] = v[j] - mean; s2 += (v[j].x * v[j].x + v[j].y * v[j].y) + (v[j].z * v[j].z + v[j].w * v[j].w); }
        const float rstd = rsqrtf(wave_sum(s2) * (1.f / DM) + LN_EPS);
        f32x4 y[4]; float am = 0.f;
#pragma unroll
        for (int j = 0; j < 4; ++j) { y[j] = v[j] * rstd * gam[j] + bet[j]; *(LAS f32x4*)(xs + r * XS + 256 * j + 4 * c.lane) = y[j];
          u32x2 o; o.x = pk_bf16(y[j].x, y[j].y); o.y = pk_bf16(y[j].z, y[j].w); ((u32x2*)(x1h + t * DM))[64 * j + c.lane] = o;
          am = fmaxf(fmaxf(am, fmaxf(fabsf(y[j].x), fabsf(y[j].y))), fmaxf(fabsf(y[j].z), fabsf(y[j].w))); }
        am = wave_max(am); const float qs = am > 0.f ? 127.f / am : 0.f;
        if (c.lane == 0) tsl[sg * 32 + r] = am * (1.f / 127.f);
#pragma unroll
        for (int j = 0; j < 4; ++j) { const unsigned w = ((unsigned)(int)rintf(y[j].x * qs) & 0xffu) | (((unsigned)(int)rintf(y[j].y * qs) & 0xffu) << 8) | (((unsigned)(int)rintf(y[j].z * qs) & 0xffu) << 16) | (((unsigned)(int)rintf(y[j].w * qs) & 0xffu) << 24);
          ((unsigned*)(ws + WS_X1Q + t * DM))[64 * j + c.lane] = w; }
      }
      __syncthreads();
      f32x16 acc;
      if (c.wave < 4) {
        const float* ap = wT + (size_t)e * DM + 256 * c.wave + 128 * hf; const LAS float* bp = xs + e * XS + 256 * c.wave + 128 * hf;
#pragma unroll
        for (int i = 0; i < 16; ++i) acc[i] = 0.f;
        f32x4 a4 = *(const f32x4*)ap, a4n = *(const f32x4*)(ap + 4);
        for (int q = 0; q < 32; ++q) {
          const f32x4 a4nn = *(const f32x4*)(ap + 4 * (q + 2 < 32 ? q + 2 : 31)); const f32x4 b4 = *(const LAS f32x4*)(bp + 4 * q);
#pragma unroll
          for (int j = 0; j < 4; ++j) acc = __builtin_amdgcn_mfma_f32_32x32x2f32(a4[j], b4[j], acc, 0, 0, 0);
          a4 = a4n; a4n = a4nn;
        }
      }
      __syncthreads();
      if (c.wave < 4) {
#pragma unroll
        for (int rg = 0; rg < 16; ++rg) xs[(c.wave * 32 + crow(rg, hf)) * 32 + e] = acc[rg];
      }
      __syncthreads();
      if (c.wave == 4) {
        float L[32];
#pragma unroll
        for (int q = 0; q < 32; ++q) L[q] = ((xs[q * 32 + e] + xs[(32 + q) * 32 + e]) + (xs[(64 + q) * 32 + e] + xs[(96 + q) * 32 + e])) + c.p.in[I_BR][q];
        float tv[4]; int ti[4];
#pragma unroll
        for (int k = 0; k < 4; ++k) {
          float bv = L[0]; int bi = 0;
#pragma unroll
          for (int q = 1; q < 32; ++q) { const bool g = L[q] > bv; bv = g ? L[q] : bv; bi = g ? q : bi; }
          tv[k] = bv; ti[k] = bi;
#pragma unroll
          for (int q = 0; q < 32; ++q) L[q] = (q == bi) ? -INFINITY : L[q];
        }
        const float e1 = __expf(tv[1] - tv[0]), e2 = __expf(tv[2] - tv[0]), e3 = __expf(tv[3] - tv[0]), inv = 1.f / (1.f + e1 + e2 + e3);
        if (hf == 0) {
          const float gk[4] = {inv, e1 * inv, e2 * inv, e3 * inv};
#pragma unroll
          for (int k = 0; k < 4; ++k) { const int si = (sg * 32 + e) * 4 + k; sel_e[si] = ti[k]; sel_g[si] = gk[k]; sel_pos[si] = (int)__hip_atomic_fetch_add((LAS unsigned*)(wcnt + ti[k]), 1u, __ATOMIC_RELAXED, __HIP_MEMORY_SCOPE_WORKGROUP); }
        }
      }
      __syncthreads();
    }
    if (c.tid < 32) { const int tot = wcnt[c.tid]; bbase[c.tid] = (tot && !(c.p.flags & 16)) ? atomicAdd(gcount + c.tid, tot) : 0; }
    __syncthreads();
    if (!(c.p.flags & 16)) {
      const int ek = sel_e[c.tid];
      u32x2 info; info.x = (unsigned)(tokg * 4 + c.tid); info.y = __float_as_uint(sel_g[c.tid]);
      rinfo[(size_t)ek * ECAP + bbase[ek] + sel_pos[c.tid]] = info;
      ((float*)(ws + WS_RSC))[(size_t)ek * ECAP + bbase[ek] + sel_pos[c.tid]] = tsl[c.tid >> 2];
    }
    __syncthreads();
  }
}
#else
DI void phase_router(const Ctx& c) {
  unsigned char* ws = c.p.ws;
  const float* h = (const float*)(ws + WS_H); float* x1 = (float*)(ws + WS_X1); bf16_t* x1b = (bf16_t*)(ws + WS_X1B);
  const float* wT = (const float*)(ws + WS_WRT); int* gcount = (int*)(ws + WS_MISC + MiB); u32x2* rinfo = (u32x2*)(ws + WS_RINFO);
  LAS int* wcnt = (LAS int*)(c.lds);
  LAS int* bbase = wcnt + 256;
  LAS float* tsl = (LAS float*)(c.lds + 16384);
  LAS int* sel_e = bbase + 32; LAS int* sel_pos = sel_e + 512; LAS float* sel_g = (LAS float*)(sel_e + 1024);
  const int e = c.lane & 31, hf = c.lane >> 5;
  f32x4 gam[4], bet[4];
#pragma unroll
  for (int j = 0; j < 4; ++j) { gam[j] = ((const f32x4*)c.p.in[I_LN1G])[64 * j + c.lane]; bet[j] = ((const f32x4*)c.p.in[I_LN1B])[64 * j + c.lane]; }
  float brl[32];
#pragma unroll
  for (int q = 0; q < 32; ++q) brl[q] = c.p.in[I_BR][q];
  for (int gi = c.bid; gi < TT / 128; gi += c.G) {
    const int tokg = gi * 128;
    if (c.tid < 32) wcnt[c.tid] = 0;
    {
      const f32x4* hr0 = (const f32x4*)(h + ((size_t)tokg + c.wave * 16) * DM) + c.lane; f32x4 vn[4];
#pragma unroll
      for (int j = 0; j < 4; ++j) vn[j] = hr0[64 * j];
      for (int tt = 0; tt < 16; ++tt) {
        const size_t t = (size_t)tokg + c.wave * 16 + tt; f32x4 v[4]; float s = 0.f;
#pragma unroll
        for (int j = 0; j < 4; ++j) { v[j] = vn[j]; s += (v[j].x + v[j].y) + (v[j].z + v[j].w); }
        { const f32x4* hrn = (const f32x4*)(h + (t + (tt < 15 ? 1 : 0)) * DM) + c.lane;
#pragma unroll
          for (int j = 0; j < 4; ++j) vn[j] = hrn[64 * j]; }
        const float mean = wave_sum(s) * (1.f / DM); float s2 = 0.f;
#pragma unroll
        for (int j = 0; j < 4; ++j) { v[j] = v[j] - mean; s2 += (v[j].x * v[j].x + v[j].y * v[j].y) + (v[j].z * v[j].z + v[j].w * v[j].w); }
        const float rstd = rsqrtf(wave_sum(s2) * (1.f / DM) + LN_EPS);
#if MOE_I8
        f32x4 y[4]; float am = 0.f;
#pragma unroll
        for (int j = 0; j < 4; ++j) { y[j] = v[j] * rstd * gam[j] + bet[j]; ((f32x4*)(x1 + t * DM))[64 * j + c.lane] = y[j];
          am = fmaxf(fmaxf(am, fmaxf(fabsf(y[j].x), fabsf(y[j].y))), fmaxf(fabsf(y[j].z), fabsf(y[j].w))); }
        am = wave_max(am); const float qs = am > 0.f ? 127.f / am : 0.f;
        if (c.lane == 0) tsl[c.wave * 16 + tt] = am * (1.f / 127.f);
#pragma unroll
        for (int j = 0; j < 4; ++j) { const unsigned w = ((unsigned)(int)rintf(y[j].x * qs) & 0xffu) | (((unsigned)(int)rintf(y[j].y * qs) & 0xffu) << 8) | (((unsigned)(int)rintf(y[j].z * qs) & 0xffu) << 16) | (((unsigned)(int)rintf(y[j].w * qs) & 0xffu) << 24);
          ((unsigned*)(ws + WS_X1Q + t * DM))[64 * j + c.lane] = w; }
#else
#pragma unroll
        for (int j = 0; j < 4; ++j) { const f32x4 y = v[j] * rstd * gam[j] + bet[j];
          ((f32x4*)(x1 + t * DM))[64 * j + c.lane] = y; u32x2 o; o.x = pk_bf16(y.x, y.y); o.y = pk_bf16(y.z, y.w); ((u32x2*)(x1b + t * DM))[64 * j + c.lane] = o; }
#endif
      }
    }
    asm volatile("s_waitcnt vmcnt(0)" ::: "memory");
    __syncthreads();
    if (c.wave < 4) {
      const float* ap = wT + (size_t)e * DM + 512 * hf; const float* bp = x1 + ((size_t)tokg + c.wave * 32 + e) * DM + 512 * hf;
      f32x16 acc;
#pragma unroll
      for (int i = 0; i < 16; ++i) acc[i] = 0.f;
      f32x4 a4 = *(const f32x4*)ap, b4 = *(const f32x4*)bp, a4n = *(const f32x4*)(ap + 4), b4n = *(const f32x4*)(bp + 4);
      for (int q = 0; q < 128; ++q) {
        const int qn = q + 2 < 128 ? q + 2 : 127;
        const f32x4 a4nn = *(const f32x4*)(ap + 4 * qn), b4nn = *(const f32x4*)(bp + 4 * qn);
#pragma unroll
        for (int j = 0; j < 4; ++j) acc = __builtin_amdgcn_mfma_f32_32x32x2f32(a4[j], b4[j], acc, 0, 0, 0);
        a4 = a4n; b4 = b4n; a4n = a4nn; b4n = b4nn;
      }
      float L[32];
#pragma unroll
      for (int rg = 0; rg < 16; ++rg) { const float own = acc[rg], oth = __shfl_xor(own, 32); L[crow(rg, 0)] = (hf ? oth : own) + brl[crow(rg, 0)]; L[crow(rg, 1)] = (hf ? own : oth) + brl[crow(rg, 1)]; }
      float tv[4]; int ti[4];
#pragma unroll
      for (int k = 0; k < 4; ++k) {
        float bv = L[0]; int bi = 0;
#pragma unroll
        for (int q = 1; q < 32; ++q) { const bool g = L[q] > bv; bv = g ? L[q] : bv; bi = g ? q : bi; }
        tv[k] = bv; ti[k] = bi;
#pragma unroll
        for (int q = 0; q < 32; ++q) L[q] = (q == bi) ? -INFINITY : L[q];
      }
      const float e1 = __expf(tv[1] - tv[0]), e2 = __expf(tv[2] - tv[0]), e3 = __expf(tv[3] - tv[0]), inv = 1.f / (1.f + e1 + e2 + e3);
      if (hf == 0) {
        const float gk[4] = {inv, e1 * inv, e2 * inv, e3 * inv};
#pragma unroll
        for (int k = 0; k < 4; ++k) { const int si = (c.wave * 32 + e) * 4 + k; sel_e[si] = ti[k]; sel_g[si] = gk[k]; sel_pos[si] = (int)__hip_atomic_fetch_add((LAS unsigned*)(wcnt + ti[k]), 1u, __ATOMIC_RELAXED, __HIP_MEMORY_SCOPE_WORKGROUP); }
      }
    }
    __syncthreads();
    if (c.tid < 32) { const int tot = wcnt[c.tid]; bbase[c.tid] = (tot && !(c.p.flags & 16)) ? atomicAdd(gcount + c.tid, tot) : 0; }
    __syncthreads();
    if (!(c.p.flags & 16)) {
      const int ek = sel_e[c.tid];
      u32x2 info; info.x = (unsigned)(tokg * 4 + c.tid); info.y = __float_as_uint(sel_g[c.tid]);
      rinfo[(size_t)ek * ECAP + bbase[ek] + sel_pos[c.tid]] = info;
#if MOE_I8
      ((float*)(ws + WS_RSC))[(size_t)ek * ECAP + bbase[ek] + sel_pos[c.tid]] = tsl[c.tid >> 2];
#endif
    }
    __syncthreads();
  }
}

#endif

DI void build_group_tab(const Ctx& c, LAS int* tab) {
  const int* gcount = (const int*)(c.p.ws + WS_MISC + MiB);
  __syncthreads();
  if (c.tid == 0) { int ps = 0;
    for (int e = 0; e < 32; ++e) { const int cnt = gcount[e]; tab[e] = cnt; tab[32 + e] = ps; const int nt_ = (cnt + 255) >> 8; for (int q = 0; q < nt_; ++q) tab[96 + (ps >> 8) + q] = e; ps += nt_ << 8; }
    tab[64] = ps; tab[65] = ps >> 8; }
  __syncthreads();
}

DI void phase_final(const Ctx& c) {
  const float* x1 = (const float*)(c.p.ws + WS_X1); const bf16_t* yp = (const bf16_t*)(c.p.ws + WS_YPAIR);
  f32x4 gam[4], bet[4];
#pragma unroll
  for (int j = 0; j < 4; ++j) { gam[j] = ((const f32x4*)c.p.in[I_LN2G])[64 * j + c.lane]; bet[j] = ((const f32x4*)c.p.in[I_LN2B])[64 * j + c.lane]; }
  for (int t = c.gw; t < TT; t += c.ngw) {
    f32x4 v[4]; float s = 0.f;
#pragma unroll
    for (int j = 0; j < 4; ++j) {
#if ROUTER_LDS
      { const u32x2 xw = ((const u32x2*)((const bf16_t*)x1 + (size_t)t * DM))[64 * j + c.lane]; v[j] = (f32x4){bflo(xw.x), bfhi(xw.x), bflo(xw.y), bfhi(xw.y)} * DN_ALPHA; }
#else
      v[j] = ((const f32x4*)(x1 + (size_t)t * DM))[64 * j + c.lane] * DN_ALPHA;
#endif
#pragma unroll
      for (int k = 0; k < 4; ++k) { const u32x2 w = ((const u32x2*)(yp + ((size_t)t * 4 + k) * DM))[64 * j + c.lane]; v[j].x += bflo(w.x); v[j].y += bfhi(w.x); v[j].z += bflo(w.y); v[j].w += bfhi(w.y); }
      s += (v[j].x + v[j].y) + (v[j].z + v[j].w); }
    const float mean = wave_sum(s) * (1.f / DM); float s2 = 0.f;
#pragma unroll
    for (int j = 0; j < 4; ++j) { v[j] = v[j] - mean; s2 += (v[j].x * v[j].x + v[j].y * v[j].y) + (v[j].z * v[j].z + v[j].w * v[j].w); }
    const float rstd = rsqrtf(wave_sum(s2) * (1.f / DM) + LN_EPS);
#pragma unroll
    for (int j = 0; j < 4; ++j) ((f32x4*)(c.p.out + (size_t)t * DM))[64 * j + c.lane] = v[j] * rstd * gam[j] + bet[j];
  }
}
DI bf16x8 pack8(const f32x16& x, int s) {
  u32x4 p; p.x = pk_bf16(x[8 * s + 0], x[8 * s + 1]); p.y = pk_bf16(x[8 * s + 2], x[8 * s + 3]); p.z = pk_bf16(x[8 * s + 4], x[8 * s + 5]); p.w = pk_bf16(x[8 * s + 6], x[8 * s + 7]);
  return __builtin_bit_cast(bf16x8, p);
}
DI void store8(bf16_t* dst, const f32x16& x, int s, float sc) {
  u32x4 p; p.x = pk_bf16(x[8 * s + 0] * sc, x[8 * s + 1] * sc); p.y = pk_bf16(x[8 * s + 2] * sc, x[8 * s + 3] * sc); p.z = pk_bf16(x[8 * s + 4] * sc, x[8 * s + 5] * sc); p.w = pk_bf16(x[8 * s + 6] * sc, x[8 * s + 7] * sc);
  *(u32x4*)dst = p;
}

#if !NAIVE_GDN
DI void phase_gdn_chunk(const Ctx& c) {
  unsigned char* ws = c.p.ws;
  const bf16_t* proj = (const bf16_t*)(ws + WS_PROJ); const float* gbeta = (const float*)(ws + WS_MISC); const float* wcv = c.p.in[I_WCONV];
  float* egl = (float*)(ws + WS_MISC + MiB + 4096);
  const int team = c.wave >> 2, tw = c.wave & 3, ttid = c.tid & 255, r = c.lane & 31, hf = c.lane >> 5;
  LAS unsigned char* tl = c.lds + team * 71680;
  LAS bf16_t* ks = (LAS bf16_t*)tl; LAS bf16_t* qs = (LAS bf16_t*)(tl + 17408); LAS bf16_t* kT = (LAS bf16_t*)(tl + 34816); LAS bf16_t* vT = (LAS bf16_t*)(tl + 53248);
  LAS float* Am = (LAS float*)(tl + 17408); LAS bf16_t* T1 = (LAS bf16_t*)tl; LAS bf16_t* T2 = (LAS bf16_t*)(tl + 9216);
  LAS float* sc = (LAS float*)(c.lds + 143360 + team * 1024);
  float wc[3][2][4];
  const int nchunk = NB * 4 * 32, niter = (nchunk + 2 * c.G - 1) / (2 * c.G);
  for (int itr = 0; itr < niter; ++itr) {
    const int ci_raw = (itr * c.G + c.bid) * 2 + team; const int ci = ci_raw < nchunk ? ci_raw : 0;
    const int n = ci & 31, hh = (ci >> 5) & 3, b = ci >> 7; const int tok0 = b * SEQ + n * 64;
    unsigned char* cb = ws + WS_GDN + (size_t)ci * GDN_CHUNK_BYTES;
#pragma unroll
    for (int part = 0; part < 3; ++part)
#pragma unroll
      for (int e = 0; e < 2; ++e)
#pragma unroll
        for (int j = 0; j < 4; ++j) wc[part][e][j] = wcv[j * 1536 + part * 512 + hh * 128 + 2 * c.lane + e];
    const float gl = gbeta[(size_t)(tok0 + c.lane) * 8 + hh], bt = gbeta[(size_t)(tok0 + c.lane) * 8 + 4 + hh];
    float gc = gl;
#pragma unroll
    for (int off = 1; off < 64; off <<= 1) { const float o2 = __shfl_up(gc, off); if (c.lane >= off) gc += o2; }
    const float glast = __shfl(gc, 63);
    if (tw == 0) { sc[c.lane] = gc; sc[64 + c.lane] = bt; sc[128 + c.lane] = fexp(glast - gc); if (c.lane == 0) egl[ci] = fexp(glast); }
    unsigned pvn[3][7];
#pragma unroll
    for (int part = 0; part < 3; ++part)
#pragma unroll
      for (int rr = 0; rr < 7; ++rr) { const int tl2 = n * 64 + tw * 16 - 3 + rr; pvn[part][rr] = tl2 >= 0 ? *(const unsigned*)(proj + (size_t)(tok0 + tw * 16 - 3 + rr) * NPROJ + part * 512 + hh * 128 + 2 * c.lane) : 0u; }
    for (int i4 = 0; i4 < 16; i4 += 4) {
    unsigned pv[3][7];
#pragma unroll
    for (int part = 0; part < 3; ++part)
#pragma unroll
      for (int rr = 0; rr < 7; ++rr) pv[part][rr] = pvn[part][rr];
    if (i4 < 12) {
#pragma unroll
      for (int part = 0; part < 3; ++part)
#pragma unroll
        for (int rr = 0; rr < 7; ++rr) pvn[part][rr] = *(const unsigned*)(proj + (size_t)(tok0 + tw * 16 + i4 + 4 - 3 + rr) * NPROJ + part * 512 + hh * 128 + 2 * c.lane);
    }
    float val[4][3][2], ssq[4], ssk[4];
#pragma unroll
    for (int ii = 0; ii < 4; ++ii)
#pragma unroll
      for (int part = 0; part < 3; ++part) { float a0 = 0.f, a1 = 0.f;
#pragma unroll
        for (int j = 0; j < 4; ++j) { a0 += wc[part][0][j] * bflo(pv[part][ii + j]); a1 += wc[part][1][j] * bfhi(pv[part][ii + j]); }
        val[ii][part][0] = a0 * sigmoidf_(a0); val[ii][part][1] = a1 * sigmoidf_(a1); }
    wave_sum8(val[0][0][0] * val[0][0][0] + val[0][0][1] * val[0][0][1], val[1][0][0] * val[1][0][0] + val[1][0][1] * val[1][0][1], val[2][0][0] * val[2][0][0] + val[2][0][1] * val[2][0][1], val[3][0][0] * val[3][0][0] + val[3][0][1] * val[3][0][1],
              val[0][1][0] * val[0][1][0] + val[0][1][1] * val[0][1][1], val[1][1][0] * val[1][1][0] + val[1][1][1] * val[1][1][1], val[2][1][0] * val[2][1][0] + val[2][1][1] * val[2][1][1], val[3][1][0] * val[3][1][0] + val[3][1][1] * val[3][1][1], ssq, ssk);
    unsigned kprev = 0u, vprev = 0u;
#pragma unroll
    for (int ii = 0; ii < 4; ++ii) {
      const int cc = tw * 16 + i4 + ii;
      const float rq = __builtin_amdgcn_rsqf(ssq[ii] + NORM_EPS) * 0.08838834764831845f, rk = __builtin_amdgcn_rsqf(ssk[ii] + NORM_EPS);
      const float q0 = val[ii][0][0] * rq, q1 = val[ii][0][1] * rq, k0 = val[ii][1][0] * rk, k1 = val[ii][1][1] * rk;
      const unsigned kp = pk_bf16(k0, k1), vp = pk_bf16(val[ii][2][0], val[ii][2][1]);
      *(LAS unsigned*)(qs + cc * 136 + 2 * c.lane) = pk_bf16(q0, q1); *(LAS unsigned*)(ks + cc * 136 + 2 * c.lane) = kp;
      if (ii & 1) {
        *(LAS unsigned*)(kT + (2 * c.lane) * 72 + cc - 1) = (kprev & 0xffffu) | (kp << 16); *(LAS unsigned*)(kT + (2 * c.lane + 1) * 72 + cc - 1) = (kprev >> 16) | (kp & 0xffff0000u);
        *(LAS unsigned*)(vT + (2 * c.lane) * 72 + cc - 1) = (vprev & 0xffffu) | (vp << 16); *(LAS unsigned*)(vT + (2 * c.lane + 1) * 72 + cc - 1) = (vprev >> 16) | (vp & 0xffff0000u);
      }
      kprev = kp; vprev = vp;
      const float eg = fexp(__shfl(gc, cc));
      { const int pos = swap23(2 * c.lane); *(unsigned*)(cb + 16384 + (size_t)cc * 256 + 16 * ((pos >> 3) ^ (cc & 15)) + 2 * (pos & 7)) = pk_bf16(q0 * eg, q1 * eg); }
    }
    }
    __syncthreads();
    if (c.p.flags & 4) continue;
    const int mi = tw >> 1, ni = tw & 1;
    f32x16 akk, aat;
#pragma unroll
    for (int i = 0; i < 16; ++i) { akk[i] = 0.f; aat[i] = 0.f; }
#pragma unroll
    for (int s = 0; s < 8; ++s) { const bf16x8 ka = *(const LAS bf16x8*)(ks + (32 * mi + r) * 136 + 16 * s + 8 * hf);
      akk = MFMA32(ka, *(const LAS bf16x8*)(ks + (32 * ni + r) * 136 + 16 * s + 8 * hf), akk);
      aat = MFMA32(ka, *(const LAS bf16x8*)(qs + (32 * ni + r) * 136 + 16 * s + 8 * hf), aat); }
    {
      const int cout = 32 * ni + r; const float gco = sc[cout];
#pragma unroll
      for (int i = 0; i < 16; ++i) { const int cr = 32 * mi + crow(i, hf); aat[i] = cout >= cr ? aat[i] * fexp(gco - sc[cr]) : 0.f; }
      { unsigned char* rp = cb + 49152 + (size_t)cout * 128; const int sw = (cout >> 1) & 7; store8((bf16_t*)(rp + 16 * ((4 * mi + hf) ^ sw)), aat, 0, 1.f); store8((bf16_t*)(rp + 16 * ((4 * mi + 2 + hf) ^ sw)), aat, 1, 1.f); }
    }
    __syncthreads();
    { const int j = 32 * ni + r; const float gcj = sc[j];
#pragma unroll
      for (int i = 0; i < 16; ++i) { const int cr = 32 * mi + crow(i, hf); Am[cr * 64 + j] = cr > j ? akk[i] * fexp(sc[cr] - gcj) * sc[64 + cr] : 0.f; } }
    __syncthreads();
    if (c.p.flags & 8) continue;
    {
      LAS float* Pt = (LAS float*)tl;
      if (c.lane < 16) {
        const int pb = tw, j = c.lane; float t[16];
#pragma unroll
        for (int i = 0; i < 16; ++i) {
          float a0 = 0.f, a1 = 0.f;
#pragma unroll
          for (int m4 = 0; m4 < i; m4 += 4) { const f32x4 av = *(const LAS f32x4*)(Am + (16 * pb + i) * 64 + 16 * pb + m4);
            a0 += av.x * t[m4]; if (m4 + 1 < i) a1 += av.y * t[m4 + 1]; if (m4 + 2 < i) a0 += av.z * t[m4 + 2]; if (m4 + 3 < i) a1 += av.w * t[m4 + 3]; }
          t[i] = (j == i ? 1.f : 0.f) - (a0 + a1);
        }
        LDS_WAIT();
#pragma unroll
        for (int i = 0; i < 16; ++i) Am[(16 * pb + i) * 64 + 16 * pb + j] = t[i];
      }
      for (int it = ttid; it < 1024; it += 256) { const int dk = it >> 3, s = (it >> 1) & 3, h2 = it & 1;
        const u32x2 lo = *(const LAS u32x2*)(kT + dk * 72 + 16 * s + 4 * h2), hi = *(const LAS u32x2*)(kT + dk * 72 + 16 * s + 8 + 4 * h2);
        const LAS float* e0 = sc + 128 + 16 * s + 4 * h2; const LAS float* e1 = e0 + 8;
        u32x4 o; o.x = pk_bf16(bflo(lo.x) * e0[0], bfhi(lo.x) * e0[1]); o.y = pk_bf16(bflo(lo.y) * e0[2], bfhi(lo.y) * e0[3]);
        o.z = pk_bf16(bflo(hi.x) * e1[0], bfhi(hi.x) * e1[1]); o.w = pk_bf16(bflo(hi.y) * e1[2], bfhi(hi.y) * e1[3]);
        *(u32x4*)(cb + 32768 + (size_t)dk * 128 + 16 * ((2 * s + h2) ^ ((dk >> 1) & 7))) = o; }
      __syncthreads();
      const int ii = ttid >> 4, jj = ttid & 15;
#pragma unroll
      for (int pb = 1; pb < 4; ++pb) {
#pragma unroll
        for (int q = 0; q < pb; ++q) {
          float acc = 0.f;
#pragma unroll
          for (int r2 = q; r2 < pb; ++r2)
#pragma unroll
            for (int m4 = 0; m4 < 16; m4 += 4) { const f32x4 av = *(const LAS f32x4*)(Am + (16 * pb + ii) * 64 + 16 * r2 + m4); const LAS float* tp = Am + (16 * r2 + m4) * 64 + 16 * q + jj;
              acc += av.x * tp[0] + av.y * tp[64] + av.z * tp[128] + av.w * tp[192]; }
          Pt[q * 256 + ii * 16 + jj] = acc;
        }
        __syncthreads();
#pragma unroll
        for (int q = 0; q < pb; ++q) {
          float acc = 0.f;
#pragma unroll
          for (int m4 = 0; m4 < 16; m4 += 4) { const f32x4 tv = *(const LAS f32x4*)(Am + (16 * pb + ii) * 64 + 16 * pb + m4); const LAS float* pp = Pt + q * 256 + m4 * 16 + jj;
            acc += tv.x * pp[0] + tv.y * pp[16] + tv.z * pp[32] + tv.w * pp[48]; }
          Am[(16 * pb + ii) * 64 + 16 * q + jj] = -acc;
        }
        __syncthreads();
      }
      float tv2[16];
#pragma unroll
      for (int k = 0; k < 16; ++k) tv2[k] = Am[(ttid >> 6) * 64 + k * 256 + (ttid & 63)];
      const float bj = sc[64 + (ttid & 63)], bej = bj * fexp(sc[ttid & 63]);
      __syncthreads();
#pragma unroll
      for (int k = 0; k < 16; ++k) { const int row = 4 * k + (ttid >> 6); T1[row * 72 + (ttid & 63)] = f2bf(tv2[k] * bj); T2[row * 72 + (ttid & 63)] = f2bf(tv2[k] * bej); }
    }
    __syncthreads();
#pragma unroll
    for (int q = 0; q < 2; ++q) {
      const int job = tw * 2 + q;
      const int mu = job & 1, nu = job >> 1, mw = job >> 1, nw = job & 1;
      f32x16 au, aw;
#pragma unroll
      for (int i = 0; i < 16; ++i) { au[i] = 0.f; aw[i] = 0.f; }
#pragma unroll
      for (int s = 0; s < 4; ++s) {
        au = MFMA32(*(const LAS bf16x8*)(T1 + (32 * mu + r) * 72 + 16 * s + 8 * hf), *(const LAS bf16x8*)(vT + (32 * nu + r) * 72 + 16 * s + 8 * hf), au);
        aw = MFMA32(*(const LAS bf16x8*)(kT + (32 * mw + r) * 72 + 16 * s + 8 * hf), *(const LAS bf16x8*)(T2 + (32 * nw + r) * 72 + 16 * s + 8 * hf), aw); }
      {
        bf16_t* up = (bf16_t*)(cb + 57344 + (size_t)(32 * nu + r) * 128) + 32 * mu + 8 * hf; store8(up, au, 0, 1.f); store8(up + 16, au, 1, 1.f);
        unsigned char* wp = cb + (size_t)(32 * nw + r) * 256; const int sw = (32 * nw + r) & 15; store8((bf16_t*)(wp + 16 * ((4 * mw + hf) ^ sw)), aw, 0, 1.f); store8((bf16_t*)(wp + 16 * ((4 * mw + 2 + hf) ^ sw)), aw, 1, 1.f); }
    }
    __syncthreads();
  }
}

DI void scan_unit(const Ctx& c, LAS unsigned char* sl) {
  const int bh = c.bid & 63, dv0 = (c.bid >> 6) * 32, b = bh >> 2, hh = bh & 3, r = c.lane & 31, hf = c.lane >> 5;
  const unsigned char* ws = c.p.ws; const float* egl = (const float*)(ws + WS_MISC + MiB + 4096); bf16_t* ycat = (bf16_t*)(c.p.ws + WS_YCAT);
  const unsigned char* cb0 = ws + WS_GDN + (size_t)(bh * 32) * GDN_CHUNK_BYTES;
  f32x16 S[4];
#pragma unroll
  for (int m = 0; m < 4; ++m)
#pragma unroll
    for (int i = 0; i < 16; ++i) S[m][i] = 0.f;
  const int sw16 = r & 15, sw8 = (r >> 1) & 7;
#define SCAN_DMA(buf, chunk) do { const unsigned char* _g = cb0 + (size_t)(chunk) * GDN_CHUNK_BYTES + c.lane * 16; LAS unsigned char* _l = sl + (buf) * 57344; \
    _Pragma("unroll") for (int _i = 0; _i < 56; ++_i) __builtin_amdgcn_global_load_lds((const unsigned*)(_g + _i * 1024), (LAS unsigned*)(_l + _i * 1024), 16, 0, 0); } while (0)
  SCAN_DMA(0, 0);
  u32x4 un[4];
#pragma unroll
  for (int q = 0; q < 4; ++q) un[q] = *(const u32x4*)(cb0 + 57344 + (size_t)(dv0 + r) * 128 + 32 * q + 16 * hf);
  for (int n = 0; n < 32; ++n) {
    asm volatile("s_waitcnt vmcnt(0)" ::: "memory");
    u32x4 uc[4];
#pragma unroll
    for (int q = 0; q < 4; ++q) uc[q] = un[q];
    const int nn = n < 31 ? n + 1 : 31;
    SCAN_DMA((n + 1) & 1, nn);
#pragma unroll
    for (int q = 0; q < 4; ++q) un[q] = *(const u32x4*)(cb0 + (size_t)nn * GDN_CHUNK_BYTES + 57344 + (size_t)(dv0 + r) * 128 + 32 * q + 16 * hf);
    const float eg = egl[bh * 32 + n];
    const LAS unsigned char* L = sl + (n & 1) * 57344;
    const LAS unsigned char* wL = L + r * 256; const LAS unsigned char* qL = L + 16384 + r * 256; const LAS unsigned char* kL = L + 32768 + r * 128; const LAS unsigned char* aL = L + 49152 + r * 128;
    bf16x8 Sb[8];
#pragma unroll
    for (int s = 0; s < 8; ++s) Sb[s] = pack8(S[s >> 1], s & 1);
    f32x16 vn[2], o[2];
#pragma unroll
    for (int m = 0; m < 2; ++m) {
#pragma unroll
      for (int i = 0; i < 16; ++i) { vn[m][i] = 0.f; o[m][i] = 0.f; }
#pragma unroll
      for (int s = 0; s < 8; ++s) { vn[m] = MFMA32(*(const LAS bf16x8*)(wL + m * 8192 + 16 * ((2 * s + hf) ^ sw16)), Sb[s], vn[m]); o[m] = MFMA32(*(const LAS bf16x8*)(qL + m * 8192 + 16 * ((2 * s + hf) ^ sw16)), Sb[s], o[m]); }
    }
#pragma unroll
    for (int m = 0; m < 2; ++m)
#pragma unroll
      for (int s2 = 0; s2 < 2; ++s2) { const u32x4 uv = uc[2 * m + s2];
#pragma unroll
        for (int q = 0; q < 4; ++q) { vn[m][8 * s2 + 2 * q] = bflo(uv[q]) - vn[m][8 * s2 + 2 * q]; vn[m][8 * s2 + 2 * q + 1] = bfhi(uv[q]) - vn[m][8 * s2 + 2 * q + 1]; } }
    bf16x8 vb[4];
#pragma unroll
    for (int s = 0; s < 4; ++s) vb[s] = pack8(vn[s >> 1], s & 1);
#pragma unroll
    for (int m = 0; m < 2; ++m)
#pragma unroll
      for (int s = 0; s < 4; ++s) o[m] = MFMA32(*(const LAS bf16x8*)(aL + m * 4096 + 16 * ((2 * s + hf) ^ sw8)), vb[s], o[m]);
#pragma unroll
    for (int m = 0; m < 4; ++m) {
#pragma unroll
      for (int i = 0; i < 16; ++i) S[m][i] *= eg;
#pragma unroll
      for (int s = 0; s < 4; ++s) S[m] = MFMA32(*(const LAS bf16x8*)(kL + m * 4096 + 16 * ((2 * s + hf) ^ sw8)), vb[s], S[m]);
    }
    bf16_t* yp = ycat + (size_t)(b * SEQ + n * 64) * 1536 + hh * 128 + dv0 + r;
#pragma unroll
    for (int m = 0; m < 2; ++m)
#pragma unroll
      for (int i = 0; i < 16; ++i) yp[(size_t)(32 * m + crow(i, hf)) * 1536] = f2bf(o[m][i]);
  }
  asm volatile("s_waitcnt vmcnt(0)" ::: "memory");
#undef SCAN_DMA
}
#endif

#if !NAIVE_ATTN
DI void load_v64(u32x4 (&vr)[4], const bf16_t* vsrc, size_t ld, int lane) {
#pragma unroll
  for (int i = 0; i < 4; ++i) { const int q = lane + 64 * i; vr[i] = *(const u32x4*)(vsrc + (size_t)(q >> 3) * ld + (q & 7) * 8); }
}
DI void put_v64(LAS bf16_t* vl, const u32x4 (&vr)[4], int lane) {
#pragma unroll
  for (int i = 0; i < 4; ++i) { const int q = lane + 64 * i; *(LAS u32x4*)(vl + (q >> 3) * 64 + (q & 7) * 8) = vr[i]; }
}
DI bf16x8 gather_vt(const LAS bf16_t* vl, int m, int s, int lane) {
  const int i16 = lane & 15, q = i16 >> 2, pp = i16 & 3, g16 = (lane >> 4) & 1, hf = lane >> 5;
  const LAS bf16_t* a0 = vl + (16 * s + 4 * hf + q) * 64 + 32 * m + 16 * g16 + 4 * pp;
  const s16x4 lo = __builtin_amdgcn_ds_read_tr16_b64_v4i16((LAS s16x4*)a0), hi = __builtin_amdgcn_ds_read_tr16_b64_v4i16((LAS s16x4*)(a0 + 8 * 64));
  return __builtin_shufflevector(lo, hi, 0, 1, 2, 3, 4, 5, 6, 7);
}
constexpr float SB_EXIT = 40.f;
#define SB_TILE(Kc, Vc, KT) do { \
    LDS_WAIT(); \
    put_v64(vl, Vc, c.lane); \
    _Pragma("unroll") for (int i = 0; i < 4; ++i) { const int q = c.lane + 64 * i; *(LAS u32x4*)(kl + (q >> 3) * 72 + (q & 7) * 8) = Kc[i]; } \
    { const int kp = (KT) - 1 > 0 ? (KT) - 1 : 0;          \
      load_v64(Kc, kbase + (size_t)(32 * kp) * NPROJ, NPROJ, c.lane); load_v64(Vc, vbase + (size_t)(32 * kp) * NPROJ, NPROJ, c.lane); } \
    LDS_WAIT(); \
    f32x16 z; \
    _Pragma("unroll") for (int i = 0; i < 16; ++i) z[i] = 0.f; \
    _Pragma("unroll") for (int s = 0; s < 4; ++s) z = MFMA32(*(const LAS bf16x8*)(kl + r * 72 + 16 * s + 8 * hf), Qf[s], z); \
    float sp[16]; \
    float mk[16];                                   \
    _Pragma("unroll") for (int i = 0; i < 16; ++i) { mk[i] = (((KT) < qt) || (crow(i, hf) < r)) ? 1.f : 0.f; z[i] *= 0.125f; sp[i] = softplus_fast(z[i]) * mk[i]; } \
    float mine[4], oth[4], both[4]; \
    _Pragma("unroll") for (int g = 0; g < 4; ++g) { mine[g] = (sp[4 * g] + sp[4 * g + 1]) + (sp[4 * g + 2] + sp[4 * g + 3]); oth[g] = __shfl_xor(mine[g], 32); both[g] = mine[g] + oth[g]; } \
    float tail[4]; tail[3] = 0.f; tail[2] = both[3]; tail[1] = both[3] + both[2]; tail[0] = tail[1] + both[1]; \
    _Pragma("unroll") for (int g = 0; g < 4; ++g) { \
      float run = carry + tail[g] + (hf == 0 ? oth[g] : 0.f); \
      _Pragma("unroll") for (int q = 3; q >= 0; --q) { const int i = 4 * g + q; run += sp[i]; z[i] = fexp(fminf(z[i] - run, 0.f)) * mk[i]; }     \
    } \
    carry += tail[0] + both[0]; \
    const bf16x8 w0 = pack8(z, 0), w1 = pack8(z, 1); \
    LDS_WAIT(); \
    _Pragma("unroll") for (int m = 0; m < 2; ++m) { O[m] = MFMA32(gather_vt(vl, m, 0, c.lane), w0, O[m]); O[m] = MFMA32(gather_vt(vl, m, 1, c.lane), w1, O[m]); } \
  } while (0)
DI void sb_unit(const Ctx& c, int u, LAS bf16_t* vl) {
  const bf16_t* proj = (const bf16_t*)(c.p.ws + WS_PROJ); bf16_t* ycat = (bf16_t*)(c.p.ws + WS_YCAT);
  const int qt = 63 - (u & 63), hh = (u >> 6) & 7, b = u >> 9, r = c.lane & 31, hf = c.lane >> 5;
  const size_t tok0 = (size_t)b * SEQ + 32 * qt;
  LAS bf16_t* kl = vl + 2048;
  const bf16_t* kbase = proj + (size_t)b * SEQ * NPROJ + C_SK + hh * 64; const bf16_t* vbase = proj + (size_t)b * SEQ * NPROJ + C_SV + hh * 64;
  bf16x8 Qf[4]; u32x4 K0[4], V0[4];
  load_v64(K0, kbase + (size_t)(32 * qt) * NPROJ, NPROJ, c.lane); load_v64(V0, vbase + (size_t)(32 * qt) * NPROJ, NPROJ, c.lane);
#pragma unroll
  for (int s = 0; s < 4; ++s) Qf[s] = *(const bf16x8*)(proj + (tok0 + r) * NPROJ + C_SQ + hh * 64 + 16 * s + 8 * hf);
  f32x16 O[2];
#pragma unroll
  for (int m = 0; m < 2; ++m)
#pragma unroll
    for (int i = 0; i < 16; ++i) O[m][i] = 0.f;
  float carry = 0.f;
  for (int kt = qt; kt >= 0; --kt) {
    SB_TILE(K0, V0, kt);
    if (__all(carry > SB_EXIT)) break;
  }
  bf16_t* yp = ycat + (tok0 + r) * 1536 + 512 + hh * 64;
#pragma unroll
  for (int m = 0; m < 2; ++m)
#pragma unroll
    for (int g = 0; g < 4; ++g) { u32x2 w; w.x = pk_bf16(O[m][4 * g], O[m][4 * g + 1]); w.y = pk_bf16(O[m][4 * g + 2], O[m][4 * g + 3]); *(u32x2*)(yp + 32 * m + 8 * g + 4 * hf) = w; }
}
#undef SB_TILE
DI bf16x8 gather_vt_p(const LAS bf16_t* vlp, int key0, int m, int s, int lane) {
  const int i16 = lane & 15, q = i16 >> 2, pp = i16 & 3, g16 = (lane >> 4) & 1, hf = lane >> 5;
  const LAS bf16_t* a0 = vlp + (key0 + 16 * s + 4 * hf + q) * 136 + 32 * m + 16 * g16 + 4 * pp;
  const s16x4 lo = __builtin_amdgcn_ds_read_tr16_b64_v4i16((LAS s16x4*)a0), hi = __builtin_amdgcn_ds_read_tr16_b64_v4i16((LAS s16x4*)(a0 + 8 * 136));
  return __builtin_shufflevector(lo, hi, 0, 1, 2, 3, 4, 5, 6, 7);
}
DI void mem_block(const Ctx& c) {
  const bf16_t* proj = (const bf16_t*)(c.p.ws + WS_PROJ); const bf16_t* mkv = (const bf16_t*)(c.p.ws + WS_MKV); bf16_t* ycat = (bf16_t*)(c.p.ws + WS_YCAT);
  LAS bf16_t* Kl = (LAS bf16_t*)c.lds; LAS bf16_t* Vl = Kl + 256 * 136;
  const int r = c.lane & 31, hf = c.lane >> 5;
  for (int it = c.bid; it < NB * 4 * 4; it += c.G) {
    const int bh = it >> 2, qq = it & 3, b = bh >> 2, hh = bh & 3;
    __syncthreads();
    { const bf16_t* ksrc = mkv + (size_t)b * MEMLEN * 1024 + hh * 128; const bf16_t* vsrc = ksrc + 512;
      u32x4 kr[8], vr[8];
#pragma unroll
      for (int j = 0; j < 8; ++j) { const int i = c.tid + 512 * j, key = i >> 4, pc = (i & 15) * 8; kr[j] = *(const u32x4*)(ksrc + (size_t)key * 1024 + pc); vr[j] = *(const u32x4*)(vsrc + (size_t)key * 1024 + pc); }
#pragma unroll
      for (int j = 0; j < 8; ++j) { const int i = c.tid + 512 * j, key = i >> 4, pc = (i & 15) * 8; *(LAS u32x4*)(Kl + key * 136 + pc) = kr[j]; *(LAS u32x4*)(Vl + key * 136 + pc) = vr[j]; } }
    __syncthreads();
    if (c.p.flags & 256) continue;
    for (int uq = 0; uq < 2; ++uq) {
      const int qt = qq * 16 + c.wave * 2 + uq; const size_t tok0 = (size_t)b * SEQ + 32 * qt;
      bf16x8 Qf[8];
#pragma unroll
      for (int s = 0; s < 8; ++s) Qf[s] = *(const bf16x8*)(proj + (tok0 + r) * NPROJ + C_MQ + hh * 128 + 16 * s + 8 * hf);
      f32x16 z[8];
#pragma unroll
      for (int kt = 0; kt < 8; ++kt) {
#pragma unroll
        for (int i = 0; i < 16; ++i) z[kt][i] = 0.f;
      }
#pragma unroll
      for (int s = 0; s < 8; ++s) {
#pragma unroll
        for (int kt = 0; kt < 8; ++kt) z[kt] = MFMA32(*(const LAS bf16x8*)(Kl + (32 * kt + r) * 136 + 16 * s + 8 * hf), Qf[s], z[kt]);
        asm volatile("" ::: "memory");
      }
      float tm = -INFINITY;
#pragma unroll
      for (int kt = 0; kt < 8; ++kt)
#pragma unroll
        for (int i = 0; i < 16; ++i) tm = fmaxf(tm, z[kt][i]);
      tm = fmaxf(tm, __shfl_xor(tm, 32)) * 0.08838834764831845f;
      float ps = 0.f;
      f32x16 O[4];
#pragma unroll
      for (int m = 0; m < 4; ++m)
#pragma unroll
        for (int i = 0; i < 16; ++i) O[m][i] = 0.f;
#pragma unroll
      for (int kt = 0; kt < 8; ++kt) {
#pragma unroll
        for (int i = 0; i < 16; ++i) { z[kt][i] = fexp(z[kt][i] * 0.08838834764831845f - tm); ps += z[kt][i]; }
        const bf16x8 w0 = pack8(z[kt], 0), w1 = pack8(z[kt], 1);
#pragma unroll
        for (int m = 0; m < 4; ++m) { O[m] = MFMA32(gather_vt_p(Vl, 32 * kt, m, 0, c.lane), w0, O[m]); O[m] = MFMA32(gather_vt_p(Vl, 32 * kt, m, 1, c.lane), w1, O[m]); }
        asm volatile("" ::: "memory");
      }
      ps += __shfl_xor(ps, 32);
      const float il = 1.f / ps;
      bf16_t* yp = ycat + (tok0 + r) * 1536 + 1024 + hh * 128;
#pragma unroll
      for (int m = 0; m < 4; ++m)
#pragma unroll
        for (int g = 0; g < 4; ++g) { u32x2 w; w.x = pk_bf16(O[m][4 * g] * il, O[m][4 * g + 1] * il); w.y = pk_bf16(O[m][4 * g + 2] * il, O[m][4 * g + 3] * il); *(u32x2*)(yp + 32 * m + 8 * g + 4 * hf) = w; }
    }
  }
  __syncthreads();
}
DI void phase_attn_scan(const Ctx& c) {
  __syncthreads();
#if !NAIVE_GDN
  if (c.wave == 0) { if (!(c.p.flags & 1)) scan_unit(c, c.lds); }
#if MOE_I8 && W8_BESIDE_SCAN
  else if (!(c.p.flags & 1)) {
    phase0b_light(c, c.lds + 114688 + (c.wave - 1) * 4608, c.bid * 7 + c.wave - 1, c.G * 7);
    wdn_light(c, (LAS bf16_t*)(c.lds + 114688 + (c.wave - 1) * 4608), c.bid * 7 + c.wave - 1, c.G * 7); }
#endif
  __syncthreads();
#endif
  if (c.p.flags & 2) return;
  if (!(c.p.flags & 64)) mem_block(c);
  LAS bf16_t* vl = (LAS bf16_t*)(c.lds + c.wave * 8704);
  if (!(c.p.flags & 128)) for (int u = c.gw; u < NB * 8 * 64; u += c.ngw) sb_unit(c, u, vl);
}
#endif
#if NAIVE_P5
DI void naive_mixed(const Ctx& c) {
  const bf16_t* ycat = (const bf16_t*)(c.p.ws + WS_YCAT); const bf16_t* wp = (const bf16_t*)(c.p.ws + WS_WP); const bf16_t* proj = (const bf16_t*)(c.p.ws + WS_PROJ); bf16_t* mixed = (bf16_t*)(c.p.ws + WS_MIXED);
  const int r = c.lane & 31, h = c.lane >> 5;
  for (int tile = c.gw; tile < (TT / 32) * 32; tile += c.ngw) {
    const int tm = tile >> 5, tn = tile & 31; float res[16];
#pragma unroll
    for (int i = 0; i < 16; ++i) res[i] = 0.f;
    for (int b = 0; b < 3; ++b) {
      const bf16_t* ap = ycat + (size_t)(tm * 32 + r) * 1536 + b * 512 + 8 * h; const bf16_t* bp = wp + (size_t)(tn * 32 + r) * 1536 + b * 512 + 8 * h;
      f32x16 acc; for (int i = 0; i < 16; ++i) acc[i] = 0.f;
      for (int k0 = 0; k0 < 512; k0 += 16) acc = MFMA32(*(const bf16x8*)(ap + k0), *(const bf16x8*)(bp + k0), acc);
#pragma unroll
      for (int i = 0; i < 16; ++i) res[i] += acc[i] * sigmoidf_(bf2f(proj[(size_t)(tm * 32 + crow(i, h)) * NPROJ + C_GATE + b * 1024 + tn * 32 + r]));
    }
#pragma unroll
    for (int i = 0; i < 16; ++i) mixed[(size_t)(tm * 32 + crow(i, h)) * DM + tn * 32 + r] = f2bf(res[i]);
  }
}
#endif
#if NAIVE_MOE
DI void naive_gateup(const Ctx& c, const LAS int* tab) {
  const bf16_t* x1b = (const bf16_t*)(c.p.ws + WS_X1B); const bf16_t* wgu = (const bf16_t*)(c.p.ws + WS_WGU); bf16_t* act = (bf16_t*)(c.p.ws + WS_ACT); const u32x2* rinfo = (const u32x2*)(c.p.ws + WS_RINFO);
  const float* bgu = c.p.in[I_BGU];
  const int r = c.lane & 31, h = c.lane >> 5, ntile = (tab[64] >> 5) * 32;
  for (int tile = c.gw; tile < ntile; tile += c.ngw) {
    const int tm = tile >> 5, tj = tile & 31, e = tab[96 + (tm >> 3)], local = tm * 32 + r - tab[32 + e];
    const int tok = local < tab[e] ? (int)(rinfo[(size_t)e * ECAP + local].x >> 2) : 0;
    const int j0 = tj * 32, wrow = (j0 >> 7) * 256 + (j0 & 127);
    const bf16_t* ap = x1b + (size_t)tok * DM + 8 * h; const bf16_t* bg = wgu + ((size_t)e * 2048 + wrow + r) * DM + 8 * h; const bf16_t* bl = bg + (size_t)128 * DM;
    f32x16 ag, al; for (int i = 0; i < 16; ++i) { ag[i] = 0.f; al[i] = 0.f; }
    for (int k0 = 0; k0 < DM; k0 += 16) { const bf16x8 a = *(const bf16x8*)(ap + k0); ag = MFMA32(a, *(const bf16x8*)(bg + k0), ag); al = MFMA32(a, *(const bf16x8*)(bl + k0), al); }
    const float bgv = bgu[(size_t)e * 2048 + j0 + r], blv = bgu[(size_t)e * 2048 + 1024 + j0 + r];
#pragma unroll
    for (int i = 0; i < 16; ++i) { const float glu = fminf(ag[i] + bgv, SWIGLU_LIMIT), lin = fminf(fmaxf(al[i] + blv, -SWIGLU_LIMIT), SWIGLU_LIMIT);
      act[(size_t)(tm * 32 + crow(i, h)) * DFF + j0 + r] = f2bf(glu * sigmoidf_(SWIGLU_ALPHA * glu) * (lin + 1.f)); }
  }
}
DI void naive_down(const Ctx& c, const LAS int* tab) {
  const bf16_t* act = (const bf16_t*)(c.p.ws + WS_ACT); const bf16_t* wdn = (const bf16_t*)(c.p.ws + WS_WDN); bf16_t* yp = (bf16_t*)(c.p.ws + WS_YPAIR); const u32x2* rinfo = (const u32x2*)(c.p.ws + WS_RINFO);
  const float* bdn = c.p.in[I_BDN];
  const int r = c.lane & 31, h = c.lane >> 5, ntile = (tab[64] >> 5) * 32;
  for (int tile = c.gw; tile < ntile; tile += c.ngw) {
    const int tm = tile >> 5, tn = tile & 31, e = tab[96 + (tm >> 3)];
    const bf16_t* ap = act + (size_t)(tm * 32 + r) * DFF + 8 * h; const bf16_t* bp = wdn + ((size_t)e * DM + tn * 32 + r) * DFF + 8 * h;
    f32x16 acc; for (int i = 0; i < 16; ++i) acc[i] = 0.f;
    for (int k0 = 0; k0 < DFF; k0 += 16) acc = MFMA32(*(const bf16x8*)(ap + k0), *(const bf16x8*)(bp + k0), acc);
    const float bv = bdn[(size_t)e * DM + tn * 32 + r];
#pragma unroll
    for (int i = 0; i < 16; ++i) { const int local = tm * 32 + crow(i, h) - tab[32 + e];
      if (local < tab[e]) { const u32x2 info = rinfo[(size_t)e * ECAP + local]; yp[(size_t)info.x * DM + tn * 32 + r] = f2bf((acc[i] + bv) * __uint_as_float(info.y)); } }
  }
}
#endif

DI void stagger(const Ctx& c, int ng, int step) {
  const int g = (c.bid >> 3) % ng;
  if (g && c.tid == 0) { const unsigned long long t0 = __builtin_amdgcn_s_memrealtime(), dt = (unsigned long long)(g * step); while (__builtin_amdgcn_s_memrealtime() - t0 < dt) __builtin_amdgcn_s_sleep(32); }
  __syncthreads();
}
__global__ void __launch_bounds__(512, 2) mega(Params p) {
  extern __shared__ __attribute__((aligned(16))) unsigned char lds_raw[];
  cg::grid_group grid = cg::this_grid();
  Ctx c; c.lds = (LAS unsigned char*)lds_raw; c.tid = threadIdx.x; c.lane = c.tid & 63; c.wave = __builtin_amdgcn_readfirstlane(c.tid >> 6);
  c.G = gridDim.x; c.bid = blockIdx.x; c.gw = c.bid * 8 + c.wave; c.ngw = c.G * 8; c.p = p;
  unsigned char* ws = p.ws;
  LAS int* gtab = (LAS int*)(c.lds + 131072);
#define IN(k) (p.ph_lo <= (k) && (k) < p.ph_hi)
  { volatile LAS unsigned* st = (volatile LAS unsigned*)(c.lds + 147440); if (c.tid < 4) st[c.tid] = 0u; }
  __syncthreads();
  const XcdBarrier xbar = xcd_barrier_post((unsigned*)(ws + WS_BAR) + p.pad * XCD_BAR_WORDS, (volatile LAS unsigned*)(c.lds + 147440));
#define SEAM(k) do { if ((k) + 1 < p.ph_hi) { if (USE_CG_ALL || (k) == 0) grid.sync(); else xcd_barrier(xbar); } } while (0)
#define REP(k)

  if (IN(0)) { REP(0) phase0(c);
#if GATE_I8
    xcd_barrier(xbar); phase0c(c);
#endif
    SEAM(0); }
  if (IN(1)) {
    REP(1) {
#if NAIVE_P1
    { bf16_t* proj = (bf16_t*)(ws + WS_PROJ); naive_gemm(c, (const bf16_t*)(ws + WS_XB), DM, (const bf16_t*)(ws + WS_WIN), DM, TT, NPROJ_N, DM, [&](int r, int cc, float v) { proj[(size_t)r * NPROJ + cc] = f2bf(v); }); }
    { bf16_t* mkv = (bf16_t*)(ws + WS_MKV); naive_gemm(c, (const bf16_t*)(ws + WS_MEMB), DM, (const bf16_t*)(ws + WS_WMKV), DM, NB * MEMLEN, DM, DM, [&](int r, int cc, float v) { mkv[(size_t)r * DM + cc] = f2bf(v); }); }
#else
#if MOE_I8 && !W8_BESIDE_SCAN
    phase0b(c); __syncthreads();
#endif
#if GATE_I8
    { pg8::Gemm g{(const bf16_t*)(ws + WS_XB), (const bf16_t*)(ws + WS_WIN), DM}; pg8::StaticOrder S; S.init(TT, C_GATE, c.G, c.bid); pg8::EpiStoreBf16 E{(bf16_t*)(ws + WS_PROJ), NPROJ, p.flags & 32, 1 << 30};
      pg8::gemm_phase<pg8::EpiStoreBf16, pg8::StaticOrder, true>(c.lds, g, S, E); }
    { pg8::Gemm g{(const bf16_t*)(ws + WS_XQ), (const bf16_t*)(ws + WS_WG8), DM}; pg8::StaticOrder S; S.init(TT, 3 * DM, c.G, c.bid);
      pg8::EpiGate8 E{(unsigned char*)(ws + WS_PROJ), NPROJ * 2, C_GATE * 2, (const float*)(ws + WS_TSC), (const float*)(ws + WS_WGS)};
      pg8::gemm_phase<pg8::EpiGate8, pg8::StaticOrder, true, true>(c.lds, g, S, E); }
#else
    { pg8::Gemm g{(const bf16_t*)(ws + WS_XB), (const bf16_t*)(ws + WS_WIN), DM}; pg8::StaticOrder S; S.init(TT, NPROJ_N, c.G, c.bid); pg8::EpiStoreBf16 E{(bf16_t*)(ws + WS_PROJ), NPROJ, p.flags & 32, C_GATE};
      pg8::gemm_phase<pg8::EpiStoreBf16, pg8::StaticOrder, true>(c.lds, g, S, E); }
#endif
    { pg8::Gemm g{(const bf16_t*)(ws + WS_MEMB), (const bf16_t*)(ws + WS_WMKV), DM}; pg8::StaticOrder S; S.init(NB * MEMLEN, DM, c.G, c.bid); pg8::EpiStoreBf16 E{(bf16_t*)(ws + WS_MKV), DM, 0, 1 << 30};
      pg8::gemm_phase<pg8::EpiStoreBf16, pg8::StaticOrder, true>(c.lds, g, S, E); }
#endif
    }
    SEAM(1);
  }
  if (IN(2)) {
#if NAIVE_GDN
    naive_gdn_prep(c);
#else
    phase_gdn_chunk(c);
#endif
    SEAM(2);
  }
  if (IN(3)) {
#if NAIVE_GDN
    naive_gdn_scan(c);
#endif
#if NAIVE_ATTN
    naive_sb(c); naive_mem(c);
#else
    phase_attn_scan(c);
#endif
    SEAM(3);
  }
  if (IN(4)) { phase_gdn_norm(c); SEAM(4); }
  if (IN(5)) {
#if NAIVE_P5
    naive_mixed(c);
#else
    REP(5) {
    pg8::Gemm g{(const bf16_t*)(ws + WS_YCAT), (const bf16_t*)(ws + WS_WP), 1536}; pg8::StaticOrder S; S.init(TT, DM, c.G, c.bid); pg8::EpiMixed E{(const unsigned char*)(ws + WS_PROJ), (bf16_t*)(ws + WS_MIXED)};
    pg8::gemm_phase<pg8::EpiMixed, pg8::StaticOrder, true>(c.lds, g, S, E);
    }
#endif
    SEAM(5);
  }
  if (IN(6)) {
#if NAIVE_P6
    { const float* x = p.in[I_X]; float* hh = (float*)(ws + WS_H);
      naive_gemm(c, (const bf16_t*)(ws + WS_MIXED), DM, (const bf16_t*)(ws + WS_WO), DM, TT, DM, DM, [&](int r, int cc, float v) { hh[(size_t)r * DM + cc] = DN_ALPHA * x[(size_t)r * DM + cc] + v; }); }
#else
    REP(6) {
    pg8::Gemm g{(const bf16_t*)(ws + WS_MIXED), (const bf16_t*)(ws + WS_WO), DM}; pg8::StaticOrder S; S.init(TT, DM, c.G, c.bid); pg8::EpiH E{p.in[I_X], (float*)(ws + WS_H)};
    pg8::gemm_phase<pg8::EpiH, pg8::StaticOrder, true>(c.lds, g, S, E);
    }
#endif
    SEAM(6);
  }
  if (IN(7)) { phase_router(c); SEAM(7); }
  if (IN(8)) {
    build_group_tab(c, gtab);
#if NAIVE_MOE
    naive_gateup(c, gtab);
#else
    REP(8) {
#if MOE_I8
    pg8::Gemm g{(const bf16_t*)(ws + WS_X1Q), (const bf16_t*)(ws + WS_WGU), DM}; pg8::GroupOrder S{gtab, (const u32x2*)(ws + WS_RINFO), 8, c.G, c.bid, 1};
    pg8::EpiGateUpI8 E{p.in[I_BGU], (const float*)(ws + WS_WSC), (const float*)(ws + WS_RSC), gtab, (bf16_t*)(ws + WS_ACT), (p.flags & 512) ? 1 : ((p.flags & 1024) ? 2 : 0)};
#if DIAG_P8
    if (p.flags & 512) pg8::gemm_phase<pg8::EpiGateUpI8, pg8::GroupOrder, ALIGN_MOE, true, DIAG_P8>(c.lds, g, S, E); else
#endif
    pg8::gemm_phase<pg8::EpiGateUpI8, pg8::GroupOrder, ALIGN_MOE, true>(c.lds, g, S, E);
#else
    pg8::Gemm g{(const bf16_t*)(ws + WS_X1B), (const bf16_t*)(ws + WS_WGU), DM}; pg8::GroupOrder S{gtab, (const u32x2*)(ws + WS_RINFO), 8, c.G, c.bid, 1}; pg8::EpiGateUp E{p.in[I_BGU], (bf16_t*)(ws + WS_ACT)};
    pg8::gemm_phase<pg8::EpiGateUp, pg8::GroupOrder, ALIGN_MOE>(c.lds, g, S, E);
#endif
    }
#endif
    SEAM(8);
  }
  if (IN(9)) {
    build_group_tab(c, gtab);
#if NAIVE_MOE
    naive_down(c, gtab);
#else
    REP(9) {
    pg8::Gemm g{(const bf16_t*)(ws + WS_ACT), (const bf16_t*)(ws + WS_WDN), DFF}; pg8::GroupOrder S{gtab, (const u32x2*)(ws + WS_RINFO), 4, c.G, c.bid, 0};
    pg8::EpiDown E{p.in[I_BDN], gtab, (const u32x2*)(ws + WS_RINFO), (bf16_t*)(ws + WS_YPAIR)};
    pg8::gemm_phase<pg8::EpiDown, pg8::GroupOrder, ALIGN_MOE>(c.lds, g, S, E);
    }
#endif
    SEAM(9);
  }
  if (IN(10)) { REP(10) phase_final(c); }
#undef IN
#undef SEAM
}

extern "C" void kernel_launch(void* const* d_in, const int* in_sizes, int n_in, void* d_out, int out_size, void* d_ws, size_t ws_size, hipStream_t stream) {
  static int grid_blocks = 0;
  if (grid_blocks == 0) {
    if (n_in != 22 || in_sizes[0] != TT * DM || out_size != TT * DM || ws_size < WS_NEED) {
      fprintf(stderr, "kernel_launch: built for 22 inputs, x/out of %d floats and >= %zu bytes of workspace; got n_in %d in0 %d out %d ws %zu; nothing launched\n", TT * DM, (size_t)WS_NEED, n_in, n_in > 0 ? in_sizes[0] : -1, out_size, ws_size);
      grid_blocks = -1; return; }
    int dev = 0, cus = 0, per_cu = 0;
    if (hipGetDevice(&dev) != hipSuccess || hipDeviceGetAttribute(&cus, hipDeviceAttributeMultiprocessorCount, dev) != hipSuccess) { grid_blocks = -1; return; }
    if (hipFuncSetAttribute((const void*)mega, hipFuncAttributeMaxDynamicSharedMemorySize, LDS_BYTES) != hipSuccess) { fprintf(stderr, "kernel_launch: hipFuncSetAttribute failed\n"); grid_blocks = -1; return; }
    if (hipOccupancyMaxActiveBlocksPerMultiprocessor(&per_cu, (const void*)mega, 512, LDS_BYTES) != hipSuccess || per_cu < 1) { fprintf(stderr, "kernel_launch: occupancy query says %d\n", per_cu); (void)hipGetLastError(); grid_blocks = -1; return; }
    if (cus != 256) { fprintf(stderr, "kernel_launch: the phase program is laid out for 256 CUs (one workgroup each), found %d; nothing launched\n", cus); grid_blocks = -1; return; }
    grid_blocks = cus;
    fprintf(stderr, "kernel_launch: grid %d (cus %d, per_cu %d), ws %zu\n", grid_blocks, cus, per_cu, ws_size);
  }
  if (grid_blocks < 0) return;
  if (hipMemsetAsync((char*)d_ws + WS_BAR, 0, WS_ZERO_BYTES, stream) != hipSuccess) { fprintf(stderr, "kernel_launch: memset of the barrier words failed\n"); return; }
  Params p{};
  for (int i = 0; i < 22; ++i) p.in[i] = (const float*)d_in[i];
  p.out = (float*)d_out; p.ws = (unsigned char*)d_ws;
#if MK_SPLIT
  for (int ph = 0; ph < 11; ++ph) { p.ph_lo = ph; p.ph_hi = ph + 1; void* args[] = {&p};
    hipError_t e = hipLaunchCooperativeKernel((const void*)mega, dim3(grid_blocks), dim3(512), args, LDS_BYTES, stream);
    if (e != hipSuccess) { fprintf(stderr, "kernel_launch: launch of phase %d failed: %s\n", ph, hipGetErrorString(e)); break; } }
#elif REPEAT_PH >= 0
  for (int li = 0; li < 2; ++li) { p.ph_lo = li ? REPEAT_PH + SPLIT_ONLY : 0; p.ph_hi = li ? 11 : REPEAT_PH + 1; p.flags = li ? REPEAT_FLAGS : 0; p.pad = li; void* args[] = {&p};
    hipError_t e = hipLaunchCooperativeKernel((const void*)mega, dim3(grid_blocks), dim3(512), args, LDS_BYTES, stream);
    if (e != hipSuccess) { fprintf(stderr, "kernel_launch: launch %d failed: %s\n", li, hipGetErrorString(e)); break; } }
#else
  p.ph_lo = 0; p.ph_hi = 11; void* args[] = {&p};
  hipError_t e = hipLaunchCooperativeKernel((const void*)mega, dim3(grid_blocks), dim3(512), args, LDS_BYTES, stream);
  if (e != hipSuccess) fprintf(stderr, "kernel_launch: cooperative launch failed: %s (grid %d)\n", hipGetErrorString(e), grid_blocks);
#endif
}
```
